# Optimizing an MI355X kernel written in HIP

```python
import jax, jax.numpy as jnp
from jax import lax
import numpy as np

D_MODEL = 1024
BATCH = 8
SEQ = 4096
DEPTH = 1
DEC_BATCH = 16
DEC_SEQ = 16
PAST_LEN = 2048

CHUNK = 64
D_RNN = D_MODEL
N_LRU_BLOCKS = 16
LRU_BLOCK = D_RNN // N_LRU_BLOCKS
LRU_CONV = 4
LRU_C = 8.0
D_POOL = D_MODEL
POOL_WINDOWS = (2, 4, 8, 16)
N_POOL_GROUPS = len(POOL_WINDOWS)
POOL_GROUP = D_POOL // N_POOL_GROUPS
POOL_HIST = max(POOL_WINDOWS) - 1
N_BRANCH = 2
D_IN = D_RNN + D_POOL + N_BRANCH * D_MODEL
D_FF = 3 * D_MODEL
FFN_CONV = 3
EPS = 1e-6

kernel_name = 'griffin_pool_hybrid_stream_step'


def rmsnorm(x, g):
    xf = x.astype(jnp.float32)
    y = xf * lax.rsqrt(jnp.mean(xf * xf, axis=-1, keepdims=True) + EPS)
    return (y * g.astype(jnp.float32)).astype(x.dtype)


def causal_dwconv(x, prev, w, b):
    width = w.shape[0]
    t_len = x.shape[1]
    buf = jnp.concatenate([prev.astype(x.dtype), x], axis=1)
    y = buf[:, 0:t_len] * w[0]
    for k in range(1, width):
        y = y + buf[:, k:k + t_len] * w[k]
    return y + b, buf[:, -(width - 1):]


def rg_lru(u, h0, w_a, b_a, w_x, b_x, lam):
    bsz, t_len, _ = u.shape
    ub = u.reshape(bsz, t_len, N_LRU_BLOCKS, LRU_BLOCK)
    r = jax.nn.sigmoid(jnp.einsum('btnc,ncd->btnd', ub, w_a).reshape(bsz, t_len, D_RNN) + b_a)
    i = jax.nn.sigmoid(jnp.einsum('btnc,ncd->btnd', ub, w_x).reshape(bsz, t_len, D_RNN) + b_x)
    log_a = (-LRU_C * r.astype(jnp.float32)) * jax.nn.softplus(-lam.astype(jnp.float32))
    a = jnp.exp(log_a)
    mult = jnp.sqrt(-jnp.expm1(2.0 * log_a))
    b = mult * (i * u).astype(jnp.float32)
    b = b.at[:, 0].add(a[:, 0] * h0.astype(jnp.float32))

    def combine(left, right):
        a1, b1 = left
        a2, b2 = right
        return a1 * a2, a2 * b1 + b2

    _, h = lax.associative_scan(combine, (a, b), axis=1)
    return h.astype(u.dtype), h[:, -1]


def multiscale_pool(p, prev, offset, w_pool, scale):
    bsz, t_len, _ = p.shape
    buf = jnp.concatenate([prev.astype(p.dtype), p], axis=1)
    buf_f = buf.astype(jnp.float32)
    cs = jnp.concatenate([jnp.zeros((bsz, 1, D_POOL), jnp.float32), jnp.cumsum(buf_f, axis=1)], axis=1)
    end = cs[:, POOL_HIST + 1:]
    pos = offset + jnp.arange(t_len)
    outs = []
    for g, w in enumerate(POOL_WINDOWS):
        sl = slice(g * POOL_GROUP, (g + 1) * POOL_GROUP)
        start = POOL_HIST + 1 - w
        s = end[..., sl] - cs[:, start:start + t_len, sl]
        cnt = jnp.minimum(pos + 1, w).astype(jnp.float32)[None, :, None]
        outs.append(s / cnt)
    pooled = (jnp.concatenate(outs, axis=-1) - p.astype(jnp.float32)).astype(p.dtype)
    pooled = pooled.reshape(bsz, t_len, N_POOL_GROUPS, POOL_GROUP)
    y = jnp.einsum('btgc,gcd->btgd', pooled, w_pool).reshape(bsz, t_len, D_POOL) * scale
    return y, buf[:, -POOL_HIST:]


def conv_ffn(xn, prev, w_up, w_conv, b_conv, w_down):
    h = xn @ w_up
    h, new_buf = causal_dwconv(h, prev, w_conv, b_conv)
    g, v = h[..., :D_FF], h[..., D_FF:]
    return (jax.nn.gelu(g) * v) @ w_down, new_buf


def trunk_layer(x, h0, lru_buf, pool_buf, ffn_buf, offset,
                norm_mix, w_in, conv_lru_w, conv_lru_b, w_ra, b_ra, w_ix, b_ix, lru_lambda,
                w_pool, pool_scale, w_br_lru, w_br_pool, w_out,
                norm_ffn, w_up, conv_ffn_w, conv_ffn_b, w_down):
    bsz, t_len, _ = x.shape
    xn = rmsnorm(x, norm_mix)
    z = xn @ w_in
    x_rnn = z[..., :D_RNN]
    x_pool = z[..., D_RNN:D_RNN + D_POOL]
    gate_logits = z[..., D_RNN + D_POOL:].reshape(bsz, t_len, N_BRANCH, D_MODEL)
    u, new_lru_buf = causal_dwconv(x_rnn, lru_buf, conv_lru_w, conv_lru_b)
    h, h_last = rg_lru(u, h0, w_ra, b_ra, w_ix, b_ix, lru_lambda)
    pp, new_pool_buf = multiscale_pool(x_pool, pool_buf, offset, w_pool, pool_scale)
    gates = jax.nn.sigmoid(gate_logits)
    merged = gates[:, :, 0] * (h @ w_br_lru) + gates[:, :, 1] * (pp @ w_br_pool)
    x = x + merged @ w_out
    f, new_ffn_buf = conv_ffn(rmsnorm(x, norm_ffn), ffn_buf, w_up, conv_ffn_w, conv_ffn_b, w_down)
    x = x + f
    return x, h_last, new_lru_buf, new_pool_buf, new_ffn_buf


def run_stack(x, st_h, st_lru, st_pool, st_ffn, offset, layer_w, norm_final):
    hs, lrus, pools, ffns = [], [], [], []
    for l in range(DEPTH):
        x, h_last, lb, pb, fb = trunk_layer(x, st_h[l], st_lru[l], st_pool[l], st_ffn[l], offset,
                                           *[w[l] for w in layer_w])
        hs.append(h_last)
        lrus.append(lb)
        pools.append(pb)
        ffns.append(fb)
    return (rmsnorm(x, norm_final), jnp.stack(hs), jnp.stack(lrus), jnp.stack(pools), jnp.stack(ffns))


def setup_inputs(seed: int = 0) -> dict:
    key = jax.random.key(seed)
    ks = jax.random.split(key, 32)

    def nrm(k, shape, scale):
        return jax.random.normal(k, shape, jnp.float32) * scale

    u_lam = jax.random.uniform(ks[12], (DEPTH, D_RNN), jnp.float32, 0.9, 0.999)
    return {
        'x_prompt': nrm(ks[0], (BATCH, SEQ, D_MODEL), 1.0),
        'x_sample': nrm(ks[1], (DEC_BATCH, DEC_SEQ, D_MODEL), 1.0),
        'state_lru_h': nrm(ks[2], (DEPTH, DEC_BATCH, D_RNN), 0.5),
        'state_lru_conv': nrm(ks[3], (DEPTH, DEC_BATCH, LRU_CONV - 1, D_RNN), 1.0),
        'state_pool': nrm(ks[4], (DEPTH, DEC_BATCH, POOL_HIST, D_POOL), 1.0),
        'state_ffn_conv': nrm(ks[5], (DEPTH, DEC_BATCH, FFN_CONV - 1, 2 * D_FF), 1.0),
        'norm_mix': 1.0 + nrm(ks[6], (DEPTH, D_MODEL), 0.02),
        'w_in': nrm(ks[7], (DEPTH, D_MODEL, D_IN), D_MODEL ** -0.5),
        'conv_lru_w': nrm(ks[8], (DEPTH, LRU_CONV, D_RNN), 0.5),
        'conv_lru_b': nrm(ks[9], (DEPTH, D_RNN), 0.02),
        'w_ra': nrm(ks[10], (DEPTH, N_LRU_BLOCKS, LRU_BLOCK, LRU_BLOCK), LRU_BLOCK ** -0.5),
        'b_ra': nrm(ks[11], (DEPTH, D_RNN), 0.02),
        'w_ix': nrm(ks[13], (DEPTH, N_LRU_BLOCKS, LRU_BLOCK, LRU_BLOCK), LRU_BLOCK ** -0.5),
        'b_ix': nrm(ks[14], (DEPTH, D_RNN), 0.02),
        'lru_lambda': jnp.log(u_lam) - jnp.log1p(-u_lam),
        'w_pool': nrm(ks[15], (DEPTH, N_POOL_GROUPS, POOL_GROUP, POOL_GROUP), POOL_GROUP ** -0.5),
        'pool_scale': 1.0 + nrm(ks[16], (DEPTH, D_POOL), 0.02),
        'w_br_lru': nrm(ks[17], (DEPTH, D_RNN, D_MODEL), D_RNN ** -0.5),
        'w_br_pool': nrm(ks[18], (DEPTH, D_POOL, D_MODEL), D_POOL ** -0.5),
        'w_out': nrm(ks[19], (DEPTH, D_MODEL, D_MODEL), D_MODEL ** -0.5),
        'norm_ffn': 1.0 + nrm(ks[20], (DEPTH, D_MODEL), 0.02),
        'w_up': nrm(ks[21], (DEPTH, D_MODEL, 2 * D_FF), D_MODEL ** -0.5),
        'conv_ffn_w': nrm(ks[22], (DEPTH, FFN_CONV, 2 * D_FF), 0.5),
        'conv_ffn_b': nrm(ks[23], (DEPTH, 2 * D_FF), 0.02),
        'w_down': nrm(ks[24], (DEPTH, D_FF, D_MODEL), D_FF ** -0.5),
        'norm_final': 1.0 + nrm(ks[25], (D_MODEL,), 0.02),
    }


def reference(x_prompt, x_sample, state_lru_h, state_lru_conv, state_pool, state_ffn_conv,
              norm_mix, w_in, conv_lru_w, conv_lru_b, w_ra, b_ra, w_ix, b_ix, lru_lambda,
              w_pool, pool_scale, w_br_lru, w_br_pool, w_out,
              norm_ffn, w_up, conv_ffn_w, conv_ffn_b, w_down, norm_final):
    layer_w = (norm_mix, w_in, conv_lru_w, conv_lru_b, w_ra, b_ra, w_ix, b_ix, lru_lambda,
               w_pool, pool_scale, w_br_lru, w_br_pool, w_out,
               norm_ffn, w_up, conv_ffn_w, conv_ffn_b, w_down)
    dt = x_prompt.dtype
    p_h0 = jnp.zeros((DEPTH, BATCH, D_RNN), jnp.float32)
    p_lru0 = jnp.zeros((DEPTH, BATCH, LRU_CONV - 1, D_RNN), dt)
    p_pool0 = jnp.zeros((DEPTH, BATCH, POOL_HIST, D_POOL), dt)
    p_ffn0 = jnp.zeros((DEPTH, BATCH, FFN_CONV - 1, 2 * D_FF), dt)
    y_prompt, p_h, p_lru, p_pool, p_ffn = run_stack(x_prompt, p_h0, p_lru0, p_pool0, p_ffn0, 0,
                                                    layer_w, norm_final)
    y_sample, s_h, s_lru, s_pool, s_ffn = run_stack(x_sample, state_lru_h, state_lru_conv, state_pool,
                                                    state_ffn_conv, PAST_LEN, layer_w, norm_final)
    return (y_prompt, y_sample, p_h, p_lru, p_pool, p_ffn, s_h, s_lru, s_pool, s_ffn)
```

```cpp
#include <hip/hip_runtime.h>
#include <cstdio>
#include <cstdint>
#define MK_ONE_LAUNCH 1
namespace pg8 {
#define PG8_LAS __attribute__((address_space(3)))
typedef unsigned short bf16_t;
typedef short bf16x8 __attribute__((ext_vector_type(8)));
typedef float f32x4 __attribute__((ext_vector_type(4)));
typedef unsigned u32x4 __attribute__((ext_vector_type(4)));
typedef unsigned u32x2 __attribute__((ext_vector_type(2)));
constexpr int BM = 256, BK = 64, HALF = 128, HTB = HALF * BK * 2  , STAGE_BYTES = 8 * HTB, NXCD = 8, WGM = 8;

__host__ __device__ __forceinline__ int lds_byte(int r, int c) { const int st = (r >> 4) * 2 + (c >> 5), rr = r & 15, cc = c & 31, ob = rr * 64 + cc * 2; return st * 1024 + (ob ^ (((ob >> 9) & 1) << 5)); }
__host__ __device__ __forceinline__ void stage_rc(int b, int& R, int& C) { const int st = b / 1024, sb = b % 1024, swz = sb ^ (((sb >> 9) & 1) << 5); R = (st >> 1) * 16 + swz / 64; C = (st & 1) * 32 + (swz % 64) / 2; }
__host__ __device__ __forceinline__ int perm32(int rho) { const int n = rho >> 4, i = rho & 15; return 8 * (i >> 2) + 4 * n + (i & 3); }
__host__ __device__ __forceinline__ int amap_row(int R) { return 128 * (R >> 6) + 8 * (R & 15) + ((R >> 4) & 3); }

struct Unit { int pm, pn; };
struct Gemm { const bf16_t* A; const bf16_t* Bt; int K, lda, ldb; };

struct StaticOrder {
    int nM, nN, nwg, G, c;
    __host__ __device__ void init(int M, int N, int G_, int c_) { nM = M / BM; nN = N / BM; nwg = nM * nN; G = G_; c = c_; }
    __host__ __device__ bool next(int i, Unit& u) const {
        const long L = (long)i * G + c; if (L >= nwg) return false;
        int wgid = (int)L; { const int q = nwg / NXCD, r = nwg % NXCD, xcd = wgid % NXCD, off = wgid / NXCD; wgid = (xcd < r ? xcd * (q + 1) : r * (q + 1) + (xcd - r) * q) + off; }
        const int nig = WGM * nN, gid = wgid / nig, fm = gid * WGM, gsz = (nM - fm) < WGM ? (nM - fm) : WGM;
        u.pm = fm + ((wgid % nig) % gsz); u.pn = (wgid % nig) / gsz; return true;
    }
    __device__ __forceinline__ void a_ready(const Unit&) const {}
    __device__ __forceinline__ void done(const Unit&) const {}
};
struct StripOrder {
    int pm0, pn, cnt;
    __device__ __forceinline__ bool next(int i, Unit& u) const { if (i >= cnt) return false; u.pm = pm0 + i; u.pn = pn; return true; }
    __device__ __forceinline__ void a_ready(const Unit&) const {}
    __device__ __forceinline__ void done(const Unit&) const {}
};

__device__ __forceinline__ unsigned cvt_pk_bf16(float lo, float hi) { unsigned r; asm volatile("v_cvt_pk_bf16_f32 %0, %1, %2" : "=v"(r) : "v"(lo), "v"(hi)); return r; }

template <class Epi, class Sched, bool ALIGN_EPI = false, bool SP2 = false>
__device__ __forceinline__ void gemm_phase(PG8_LAS unsigned char* lds, const Gemm g, const Sched& S, const Epi& E) {
    const int tid = threadIdx.x, wid = __builtin_amdgcn_readfirstlane(tid >> 6), lane = tid & 63, wr = wid >> 2, wc = wid & 3, fr = lane & 15, fq = lane >> 4;
    const int K = g.K, nt = K / BK;
    unsigned voffA[2], voffB[2];
#pragma unroll
    for (int i = 0; i < 2; ++i) { int R, C; stage_rc(tid * 16 + i * 8192, R, C); const int Rb = Epi::PERM ? ((R & ~31) + perm32(R & 31)) : R; const int Ra = Epi::AMAP ? amap_row(R) : R;
        voffA[i] = (unsigned)(Ra * g.lda + C) * 2u; voffB[i] = (unsigned)(Rb * g.ldb + C) * 2u; }
    const size_t kstep = (size_t)(BK * 2);
    const size_t hstepA = Epi::AMAP ? (size_t)4 * g.lda * 2 : (size_t)HALF * g.lda * 2;
    const size_t hstepB = (size_t)HALF * g.ldb * 2;
    const size_t tstepA = (size_t)BM * g.lda * 2, tstepB = (size_t)BM * g.ldb * 2;
    const unsigned ldsw = (unsigned)wid * 1024u;
    const int aoff = lds_byte(wr * 64 + fr, fq * 8), boff = lds_byte(wc * 32 + fr, fq * 8);
#define PG8_SA(b, h) (((b) * 2 + (h)) * HTB)
#define PG8_SB(b, h) ((4 + (b) * 2 + (h)) * HTB)
#define PG8_STAGE(bufoff, gbase, voff) do { _Pragma("unroll") for (int _i = 0; _i < 2; ++_i) \
        __builtin_amdgcn_global_load_lds((const unsigned*)((const char*)(gbase) + (voff)[_i]), (PG8_LAS unsigned*)(lds + (bufoff) + ldsw + _i * 8192), 16, 0, 0); } while (0)
#define PG8_LDA(dst, b, h) do { _Pragma("unroll") for (int m = 0; m < 4; ++m) _Pragma("unroll") for (int k = 0; k < 2; ++k) dst[m][k] = *(const PG8_LAS bf16x8*)(lds + PG8_SA(b, h) + aoff + m * 2048 + k * 1024); } while (0)
#define PG8_LDB(dst, b, h) do { _Pragma("unroll") for (int n = 0; n < 2; ++n) _Pragma("unroll") for (int k = 0; k < 2; ++k) dst[n][k] = *(const PG8_LAS bf16x8*)(lds + PG8_SB(b, h) + boff + n * 2048 + k * 1024); } while (0)
#define PG8_MMA(ai, bj, At, Bt) do { __builtin_amdgcn_s_setprio(1); _Pragma("unroll") for (int m = 0; m < 4; ++m) _Pragma("unroll") for (int n = 0; n < 2; ++n) _Pragma("unroll") for (int k = 0; k < 2; ++k) \
        acc[ai][bj][m][n] = __builtin_amdgcn_mfma_f32_16x16x32_bf16(Bt[n][k], At[m][k], acc[ai][bj][m][n], 0, 0, 0); __builtin_amdgcn_s_setprio(0); } while (0)
#define PG8_WAIT_V(n) asm volatile("s_waitcnt vmcnt(" #n ")" ::: "memory")
#define PG8_WAIT_L(n) asm volatile("s_waitcnt lgkmcnt(" #n ")" ::: "memory")
#define PG8_BAR __builtin_amdgcn_s_barrier()
#define PG8_SCHED __builtin_amdgcn_sched_barrier(0)
    Unit cur, nxt; int ui = 0;
    if (!S.next(0, cur)) return;
    f32x4 acc[2][2][4][2];
#pragma unroll
    for (int a = 0; a < 2; ++a)
#pragma unroll
        for (int b = 0; b < 2; ++b)
#pragma unroll
            for (int m = 0; m < 4; ++m)
#pragma unroll
                for (int n = 0; n < 2; ++n) acc[a][b][m][n] = (f32x4){0.f, 0.f, 0.f, 0.f};
    bf16x8 At[4][2], B0[2][2], B1[2][2];
    const char* cA = (const char*)g.A + (size_t)cur.pm * tstepA; const char* cB = (const char*)g.Bt + (size_t)cur.pn * tstepB;
    S.a_ready(cur);
    if constexpr (SP2) {
        PG8_STAGE(PG8_SB(0, 0), cB, voffB); PG8_STAGE(PG8_SB(0, 1), cB + hstepB, voffB); PG8_STAGE(PG8_SA(0, 0), cA, voffA); PG8_STAGE(PG8_SA(0, 1), cA + hstepA, voffA);
        if (wr == 1) PG8_BAR;
        PG8_WAIT_V(2); PG8_BAR;
        PG8_STAGE(PG8_SB(1, 0), cB + kstep, voffB); PG8_STAGE(PG8_SA(1, 0), cA + kstep, voffA); PG8_STAGE(PG8_SB(1, 1), cB + hstepB + kstep, voffB);
        PG8_WAIT_V(6); PG8_BAR;
    } else {
        PG8_STAGE(PG8_SB(0, 0), cB, voffB); PG8_STAGE(PG8_SA(0, 0), cA, voffA); PG8_STAGE(PG8_SB(0, 1), cB + hstepB, voffB); PG8_STAGE(PG8_SA(0, 1), cA + hstepA, voffA);
        if (wr == 1) PG8_BAR;
        PG8_WAIT_V(4); PG8_BAR;
        PG8_STAGE(PG8_SB(1, 0), cB + kstep, voffB); PG8_STAGE(PG8_SA(1, 0), cA + kstep, voffA); PG8_STAGE(PG8_SB(1, 1), cB + hstepB + kstep, voffB);
        PG8_WAIT_V(6); PG8_BAR;
    }
    for (;;) {
        const bool has_next = S.next(ui + 1, nxt);
        const char* nA = has_next ? (const char*)g.A + (size_t)nxt.pm * tstepA : cA; const char* nB = has_next ? (const char*)g.Bt + (size_t)nxt.pn * tstepB : cB;
        for (int t = 0; t < nt; t += 2) {
            const bool last = (t == nt - 2);
            const char* a1 = cA + (size_t)(t + 1) * kstep;
            const char* a2 = last ? nA : cA + (size_t)(t + 2) * kstep; const char* b2 = last ? nB : cB + (size_t)(t + 2) * kstep;
            const char* a3 = a2 + kstep; const char* b3 = b2 + kstep;
            if (last && has_next) S.a_ready(nxt);
            if constexpr (SP2) {
            PG8_LDB(B0, 0, 0); PG8_LDB(B1, 0, 1); PG8_SCHED; PG8_LDA(At, 0, 0); PG8_STAGE(PG8_SA(1, 1), a1 + hstepA, voffA);
            PG8_WAIT_V(8); PG8_WAIT_L(0); PG8_BAR; PG8_MMA(0, 0, At, B0); PG8_MMA(0, 1, At, B1); PG8_BAR; PG8_SCHED;
            PG8_LDA(At, 0, 1); PG8_STAGE(PG8_SB(0, 0), b2, voffB); PG8_STAGE(PG8_SB(0, 1), b2 + hstepB, voffB); PG8_STAGE(PG8_SA(0, 0), a2, voffA);
            PG8_WAIT_V(8); PG8_WAIT_L(0); PG8_BAR; PG8_MMA(1, 0, At, B0); PG8_MMA(1, 1, At, B1); PG8_BAR; PG8_SCHED;
            PG8_LDB(B0, 1, 0); PG8_LDB(B1, 1, 1); PG8_SCHED; PG8_LDA(At, 1, 0); PG8_STAGE(PG8_SA(0, 1), a2 + hstepA, voffA);
            PG8_WAIT_V(8); PG8_WAIT_L(0); PG8_BAR; PG8_MMA(0, 0, At, B0); PG8_MMA(0, 1, At, B1); PG8_BAR; PG8_SCHED;
            PG8_LDA(At, 1, 1); PG8_STAGE(PG8_SB(1, 0), b3, voffB); PG8_STAGE(PG8_SB(1, 1), b3 + hstepB, voffB); PG8_STAGE(PG8_SA(1, 0), a3, voffA);
            PG8_WAIT_V(8); PG8_WAIT_L(0); PG8_BAR; PG8_MMA(1, 0, At, B0); PG8_MMA(1, 1, At, B1); PG8_BAR; PG8_SCHED;
            } else {
            PG8_LDB(B0, 0, 0); PG8_SCHED; PG8_LDA(At, 0, 0); PG8_STAGE(PG8_SA(1, 1), a1 + hstepA, voffA);
            PG8_WAIT_L(8); PG8_BAR; PG8_WAIT_L(0); PG8_MMA(0, 0, At, B0); PG8_BAR; PG8_SCHED;
            PG8_LDB(B1, 0, 1); PG8_STAGE(PG8_SB(0, 0), b2, voffB);
            PG8_BAR; PG8_WAIT_L(0); PG8_MMA(0, 1, At, B1); PG8_BAR;
            PG8_LDA(At, 0, 1); PG8_STAGE(PG8_SA(0, 0), a2, voffA);
            PG8_BAR; PG8_WAIT_L(0); PG8_MMA(1, 0, At, B0); PG8_BAR; PG8_SCHED;
            PG8_STAGE(PG8_SB(0, 1), b2 + hstepB, voffB);
            PG8_WAIT_V(6); PG8_BAR; PG8_MMA(1, 1, At, B1); PG8_BAR;
            PG8_LDB(B0, 1, 0); PG8_SCHED; PG8_LDA(At, 1, 0); PG8_STAGE(PG8_SA(0, 1), a2 + hstepA, voffA);
            PG8_WAIT_L(8); PG8_BAR; PG8_WAIT_L(0); PG8_MMA(0, 0, At, B0); PG8_BAR; PG8_SCHED;
            PG8_LDB(B1, 1, 1); PG8_STAGE(PG8_SB(1, 0), b3, voffB);
            PG8_BAR; PG8_WAIT_L(0); PG8_MMA(0, 1, At, B1); PG8_BAR;
            PG8_LDA(At, 1, 1); PG8_STAGE(PG8_SA(1, 0), a3, voffA);
            PG8_BAR; PG8_WAIT_L(0); PG8_MMA(1, 0, At, B0); PG8_BAR; PG8_SCHED;
            PG8_STAGE(PG8_SB(1, 1), b3 + hstepB, voffB);
            PG8_WAIT_V(6); PG8_BAR; PG8_MMA(1, 1, At, B1); PG8_BAR;
            }
        }
        if constexpr (ALIGN_EPI) { if (wr == 0) PG8_BAR; }
        E(acc, cur, wr, wc, fr, fq); S.done(cur);
        if (!has_next) break;
#pragma unroll
        for (int a = 0; a < 2; ++a)
#pragma unroll
            for (int b = 0; b < 2; ++b)
#pragma unroll
                for (int m = 0; m < 4; ++m)
#pragma unroll
                    for (int n = 0; n < 2; ++n) acc[a][b][m][n] = (f32x4){0.f, 0.f, 0.f, 0.f};
        cur = nxt; cA = nA; cB = nB; ++ui;
        if constexpr (ALIGN_EPI) { if (wr == 1) PG8_BAR; }
    }
    PG8_WAIT_V(0);
    if constexpr (!ALIGN_EPI) { if (wr == 0) PG8_BAR; }
    PG8_BAR;
#undef PG8_SA
#undef PG8_SB
#undef PG8_STAGE
#undef PG8_LDA
#undef PG8_LDB
#undef PG8_MMA
#undef PG8_WAIT_V
#undef PG8_WAIT_L
#undef PG8_BAR
#undef PG8_SCHED
}
}
constexpr int NWAVES = 8;
constexpr int DM = 1024, NBATCH = 8, SEQ = 4096, SBATCH = 16, SSEQ = 16, PAST = 2048;
constexpr int MP = NBATCH * SEQ, MS = SBATCH * SSEQ, M = MP + MS, NTILE = M / 256, STILE = MP / 256;
constexpr int DIN = 4096, DFF = 3072, DUP = 6144;
constexpr float EPS = 1e-6f;
constexpr size_t OFF_Y = 0, OFF_HP = (size_t)M * DM, OFF_LCP = OFF_HP + NBATCH * DM, OFF_PLP = OFF_LCP + NBATCH * 3 * DM, OFF_FCP = OFF_PLP + NBATCH * 15 * DM,
                 OFF_HS = OFF_FCP + NBATCH * 2 * DUP, OFF_LCS = OFF_HS + SBATCH * DM, OFF_PLS = OFF_LCS + SBATCH * 3 * DM, OFF_FCS = OFF_PLS + SBATCH * 15 * DM,
                 OUT_TOTAL = OFF_FCS + SBATCH * 2 * DUP;
constexpr size_t MiB = 1u << 20;
constexpr size_t WS_CTL = 0, CTL_ZERO_BYTES = 64 * 1024;
constexpr size_t WS_WIN = 1 * MiB, WS_WCAT = 9 * MiB, WS_WOUT = 13 * MiB, WS_WUP = 15 * MiB, WS_WDN = 27 * MiB, WS_WG = 33 * MiB;
constexpr size_t WS_SUMM = 34 * MiB, WS_SSQ = 36 * MiB, WS_SSQ2 = 39 * MiB;
constexpr size_t WS_R0 = 42 * MiB, WS_R1 = 107 * MiB, WS_R2 = 236 * MiB, WS_R3 = 365 * MiB, WS_END = 494 * MiB;
static_assert((size_t)M * DM * 2 <= WS_R1 - WS_R0 && (size_t)M * 2048 * 2 <= WS_R2 - WS_R1 && (size_t)M * 2048 * 2 <= WS_R3 - WS_R2 && (size_t)M * 2048 * 2 <= WS_END - WS_R3 && (size_t)M * DFF * 2 <= WS_END - WS_R2, "ws map");
constexpr int CW_BAR = 1024;
constexpr int RING_BYTES = 131072;
constexpr int MISC_OFF = RING_BYTES, RS_OFF = RING_BYTES + 512, EDGE_START_OFF = RS_OFF + 4096, EDGE_MID_OFF = EDGE_START_OFF + 2048, EDGE_PREV_OFF = EDGE_MID_OFF + 2048;
constexpr int LDS_BYTES = 147456;
static_assert(EDGE_PREV_OFF + 2048 <= LDS_BYTES, "LDS map");

#define GAS __attribute__((address_space(1)))
#define LAS __attribute__((address_space(3)))
typedef unsigned short bf16;
typedef unsigned v4u __attribute__((ext_vector_type(4)));
typedef unsigned v2u __attribute__((ext_vector_type(2)));
typedef float f32x4 __attribute__((ext_vector_type(4)));
typedef short bf16x8 __attribute__((ext_vector_type(8)));
#define LDS_WAIT() asm volatile("s_waitcnt lgkmcnt(0)" ::: "memory")
#define VM_WAIT() asm volatile("s_waitcnt vmcnt(0)" ::: "memory")
__device__ __forceinline__ unsigned f2bf(float f) { unsigned u = __builtin_bit_cast(unsigned, f); return (u + 0x7fffu + ((u >> 16) & 1u)) >> 16; }
__device__ __forceinline__ unsigned pk2(float lo, float hi) { return f2bf(lo) | (f2bf(hi) << 16); }
__device__ __forceinline__ float bflo(unsigned w) { return __builtin_bit_cast(float, w << 16); }
__device__ __forceinline__ float bfhi(unsigned w) { return __builtin_bit_cast(float, w & 0xffff0000u); }
__device__ __forceinline__ float sigmoidf_fast(float x) { return __builtin_amdgcn_rcpf(1.0f + __builtin_amdgcn_exp2f(-1.4426950408889634f * x)); }
__device__ __forceinline__ float gelu_tanh(float g) { const float z = g * (1.0f + 0.044715f * g * g); return g * __builtin_amdgcn_rcpf(1.0f + __builtin_amdgcn_exp2f(-2.302208198f * z)); }
__device__ __forceinline__ float wave_sum(float v) {
#pragma unroll
    for (int o = 1; o < 64; o <<= 1) v += __shfl_xor(v, o);
    return v;
}

#define XB_TMO      128
#define XB_XCNT(j)  (256  + 64 * (j))
#define XB_XSUB(j)  (1280 + 64 * (j))
#define XB_XGEN(j)  (2304 + 64 * (j))
#define XB_TOP      3328
#define XB_TOPGEN   3392
#define XCD_BAR_WORDS 3456
#define XB_SPIN_CAP (1u << 20)
static_assert((CW_BAR + XCD_BAR_WORDS) * 4 <= (int)CTL_ZERO_BYTES, "barrier words inside the memset region");
__device__ __forceinline__ unsigned xb_ld(unsigned* p)              { return __hip_atomic_load(p, __ATOMIC_RELAXED, __HIP_MEMORY_SCOPE_AGENT); }
__device__ __forceinline__ unsigned xb_add(unsigned* p, unsigned v) { return __hip_atomic_fetch_add(p, v, __ATOMIC_RELAXED, __HIP_MEMORY_SCOPE_AGENT); }
__device__ __forceinline__ unsigned xb_xcc_id() { return (unsigned)__builtin_amdgcn_s_getreg((3 << 11) | 20) & 0xFu; }
#define XB_SPIN(cond, bar) do { unsigned _sp = 0; while (cond) { __builtin_amdgcn_s_sleep(1); \
    if ((++_sp & 255u) == 0u) { if (xb_ld(&(bar)[XB_TMO])) break; if (_sp > XB_SPIN_CAP) { atomicAdd(&(bar)[XB_TMO], 1u); break; } } } } while (0)
struct XcdBarrier { unsigned* bar; unsigned x; volatile LAS unsigned* st; };
__device__ __forceinline__ XcdBarrier xcd_barrier_post(unsigned* bar, volatile LAS unsigned* st) {
    XcdBarrier b; b.bar = bar; b.x = xb_xcc_id(); b.st = st;
    if (threadIdx.x == 0) (void)xb_add(&bar[XB_XCNT(b.x)], 1u);
    return b;
}
__device__ __forceinline__ void xcd_barrier_complete(unsigned* bar, unsigned x, unsigned& nloc, unsigned& nx) {
    const unsigned G = gridDim.x * gridDim.y * gridDim.z;
    unsigned sum, cnt, mine, sp = 0u;
    for (;;) {
        sum = 0u; cnt = 0u; mine = 0u;
#pragma unroll
        for (unsigned j = 0; j < 16; ++j) { const unsigned c = xb_ld(&bar[XB_XCNT(j)]); sum += c; cnt += (c > 0u) ? 1u : 0u; mine = (j == x) ? c : mine; }
        if (sum == G) break;
        __builtin_amdgcn_s_sleep(1);
        if ((++sp & 255u) == 0u) { if (xb_ld(&bar[XB_TMO])) break; if (sp > XB_SPIN_CAP) { atomicAdd(&bar[XB_TMO], 1u); break; } }
    }
    nloc = mine > 0u ? mine : 1u; nx = cnt > 0u ? cnt : 1u;
}
__device__ __forceinline__ void xcd_barrier(const XcdBarrier& b) {
    asm volatile("s_waitcnt vmcnt(0)" ::: "memory");
    __syncthreads();
    if (threadIdx.x == 0) {
        unsigned* bar = b.bar;
        __builtin_amdgcn_s_waitcnt(0);
        unsigned nloc = b.st[0], nx = b.st[1];
        if (nloc == 0u) { xcd_barrier_complete(bar, b.x, nloc, nx); b.st[0] = nloc; b.st[1] = nx; }
        const unsigned old = xb_add(&bar[XB_XSUB(b.x)], 1u);
        const unsigned gen = old / nloc;
        if (old + 1u == (gen + 1u) * nloc) {
            __builtin_amdgcn_fence(__ATOMIC_RELEASE, "agent");
            asm volatile("s_waitcnt vmcnt(0)" ::: "memory");
            const unsigned og = xb_add(&bar[XB_TOP], 1u);
            const unsigned tg = og / nx;
            if (og + 1u == (tg + 1u) * nx) xb_add(&bar[XB_TOPGEN], 1u);
            else XB_SPIN(xb_ld(&bar[XB_TOPGEN]) == tg, bar);
            __builtin_amdgcn_fence(__ATOMIC_ACQUIRE, "agent");
            xb_add(&bar[XB_XGEN(b.x)], 1u);
            asm volatile("s_waitcnt vmcnt(0)" ::: "memory");
        } else {
            XB_SPIN(xb_ld(&bar[XB_XGEN(b.x)]) == gen, bar);
            __builtin_amdgcn_fence(__ATOMIC_ACQUIRE, "agent");
            asm volatile("s_waitcnt vmcnt(0)" ::: "memory");
        }
    }
    __syncthreads();
}

struct KP {
    const float* in[26];
    float* out; unsigned char* ws;
    int ph_lo, ph_hi;
};
enum { I_XP = 0, I_XS, I_STH, I_STLC, I_STPOOL, I_STFFN, I_NMIX, I_WIN, I_CLW, I_CLB, I_WRA, I_BRA, I_WIX, I_BIX, I_LAM, I_WPOOL, I_PSCALE, I_WBRL, I_WBRP, I_WOUT, I_NFFN, I_WUP, I_CFW, I_CFB, I_WDN, I_NFIN };

using pg8::Unit;
struct EpiZ {
    static constexpr bool PERM = true, AMAP = false;
    bf16* ZR; bf16* G;
    __device__ __forceinline__ void operator()(const f32x4 (&acc)[2][2][4][2], const Unit& u, int wr, int wc, int fr, int fq) const {
        const int row0 = u.pm * 256 + wr * 64 + fr; const bool gate = u.pn >= 8;
        bf16* base = gate ? G : ZR; const int col0 = (u.pn & 7) * 256 + wc * 32 + 8 * fq;
#pragma unroll
        for (int ai = 0; ai < 2; ++ai)
#pragma unroll
            for (int m = 0; m < 4; ++m) { bf16* rowp = base + (size_t)(row0 + ai * 128 + m * 16) * 2048 + col0;
#pragma unroll
                for (int bj = 0; bj < 2; ++bj) { f32x4 v0 = acc[ai][bj][m][0], v1 = acc[ai][bj][m][1];
                    if (gate) {
#pragma unroll
                        for (int j = 0; j < 4; ++j) { v0[j] = sigmoidf_fast(v0[j]); v1[j] = sigmoidf_fast(v1[j]); } }
                    v4u w; w.x = pg8::cvt_pk_bf16(v0[0], v0[1]); w.y = pg8::cvt_pk_bf16(v0[2], v0[3]); w.z = pg8::cvt_pk_bf16(v1[0], v1[1]); w.w = pg8::cvt_pk_bf16(v1[2], v1[3]);
                    *(v4u*)(rowp + bj * 128) = w; } }
    }
};
template <bool SECOND> struct EpiBr {
    static constexpr bool PERM = true, AMAP = false;
    const bf16* G; float* T; bf16* MG;
    __device__ __forceinline__ void operator()(const f32x4 (&acc)[2][2][4][2], const Unit& u, int wr, int wc, int fr, int fq) const {
        const int row0 = u.pm * 256 + wr * 64 + fr, col0 = u.pn * 256 + wc * 32 + 8 * fq;
#pragma unroll
        for (int ai = 0; ai < 2; ++ai)
#pragma unroll
            for (int m = 0; m < 4; ++m) { const size_t row = (size_t)(row0 + ai * 128 + m * 16);
#pragma unroll
                for (int bj = 0; bj < 2; ++bj) { const int col = col0 + bj * 128;
                    const v4u gw = *(const v4u*)(G + row * 2048 + (SECOND ? 1024 : 0) + col);
                    f32x4 g0 = {bflo(gw.x), bfhi(gw.x), bflo(gw.y), bfhi(gw.y)}, g1 = {bflo(gw.z), bfhi(gw.z), bflo(gw.w), bfhi(gw.w)};
                    f32x4 v0 = acc[ai][bj][m][0] * g0, v1 = acc[ai][bj][m][1] * g1;
                    float* tp = T + row * 1024 + col;
                    if (!SECOND) { *(f32x4*)tp = v0; *(f32x4*)(tp + 4) = v1; }
                    else { v0 += *(const f32x4*)tp; v1 += *(const f32x4*)(tp + 4);
                        v4u w; w.x = pg8::cvt_pk_bf16(v0[0], v0[1]); w.y = pg8::cvt_pk_bf16(v0[2], v0[3]); w.z = pg8::cvt_pk_bf16(v1[0], v1[1]); w.w = pg8::cvt_pk_bf16(v1[2], v1[3]);
                        *(v4u*)(MG + row * 1024 + col) = w; } } }
    }
};
template <bool DOWN> struct EpiRes {
    static constexpr bool PERM = true, AMAP = false;
    const float* xp; const float* xs; float* Y; bf16* XG2; const float* g2; float* SSQ;
    __device__ __forceinline__ void operator()(const f32x4 (&acc)[2][2][4][2], const Unit& u, int wr, int wc, int fr, int fq) const {
        const int row0 = u.pm * 256 + wr * 64 + fr, col0 = u.pn * 256 + wc * 32 + 8 * fq;
        const float* xb = DOWN ? (const float*)Y : (u.pm < STILE ? xp : xs - (size_t)MP * DM);
        f32x4 gg[2][2];
        if (!DOWN) {
#pragma unroll
            for (int bj = 0; bj < 2; ++bj) { gg[bj][0] = *(const f32x4*)(g2 + col0 + bj * 128); gg[bj][1] = *(const f32x4*)(g2 + col0 + bj * 128 + 4); } }
#pragma unroll
        for (int ai = 0; ai < 2; ++ai)
#pragma unroll
            for (int m = 0; m < 4; ++m) { const size_t row = (size_t)(row0 + ai * 128 + m * 16); float s = 0.f;
#pragma unroll
                for (int bj = 0; bj < 2; ++bj) { const size_t off = row * 1024 + col0 + bj * 128;
                    f32x4 v0 = acc[ai][bj][m][0] + *(const f32x4*)(xb + off), v1 = acc[ai][bj][m][1] + *(const f32x4*)(xb + off + 4);
                    *(f32x4*)(Y + off) = v0; *(f32x4*)(Y + off + 4) = v1;
                    s += (v0[0] * v0[0] + v0[1] * v0[1]) + (v0[2] * v0[2] + v0[3] * v0[3]) + (v1[0] * v1[0] + v1[1] * v1[1]) + (v1[2] * v1[2] + v1[3] * v1[3]);
                    if (!DOWN) { v0 *= gg[bj][0]; v1 *= gg[bj][1];
                        v4u w; w.x = pg8::cvt_pk_bf16(v0[0], v0[1]); w.y = pg8::cvt_pk_bf16(v0[2], v0[3]); w.z = pg8::cvt_pk_bf16(v1[0], v1[1]); w.w = pg8::cvt_pk_bf16(v1[2], v1[3]);
                        *(v4u*)(XG2 + off) = w; } }
                s += __shfl_xor(s, 16); s += __shfl_xor(s, 32);
                if (fq == 0) SSQ[row * 16 + u.pn * 4 + wc] = s; }
    }
};
struct EpiUp {
    static constexpr bool PERM = true, AMAP = true;
    bf16* ACT; const float* cw; const float* cb; const float* stf; float* ofp; float* ofs; LAS unsigned char* lx; int pm0;
    __device__ __forceinline__ void operator()(const f32x4 (&acc)[2][2][4][2], const Unit& u, int wr, int wc, int fr, int fq) const {
        int pm_ = u.pm, pn_ = u.pn, fr_ = fr, fq_ = fq; asm volatile("" : "+s"(pm_), "+s"(pn_), "+v"(fr_), "+v"(fq_));
        const bool samp = (pm_ == STILE); const int j = pm_ - pm0;
        const LAS float* RS = (const LAS float*)(lx + RS_OFF) + j * 256 + 128 * wr + 8 * fr_;
        const f32x4 rsa = *(const LAS f32x4*)RS, rsb = *(const LAS f32x4*)(RS + 4);
        const float rs[8] = {rsa[0], rsa[1], rsa[2], rsa[3], rsb[0], rsb[1], rsb[2], rsb[3]};
        const int cbase = 32 * wc + 8 * fq_, gcol = 128 * pn_ + cbase;
        const LAS float* Ein = (const LAS float*)(lx + (wr == 0 ? (j == 0 ? EDGE_START_OFF : EDGE_PREV_OFF) : EDGE_MID_OFF));
        LAS float* Eout = (LAS float*)(lx + (wr == 0 ? EDGE_MID_OFF : EDGE_PREV_OFF));
        const int seq = samp ? (8 * wr + (fr_ >> 1)) : (pm_ >> 4);
        const bool lastp = (!samp) && ((pm_ & 15) == 15) && wr == 1 && fr_ == 15;
        bf16* ap = ACT + (size_t)(pm_ * 256 + 128 * wr + 8 * fr_) * DFF + gcol;
#pragma unroll
        for (int n = 0; n < 2; ++n) {
            f32x4 gc[8];
#pragma unroll
            for (int bj = 0; bj < 2; ++bj) {
                __builtin_amdgcn_sched_barrier(0);
                const int cc = bj * 128 + cbase + 4 * n, oc = bj * DFF + gcol + 4 * n;
                const f32x4 w0 = *(const f32x4*)(cw + oc), w1 = *(const f32x4*)(cw + DUP + oc), w2 = *(const f32x4*)(cw + 2 * DUP + oc), bb = *(const f32x4*)(cb + oc);
                f32x4 h[8];
#pragma unroll
                for (int q = 0; q < 8; ++q) h[q] = acc[q >> 2][bj][q & 3][n] * rs[q];
                f32x4 hm1, hm2;
#pragma unroll
                for (int e = 0; e < 4; ++e) { hm1[e] = __shfl_up(h[7][e], 1, 16); hm2[e] = __shfl_up(h[6][e], 1, 16); }
                if (!samp) {
                    if (fr_ == 0) { hm2 = *(const LAS f32x4*)(Ein + cc); hm1 = *(const LAS f32x4*)(Ein + 256 + cc); }
                    if (fr_ == 15) { *(LAS f32x4*)(Eout + cc) = h[6]; *(LAS f32x4*)(Eout + 256 + cc) = h[7]; }
                    if (lastp) { *(f32x4*)(ofp + (size_t)(seq * 2 + 0) * DUP + oc) = h[6]; *(f32x4*)(ofp + (size_t)(seq * 2 + 1) * DUP + oc) = h[7]; }
                } else {
                    if (!(fr_ & 1)) { hm2 = *(const f32x4*)(stf + (size_t)(seq * 2 + 0) * DUP + oc); hm1 = *(const f32x4*)(stf + (size_t)(seq * 2 + 1) * DUP + oc); }
                    else { *(f32x4*)(ofs + (size_t)(seq * 2 + 0) * DUP + oc) = h[6]; *(f32x4*)(ofs + (size_t)(seq * 2 + 1) * DUP + oc) = h[7]; }
                }
#pragma unroll
                for (int q = 0; q < 8; ++q) {
                    const f32x4 a2 = (q >= 2) ? h[q >= 2 ? q - 2 : 0] : (q == 1 ? hm1 : hm2);
                    const f32x4 a1 = (q >= 1) ? h[q >= 1 ? q - 1 : 0] : hm1;
                    const f32x4 c = bb + w0 * a2 + w1 * a1 + w2 * h[q];
                    if (bj == 0) gc[q] = c;
                    else { f32x4 a;
#pragma unroll
                        for (int e = 0; e < 4; ++e) a[e] = gelu_tanh(gc[q][e]) * c[e];
                        v2u w; w.x = pg8::cvt_pk_bf16(a[0], a[1]); w.y = pg8::cvt_pk_bf16(a[2], a[3]);
                        *(v2u*)(ap + (size_t)q * DFF + 4 * n) = w; }
                }
            }
        }
        LDS_WAIT();
    }
};
template <class RowMap>
__device__ __forceinline__ void p0_transpose_item(const float* W, int ldw, int k0, int n0, bf16* WT, size_t ldt, int kcol0, RowMap drow, const float* kscale, LAS float* scr, int lane) {
#pragma unroll 8
    for (int i = 0; i < 32; ++i) { const int kk = 2 * i + (lane >> 5); float v = W[(size_t)(k0 + kk) * ldw + n0 + (lane & 31)]; if (kscale) v *= kscale[k0 + kk]; scr[kk * 33 + (lane & 31)] = v; }
    LDS_WAIT(); asm volatile("" ::: "memory");
    const int c = lane & 7;
#pragma unroll
    for (int j = 0; j < 4; ++j) { const int n = (lane >> 3) + 8 * j; const LAS float* s = scr + (8 * c) * 33 + n;
        v4u o; o.x = pk2(s[0 * 33], s[1 * 33]); o.y = pk2(s[2 * 33], s[3 * 33]); o.z = pk2(s[4 * 33], s[5 * 33]); o.w = pk2(s[6 * 33], s[7 * 33]);
        *(v4u*)(WT + (size_t)drow(n0 + n) * ldt + kcol0 + k0 + 8 * c) = o; }
    LDS_WAIT(); asm volatile("" ::: "memory");
}
struct RowId { __device__ __forceinline__ int operator()(int n) const { return n; } };
struct RowUp { __device__ __forceinline__ int operator()(int n) const { const int half = n >= DFF ? 1 : 0, c = n - half * DFF; return (c >> 7) * 256 + half * 128 + (c & 127); } };

__device__ __forceinline__ void p0_prologue(const KP& p, LAS unsigned char* lds, int vcu, int G, int wave, int lane) {
    LAS float* scr = (LAS float*)(lds + wave * 16384);
    const int gw = vcu * NWAVES + wave, NGW = G * NWAVES;
    unsigned char* ws = p.ws;
    bf16* Win_t = (bf16*)(ws + WS_WIN); bf16* Wcat_t = (bf16*)(ws + WS_WCAT); bf16* Wout_t = (bf16*)(ws + WS_WOUT); bf16* Wup_t = (bf16*)(ws + WS_WUP); bf16* Wdn_t = (bf16*)(ws + WS_WDN); bf16* Wg_t = (bf16*)(ws + WS_WG);
    constexpr int I_IN = (DM / 64) * (DIN / 32), I_UP = (DM / 64) * (DUP / 32), I_SQ = (DM / 64) * (DM / 32), I_DN = (DFF / 64) * (DM / 32), I_G = 32 * 2;
    constexpr int NITEMS = I_IN + I_UP + 2 * I_SQ + I_DN + I_G;
    for (int it = gw; it < NITEMS; it += NGW) {
        int r = it;
        if (r < I_IN) { const int nblk = DIN / 32; p0_transpose_item(p.in[I_WIN], DIN, 64 * (r / nblk), 32 * (r % nblk), Win_t, DM, 0, RowId(), nullptr, scr, lane); continue; } r -= I_IN;
        if (r < I_UP) { const int nblk = DUP / 32; p0_transpose_item(p.in[I_WUP], DUP, 64 * (r / nblk), 32 * (r % nblk), Wup_t, DM, 0, RowUp(), nullptr, scr, lane); continue; } r -= I_UP;
        if (r < I_SQ) { const int nblk = DM / 32; p0_transpose_item(p.in[I_WBRL], DM, 64 * (r / nblk), 32 * (r % nblk), Wcat_t, 2048, 0, RowId(), nullptr, scr, lane); continue; } r -= I_SQ;
        if (r < I_SQ) { const int nblk = DM / 32; p0_transpose_item(p.in[I_WOUT], DM, 64 * (r / nblk), 32 * (r % nblk), Wout_t, DM, 0, RowId(), nullptr, scr, lane); continue; } r -= I_SQ;
        if (r < I_DN) { const int nblk = DM / 32; p0_transpose_item(p.in[I_WDN], DM, 64 * (r / nblk), 32 * (r % nblk), Wdn_t, DFF, 0, RowId(), nullptr, scr, lane); continue; } r -= I_DN;
        { const int mat = r >> 1, nb = r & 1; const float* W = (mat < 16 ? p.in[I_WRA] : p.in[I_WIX]) + (size_t)(mat & 15) * 4096;
          p0_transpose_item(W, 64, 0, 32 * nb, Wg_t + (size_t)mat * 4096, 64, 0, RowId(), nullptr, scr, lane); }
    }
    {
        const float* wpool = p.in[I_WPOOL]; const float* psc = p.in[I_PSCALE]; const float* wbp = p.in[I_WBRP];
        for (int it = gw; it < 4 * 32 * 16; it += NGW) {
            const int g = it >> 9, kc = (it >> 4) & 31, nc = it & 15; const int nn = nc * 64 + lane;
            float a[8];
#pragma unroll
            for (int i = 0; i < 8; ++i) a[i] = 0.f;
            const float* wp = wpool + (size_t)(g * 256 + kc * 8) * 256;
            for (int j = 0; j < 256; j += 4) {
                float b[4];
#pragma unroll
                for (int jj = 0; jj < 4; ++jj) b[jj] = wbp[(size_t)(256 * g + j + jj) * DM + nn] * psc[256 * g + j + jj];
#pragma unroll
                for (int i = 0; i < 8; ++i) { const f32x4 w = *(const f32x4*)(wp + i * 256 + j); a[i] += w[0] * b[0] + w[1] * b[1] + w[2] * b[2] + w[3] * b[3]; }
            }
            v4u o; o.x = pk2(a[0], a[1]); o.y = pk2(a[2], a[3]); o.z = pk2(a[4], a[5]); o.w = pk2(a[6], a[7]);
            *(v4u*)(Wcat_t + (size_t)nn * 2048 + 1024 + 256 * g + kc * 8) = o;
        }
    }
    {
        bf16* XN = (bf16*)(ws + WS_R0); const float* g1 = p.in[I_NMIX];
        f32x4 gv[4];
#pragma unroll
        for (int j = 0; j < 4; ++j) gv[j] = *((const f32x4*)g1 + lane + 64 * j);
        for (int m = gw; m < M; m += NGW) {
            const float* xrow = m < MP ? p.in[I_XP] + (size_t)m * DM : p.in[I_XS] + (size_t)(m - MP) * DM;
            const f32x4* xr = (const f32x4*)xrow + lane; f32x4 v[4]; float s = 0.f;
#pragma unroll
            for (int j = 0; j < 4; ++j) { v[j] = xr[64 * j]; s += (v[j][0] * v[j][0] + v[j][1] * v[j][1]) + (v[j][2] * v[j][2] + v[j][3] * v[j][3]); }
            const float rstd = 1.0f / sqrtf(wave_sum(s) * (1.f / DM) + EPS);
            v2u* o8 = (v2u*)(XN + (size_t)m * DM) + lane;
#pragma unroll
            for (int j = 0; j < 4; ++j) { const f32x4 y = v[j] * rstd * gv[j]; v2u o; o.x = pk2(y[0], y[1]); o.y = pk2(y[2], y[3]); o8[64 * j] = o; }
        }
    }
}

constexpr int XR_OFF = 0, XR_BYTES = 16 * 19 * 128, SEG_OFF = 40960, CIN_OFF = 45056;
template <bool FINAL>
__device__ __forceinline__ void lru_unit(const KP& p, LAS unsigned char* lds, int pm, int n, int tid, int lane, int wave) {
    const bool samp = (pm == STILE);
    if (samp && !FINAL) return;
    const bf16* ZR = (const bf16*)(p.ws + WS_R1); const bf16* Wg_t = (const bf16*)(p.ws + WS_WG);
    typedef float f32x2v __attribute__((ext_vector_type(2)));
    f32x2v* SUMM = (f32x2v*)(p.ws + WS_SUMM);
    bf16* HP = (bf16*)(p.ws + WS_R3);
    LAS unsigned char* XR = lds + XR_OFF; LAS f32x2v* SEG = (LAS f32x2v*)(lds + SEG_OFF); LAS float* CIN = (LAS float*)(lds + CIN_OFF);
    const int t0 = samp ? 0 : 256 * (pm & 15);
    __syncthreads();
    for (int idx = tid; idx < 304 * 8; idx += NWAVES * 64) {
        const int row = idx >> 3, ck = idx & 7, g = row / 19, k = row - g * 19, tt = 16 * g + k - 3;
        v4u v = {0u, 0u, 0u, 0u};
        if (!samp) { if (t0 + tt >= 0) v = *(const v4u*)(ZR + (size_t)(pm * 256 + tt) * 2048 + n * 64 + ck * 8); }
        else if (k < 3) { const float* s = p.in[I_STLC] + (size_t)(g * 3 + k) * DM + n * 64 + ck * 8; const f32x4 a = *(const f32x4*)s, b = *(const f32x4*)(s + 4);
            v.x = pk2(a[0], a[1]); v.y = pk2(a[2], a[3]); v.z = pk2(b[0], b[1]); v.w = pk2(b[2], b[3]); }
        else v = *(const v4u*)(ZR + (size_t)(MP + 16 * g + k - 3) * 2048 + n * 64 + ck * 8);
        *(LAS v4u*)(XR + row * 128 + ck * 16) = v;
    }
    if (FINAL && !samp && tid < 64) {
        const int npre = pm & 15; f32x2v sv[15];
#pragma unroll
        for (int k = 0; k < 15; ++k) sv[k] = (k < npre) ? SUMM[(size_t)(pm - npre + k) * DM + n * 64 + tid] : (f32x2v){1.f, 0.f};
        float c = 0.f;
#pragma unroll
        for (int k = 0; k < 15; ++k) c = sv[k].y + sv[k].x * c;
        CIN[tid] = c;
    }
    __syncthreads();
    const int i16 = lane & 15, fq = lane >> 4;
    const float* cwl = p.in[I_CLW]; const float* cbl = p.in[I_CLB];
    bf16x8 fa[2][2];
#pragma unroll
    for (int ks = 0; ks < 2; ++ks) {
        const int ch0 = 32 * ks + 8 * fq; f32x4 w[4][2], bb[2];
#pragma unroll
        for (int tp = 0; tp < 4; ++tp) { w[tp][0] = *(const f32x4*)(cwl + tp * DM + n * 64 + ch0); w[tp][1] = *(const f32x4*)(cwl + tp * DM + n * 64 + ch0 + 4); }
        bb[0] = *(const f32x4*)(cbl + n * 64 + ch0); bb[1] = *(const f32x4*)(cbl + n * 64 + ch0 + 4);
#pragma unroll
        for (int m = 0; m < 2; ++m) {
            const int tau = 8 * (i16 >> 2) + 4 * m + (i16 & 3), T = 32 * wave + tau, rb = (T >> 4) * 19 + (T & 15);
            f32x4 u0 = bb[0], u1 = bb[1];
#pragma unroll
            for (int tp = 0; tp < 4; ++tp) { const v4u x = *(const LAS v4u*)(XR + (rb + tp) * 128 + ch0 * 2);
                u0 += w[tp][0] * (f32x4){bflo(x.x), bfhi(x.x), bflo(x.y), bfhi(x.y)}; u1 += w[tp][1] * (f32x4){bflo(x.z), bfhi(x.z), bflo(x.w), bfhi(x.w)}; }
            v4u f; f.x = pk2(u0[0], u0[1]); f.y = pk2(u0[2], u0[3]); f.z = pk2(u1[0], u1[1]); f.w = pk2(u1[2], u1[3]);
            fa[m][ks] = __builtin_bit_cast(bf16x8, f);
        }
    }
    float hloc[4][8], pc[4][8], P8[4], H8[4];
    const int T0 = 32 * wave + 8 * fq, rb0 = (T0 >> 4) * 19 + (T0 & 15);
#pragma unroll
    for (int nb = 0; nb < 4; ++nb) {
        const int ch = 16 * nb + i16, gch = n * 64 + ch;
        f32x4 aR[2] = {{0.f, 0.f, 0.f, 0.f}, {0.f, 0.f, 0.f, 0.f}}, aI[2] = {{0.f, 0.f, 0.f, 0.f}, {0.f, 0.f, 0.f, 0.f}};
#pragma unroll
        for (int ks = 0; ks < 2; ++ks) {
            const bf16x8 bR = *(const bf16x8*)(Wg_t + (size_t)(n * 64 + ch) * 64 + 8 * fq + 32 * ks);
            const bf16x8 bI = *(const bf16x8*)(Wg_t + (size_t)((16 + n) * 64 + ch) * 64 + 8 * fq + 32 * ks);
#pragma unroll
            for (int m = 0; m < 2; ++m) { aR[m] = __builtin_amdgcn_mfma_f32_16x16x32_bf16(fa[m][ks], bR, aR[m], 0, 0, 0); aI[m] = __builtin_amdgcn_mfma_f32_16x16x32_bf16(fa[m][ks], bI, aI[m], 0, 0, 0); }
        }
        float x[11];
#pragma unroll
        for (int r = 0; r < 11; ++r) x[r] = __builtin_bit_cast(float, (unsigned)(*(const LAS unsigned short*)(XR + (rb0 + r) * 128 + ch * 2)) << 16);
        const float c0 = cwl[gch], c1 = cwl[DM + gch], c2 = cwl[2 * DM + gch], c3 = cwl[3 * DM + gch], cbv = cbl[gch];
        const float bra = p.in[I_BRA][gch], bix = p.in[I_BIX][gch], lam = p.in[I_LAM][gch];
        const float zz = -lam, sp = fmaxf(zz, 0.f) + log1pf(expf(-fabsf(zz))), c8 = -8.0f * sp;
        float hl = 0.f, P = 1.f;
#pragma unroll
        for (int q = 0; q < 8; ++q) {
            const float u = cbv + c0 * x[q] + c1 * x[q + 1] + c2 * x[q + 2] + c3 * x[q + 3];
            const float r = sigmoidf_fast(aR[q >> 2][q & 3] + bra), ig = sigmoidf_fast(aI[q >> 2][q & 3] + bix);
            const float la = r * c8, a = __builtin_amdgcn_exp2f(la * 1.4426950408889634f);
            const float x2 = 2.0f * la, em_small = -x2 * (1.0f + x2 * (0.5f + x2 * (0.16666667f + x2 * 0.041666668f))), em = (x2 > -0.05f) ? em_small : (1.0f - a * a);
            const float b = sqrtf(em) * ig * u;
            hl = a * hl + b; P = P * a;
            hloc[nb][q] = hl; pc[nb][q] = P;
        }
        P8[nb] = P; H8[nb] = hl;
    }
    float Pf[4][4], Hf[4][4];
#pragma unroll
    for (int nb = 0; nb < 4; ++nb)
#pragma unroll
        for (int f = 0; f < 4; ++f) { Pf[nb][f] = __shfl(P8[nb], i16 + 16 * f); Hf[nb][f] = __shfl(H8[nb], i16 + 16 * f); }
    if (!samp) {
        if (fq == 0) {
#pragma unroll
            for (int nb = 0; nb < 4; ++nb) { float hw = 0.f, pw = 1.f;
#pragma unroll
                for (int f = 0; f < 4; ++f) { hw = Hf[nb][f] + Pf[nb][f] * hw; pw *= Pf[nb][f]; }
                SEG[wave * 64 + 16 * nb + i16] = (f32x2v){pw, hw}; }
        }
        __syncthreads();
        if (!FINAL) {
            if (tid < 64) { float hu = 0.f, pu = 1.f;
#pragma unroll
                for (int w = 0; w < 8; ++w) { const f32x2v s = SEG[w * 64 + tid]; hu = s.y + s.x * hu; pu *= s.x; }
                SUMM[(size_t)pm * DM + n * 64 + tid] = (f32x2v){pu, hu}; }
            return;
        }
    }
#pragma unroll
    for (int nb = 0; nb < 4; ++nb) {
        const int ch = 16 * nb + i16, gch = n * 64 + ch;
        float c;
        if (!samp) {
            c = CIN[ch];
#pragma unroll
            for (int w = 0; w < 8; ++w) { const f32x2v s = SEG[w * 64 + ch]; if (w < wave) c = s.y + s.x * c; }
#pragma unroll
            for (int f = 0; f < 4; ++f) if (f < fq) c = Hf[nb][f] + Pf[nb][f] * c;
        } else {
            const int sq = 2 * wave + (fq >> 1);
            c = p.in[I_STH][(size_t)sq * DM + gch];
            if (fq & 1) { const float pp = (fq == 1) ? Pf[nb][0] : Pf[nb][2], hh = (fq == 1) ? Hf[nb][0] : Hf[nb][2]; c = hh + pp * c; }
        }
        bf16* hp = HP + (size_t)(pm * 256 + T0) * 2048 + gch; float hlast = 0.f;
#pragma unroll
        for (int q = 0; q < 8; ++q) { const float h = hloc[nb][q] + pc[nb][q] * c; hp[(size_t)q * 2048] = (bf16)f2bf(h); hlast = h; }
        if (!samp) { if ((pm & 15) == 15 && wave == 7 && fq == 3) p.out[OFF_HP + (size_t)(pm >> 4) * DM + gch] = hlast; }
        else if (fq & 1) p.out[OFF_HS + (size_t)(2 * wave + (fq >> 1)) * DM + gch] = hlast;
    }
}

__device__ __forceinline__ void pool_load8(const KP& p, const bf16* ZR, int pm, int tt, int run, int ch, float (&v)[8]) {
    const bool samp = (pm == STILE);
    if (!samp) {
        if (256 * (pm & 15) + tt < 0) {
#pragma unroll
            for (int e = 0; e < 8; ++e) v[e] = 0.f;
            return; }
        const v4u w = *(const v4u*)(ZR + (size_t)(pm * 256 + tt) * 2048 + 1024 + ch);
        v[0] = bflo(w.x); v[1] = bfhi(w.x); v[2] = bflo(w.y); v[3] = bfhi(w.y); v[4] = bflo(w.z); v[5] = bfhi(w.z); v[6] = bflo(w.w); v[7] = bfhi(w.w);
    } else {
        const int tl = tt - 16 * run;
        if (tl < 0) { const float* s = p.in[I_STPOOL] + (size_t)(run * 15 + 15 + tl) * DM + ch; const f32x4 a = *(const f32x4*)s, b = *(const f32x4*)(s + 4);
            v[0] = a[0]; v[1] = a[1]; v[2] = a[2]; v[3] = a[3]; v[4] = b[0]; v[5] = b[1]; v[6] = b[2]; v[7] = b[3]; }
        else { const v4u w = *(const v4u*)(ZR + (size_t)(MP + tt) * 2048 + 1024 + ch);
            v[0] = bflo(w.x); v[1] = bfhi(w.x); v[2] = bflo(w.y); v[3] = bfhi(w.y); v[4] = bflo(w.z); v[5] = bfhi(w.z); v[6] = bflo(w.w); v[7] = bfhi(w.w); }
    }
}
__device__ __forceinline__ void pool_unit(const KP& p, int pm, int g, int tid) {
    const bf16* ZR = (const bf16*)(p.ws + WS_R1); bf16* HP = (bf16*)(p.ws + WS_R3);
    const bool samp = (pm == STILE);
    const int oct = tid & 31, run = tid >> 5, ch = 256 * g + 8 * oct, w = 2 << g, tf = 16 * run;
    const int pos0 = samp ? PAST : 256 * (pm & 15) + tf;
    float s[8];
#pragma unroll
    for (int e = 0; e < 8; ++e) s[e] = 0.f;
    for (int k = 1; k < w; ++k) { float v[8]; pool_load8(p, ZR, pm, tf - k, run, ch, v);
#pragma unroll
        for (int e = 0; e < 8; ++e) s[e] += v[e]; }
    for (int i = 0; i < 16; ++i) {
        float v[8], o[8]; pool_load8(p, ZR, pm, tf + i, run, ch, v);
        const int cnt = min(pos0 + i + 1, w); const float inv = 1.0f / (float)cnt;
#pragma unroll
        for (int e = 0; e < 8; ++e) { s[e] += v[e]; o[e] = s[e] * inv - v[e]; }
        v4u ow; ow.x = pk2(o[0], o[1]); ow.y = pk2(o[2], o[3]); ow.z = pk2(o[4], o[5]); ow.w = pk2(o[6], o[7]);
        *(v4u*)(HP + (size_t)(pm * 256 + tf + i) * 2048 + 1024 + ch) = ow;
        float vo[8]; pool_load8(p, ZR, pm, tf + i - w + 1, run, ch, vo);
#pragma unroll
        for (int e = 0; e < 8; ++e) s[e] -= vo[e];
    }
}
__device__ __forceinline__ void state_copy(const KP& p, int gtid, int gthreads) {
    const bf16* ZR = (const bf16*)(p.ws + WS_R1);
    constexpr int N1 = NBATCH * 3 * DM, N2 = NBATCH * 15 * DM, N3 = SBATCH * 3 * DM, N4 = SBATCH * 15 * DM;
    for (int i = gtid; i < N1 + N2 + N3 + N4; i += gthreads) {
        int r = i; size_t row, col; float* dst;
        if (r < N1) { const int b = r / (3 * DM), k = (r / DM) % 3, c = r % DM; row = (size_t)b * SEQ + SEQ - 3 + k; col = c; dst = p.out + OFF_LCP + r; }
        else if ((r -= N1) < N2) { const int b = r / (15 * DM), k = (r / DM) % 15, c = r % DM; row = (size_t)b * SEQ + SEQ - 15 + k; col = 1024 + c; dst = p.out + OFF_PLP + r; }
        else if ((r -= N2) < N3) { const int b = r / (3 * DM), k = (r / DM) % 3, c = r % DM; row = (size_t)MP + b * SSEQ + SSEQ - 3 + k; col = c; dst = p.out + OFF_LCS + r; }
        else { r -= N3; const int b = r / (15 * DM), k = (r / DM) % 15, c = r % DM; row = (size_t)MP + b * SSEQ + SSEQ - 15 + k; col = 1024 + c; dst = p.out + OFF_PLS + r; }
        *dst = __builtin_bit_cast(float, (unsigned)ZR[row * 2048 + col] << 16);
    }
}

__device__ __forceinline__ void strip_pre(const KP& p, LAS unsigned char* lds, int pm0, int pn, int cnt, int tid, int lane, int wave) {
    const float* SSQ = (const float*)(p.ws + WS_SSQ); const bf16* XG2 = (const bf16*)(p.ws + WS_R1); const bf16* Wup_t = (const bf16*)(p.ws + WS_WUP);
    LAS float* RS = (LAS float*)(lds + RS_OFF); LAS float* ES = (LAS float*)(lds + EDGE_START_OFF);
    __syncthreads();
    for (int i = tid; i < cnt * 256; i += NWAVES * 64) { const f32x4* q = (const f32x4*)(SSQ + (size_t)(pm0 * 256 + i) * 16); const f32x4 a = q[0], b = q[1], c = q[2], d = q[3];
        const float s = ((a[0] + a[1]) + (a[2] + a[3])) + ((b[0] + b[1]) + (b[2] + b[3])) + ((c[0] + c[1]) + (c[2] + c[3])) + ((d[0] + d[1]) + (d[2] + d[3]));
        RS[i] = 1.0f / sqrtf(s * (1.f / DM) + EPS); }
    if (pm0 != STILE && (pm0 & 15) != 0) {
        float xa[2][16], rsh[2];
#pragma unroll
        for (int r = 0; r < 2; ++r) { const size_t row = (size_t)pm0 * 256 - 2 + r;
            const v4u w0 = *(const v4u*)(XG2 + row * DM + 16 * lane), w1 = *(const v4u*)(XG2 + row * DM + 16 * lane + 8);
            xa[r][0] = bflo(w0.x); xa[r][1] = bfhi(w0.x); xa[r][2] = bflo(w0.y); xa[r][3] = bfhi(w0.y); xa[r][4] = bflo(w0.z); xa[r][5] = bfhi(w0.z); xa[r][6] = bflo(w0.w); xa[r][7] = bfhi(w0.w);
            xa[r][8] = bflo(w1.x); xa[r][9] = bfhi(w1.x); xa[r][10] = bflo(w1.y); xa[r][11] = bfhi(w1.y); xa[r][12] = bflo(w1.z); xa[r][13] = bfhi(w1.z); xa[r][14] = bflo(w1.w); xa[r][15] = bfhi(w1.w);
            const f32x4* q = (const f32x4*)(SSQ + row * 16); const f32x4 a = q[0], b = q[1], c = q[2], d = q[3];
            const float s = ((a[0] + a[1]) + (a[2] + a[3])) + ((b[0] + b[1]) + (b[2] + b[3])) + ((c[0] + c[1]) + (c[2] + c[3])) + ((d[0] + d[1]) + (d[2] + d[3]));
            rsh[r] = 1.0f / sqrtf(s * (1.f / DM) + EPS); }
        for (int c = 0; c < 32; ++c) { const int tc = 32 * wave + c; const bf16* wr_ = Wup_t + (size_t)(256 * pn + tc) * DM + 16 * lane;
            const v4u w0 = *(const v4u*)wr_, w1 = *(const v4u*)(wr_ + 8);
            const float wv[16] = {bflo(w0.x), bfhi(w0.x), bflo(w0.y), bfhi(w0.y), bflo(w0.z), bfhi(w0.z), bflo(w0.w), bfhi(w0.w), bflo(w1.x), bfhi(w1.x), bflo(w1.y), bfhi(w1.y), bflo(w1.z), bfhi(w1.z), bflo(w1.w), bfhi(w1.w)};
            float p0 = 0.f, p1 = 0.f;
#pragma unroll
            for (int e = 0; e < 16; ++e) { p0 += xa[0][e] * wv[e]; p1 += xa[1][e] * wv[e]; }
            p0 = wave_sum(p0); p1 = wave_sum(p1);
            if (lane == 0) { ES[tc] = p0 * rsh[0]; ES[256 + tc] = p1 * rsh[1]; } }
    } else { ES[tid] = 0.f; }
    __syncthreads();
}

__device__ __forceinline__ void final_norm(const KP& p, int gw, int NGW, int lane) {
    const float* SSQ2 = (const float*)(p.ws + WS_SSQ2); const float* gf = p.in[I_NFIN];
    f32x4 gv[4];
#pragma unroll
    for (int j = 0; j < 4; ++j) gv[j] = *((const f32x4*)gf + lane + 64 * j);
    for (int m = gw; m < M; m += NGW) {
        const float sv = (lane < 16) ? SSQ2[(size_t)m * 16 + lane] : 0.f;
        const float rstd = 1.0f / sqrtf(wave_sum(sv) * (1.f / DM) + EPS);
        f32x4* yr = (f32x4*)(p.out + OFF_Y + (size_t)m * DM) + lane;
#pragma unroll
        for (int j = 0; j < 4; ++j) { const f32x4 v = yr[64 * j]; yr[64 * j] = v * rstd * gv[j]; }
    }
}
#ifndef MK_ONE_LAUNCH
#define MK_ONE_LAUNCH 1
#endif
#ifndef PG8_SP2
#define PG8_SP2 false
#endif
constexpr int N_PHASES = 10;
__global__ void __launch_bounds__(NWAVES * 64, 2) mk_fwd(KP p) {
    extern __shared__ __attribute__((aligned(16))) unsigned char lds_raw[];
    LAS unsigned char* lds = (LAS unsigned char*)lds_raw;
    const int tid = threadIdx.x, lane = tid & 63, wave = __builtin_amdgcn_readfirstlane(tid >> 6);
    const int G = gridDim.x, bx = blockIdx.x, vcu = (G % 8 == 0) ? (bx % 8) * (G / 8) + bx / 8 : bx;
    volatile LAS unsigned* MISC = (volatile LAS unsigned*)(lds + MISC_OFF);
    if (tid < 32) MISC[tid] = 0u;
    __syncthreads();
    unsigned* ctl = (unsigned*)(p.ws + WS_CTL);
    const int lo = p.ph_lo, hi = p.ph_hi;
    XcdBarrier bar; bar.bar = ctl + CW_BAR; bar.x = 0; bar.st = MISC + 8;
    if (hi - lo > 1) bar = xcd_barrier_post(ctl + CW_BAR, MISC + 8);
#ifndef PH_MASK
#define PH_MASK 0x3ff
#endif
#define IN(k) (((PH_MASK >> (k)) & 1) && lo <= (k) && (k) < hi)
#define SEAM(k) do { if (IN(k) && IN((k) + 1)) xcd_barrier(bar); } while (0)
    unsigned char* ws = p.ws;
    bf16* XN = (bf16*)(ws + WS_R0); bf16* MG = (bf16*)(ws + WS_R0); bf16* ZR = (bf16*)(ws + WS_R1); float* T = (float*)(ws + WS_R1); bf16* XG2 = (bf16*)(ws + WS_R1);
    bf16* GT = (bf16*)(ws + WS_R2); bf16* HP = (bf16*)(ws + WS_R3); bf16* ACT = (bf16*)(ws + WS_R2);
    bf16* Win_t = (bf16*)(ws + WS_WIN); bf16* Wcat_t = (bf16*)(ws + WS_WCAT); bf16* Wout_t = (bf16*)(ws + WS_WOUT); bf16* Wup_t = (bf16*)(ws + WS_WUP); bf16* Wdn_t = (bf16*)(ws + WS_WDN);
    float* SSQ = (float*)(ws + WS_SSQ); float* SSQ2 = (float*)(ws + WS_SSQ2);
    float* Y = p.out + OFF_Y;

    if (IN(0)) { p0_prologue(p, lds, vcu, G, wave, lane); }
    SEAM(0);
    if (IN(1)) {
        pg8::Gemm g{XN, Win_t, DM, DM, DM}; pg8::StaticOrder S; S.init(M, DIN, G, bx);
        EpiZ E{ZR, GT};
        pg8::gemm_phase<EpiZ, pg8::StaticOrder, false, PG8_SP2>(lds, g, S, E);
    }
    SEAM(1);
    if (IN(2)) { for (int L = bx; L < STILE * 16; L += G) lru_unit<false>(p, lds, L >> 4, L & 15, tid, lane, wave); }
    SEAM(2);
    if (IN(3)) {
        state_copy(p, bx * NWAVES * 64 + tid, G * NWAVES * 64);
        for (int L = bx; L < NTILE * 16 + NTILE * 4; L += G) {
            if (L < NTILE * 16) lru_unit<true>(p, lds, L >> 4, L & 15, tid, lane, wave);
            else { const int r = L - NTILE * 16; pool_unit(p, r >> 2, r & 3, tid); }
        }
    }
    SEAM(3);
    if (IN(4)) {
        pg8::Gemm g{HP, Wcat_t, DM, 2048, 2048}; pg8::StaticOrder S; S.init(M, DM, G, bx);
        EpiBr<false> E{GT, T, MG};
        pg8::gemm_phase<EpiBr<false>, pg8::StaticOrder, false, PG8_SP2>(lds, g, S, E);
    }
    SEAM(4);
    if (IN(5)) {
        pg8::Gemm g{HP + 1024, Wcat_t + 1024, DM, 2048, 2048}; pg8::StaticOrder S; S.init(M, DM, G, bx);
        EpiBr<true> E{GT, T, MG};
        pg8::gemm_phase<EpiBr<true>, pg8::StaticOrder, false, PG8_SP2>(lds, g, S, E);
    }
    SEAM(5);
    if (IN(6)) {
        pg8::Gemm g{MG, Wout_t, DM, DM, DM}; pg8::StaticOrder S; S.init(M, DM, G, bx);
        EpiRes<false> E{p.in[I_XP], p.in[I_XS], Y, XG2, p.in[I_NFFN], SSQ};
        pg8::gemm_phase<EpiRes<false>, pg8::StaticOrder, false, PG8_SP2>(lds, g, S, E);
    }
    SEAM(6);
    if (IN(7)) {
        pg8::Gemm g{XG2, Wup_t, DM, DM, DM};
        for (int sidx = vcu; sidx < 768 + 24; sidx += G) {
            int pm0, pn, cnt;
            if (sidx < 768) { const int rg = sidx >> 8, v = sidx & 255, x = v >> 5, w = v & 31; pm0 = 4 * (4 * x + (w >> 3)); pn = 8 * rg + (w & 7); cnt = 4; }
            else { pm0 = STILE; pn = sidx - 768; cnt = 1; }
            strip_pre(p, lds, pm0, pn, cnt, tid, lane, wave);
            pg8::StripOrder S{pm0, pn, cnt};
            EpiUp E{ACT, p.in[I_CFW], p.in[I_CFB], p.in[I_STFFN], p.out + OFF_FCP, p.out + OFF_FCS, lds, pm0};
            pg8::gemm_phase<EpiUp, pg8::StripOrder, false, PG8_SP2>(lds, g, S, E);
        }
    }
    SEAM(7);
    if (IN(8)) {
        pg8::Gemm g{ACT, Wdn_t, DFF, DFF, DFF}; pg8::StaticOrder S; S.init(M, DM, G, bx);
        EpiRes<true> E{nullptr, nullptr, Y, nullptr, nullptr, SSQ2};
        pg8::gemm_phase<EpiRes<true>, pg8::StaticOrder, false, PG8_SP2>(lds, g, S, E);
    }
    SEAM(8);
    if (IN(9)) { final_norm(p, vcu * NWAVES + wave, G * NWAVES, lane); }
#undef IN
#undef SEAM
}

extern "C" void kernel_launch(void* const* d_in, const int* in_sizes, int n_in, void* d_out, int out_size, void* d_ws, size_t ws_size, hipStream_t stream) {
    static int grid = 0;
    if (grid == 0) {
        if (n_in != 26 || in_sizes[0] != MP * DM || (size_t)out_size != OUT_TOTAL || ws_size < WS_END) {
            fprintf(stderr, "kernel_launch: unexpected shapes: n_in %d in0 %d out %d ws %zu (need %zu)\n", n_in, n_in > 0 ? in_sizes[0] : -1, out_size, ws_size, (size_t)WS_END); grid = -1; return; }
        int dev = 0, cus = 0, per_cu = 0;
        if (hipGetDevice(&dev) != hipSuccess || hipDeviceGetAttribute(&cus, hipDeviceAttributeMultiprocessorCount, dev) != hipSuccess) { fprintf(stderr, "kernel_launch: device query failed\n"); grid = -1; return; }
        if (hipFuncSetAttribute((const void*)mk_fwd, hipFuncAttributeMaxDynamicSharedMemorySize, LDS_BYTES) != hipSuccess) { fprintf(stderr, "kernel_launch: hipFuncSetAttribute failed\n"); grid = -1; return; }
        if (hipOccupancyMaxActiveBlocksPerMultiprocessor(&per_cu, (const void*)mk_fwd, NWAVES * 64, LDS_BYTES) != hipSuccess || per_cu < 1) {
            fprintf(stderr, "kernel_launch: occupancy query reports %d blocks per CU\n", per_cu); (void)hipGetLastError(); per_cu = 1; }
        grid = cus;
        fprintf(stderr, "kernel_launch: grid %d (cus %d, occupancy %d/CU)\n", grid, cus, per_cu);
    }
    if (grid < 0) return;
    if (hipMemsetAsync((char*)d_ws + WS_CTL, 0, CTL_ZERO_BYTES, stream) != hipSuccess) { fprintf(stderr, "kernel_launch: memset failed\n"); return; }
    KP a{};
    for (int i = 0; i < 26; ++i) a.in[i] = (const float*)d_in[i];
    a.out = (float*)d_out; a.ws = (unsigned char*)d_ws;
#if MK_ONE_LAUNCH
    a.ph_lo = 0; a.ph_hi = N_PHASES;
    hipLaunchKernelGGL(mk_fwd, dim3(grid), dim3(NWAVES * 64), LDS_BYTES, stream, a);
#else
    for (int k = 0; k < N_PHASES; ++k) { a.ph_lo = k; a.ph_hi = k + 1; hipLaunchKernelGGL(mk_fwd, dim3(grid), dim3(NWAVES * 64), LDS_BYTES, stream, a); }
#endif
    const hipError_t le = hipPeekAtLastError();
    if (le != hipSuccess) fprintf(stderr, "kernel_launch: launch failed: %s\n", hipGetErrorName(le));
}
```

```cpp
#include <hip/hip_runtime.h>
#include <cstdio>
#include <cstdint>
#define MK_ONE_LAUNCH 1
namespace pg8 {
#define PG8_LAS __attribute__((address_space(3)))
typedef unsigned short bf16_t;
typedef short bf16x8 __attribute__((ext_vector_type(8)));
typedef float f32x4 __attribute__((ext_vector_type(4)));
typedef unsigned u32x4 __attribute__((ext_vector_type(4)));
typedef unsigned u32x2 __attribute__((ext_vector_type(2)));
constexpr int BM = 256, BK = 64, HALF = 128, HTB = HALF * BK * 2  , STAGE_BYTES = 8 * HTB, NXCD = 8, WGM = 8;

__host__ __device__ __forceinline__ int lds_byte(int r, int c) { const int st = (r >> 4) * 2 + (c >> 5), rr = r & 15, cc = c & 31, ob = rr * 64 + cc * 2; return st * 1024 + (ob ^ (((ob >> 9) & 1) << 5)); }
__host__ __device__ __forceinline__ void stage_rc(int b, int& R, int& C) { const int st = b / 1024, sb = b % 1024, swz = sb ^ (((sb >> 9) & 1) << 5); R = (st >> 1) * 16 + swz / 64; C = (st & 1) * 32 + (swz % 64) / 2; }
__host__ __device__ __forceinline__ int perm32(int rho) { const int n = rho >> 4, i = rho & 15; return 8 * (i >> 2) + 4 * n + (i & 3); }
__host__ __device__ __forceinline__ int amap_row(int R) { return 128 * (R >> 6) + 8 * (R & 15) + ((R >> 4) & 3); }

struct Unit { int pm, pn; };
struct Gemm { const bf16_t* A; const bf16_t* Bt; int K, lda, ldb; };

struct StaticOrder {
    int nM, nN, nwg, G, c;
    __host__ __device__ void init(int M, int N, int G_, int c_) { nM = M / BM; nN = N / BM; nwg = nM * nN; G = G_; c = c_; }
    __host__ __device__ bool next(int i, Unit& u) const {
        const long L = (long)i * G + c; if (L >= nwg) return false;
        int wgid = (int)L; { const int q = nwg / NXCD, r = nwg % NXCD, xcd = wgid % NXCD, off = wgid / NXCD; wgid = (xcd < r ? xcd * (q + 1) : r * (q + 1) + (xcd - r) * q) + off; }
        const int nig = WGM * nN, gid = wgid / nig, fm = gid * WGM, gsz = (nM - fm) < WGM ? (nM - fm) : WGM;
        u.pm = fm + ((wgid % nig) % gsz); u.pn = (wgid % nig) / gsz; return true;
    }
    __device__ __forceinline__ void a_ready(const Unit&) const {}
    __device__ __forceinline__ void done(const Unit&) const {}
};
struct StripOrder {
    int pm0, pn, cnt;
    __device__ __forceinline__ bool next(int i, Unit& u) const { if (i >= cnt) return false; u.pm = pm0 + i; u.pn = pn; return true; }
    __device__ __forceinline__ void a_ready(const Unit&) const {}
    __device__ __forceinline__ void done(const Unit&) const {}
};

__device__ __forceinline__ unsigned cvt_pk_bf16(float lo, float hi) { unsigned r; asm volatile("v_cvt_pk_bf16_f32 %0, %1, %2" : "=v"(r) : "v"(lo), "v"(hi)); return r; }

template <class Epi, class Sched, bool ALIGN_EPI = false, bool SP2 = false>
__device__ __forceinline__ void gemm_phase(PG8_LAS unsigned char* lds, const Gemm g, const Sched& S, const Epi& E) {
    const int tid = threadIdx.x, wid = __builtin_amdgcn_readfirstlane(tid >> 6), lane = tid & 63, wr = wid >> 2, wc = wid & 3, fr = lane & 15, fq = lane >> 4;
    const int K = g.K, nt = K / BK;
    unsigned voffA[2], voffB[2];
#pragma unroll
    for (int i = 0; i < 2; ++i) { int R, C; stage_rc(tid * 16 + i * 8192, R, C); const int Rb = Epi::PERM ? ((R & ~31) + perm32(R & 31)) : R; const int Ra = Epi::AMAP ? amap_row(R) : R;
        voffA[i] = (unsigned)(Ra * g.lda + C) * 2u; voffB[i] = (unsigned)(Rb * g.ldb + C) * 2u; }
    const size_t kstep = (size_t)(BK * 2);
    const size_t hstepA = Epi::AMAP ? (size_t)4 * g.lda * 2 : (size_t)HALF * g.lda * 2;
    const size_t hstepB = (size_t)HALF * g.ldb * 2;
    const size_t tstepA = (size_t)BM * g.lda * 2, tstepB = (size_t)BM * g.ldb * 2;
    const unsigned ldsw = (unsigned)wid * 1024u;
    const int aoff = lds_byte(wr * 64 + fr, fq * 8), boff = lds_byte(wc * 32 + fr, fq * 8);
#define PG8_SA(b, h) (((b) * 2 + (h)) * HTB)
#define PG8_SB(b, h) ((4 + (b) * 2 + (h)) * HTB)
#define PG8_STAGE(bufoff, gbase, voff) do { _Pragma("unroll") for (int _i = 0; _i < 2; ++_i) \
        __builtin_amdgcn_global_load_lds((const unsigned*)((const char*)(gbase) + (voff)[_i]), (PG8_LAS unsigned*)(lds + (bufoff) + ldsw + _i * 8192), 16, 0, 0); } while (0)
#define PG8_LDA(dst, b, h) do { _Pragma("unroll") for (int m = 0; m < 4; ++m) _Pragma("unroll") for (int k = 0; k < 2; ++k) dst[m][k] = *(const PG8_LAS bf16x8*)(lds + PG8_SA(b, h) + aoff + m * 2048 + k * 1024); } while (0)
#define PG8_LDB(dst, b, h) do { _Pragma("unroll") for (int n = 0; n < 2; ++n) _Pragma("unroll") for (int k = 0; k < 2; ++k) dst[n][k] = *(const PG8_LAS bf16x8*)(lds + PG8_SB(b, h) + boff + n * 2048 + k * 1024); } while (0)
#define PG8_MMA(ai, bj, At, Bt) do { __builtin_amdgcn_s_setprio(1); _Pragma("unroll") for (int m = 0; m < 4; ++m) _Pragma("unroll") for (int n = 0; n < 2; ++n) _Pragma("unroll") for (int k = 0; k < 2; ++k) \
        acc[ai][bj][m][n] = __builtin_amdgcn_mfma_f32_16x16x32_bf16(Bt[n][k], At[m][k], acc[ai][bj][m][n], 0, 0, 0); __builtin_amdgcn_s_setprio(0); } while (0)
#define PG8_WAIT_V(n) asm volatile("s_waitcnt vmcnt(" #n ")" ::: "memory")
#define PG8_WAIT_L(n) asm volatile("s_waitcnt lgkmcnt(" #n ")" ::: "memory")
#define PG8_BAR __builtin_amdgcn_s_barrier()
#define PG8_SCHED __builtin_amdgcn_sched_barrier(0)
    Unit cur, nxt; int ui = 0;
    if (!S.next(0, cur)) return;
    f32x4 acc[2][2][4][2];
#pragma unroll
    for (int a = 0; a < 2; ++a)
#pragma unroll
        for (int b = 0; b < 2; ++b)
#pragma unroll
            for (int m = 0; m < 4; ++m)
#pragma unroll
                for (int n = 0; n < 2; ++n) acc[a][b][m][n] = (f32x4){0.f, 0.f, 0.f, 0.f};
    bf16x8 At[4][2], B0[2][2], B1[2][2];
    const char* cA = (const char*)g.A + (size_t)cur.pm * tstepA; const char* cB = (const char*)g.Bt + (size_t)cur.pn * tstepB;
    S.a_ready(cur);
    if constexpr (SP2) {
        PG8_STAGE(PG8_SB(0, 0), cB, voffB); PG8_STAGE(PG8_SB(0, 1), cB + hstepB, voffB); PG8_STAGE(PG8_SA(0, 0), cA, voffA); PG8_STAGE(PG8_SA(0, 1), cA + hstepA, voffA);
        if (wr == 1) PG8_BAR;
        PG8_WAIT_V(2); PG8_BAR;
        PG8_STAGE(PG8_SB(1, 0), cB + kstep, voffB); PG8_STAGE(PG8_SA(1, 0), cA + kstep, voffA); PG8_STAGE(PG8_SB(1, 1), cB + hstepB + kstep, voffB);
        PG8_WAIT_V(6); PG8_BAR;
    } else {
        PG8_STAGE(PG8_SB(0, 0), cB, voffB); PG8_STAGE(PG8_SA(0, 0), cA, voffA); PG8_STAGE(PG8_SB(0, 1), cB + hstepB, voffB); PG8_STAGE(PG8_SA(0, 1), cA + hstepA, voffA);
        if (wr == 1) PG8_BAR;
        PG8_WAIT_V(4); PG8_BAR;
        PG8_STAGE(PG8_SB(1, 0), cB + kstep, voffB); PG8_STAGE(PG8_SA(1, 0), cA + kstep, voffA); PG8_STAGE(PG8_SB(1, 1), cB + hstepB + kstep, voffB);
        PG8_WAIT_V(6); PG8_BAR;
    }
    for (;;) {
        const bool has_next = S.next(ui + 1, nxt);
        const char* nA = has_next ? (const char*)g.A + (size_t)nxt.pm * tstepA : cA; const char* nB = has_next ? (const char*)g.Bt + (size_t)nxt.pn * tstepB : cB;
        for (int t = 0; t < nt; t += 2) {
            const bool last = (t == nt - 2);
            const char* a1 = cA + (size_t)(t + 1) * kstep;
            const char* a2 = last ? nA : cA + (size_t)(t + 2) * kstep; const char* b2 = last ? nB : cB + (size_t)(t + 2) * kstep;
            const char* a3 = a2 + kstep; const char* b3 = b2 + kstep;
            if (last && has_next) S.a_ready(nxt);
            if constexpr (Epi::MID) { if (t == (nt >> 1)) E.mid(acc, cur, wr, wc, fr, fq); }
            if constexpr (SP2) {
            PG8_LDB(B0, 0, 0); PG8_LDB(B1, 0, 1); PG8_SCHED; PG8_LDA(At, 0, 0); PG8_STAGE(PG8_SA(1, 1), a1 + hstepA, voffA);
            PG8_WAIT_V(8); PG8_WAIT_L(0); PG8_BAR; PG8_MMA(0, 0, At, B0); PG8_MMA(0, 1, At, B1); PG8_BAR; PG8_SCHED;
            PG8_LDA(At, 0, 1); PG8_STAGE(PG8_SB(0, 0), b2, voffB); PG8_STAGE(PG8_SB(0, 1), b2 + hstepB, voffB); PG8_STAGE(PG8_SA(0, 0), a2, voffA);
            PG8_WAIT_V(8); PG8_WAIT_L(0); PG8_BAR; PG8_MMA(1, 0, At, B0); PG8_MMA(1, 1, At, B1); PG8_BAR; PG8_SCHED;
            PG8_LDB(B0, 1, 0); PG8_LDB(B1, 1, 1); PG8_SCHED; PG8_LDA(At, 1, 0); PG8_STAGE(PG8_SA(0, 1), a2 + hstepA, voffA);
            PG8_WAIT_V(8); PG8_WAIT_L(0); PG8_BAR; PG8_MMA(0, 0, At, B0); PG8_MMA(0, 1, At, B1); PG8_BAR; PG8_SCHED;
            PG8_LDA(At, 1, 1); PG8_STAGE(PG8_SB(1, 0), b3, voffB); PG8_STAGE(PG8_SB(1, 1), b3 + hstepB, voffB); PG8_STAGE(PG8_SA(1, 0), a3, voffA);
            PG8_WAIT_V(8); PG8_WAIT_L(0); PG8_BAR; PG8_MMA(1, 0, At, B0); PG8_MMA(1, 1, At, B1); PG8_BAR; PG8_SCHED;
            } else {
            PG8_LDB(B0, 0, 0); PG8_SCHED; PG8_LDA(At, 0, 0); PG8_STAGE(PG8_SA(1, 1), a1 + hstepA, voffA);
            PG8_WAIT_L(8); PG8_BAR; PG8_WAIT_L(0); PG8_MMA(0, 0, At, B0); PG8_BAR; PG8_SCHED;
            PG8_LDB(B1, 0, 1); PG8_STAGE(PG8_SB(0, 0), b2, voffB);
            PG8_BAR; PG8_WAIT_L(0); PG8_MMA(0, 1, At, B1); PG8_BAR;
            PG8_LDA(At, 0, 1); PG8_STAGE(PG8_SA(0, 0), a2, voffA);
            PG8_BAR; PG8_WAIT_L(0); PG8_MMA(1, 0, At, B0); PG8_BAR; PG8_SCHED;
            PG8_STAGE(PG8_SB(0, 1), b2 + hstepB, voffB);
            PG8_WAIT_V(6); PG8_BAR; PG8_MMA(1, 1, At, B1); PG8_BAR;
            PG8_LDB(B0, 1, 0); PG8_SCHED; PG8_LDA(At, 1, 0); PG8_STAGE(PG8_SA(0, 1), a2 + hstepA, voffA);
            PG8_WAIT_L(8); PG8_BAR; PG8_WAIT_L(0); PG8_MMA(0, 0, At, B0); PG8_BAR; PG8_SCHED;
            PG8_LDB(B1, 1, 1); PG8_STAGE(PG8_SB(1, 0), b3, voffB);
            PG8_BAR; PG8_WAIT_L(0); PG8_MMA(0, 1, At, B1); PG8_BAR;
            PG8_LDA(At, 1, 1); PG8_STAGE(PG8_SA(1, 0), a3, voffA);
            PG8_BAR; PG8_WAIT_L(0); PG8_MMA(1, 0, At, B0); PG8_BAR; PG8_SCHED;
            PG8_STAGE(PG8_SB(1, 1), b3 + hstepB, voffB);
            PG8_WAIT_V(6); PG8_BAR; PG8_MMA(1, 1, At, B1); PG8_BAR;
            }
        }
        if constexpr (ALIGN_EPI) { if (wr == 0) PG8_BAR; }
        E(acc, cur, wr, wc, fr, fq); S.done(cur);
        if (!has_next) break;
#pragma unroll
        for (int a = 0; a < 2; ++a)
#pragma unroll
            for (int b = 0; b < 2; ++b)
#pragma unroll
                for (int m = 0; m < 4; ++m)
#pragma unroll
                    for (int n = 0; n < 2; ++n) acc[a][b][m][n] = (f32x4){0.f, 0.f, 0.f, 0.f};
        cur = nxt; cA = nA; cB = nB; ++ui;
        if constexpr (ALIGN_EPI) { if (wr == 1) PG8_BAR; }
    }
    PG8_WAIT_V(0);
    if constexpr (!ALIGN_EPI) { if (wr == 0) PG8_BAR; }
    PG8_BAR;
#undef PG8_SA
#undef PG8_SB
#undef PG8_STAGE
#undef PG8_LDA
#undef PG8_LDB
#undef PG8_MMA
#undef PG8_WAIT_V
#undef PG8_WAIT_L
#undef PG8_BAR
#undef PG8_SCHED
}
}
constexpr int NWAVES = 8;
constexpr int DM = 1024, NBATCH = 8, SEQ = 4096, SBATCH = 16, SSEQ = 16, PAST = 2048;
constexpr int MP = NBATCH * SEQ, MS = SBATCH * SSEQ, M = MP + MS, NTILE = M / 256, STILE = MP / 256;
constexpr int DIN = 4096, DFF = 3072, DUP = 6144;
constexpr float EPS = 1e-6f;
constexpr size_t OFF_Y = 0, OFF_HP = (size_t)M * DM, OFF_LCP = OFF_HP + NBATCH * DM, OFF_PLP = OFF_LCP + NBATCH * 3 * DM, OFF_FCP = OFF_PLP + NBATCH * 15 * DM,
                 OFF_HS = OFF_FCP + NBATCH * 2 * DUP, OFF_LCS = OFF_HS + SBATCH * DM, OFF_PLS = OFF_LCS + SBATCH * 3 * DM, OFF_FCS = OFF_PLS + SBATCH * 15 * DM,
                 OUT_TOTAL = OFF_FCS + SBATCH * 2 * DUP;
constexpr size_t MiB = 1u << 20;
constexpr size_t WS_CTL = 0, CTL_ZERO_BYTES = 64 * 1024;
constexpr size_t WS_WIN = 1 * MiB, WS_WCAT = 9 * MiB, WS_WOUT = 13 * MiB, WS_WUP = 15 * MiB, WS_WDN = 27 * MiB, WS_WG = 33 * MiB;
constexpr size_t WS_SUMM = 34 * MiB, WS_SSQ = 36 * MiB, WS_SSQ2 = 39 * MiB;
constexpr size_t WS_R0 = 42 * MiB, WS_R1 = 107 * MiB, WS_R2 = 236 * MiB, WS_R3 = 365 * MiB, WS_END = 494 * MiB;
static_assert((size_t)M * DM * 2 <= WS_R1 - WS_R0 && (size_t)M * 2048 * 2 <= WS_R2 - WS_R1 && (size_t)M * 2048 * 2 <= WS_R3 - WS_R2 && (size_t)M * 2048 * 2 <= WS_END - WS_R3 && (size_t)M * DFF * 2 <= WS_END - WS_R2, "ws map");
constexpr int CW_BAR = 1024;
constexpr int RING_BYTES = 131072;
constexpr int MISC_OFF = RING_BYTES, RS_OFF = RING_BYTES + 512, EDGE_START_OFF = RS_OFF + 4096, EDGE_MID_OFF = EDGE_START_OFF + 2048, EDGE_PREV_OFF = EDGE_MID_OFF + 2048;
constexpr int LDS_BYTES = 147456;
static_assert(EDGE_PREV_OFF + 2048 <= LDS_BYTES, "LDS map");

#define GAS __attribute__((address_space(1)))
#define LAS __attribute__((address_space(3)))
typedef unsigned short bf16;
typedef unsigned v4u __attribute__((ext_vector_type(4)));
typedef unsigned v2u __attribute__((ext_vector_type(2)));
typedef float f32x4 __attribute__((ext_vector_type(4)));
typedef short bf16x8 __attribute__((ext_vector_type(8)));
#define LDS_WAIT() asm volatile("s_waitcnt lgkmcnt(0)" ::: "memory")
#define VM_WAIT() asm volatile("s_waitcnt vmcnt(0)" ::: "memory")
__device__ __forceinline__ unsigned f2bf(float f) { unsigned u = __builtin_bit_cast(unsigned, f); return (u + 0x7fffu + ((u >> 16) & 1u)) >> 16; }
__device__ __forceinline__ unsigned pk2(float lo, float hi) { return f2bf(lo) | (f2bf(hi) << 16); }
__device__ __forceinline__ float bflo(unsigned w) { return __builtin_bit_cast(float, w << 16); }
__device__ __forceinline__ float bfhi(unsigned w) { return __builtin_bit_cast(float, w & 0xffff0000u); }
__device__ __forceinline__ float sigmoidf_fast(float x) { return __builtin_amdgcn_rcpf(1.0f + __builtin_amdgcn_exp2f(-1.4426950408889634f * x)); }
__device__ __forceinline__ float gelu_tanh(float g) { const float z = g * (1.0f + 0.044715f * g * g); return g * __builtin_amdgcn_rcpf(1.0f + __builtin_amdgcn_exp2f(-2.302208198f * z)); }
__device__ __forceinline__ float wave_sum(float v) {
#pragma unroll
    for (int o = 1; o < 64; o <<= 1) v += __shfl_xor(v, o);
    return v;
}

#define XB_TMO      128
#define XB_XCNT(j)  (256  + 64 * (j))
#define XB_XSUB(j)  (1280 + 64 * (j))
#define XB_XGEN(j)  (2304 + 64 * (j))
#define XB_TOP      3328
#define XB_TOPGEN   3392
#define XCD_BAR_WORDS 3456
#define XB_SPIN_CAP (1u << 20)
static_assert((CW_BAR + XCD_BAR_WORDS) * 4 <= (int)CTL_ZERO_BYTES, "barrier words inside the memset region");
__device__ __forceinline__ unsigned xb_ld(unsigned* p)              { return __hip_atomic_load(p, __ATOMIC_RELAXED, __HIP_MEMORY_SCOPE_AGENT); }
__device__ __forceinline__ unsigned xb_add(unsigned* p, unsigned v) { return __hip_atomic_fetch_add(p, v, __ATOMIC_RELAXED, __HIP_MEMORY_SCOPE_AGENT); }
__device__ __forceinline__ unsigned xb_xcc_id() { return (unsigned)__builtin_amdgcn_s_getreg((3 << 11) | 20) & 0xFu; }
#define XB_SPIN(cond, bar) do { unsigned _sp = 0; while (cond) { __builtin_amdgcn_s_sleep(1); \
    if ((++_sp & 255u) == 0u) { if (xb_ld(&(bar)[XB_TMO])) break; if (_sp > XB_SPIN_CAP) { atomicAdd(&(bar)[XB_TMO], 1u); break; } } } } while (0)
struct XcdBarrier { unsigned* bar; unsigned x; volatile LAS unsigned* st; };
__device__ __forceinline__ XcdBarrier xcd_barrier_post(unsigned* bar, volatile LAS unsigned* st) {
    XcdBarrier b; b.bar = bar; b.x = xb_xcc_id(); b.st = st;
    if (threadIdx.x == 0) (void)xb_add(&bar[XB_XCNT(b.x)], 1u);
    return b;
}
__device__ __forceinline__ void xcd_barrier_complete(unsigned* bar, unsigned x, unsigned& nloc, unsigned& nx) {
    const unsigned G = gridDim.x * gridDim.y * gridDim.z;
    unsigned sum, cnt, mine, sp = 0u;
    for (;;) {
        sum = 0u; cnt = 0u; mine = 0u;
#pragma unroll
        for (unsigned j = 0; j < 16; ++j) { const unsigned c = xb_ld(&bar[XB_XCNT(j)]); sum += c; cnt += (c > 0u) ? 1u : 0u; mine = (j == x) ? c : mine; }
        if (sum == G) break;
        __builtin_amdgcn_s_sleep(1);
        if ((++sp & 255u) == 0u) { if (xb_ld(&bar[XB_TMO])) break; if (sp > XB_SPIN_CAP) { atomicAdd(&bar[XB_TMO], 1u); break; } }
    }
    nloc = mine > 0u ? mine : 1u; nx = cnt > 0u ? cnt : 1u;
}
__device__ __forceinline__ void xcd_barrier(const XcdBarrier& b) {
    asm volatile("s_waitcnt vmcnt(0)" ::: "memory");
    __syncthreads();
    if (threadIdx.x == 0) {
        unsigned* bar = b.bar;
        __builtin_amdgcn_s_waitcnt(0);
        unsigned nloc = b.st[0], nx = b.st[1];
        if (nloc == 0u) { xcd_barrier_complete(bar, b.x, nloc, nx); b.st[0] = nloc; b.st[1] = nx; }
        const unsigned old = xb_add(&bar[XB_XSUB(b.x)], 1u);
        const unsigned gen = old / nloc;
        if (old + 1u == (gen + 1u) * nloc) {
            __builtin_amdgcn_fence(__ATOMIC_RELEASE, "agent");
            asm volatile("s_waitcnt vmcnt(0)" ::: "memory");
            const unsigned og = xb_add(&bar[XB_TOP], 1u);
            const unsigned tg = og / nx;
            if (og + 1u == (tg + 1u) * nx) xb_add(&bar[XB_TOPGEN], 1u);
            else XB_SPIN(xb_ld(&bar[XB_TOPGEN]) == tg, bar);
            __builtin_amdgcn_fence(__ATOMIC_ACQUIRE, "agent");
            xb_add(&bar[XB_XGEN(b.x)], 1u);
            asm volatile("s_waitcnt vmcnt(0)" ::: "memory");
        } else {
            XB_SPIN(xb_ld(&bar[XB_XGEN(b.x)]) == gen, bar);
            __builtin_amdgcn_fence(__ATOMIC_ACQUIRE, "agent");
            asm volatile("s_waitcnt vmcnt(0)" ::: "memory");
        }
    }
    __syncthreads();
}

struct KP {
    const float* in[26];
    float* out; unsigned char* ws;
    int ph_lo, ph_hi;
};
enum { I_XP = 0, I_XS, I_STH, I_STLC, I_STPOOL, I_STFFN, I_NMIX, I_WIN, I_CLW, I_CLB, I_WRA, I_BRA, I_WIX, I_BIX, I_LAM, I_WPOOL, I_PSCALE, I_WBRL, I_WBRP, I_WOUT, I_NFFN, I_WUP, I_CFW, I_CFB, I_WDN, I_NFIN };

using pg8::Unit;
struct EpiZ {
    static constexpr bool PERM = true, AMAP = false, MID = false;
    bf16* ZR; bf16* G;
    __device__ __forceinline__ void operator()(const f32x4 (&acc)[2][2][4][2], const Unit& u, int wr, int wc, int fr, int fq) const {
        const int row0 = u.pm * 256 + wr * 64 + fr; const bool gate = u.pn >= 8;
        bf16* base = gate ? G : ZR; const int col0 = (u.pn & 7) * 256 + wc * 32 + 8 * fq;
#pragma unroll
        for (int ai = 0; ai < 2; ++ai)
#pragma unroll
            for (int m = 0; m < 4; ++m) { bf16* rowp = base + (size_t)(row0 + ai * 128 + m * 16) * 2048 + col0;
#pragma unroll
                for (int bj = 0; bj < 2; ++bj) { f32x4 v0 = acc[ai][bj][m][0], v1 = acc[ai][bj][m][1];
                    if (gate) {
#pragma unroll
                        for (int j = 0; j < 4; ++j) { v0[j] = sigmoidf_fast(v0[j]); v1[j] = sigmoidf_fast(v1[j]); } }
                    v4u w; w.x = pg8::cvt_pk_bf16(v0[0], v0[1]); w.y = pg8::cvt_pk_bf16(v0[2], v0[3]); w.z = pg8::cvt_pk_bf16(v1[0], v1[1]); w.w = pg8::cvt_pk_bf16(v1[2], v1[3]);
                    *(v4u*)(rowp + bj * 128) = w; } }
    }
};
struct EpiBr {
    static constexpr bool PERM = true, AMAP = false, MID = true;
    const bf16* G; bf16* MG;
    __device__ __forceinline__ void mid(f32x4 (&acc)[2][2][4][2], const Unit& u, int wr, int wc, int fr, int fq) const {
        int pm_ = u.pm, pn_ = u.pn; asm volatile("" : "+s"(pm_), "+s"(pn_));
        const int row0 = pm_ * 256 + wr * 64 + fr, col0 = pn_ * 256 + wc * 32 + 8 * fq;
#pragma unroll
        for (int ai = 0; ai < 2; ++ai)
#pragma unroll
            for (int m = 0; m < 4; ++m) { const size_t row = (size_t)(row0 + ai * 128 + m * 16);
#pragma unroll
                for (int bj = 0; bj < 2; ++bj) { const int col = col0 + bj * 128;
                    const v4u ga = *(const v4u*)(G + row * 2048 + col), gb = *(const v4u*)(G + row * 2048 + 1024 + col);
                    const float a_[8] = {bflo(ga.x), bfhi(ga.x), bflo(ga.y), bfhi(ga.y), bflo(ga.z), bfhi(ga.z), bflo(ga.w), bfhi(ga.w)};
                    const float b_[8] = {bflo(gb.x), bfhi(gb.x), bflo(gb.y), bfhi(gb.y), bflo(gb.z), bfhi(gb.z), bflo(gb.w), bfhi(gb.w)};
#pragma unroll
                    for (int e = 0; e < 4; ++e) { acc[ai][bj][m][0][e] *= a_[e] * __builtin_amdgcn_rcpf(fmaxf(b_[e], 1e-30f)); acc[ai][bj][m][1][e] *= a_[4 + e] * __builtin_amdgcn_rcpf(fmaxf(b_[4 + e], 1e-30f)); } } }
    }
    __device__ __forceinline__ void operator()(const f32x4 (&acc)[2][2][4][2], const Unit& u, int wr, int wc, int fr, int fq) const {
        const int row0 = u.pm * 256 + wr * 64 + fr, col0 = u.pn * 256 + wc * 32 + 8 * fq;
#pragma unroll
        for (int ai = 0; ai < 2; ++ai)
#pragma unroll
            for (int m = 0; m < 4; ++m) { const size_t row = (size_t)(row0 + ai * 128 + m * 16);
#pragma unroll
                for (int bj = 0; bj < 2; ++bj) { const int col = col0 + bj * 128;
                    const v4u gw = *(const v4u*)(G + row * 2048 + 1024 + col);
                    const f32x4 g0 = {bflo(gw.x), bfhi(gw.x), bflo(gw.y), bfhi(gw.y)}, g1 = {bflo(gw.z), bfhi(gw.z), bflo(gw.w), bfhi(gw.w)};
                    const f32x4 v0 = acc[ai][bj][m][0] * g0, v1 = acc[ai][bj][m][1] * g1;
                    v4u w; w.x = pg8::cvt_pk_bf16(v0[0], v0[1]); w.y = pg8::cvt_pk_bf16(v0[2], v0[3]); w.z = pg8::cvt_pk_bf16(v1[0], v1[1]); w.w = pg8::cvt_pk_bf16(v1[2], v1[3]);
                    *(v4u*)(MG + row * 1024 + col) = w; } }
    }
};
template <bool DOWN> struct EpiRes {
    static constexpr bool PERM = true, AMAP = false, MID = false;
    const float* xp; const float* xs; float* Y; bf16* XG2; const float* g2; float* SSQ;
    __device__ __forceinline__ void operator()(const f32x4 (&acc)[2][2][4][2], const Unit& u, int wr, int wc, int fr, int fq) const {
        const int row0 = u.pm * 256 + wr * 64 + fr, col0 = u.pn * 256 + wc * 32 + 8 * fq;
        const float* xb = DOWN ? (const float*)Y : (u.pm < STILE ? xp : xs - (size_t)MP * DM);
        f32x4 gg[2][2];
        if (!DOWN) {
#pragma unroll
            for (int bj = 0; bj < 2; ++bj) { gg[bj][0] = *(const f32x4*)(g2 + col0 + bj * 128); gg[bj][1] = *(const f32x4*)(g2 + col0 + bj * 128 + 4); } }
#pragma unroll
        for (int ai = 0; ai < 2; ++ai)
#pragma unroll
            for (int m = 0; m < 4; ++m) { const size_t row = (size_t)(row0 + ai * 128 + m * 16); float s = 0.f;
#pragma unroll
                for (int bj = 0; bj < 2; ++bj) { const size_t off = row * 1024 + col0 + bj * 128;
                    f32x4 v0 = acc[ai][bj][m][0] + *(const f32x4*)(xb + off), v1 = acc[ai][bj][m][1] + *(const f32x4*)(xb + off + 4);
                    *(f32x4*)(Y + off) = v0; *(f32x4*)(Y + off + 4) = v1;
                    s += (v0[0] * v0[0] + v0[1] * v0[1]) + (v0[2] * v0[2] + v0[3] * v0[3]) + (v1[0] * v1[0] + v1[1] * v1[1]) + (v1[2] * v1[2] + v1[3] * v1[3]);
                    if (!DOWN) { v0 *= gg[bj][0]; v1 *= gg[bj][1];
                        v4u w; w.x = pg8::cvt_pk_bf16(v0[0], v0[1]); w.y = pg8::cvt_pk_bf16(v0[2], v0[3]); w.z = pg8::cvt_pk_bf16(v1[0], v1[1]); w.w = pg8::cvt_pk_bf16(v1[2], v1[3]);
                        *(v4u*)(XG2 + off) = w; } }
                s += __shfl_xor(s, 16); s += __shfl_xor(s, 32);
                if (fq == 0) SSQ[row * 16 + u.pn * 4 + wc] = s; }
    }
};
struct EpiUp {
    static constexpr bool PERM = true, AMAP = true, MID = false;
    bf16* ACT; const float* cw; const float* cb; const float* stf; float* ofp; float* ofs; LAS unsigned char* lx; int pm0;
    __device__ __forceinline__ void operator()(const f32x4 (&acc)[2][2][4][2], const Unit& u, int wr, int wc, int fr, int fq) const {
        int pm_ = u.pm, pn_ = u.pn, fr_ = fr, fq_ = fq; asm volatile("" : "+s"(pm_), "+s"(pn_), "+v"(fr_), "+v"(fq_));
        const bool samp = (pm_ == STILE); const int j = pm_ - pm0;
        const LAS float* RS = (const LAS float*)(lx + RS_OFF) + j * 256 + 128 * wr + 8 * fr_;
        const f32x4 rsa = *(const LAS f32x4*)RS, rsb = *(const LAS f32x4*)(RS + 4);
        const float rs[8] = {rsa[0], rsa[1], rsa[2], rsa[3], rsb[0], rsb[1], rsb[2], rsb[3]};
        const int cbase = 32 * wc + 8 * fq_, gcol = 128 * pn_ + cbase;
        const LAS float* Ein = (const LAS float*)(lx + (wr == 0 ? (j == 0 ? EDGE_START_OFF : EDGE_PREV_OFF) : EDGE_MID_OFF));
        LAS float* Eout = (LAS float*)(lx + (wr == 0 ? EDGE_MID_OFF : EDGE_PREV_OFF));
        const int seq = samp ? (8 * wr + (fr_ >> 1)) : (pm_ >> 4);
        const bool lastp = (!samp) && ((pm_ & 15) == 15) && wr == 1 && fr_ == 15;
        bf16* ap = ACT + (size_t)(pm_ * 256 + 128 * wr + 8 * fr_) * DFF + gcol;
#pragma unroll
        for (int n = 0; n < 2; ++n) {
            f32x4 gc[8];
#pragma unroll
            for (int bj = 0; bj < 2; ++bj) {
                __builtin_amdgcn_sched_barrier(0);
                const int cc = bj * 128 + cbase + 4 * n, oc = bj * DFF + gcol + 4 * n;
                const f32x4 w0 = *(const f32x4*)(cw + oc), w1 = *(const f32x4*)(cw + DUP + oc), w2 = *(const f32x4*)(cw + 2 * DUP + oc), bb = *(const f32x4*)(cb + oc);
                f32x4 h[8];
#pragma unroll
                for (int q = 0; q < 8; ++q) h[q] = acc[q >> 2][bj][q & 3][n] * rs[q];
                f32x4 hm1, hm2;
#pragma unroll
                for (int e = 0; e < 4; ++e) { hm1[e] = __shfl_up(h[7][e], 1, 16); hm2[e] = __shfl_up(h[6][e], 1, 16); }
                if (!samp) {
                    if (fr_ == 0) { hm2 = *(const LAS f32x4*)(Ein + cc); hm1 = *(const LAS f32x4*)(Ein + 256 + cc); }
                    if (fr_ == 15) { *(LAS f32x4*)(Eout + cc) = h[6]; *(LAS f32x4*)(Eout + 256 + cc) = h[7]; }
                    if (lastp) { *(f32x4*)(ofp + (size_t)(seq * 2 + 0) * DUP + oc) = h[6]; *(f32x4*)(ofp + (size_t)(seq * 2 + 1) * DUP + oc) = h[7]; }
                } else {
                    if (!(fr_ & 1)) { hm2 = *(const f32x4*)(stf + (size_t)(seq * 2 + 0) * DUP + oc); hm1 = *(const f32x4*)(stf + (size_t)(seq * 2 + 1) * DUP + oc); }
                    else { *(f32x4*)(ofs + (size_t)(seq * 2 + 0) * DUP + oc) = h[6]; *(f32x4*)(ofs + (size_t)(seq * 2 + 1) * DUP + oc) = h[7]; }
                }
#pragma unroll
                for (int q = 0; q < 8; ++q) {
                    const f32x4 a2 = (q >= 2) ? h[q >= 2 ? q - 2 : 0] : (q == 1 ? hm1 : hm2);
                    const f32x4 a1 = (q >= 1) ? h[q >= 1 ? q - 1 : 0] : hm1;
                    const f32x4 c = bb + w0 * a2 + w1 * a1 + w2 * h[q];
                    if (bj == 0) gc[q] = c;
                    else { f32x4 a;
#pragma unroll
                        for (int e = 0; e < 4; ++e) a[e] = gelu_tanh(gc[q][e]) * c[e];
                        v2u w; w.x = pg8::cvt_pk_bf16(a[0], a[1]); w.y = pg8::cvt_pk_bf16(a[2], a[3]);
                        *(v2u*)(ap + (size_t)q * DFF + 4 * n) = w; }
                }
            }
        }
        LDS_WAIT();
    }
};
template <class RowMap>
__device__ __forceinline__ void p0_transpose_item(const float* W, int ldw, int k0, int n0, bf16* WT, size_t ldt, int kcol0, RowMap drow, const float* kscale, LAS float* scr, int lane) {
#pragma unroll 8
    for (int i = 0; i < 32; ++i) { const int kk = 2 * i + (lane >> 5); float v = W[(size_t)(k0 + kk) * ldw + n0 + (lane & 31)]; if (kscale) v *= kscale[k0 + kk]; scr[kk * 33 + (lane & 31)] = v; }
    LDS_WAIT(); asm volatile("" ::: "memory");
    const int c = lane & 7;
#pragma unroll
    for (int j = 0; j < 4; ++j) { const int n = (lane >> 3) + 8 * j; const LAS float* s = scr + (8 * c) * 33 + n;
        v4u o; o.x = pk2(s[0 * 33], s[1 * 33]); o.y = pk2(s[2 * 33], s[3 * 33]); o.z = pk2(s[4 * 33], s[5 * 33]); o.w = pk2(s[6 * 33], s[7 * 33]);
        *(v4u*)(WT + (size_t)drow(n0 + n) * ldt + kcol0 + k0 + 8 * c) = o; }
    LDS_WAIT(); asm volatile("" ::: "memory");
}
struct RowId { __device__ __forceinline__ int operator()(int n) const { return n; } };
struct RowUp { __device__ __forceinline__ int operator()(int n) const { const int half = n >= DFF ? 1 : 0, c = n - half * DFF; return (c >> 7) * 256 + half * 128 + (c & 127); } };

__device__ __forceinline__ void p0_prologue(const KP& p, LAS unsigned char* lds, int vcu, int G, int wave, int lane) {
    LAS float* scr = (LAS float*)(lds + wave * 16384);
    const int gw = vcu * NWAVES + wave, NGW = G * NWAVES;
    unsigned char* ws = p.ws;
    bf16* Win_t = (bf16*)(ws + WS_WIN); bf16* Wcat_t = (bf16*)(ws + WS_WCAT); bf16* Wout_t = (bf16*)(ws + WS_WOUT); bf16* Wup_t = (bf16*)(ws + WS_WUP); bf16* Wdn_t = (bf16*)(ws + WS_WDN); bf16* Wg_t = (bf16*)(ws + WS_WG);
    constexpr int I_IN = (DM / 64) * (DIN / 32), I_UP = (DM / 64) * (DUP / 32), I_SQ = (DM / 64) * (DM / 32), I_DN = (DFF / 64) * (DM / 32), I_G = 32 * 2;
    constexpr int NITEMS = I_IN + I_UP + 2 * I_SQ + I_DN + I_G;
    for (int it = gw; it < NITEMS; it += NGW) {
        int r = it;
        if (r < I_IN) { const int nblk = DIN / 32; p0_transpose_item(p.in[I_WIN], DIN, 64 * (r / nblk), 32 * (r % nblk), Win_t, DM, 0, RowId(), nullptr, scr, lane); continue; } r -= I_IN;
        if (r < I_UP) { const int nblk = DUP / 32; p0_transpose_item(p.in[I_WUP], DUP, 64 * (r / nblk), 32 * (r % nblk), Wup_t, DM, 0, RowUp(), nullptr, scr, lane); continue; } r -= I_UP;
        if (r < I_SQ) { const int nblk = DM / 32; p0_transpose_item(p.in[I_WBRL], DM, 64 * (r / nblk), 32 * (r % nblk), Wcat_t, 2048, 0, RowId(), nullptr, scr, lane); continue; } r -= I_SQ;
        if (r < I_SQ) { const int nblk = DM / 32; p0_transpose_item(p.in[I_WOUT], DM, 64 * (r / nblk), 32 * (r % nblk), Wout_t, DM, 0, RowId(), nullptr, scr, lane); continue; } r -= I_SQ;
        if (r < I_DN) { const int nblk = DM / 32; p0_transpose_item(p.in[I_WDN], DM, 64 * (r / nblk), 32 * (r % nblk), Wdn_t, DFF, 0, RowId(), nullptr, scr, lane); continue; } r -= I_DN;
        { const int mat = r >> 1, nb = r & 1; const float* W = (mat < 16 ? p.in[I_WRA] : p.in[I_WIX]) + (size_t)(mat & 15) * 4096;
          p0_transpose_item(W, 64, 0, 32 * nb, Wg_t + (size_t)mat * 4096, 64, 0, RowId(), nullptr, scr, lane); }
    }
    {
        const float* wpool = p.in[I_WPOOL]; const float* psc = p.in[I_PSCALE]; const float* wbp = p.in[I_WBRP];
        for (int it = gw; it < 4 * 32 * 16; it += NGW) {
            const int g = it >> 9, kc = (it >> 4) & 31, nc = it & 15; const int nn = nc * 64 + lane;
            float a[8];
#pragma unroll
            for (int i = 0; i < 8; ++i) a[i] = 0.f;
            const float* wp = wpool + (size_t)(g * 256 + kc * 8) * 256;
            for (int j = 0; j < 256; j += 4) {
                float b[4];
#pragma unroll
                for (int jj = 0; jj < 4; ++jj) b[jj] = wbp[(size_t)(256 * g + j + jj) * DM + nn] * psc[256 * g + j + jj];
#pragma unroll
                for (int i = 0; i < 8; ++i) { const f32x4 w = *(const f32x4*)(wp + i * 256 + j); a[i] += w[0] * b[0] + w[1] * b[1] + w[2] * b[2] + w[3] * b[3]; }
            }
            v4u o; o.x = pk2(a[0], a[1]); o.y = pk2(a[2], a[3]); o.z = pk2(a[4], a[5]); o.w = pk2(a[6], a[7]);
            *(v4u*)(Wcat_t + (size_t)nn * 2048 + 1024 + 256 * g + kc * 8) = o;
        }
    }
    {
        bf16* XN = (bf16*)(ws + WS_R0); const float* g1 = p.in[I_NMIX];
        f32x4 gv[4];
#pragma unroll
        for (int j = 0; j < 4; ++j) gv[j] = *((const f32x4*)g1 + lane + 64 * j);
        for (int m = gw; m < M; m += NGW) {
            const float* xrow = m < MP ? p.in[I_XP] + (size_t)m * DM : p.in[I_XS] + (size_t)(m - MP) * DM;
            const f32x4* xr = (const f32x4*)xrow + lane; f32x4 v[4]; float s = 0.f;
#pragma unroll
            for (int j = 0; j < 4; ++j) { v[j] = xr[64 * j]; s += (v[j][0] * v[j][0] + v[j][1] * v[j][1]) + (v[j][2] * v[j][2] + v[j][3] * v[j][3]); }
            const float rstd = 1.0f / sqrtf(wave_sum(s) * (1.f / DM) + EPS);
            v2u* o8 = (v2u*)(XN + (size_t)m * DM) + lane;
#pragma unroll
            for (int j = 0; j < 4; ++j) { const f32x4 y = v[j] * rstd * gv[j]; v2u o; o.x = pk2(y[0], y[1]); o.y = pk2(y[2], y[3]); o8[64 * j] = o; }
        }
    }
}

constexpr int XR_OFF = 0, XR_BYTES = 16 * 19 * 128, SEG_OFF = 40960, CIN_OFF = 45056;
template <bool FINAL>
__device__ __forceinline__ void lru_unit(const KP& p, LAS unsigned char* lds, int pm, int n, int tid, int lane, int wave) {
    const bool samp = (pm == STILE);
    if (samp && !FINAL) return;
    const bf16* ZR = (const bf16*)(p.ws + WS_R1); const bf16* Wg_t = (const bf16*)(p.ws + WS_WG);
    typedef float f32x2v __attribute__((ext_vector_type(2)));
    f32x2v* SUMM = (f32x2v*)(p.ws + WS_SUMM);
    bf16* HP = (bf16*)(p.ws + WS_R3);
    LAS unsigned char* XR = lds + XR_OFF; LAS f32x2v* SEG = (LAS f32x2v*)(lds + SEG_OFF); LAS float* CIN = (LAS float*)(lds + CIN_OFF);
    const int t0 = samp ? 0 : 256 * (pm & 15);
    __syncthreads();
    for (int idx = tid; idx < 304 * 8; idx += NWAVES * 64) {
        const int row = idx >> 3, ck = idx & 7, g = row / 19, k = row - g * 19, tt = 16 * g + k - 3;
        v4u v = {0u, 0u, 0u, 0u};
        if (!samp) { if (t0 + tt >= 0) v = *(const v4u*)(ZR + (size_t)(pm * 256 + tt) * 2048 + n * 64 + ck * 8); }
        else if (k < 3) { const float* s = p.in[I_STLC] + (size_t)(g * 3 + k) * DM + n * 64 + ck * 8; const f32x4 a = *(const f32x4*)s, b = *(const f32x4*)(s + 4);
            v.x = pk2(a[0], a[1]); v.y = pk2(a[2], a[3]); v.z = pk2(b[0], b[1]); v.w = pk2(b[2], b[3]); }
        else v = *(const v4u*)(ZR + (size_t)(MP + 16 * g + k - 3) * 2048 + n * 64 + ck * 8);
        *(LAS v4u*)(XR + row * 128 + ck * 16) = v;
    }
    if (FINAL && !samp && tid < 64) {
        const int npre = pm & 15; f32x2v sv[15];
#pragma unroll
        for (int k = 0; k < 15; ++k) sv[k] = (k < npre) ? SUMM[(size_t)(pm - npre + k) * DM + n * 64 + tid] : (f32x2v){1.f, 0.f};
        float c = 0.f;
#pragma unroll
        for (int k = 0; k < 15; ++k) c = sv[k].y + sv[k].x * c;
        CIN[tid] = c;
    }
    __syncthreads();
    const int i16 = lane & 15, fq = lane >> 4;
    const float* cwl = p.in[I_CLW]; const float* cbl = p.in[I_CLB];
    bf16x8 fa[2][2];
#pragma unroll
    for (int ks = 0; ks < 2; ++ks) {
        const int ch0 = 32 * ks + 8 * fq; f32x4 w[4][2], bb[2];
#pragma unroll
        for (int tp = 0; tp < 4; ++tp) { w[tp][0] = *(const f32x4*)(cwl + tp * DM + n * 64 + ch0); w[tp][1] = *(const f32x4*)(cwl + tp * DM + n * 64 + ch0 + 4); }
        bb[0] = *(const f32x4*)(cbl + n * 64 + ch0); bb[1] = *(const f32x4*)(cbl + n * 64 + ch0 + 4);
#pragma unroll
        for (int m = 0; m < 2; ++m) {
            const int tau = 8 * (i16 >> 2) + 4 * m + (i16 & 3), T = 32 * wave + tau, rb = (T >> 4) * 19 + (T & 15);
            f32x4 u0 = bb[0], u1 = bb[1];
#pragma unroll
            for (int tp = 0; tp < 4; ++tp) { const v4u x = *(const LAS v4u*)(XR + (rb + tp) * 128 + ch0 * 2);
                u0 += w[tp][0] * (f32x4){bflo(x.x), bfhi(x.x), bflo(x.y), bfhi(x.y)}; u1 += w[tp][1] * (f32x4){bflo(x.z), bfhi(x.z), bflo(x.w), bfhi(x.w)}; }
            v4u f; f.x = pk2(u0[0], u0[1]); f.y = pk2(u0[2], u0[3]); f.z = pk2(u1[0], u1[1]); f.w = pk2(u1[2], u1[3]);
            fa[m][ks] = __builtin_bit_cast(bf16x8, f);
        }
    }
    float hloc[4][8], pc[4][8], P8[4], H8[4];
    const int T0 = 32 * wave + 8 * fq, rb0 = (T0 >> 4) * 19 + (T0 & 15);
#pragma unroll
    for (int nb = 0; nb < 4; ++nb) {
        const int ch = 16 * nb + i16, gch = n * 64 + ch;
        f32x4 aR[2] = {{0.f, 0.f, 0.f, 0.f}, {0.f, 0.f, 0.f, 0.f}}, aI[2] = {{0.f, 0.f, 0.f, 0.f}, {0.f, 0.f, 0.f, 0.f}};
#pragma unroll
        for (int ks = 0; ks < 2; ++ks) {
            const bf16x8 bR = *(const bf16x8*)(Wg_t + (size_t)(n * 64 + ch) * 64 + 8 * fq + 32 * ks);
            const bf16x8 bI = *(const bf16x8*)(Wg_t + (size_t)((16 + n) * 64 + ch) * 64 + 8 * fq + 32 * ks);
#pragma unroll
            for (int m = 0; m < 2; ++m) { aR[m] = __builtin_amdgcn_mfma_f32_16x16x32_bf16(fa[m][ks], bR, aR[m], 0, 0, 0); aI[m] = __builtin_amdgcn_mfma_f32_16x16x32_bf16(fa[m][ks], bI, aI[m], 0, 0, 0); }
        }
        float x[11];
#pragma unroll
        for (int r = 0; r < 11; ++r) x[r] = __builtin_bit_cast(float, (unsigned)(*(const LAS unsigned short*)(XR + (rb0 + r) * 128 + ch * 2)) << 16);
        const float c0 = cwl[gch], c1 = cwl[DM + gch], c2 = cwl[2 * DM + gch], c3 = cwl[3 * DM + gch], cbv = cbl[gch];
        const float bra = p.in[I_BRA][gch], bix = p.in[I_BIX][gch], lam = p.in[I_LAM][gch];
        const float zz = -lam, sp = fmaxf(zz, 0.f) + log1pf(expf(-fabsf(zz))), c8 = -8.0f * sp;
        float hl = 0.f, P = 1.f;
#pragma unroll
        for (int q = 0; q < 8; ++q) {
            const float u = cbv + c0 * x[q] + c1 * x[q + 1] + c2 * x[q + 2] + c3 * x[q + 3];
            const float r = sigmoidf_fast(aR[q >> 2][q & 3] + bra), ig = sigmoidf_fast(aI[q >> 2][q & 3] + bix);
            const float la = r * c8, a = __builtin_amdgcn_exp2f(la * 1.4426950408889634f);
            const float x2 = 2.0f * la, em_small = -x2 * (1.0f + x2 * (0.5f + x2 * (0.16666667f + x2 * 0.041666668f))), em = (x2 > -0.05f) ? em_small : (1.0f - a * a);
            const float b = sqrtf(em) * ig * u;
            hl = a * hl + b; P = P * a;
            hloc[nb][q] = hl; pc[nb][q] = P;
        }
        P8[nb] = P; H8[nb] = hl;
    }
    float Pf[4][4], Hf[4][4];
#pragma unroll
    for (int nb = 0; nb < 4; ++nb)
#pragma unroll
        for (int f = 0; f < 4; ++f) { Pf[nb][f] = __shfl(P8[nb], i16 + 16 * f); Hf[nb][f] = __shfl(H8[nb], i16 + 16 * f); }
    if (!samp) {
        if (fq == 0) {
#pragma unroll
            for (int nb = 0; nb < 4; ++nb) { float hw = 0.f, pw = 1.f;
#pragma unroll
                for (int f = 0; f < 4; ++f) { hw = Hf[nb][f] + Pf[nb][f] * hw; pw *= Pf[nb][f]; }
                SEG[wave * 64 + 16 * nb + i16] = (f32x2v){pw, hw}; }
        }
        __syncthreads();
        if (!FINAL) {
            if (tid < 64) { float hu = 0.f, pu = 1.f;
#pragma unroll
                for (int w = 0; w < 8; ++w) { const f32x2v s = SEG[w * 64 + tid]; hu = s.y + s.x * hu; pu *= s.x; }
                SUMM[(size_t)pm * DM + n * 64 + tid] = (f32x2v){pu, hu}; }
            return;
        }
    }
#pragma unroll
    for (int nb = 0; nb < 4; ++nb) {
        const int ch = 16 * nb + i16, gch = n * 64 + ch;
        float c;
        if (!samp) {
            c = CIN[ch];
#pragma unroll
            for (int w = 0; w < 8; ++w) { const f32x2v s = SEG[w * 64 + ch]; if (w < wave) c = s.y + s.x * c; }
#pragma unroll
            for (int f = 0; f < 4; ++f) if (f < fq) c = Hf[nb][f] + Pf[nb][f] * c;
        } else {
            const int sq = 2 * wave + (fq >> 1);
            c = p.in[I_STH][(size_t)sq * DM + gch];
            if (fq & 1) { const float pp = (fq == 1) ? Pf[nb][0] : Pf[nb][2], hh = (fq == 1) ? Hf[nb][0] : Hf[nb][2]; c = hh + pp * c; }
        }
        bf16* hp = HP + (size_t)(pm * 256 + T0) * 2048 + gch; float hlast = 0.f;
#pragma unroll
        for (int q = 0; q < 8; ++q) { const float h = hloc[nb][q] + pc[nb][q] * c; hp[(size_t)q * 2048] = (bf16)f2bf(h); hlast = h; }
        if (!samp) { if ((pm & 15) == 15 && wave == 7 && fq == 3) p.out[OFF_HP + (size_t)(pm >> 4) * DM + gch] = hlast; }
        else if (fq & 1) p.out[OFF_HS + (size_t)(2 * wave + (fq >> 1)) * DM + gch] = hlast;
    }
}

constexpr int XL_BYTES = 33280, XL_SEG = 2 * XL_BYTES, XL_CW = XL_SEG + 4096;
__device__ __forceinline__ void lru_task(const KP& p, LAS unsigned char* lds, int s, int n, int hf, int tid, int lane, int wave) {
    const bf16* ZR = (const bf16*)(p.ws + WS_R1); const bf16* Wg_t = (const bf16*)(p.ws + WS_WG); bf16* HP = (bf16*)(p.ws + WS_R3);
    typedef float f32x2v __attribute__((ext_vector_type(2)));
    LAS f32x2v* SEG = (LAS f32x2v*)(lds + XL_SEG); LAS float* CW = (LAS float*)(lds + XL_CW);
    const int i16 = lane & 15, fq = lane >> 4;
    const float* cwl = p.in[I_CLW]; const float* cbl = p.in[I_CLB];
    const size_t rowbase = (size_t)s * SEQ;
    __syncthreads();
    if (tid < 320) { const int tp = tid >> 6, c = tid & 63; CW[tid] = tp < 4 ? cwl[tp * DM + n * 64 + c] : cbl[n * 64 + c]; }
    for (int idx = tid; idx < 259 * 8; idx += NWAVES * 64) { const int row = idx >> 3, ck = idx & 7; v4u v = {0u, 0u, 0u, 0u};
        if (row >= 3) v = *(const v4u*)(ZR + (rowbase + row - 3) * 2048 + n * 64 + ck * 8);
        *(LAS v4u*)(lds + row * 128 + ck * 16) = v; }
    bf16x8 bR[2][2], bI[2][2]; float c0[2], c1[2], c2[2], c3[2], cbv[2], bra[2], bix[2], c8[2], cin[2];
#pragma unroll
    for (int b2 = 0; b2 < 2; ++b2) { const int ch = 16 * (2 * hf + b2) + i16, gch = n * 64 + ch;
#pragma unroll
        for (int ks = 0; ks < 2; ++ks) { bR[b2][ks] = *(const bf16x8*)(Wg_t + (size_t)(n * 64 + ch) * 64 + 8 * fq + 32 * ks); bI[b2][ks] = *(const bf16x8*)(Wg_t + (size_t)((16 + n) * 64 + ch) * 64 + 8 * fq + 32 * ks); }
        c0[b2] = cwl[gch]; c1[b2] = cwl[DM + gch]; c2[b2] = cwl[2 * DM + gch]; c3[b2] = cwl[3 * DM + gch]; cbv[b2] = cbl[gch];
        bra[b2] = p.in[I_BRA][gch]; bix[b2] = p.in[I_BIX][gch];
        const float zz = -p.in[I_LAM][gch]; c8[b2] = -8.0f * (fmaxf(zz, 0.f) + log1pf(expf(-fabsf(zz)))) * 1.4426950408889634f;
        cin[b2] = 0.f; }
    __syncthreads();
    for (int tt = 0; tt < 16; ++tt) {
        LAS unsigned char* XR = lds + (tt & 1) * XL_BYTES; LAS unsigned char* XN_ = lds + ((tt + 1) & 1) * XL_BYTES;
        v4u pf[5];
        if (tt < 15) {
#pragma unroll
            for (int k = 0; k < 5; ++k) { const int idx = tid + k * (NWAVES * 64); if (idx < 259 * 8) pf[k] = *(const v4u*)(ZR + (rowbase + 256 * (tt + 1) - 3 + (idx >> 3)) * 2048 + n * 64 + (idx & 7) * 8); } }
        bf16x8 fa[2][2];
#pragma unroll
        for (int ks = 0; ks < 2; ++ks) { const int ch0 = 32 * ks + 8 * fq; f32x4 w[4][2], bb[2];
#pragma unroll
            for (int tp = 0; tp < 4; ++tp) { w[tp][0] = *(const LAS f32x4*)(CW + tp * 64 + ch0); w[tp][1] = *(const LAS f32x4*)(CW + tp * 64 + ch0 + 4); }
            bb[0] = *(const LAS f32x4*)(CW + 256 + ch0); bb[1] = *(const LAS f32x4*)(CW + 256 + ch0 + 4);
#pragma unroll
            for (int m = 0; m < 2; ++m) { const int rb = 32 * wave + 8 * (i16 >> 2) + 4 * m + (i16 & 3); f32x4 u0 = bb[0], u1 = bb[1];
#pragma unroll
                for (int tp = 0; tp < 4; ++tp) { const v4u x = *(const LAS v4u*)(XR + (rb + tp) * 128 + ch0 * 2);
                    u0 += w[tp][0] * (f32x4){bflo(x.x), bfhi(x.x), bflo(x.y), bfhi(x.y)}; u1 += w[tp][1] * (f32x4){bflo(x.z), bfhi(x.z), bflo(x.w), bfhi(x.w)}; }
                v4u f; f.x = pg8::cvt_pk_bf16(u0[0], u0[1]); f.y = pg8::cvt_pk_bf16(u0[2], u0[3]); f.z = pg8::cvt_pk_bf16(u1[0], u1[1]); f.w = pg8::cvt_pk_bf16(u1[2], u1[3]);
                fa[m][ks] = __builtin_bit_cast(bf16x8, f); } }
        float hloc[2][8], pc[2][8], P8[2], H8[2];
        const int rb0 = 32 * wave + 8 * fq;
#pragma unroll
        for (int b2 = 0; b2 < 2; ++b2) { const int ch = 16 * (2 * hf + b2) + i16;
            f32x4 aR[2] = {{0.f, 0.f, 0.f, 0.f}, {0.f, 0.f, 0.f, 0.f}}, aI[2] = {{0.f, 0.f, 0.f, 0.f}, {0.f, 0.f, 0.f, 0.f}};
#pragma unroll
            for (int ks = 0; ks < 2; ++ks)
#pragma unroll
                for (int m = 0; m < 2; ++m) { aR[m] = __builtin_amdgcn_mfma_f32_16x16x32_bf16(fa[m][ks], bR[b2][ks], aR[m], 0, 0, 0); aI[m] = __builtin_amdgcn_mfma_f32_16x16x32_bf16(fa[m][ks], bI[b2][ks], aI[m], 0, 0, 0); }
            float x[11];
#pragma unroll
            for (int r = 0; r < 11; ++r) x[r] = __builtin_bit_cast(float, (unsigned)(*(const LAS unsigned short*)(XR + (rb0 + r) * 128 + ch * 2)) << 16);
            float hl = 0.f, P = 1.f;
#pragma unroll
            for (int q = 0; q < 8; ++q) {
                const float u = cbv[b2] + c0[b2] * x[q] + c1[b2] * x[q + 1] + c2[b2] * x[q + 2] + c3[b2] * x[q + 3];
                const float r = sigmoidf_fast(aR[q >> 2][q & 3] + bra[b2]), ig = sigmoidf_fast(aI[q >> 2][q & 3] + bix[b2]);
                const float a = __builtin_amdgcn_exp2f(r * c8[b2]);
                const float b = __builtin_amdgcn_sqrtf(fmaxf(__builtin_fmaf(-a, a, 1.0f), 0.f)) * ig * u;
                hl = __builtin_fmaf(a, hl, b); P = P * a; hloc[b2][q] = hl; pc[b2][q] = P; }
            P8[b2] = P; H8[b2] = hl; }
        float Pf[2][4], Hf[2][4];
#pragma unroll
        for (int b2 = 0; b2 < 2; ++b2)
#pragma unroll
            for (int f = 0; f < 4; ++f) { Pf[b2][f] = __shfl(P8[b2], i16 + 16 * f); Hf[b2][f] = __shfl(H8[b2], i16 + 16 * f); }
        if (fq == 0) {
#pragma unroll
            for (int b2 = 0; b2 < 2; ++b2) { float hw = 0.f, pw = 1.f;
#pragma unroll
                for (int f = 0; f < 4; ++f) { hw = __builtin_fmaf(Pf[b2][f], hw, Hf[b2][f]); pw *= Pf[b2][f]; }
                SEG[(tt & 1) * 256 + wave * 32 + 16 * b2 + i16] = (f32x2v){pw, hw}; } }
        if (tt < 15) {
#pragma unroll
            for (int k = 0; k < 5; ++k) { const int idx = tid + k * (NWAVES * 64); if (idx < 259 * 8) *(LAS v4u*)(XN_ + (idx >> 3) * 128 + (idx & 7) * 16) = pf[k]; } }
        LDS_WAIT(); __syncthreads();
#pragma unroll
        for (int b2 = 0; b2 < 2; ++b2) { const int ch = 16 * (2 * hf + b2) + i16, gch = n * 64 + ch;
            float c = cin[b2], call = cin[b2];
#pragma unroll
            for (int w = 0; w < 8; ++w) { const f32x2v sg = SEG[(tt & 1) * 256 + w * 32 + 16 * b2 + i16]; call = __builtin_fmaf(sg.x, call, sg.y); if (w < wave) c = __builtin_fmaf(sg.x, c, sg.y); }
            cin[b2] = call;
#pragma unroll
            for (int f = 0; f < 4; ++f) if (f < fq) c = __builtin_fmaf(Pf[b2][f], c, Hf[b2][f]);
            bf16* hp = HP + (rowbase + 256 * tt + rb0) * 2048 + gch; float hlast = 0.f;
#pragma unroll
            for (int q = 0; q < 8; ++q) { const float h = __builtin_fmaf(pc[b2][q], c, hloc[b2][q]); hp[(size_t)q * 2048] = (bf16)f2bf(h); hlast = h; }
            if (tt == 15 && wave == 7 && fq == 3) p.out[OFF_HP + (size_t)s * DM + gch] = hlast; }
    }
}

__device__ __forceinline__ void pool_load8(const KP& p, const bf16* ZR, int pm, int tt, int run, int ch, float (&v)[8]) {
    const bool samp = (pm == STILE);
    if (!samp) {
        if (256 * (pm & 15) + tt < 0) {
#pragma unroll
            for (int e = 0; e < 8; ++e) v[e] = 0.f;
            return; }
        const v4u w = *(const v4u*)(ZR + (size_t)(pm * 256 + tt) * 2048 + 1024 + ch);
        v[0] = bflo(w.x); v[1] = bfhi(w.x); v[2] = bflo(w.y); v[3] = bfhi(w.y); v[4] = bflo(w.z); v[5] = bfhi(w.z); v[6] = bflo(w.w); v[7] = bfhi(w.w);
    } else {
        const int tl = tt - 16 * run;
        if (tl < 0) { const float* s = p.in[I_STPOOL] + (size_t)(run * 15 + 15 + tl) * DM + ch; const f32x4 a = *(const f32x4*)s, b = *(const f32x4*)(s + 4);
            v[0] = a[0]; v[1] = a[1]; v[2] = a[2]; v[3] = a[3]; v[4] = b[0]; v[5] = b[1]; v[6] = b[2]; v[7] = b[3]; }
        else { const v4u w = *(const v4u*)(ZR + (size_t)(MP + tt) * 2048 + 1024 + ch);
            v[0] = bflo(w.x); v[1] = bfhi(w.x); v[2] = bflo(w.y); v[3] = bfhi(w.y); v[4] = bflo(w.z); v[5] = bfhi(w.z); v[6] = bflo(w.w); v[7] = bfhi(w.w); }
    }
}
__device__ __forceinline__ void pool_unit(const KP& p, int pm, int g, int tid) {
    const bf16* ZR = (const bf16*)(p.ws + WS_R1); bf16* HP = (bf16*)(p.ws + WS_R3);
    const bool samp = (pm == STILE);
    const int oct = tid & 31, run = tid >> 5, ch = 256 * g + 8 * oct, w = 2 << g, tf = 16 * run;
    const int pos0 = samp ? PAST : 256 * (pm & 15) + tf;
    float s[8];
#pragma unroll
    for (int e = 0; e < 8; ++e) s[e] = 0.f;
    for (int k = 1; k < w; ++k) { float v[8]; pool_load8(p, ZR, pm, tf - k, run, ch, v);
#pragma unroll
        for (int e = 0; e < 8; ++e) s[e] += v[e]; }
    for (int i = 0; i < 16; ++i) {
        float v[8], o[8]; pool_load8(p, ZR, pm, tf + i, run, ch, v);
        const int cnt = min(pos0 + i + 1, w); const float inv = 1.0f / (float)cnt;
#pragma unroll
        for (int e = 0; e < 8; ++e) { s[e] += v[e]; o[e] = s[e] * inv - v[e]; }
        v4u ow; ow.x = pk2(o[0], o[1]); ow.y = pk2(o[2], o[3]); ow.z = pk2(o[4], o[5]); ow.w = pk2(o[6], o[7]);
        *(v4u*)(HP + (size_t)(pm * 256 + tf + i) * 2048 + 1024 + ch) = ow;
        float vo[8]; pool_load8(p, ZR, pm, tf + i - w + 1, run, ch, vo);
#pragma unroll
        for (int e = 0; e < 8; ++e) s[e] -= vo[e];
    }
}
__device__ __forceinline__ void state_copy(const KP& p, int gtid, int gthreads) {
    const bf16* ZR = (const bf16*)(p.ws + WS_R1);
    constexpr int N1 = NBATCH * 3 * DM, N2 = NBATCH * 15 * DM, N3 = SBATCH * 3 * DM, N4 = SBATCH * 15 * DM;
    for (int i = gtid; i < N1 + N2 + N3 + N4; i += gthreads) {
        int r = i; size_t row, col; float* dst;
        if (r < N1) { const int b = r / (3 * DM), k = (r / DM) % 3, c = r % DM; row = (size_t)b * SEQ + SEQ - 3 + k; col = c; dst = p.out + OFF_LCP + r; }
        else if ((r -= N1) < N2) { const int b = r / (15 * DM), k = (r / DM) % 15, c = r % DM; row = (size_t)b * SEQ + SEQ - 15 + k; col = 1024 + c; dst = p.out + OFF_PLP + r; }
        else if ((r -= N2) < N3) { const int b = r / (3 * DM), k = (r / DM) % 3, c = r % DM; row = (size_t)MP + b * SSEQ + SSEQ - 3 + k; col = c; dst = p.out + OFF_LCS + r; }
        else { r -= N3; const int b = r / (15 * DM), k = (r / DM) % 15, c = r % DM; row = (size_t)MP + b * SSEQ + SSEQ - 15 + k; col = 1024 + c; dst = p.out + OFF_PLS + r; }
        *dst = __builtin_bit_cast(float, (unsigned)ZR[row * 2048 + col] << 16);
    }
}

__device__ __forceinline__ void strip_pre(const KP& p, LAS unsigned char* lds, int pm0, int pn, int cnt, int tid, int lane, int wave) {
    const float* SSQ = (const float*)(p.ws + WS_SSQ); const bf16* XG2 = (const bf16*)(p.ws + WS_R1); const bf16* Wup_t = (const bf16*)(p.ws + WS_WUP);
    LAS float* RS = (LAS float*)(lds + RS_OFF); LAS float* ES = (LAS float*)(lds + EDGE_START_OFF);
    __syncthreads();
    for (int i = tid; i < cnt * 256; i += NWAVES * 64) { const f32x4* q = (const f32x4*)(SSQ + (size_t)(pm0 * 256 + i) * 16); const f32x4 a = q[0], b = q[1], c = q[2], d = q[3];
        const float s = ((a[0] + a[1]) + (a[2] + a[3])) + ((b[0] + b[1]) + (b[2] + b[3])) + ((c[0] + c[1]) + (c[2] + c[3])) + ((d[0] + d[1]) + (d[2] + d[3]));
        RS[i] = 1.0f / sqrtf(s * (1.f / DM) + EPS); }
    if (pm0 != STILE && (pm0 & 15) != 0) {
        float xa[2][16], rsh[2];
#pragma unroll
        for (int r = 0; r < 2; ++r) { const size_t row = (size_t)pm0 * 256 - 2 + r;
            const v4u w0 = *(const v4u*)(XG2 + row * DM + 16 * lane), w1 = *(const v4u*)(XG2 + row * DM + 16 * lane + 8);
            xa[r][0] = bflo(w0.x); xa[r][1] = bfhi(w0.x); xa[r][2] = bflo(w0.y); xa[r][3] = bfhi(w0.y); xa[r][4] = bflo(w0.z); xa[r][5] = bfhi(w0.z); xa[r][6] = bflo(w0.w); xa[r][7] = bfhi(w0.w);
            xa[r][8] = bflo(w1.x); xa[r][9] = bfhi(w1.x); xa[r][10] = bflo(w1.y); xa[r][11] = bfhi(w1.y); xa[r][12] = bflo(w1.z); xa[r][13] = bfhi(w1.z); xa[r][14] = bflo(w1.w); xa[r][15] = bfhi(w1.w);
            const f32x4* q = (const f32x4*)(SSQ + row * 16); const f32x4 a = q[0], b = q[1], c = q[2], d = q[3];
            const float s = ((a[0] + a[1]) + (a[2] + a[3])) + ((b[0] + b[1]) + (b[2] + b[3])) + ((c[0] + c[1]) + (c[2] + c[3])) + ((d[0] + d[1]) + (d[2] + d[3]));
            rsh[r] = 1.0f / sqrtf(s * (1.f / DM) + EPS); }
        for (int c = 0; c < 32; ++c) { const int tc = 32 * wave + c; const bf16* wr_ = Wup_t + (size_t)(256 * pn + tc) * DM + 16 * lane;
            const v4u w0 = *(const v4u*)wr_, w1 = *(const v4u*)(wr_ + 8);
            const float wv[16] = {bflo(w0.x), bfhi(w0.x), bflo(w0.y), bfhi(w0.y), bflo(w0.z), bfhi(w0.z), bflo(w0.w), bfhi(w0.w), bflo(w1.x), bfhi(w1.x), bflo(w1.y), bfhi(w1.y), bflo(w1.z), bfhi(w1.z), bflo(w1.w), bfhi(w1.w)};
            float p0 = 0.f, p1 = 0.f;
#pragma unroll
            for (int e = 0; e < 16; ++e) { p0 += xa[0][e] * wv[e]; p1 += xa[1][e] * wv[e]; }
            p0 = wave_sum(p0); p1 = wave_sum(p1);
            if (lane == 0) { ES[tc] = p0 * rsh[0]; ES[256 + tc] = p1 * rsh[1]; } }
    } else { ES[tid] = 0.f; }
    __syncthreads();
}

__device__ __forceinline__ void final_norm(const KP& p, int gw, int NGW, int lane) {
    const float* SSQ2 = (const float*)(p.ws + WS_SSQ2); const float* gf = p.in[I_NFIN];
    f32x4 gv[4];
#pragma unroll
    for (int j = 0; j < 4; ++j) gv[j] = *((const f32x4*)gf + lane + 64 * j);
    for (int m = gw; m < M; m += NGW) {
        const float sv = (lane < 16) ? SSQ2[(size_t)m * 16 + lane] : 0.f;
        const float rstd = 1.0f / sqrtf(wave_sum(sv) * (1.f / DM) + EPS);
        f32x4* yr = (f32x4*)(p.out + OFF_Y + (size_t)m * DM) + lane;
#pragma unroll
        for (int j = 0; j < 4; ++j) { const f32x4 v = yr[64 * j]; yr[64 * j] = v * rstd * gv[j]; }
    }
}
#ifndef MK_ONE_LAUNCH
#define MK_ONE_LAUNCH 1
#endif
#ifndef PG8_SP2
#define PG8_SP2 false
#endif
constexpr int N_PHASES = 10;
__global__ void __launch_bounds__(NWAVES * 64, 2) mk_fwd(KP p) {
    extern __shared__ __attribute__((aligned(16))) unsigned char lds_raw[];
    LAS unsigned char* lds = (LAS unsigned char*)lds_raw;
    const int tid = threadIdx.x, lane = tid & 63, wave = __builtin_amdgcn_readfirstlane(tid >> 6);
    const int G = gridDim.x, bx = blockIdx.x, vcu = (G % 8 == 0) ? (bx % 8) * (G / 8) + bx / 8 : bx;
    volatile LAS unsigned* MISC = (volatile LAS unsigned*)(lds + MISC_OFF);
    if (tid < 32) MISC[tid] = 0u;
    __syncthreads();
    unsigned* ctl = (unsigned*)(p.ws + WS_CTL);
    const int lo = p.ph_lo, hi = p.ph_hi;
    XcdBarrier bar; bar.bar = ctl + CW_BAR; bar.x = 0; bar.st = MISC + 8;
    if (hi - lo > 1) bar = xcd_barrier_post(ctl + CW_BAR, MISC + 8);
#ifndef PH_MASK
#define PH_MASK 0x3ff
#endif
#define IN(k) (((PH_MASK >> (k)) & 1) && lo <= (k) && (k) < hi)
#ifndef REP_MASK
#define REP_MASK 0
#endif
#define PH(k) if (IN(k)) for (int rep_ = 0; rep_ <= ((REP_MASK >> (k)) & 1); ++rep_)
#define REPBAR() do { if (rep_) xcd_barrier(bar); } while (0)
#define SEAM(k) do { if (IN(k) && IN((k) + 1)) xcd_barrier(bar); } while (0)
    unsigned char* ws = p.ws;
    bf16* XN = (bf16*)(ws + WS_R0); bf16* MG = (bf16*)(ws + WS_R0); bf16* ZR = (bf16*)(ws + WS_R1); bf16* XG2 = (bf16*)(ws + WS_R1);
    bf16* GT = (bf16*)(ws + WS_R2); bf16* HP = (bf16*)(ws + WS_R3); bf16* ACT = (bf16*)(ws + WS_R2);
    bf16* Win_t = (bf16*)(ws + WS_WIN); bf16* Wcat_t = (bf16*)(ws + WS_WCAT); bf16* Wout_t = (bf16*)(ws + WS_WOUT); bf16* Wup_t = (bf16*)(ws + WS_WUP); bf16* Wdn_t = (bf16*)(ws + WS_WDN);
    float* SSQ = (float*)(ws + WS_SSQ); float* SSQ2 = (float*)(ws + WS_SSQ2);
    float* Y = p.out + OFF_Y;

    PH(0) { REPBAR(); p0_prologue(p, lds, vcu, G, wave, lane); }
    SEAM(0);
    PH(1) { REPBAR();
        pg8::Gemm g{XN, Win_t, DM, DM, DM}; pg8::StaticOrder S; S.init(M, DIN, G, bx);
        EpiZ E{ZR, GT};
        pg8::gemm_phase<EpiZ, pg8::StaticOrder, false, PG8_SP2>(lds, g, S, E);
    }
    SEAM(1);
    PH(2) { REPBAR();
        state_copy(p, bx * NWAVES * 64 + tid, G * NWAVES * 64);
        for (int t = bx; t < NBATCH * 32; t += G) lru_task(p, lds, t >> 5, (t >> 1) & 15, t & 1, tid, lane, wave);
        for (int L = bx; L < 16 + NTILE * 4; L += G) {
            if (L < 16) lru_unit<true>(p, lds, STILE, L, tid, lane, wave);
            else { const int r = L - 16; pool_unit(p, r >> 2, r & 3, tid); }
        }
    }
    if (IN(2) && IN(4)) xcd_barrier(bar);
    PH(4) { REPBAR();
        pg8::Gemm g{HP, Wcat_t, 2048, 2048, 2048}; pg8::StaticOrder S; S.init(M, DM, G, bx);
        EpiBr E{GT, MG};
        pg8::gemm_phase<EpiBr, pg8::StaticOrder, false, PG8_SP2>(lds, g, S, E);
    }
    if (IN(4) && IN(6)) xcd_barrier(bar);
    PH(6) { REPBAR();
        pg8::Gemm g{MG, Wout_t, DM, DM, DM}; pg8::StaticOrder S; S.init(M, DM, G, bx);
        EpiRes<false> E{p.in[I_XP], p.in[I_XS], Y, XG2, p.in[I_NFFN], SSQ};
        pg8::gemm_phase<EpiRes<false>, pg8::StaticOrder, false, PG8_SP2>(lds, g, S, E);
    }
    SEAM(6);
    PH(7) { REPBAR();
        pg8::Gemm g{XG2, Wup_t, DM, DM, DM};
        for (int sidx = vcu; sidx < 768 + 24; sidx += G) {
            int pm0, pn, cnt;
            if (sidx < 768) { const int rg = sidx >> 8, v = sidx & 255, x = v >> 5, w = v & 31; pm0 = 4 * (4 * x + (w >> 3)); pn = 8 * rg + (w & 7); cnt = 4; }
            else { pm0 = STILE; pn = sidx - 768; cnt = 1; }
            strip_pre(p, lds, pm0, pn, cnt, tid, lane, wave);
            pg8::StripOrder S{pm0, pn, cnt};
            EpiUp E{ACT, p.in[I_CFW], p.in[I_CFB], p.in[I_STFFN], p.out + OFF_FCP, p.out + OFF_FCS, lds, pm0};
            pg8::gemm_phase<EpiUp, pg8::StripOrder, false, PG8_SP2>(lds, g, S, E);
        }
    }
    SEAM(7);
    PH(8) { REPBAR();
        pg8::Gemm g{ACT, Wdn_t, DFF, DFF, DFF}; pg8::StaticOrder S; S.init(M, DM, G, bx);
        EpiRes<true> E{nullptr, nullptr, Y, nullptr, nullptr, SSQ2};
        pg8::gemm_phase<EpiRes<true>, pg8::StaticOrder, false, PG8_SP2>(lds, g, S, E);
    }
    SEAM(8);
    PH(9) { REPBAR(); final_norm(p, vcu * NWAVES + wave, G * NWAVES, lane); }
#undef IN
#undef SEAM
}

extern "C" void kernel_launch(void* const* d_in, const int* in_sizes, int n_in, void* d_out, int out_size, void* d_ws, size_t ws_size, hipStream_t stream) {
    static int grid = 0;
    if (grid == 0) {
        if (n_in != 26 || in_sizes[0] != MP * DM || (size_t)out_size != OUT_TOTAL || ws_size < WS_END) {
            fprintf(stderr, "kernel_launch: unexpected shapes: n_in %d in0 %d out %d ws %zu (need %zu)\n", n_in, n_in > 0 ? in_sizes[0] : -1, out_size, ws_size, (size_t)WS_END); grid = -1; return; }
        int dev = 0, cus = 0, per_cu = 0;
        if (hipGetDevice(&dev) != hipSuccess || hipDeviceGetAttribute(&cus, hipDeviceAttributeMultiprocessorCount, dev) != hipSuccess) { fprintf(stderr, "kernel_launch: device query failed\n"); grid = -1; return; }
        if (hipFuncSetAttribute((const void*)mk_fwd, hipFuncAttributeMaxDynamicSharedMemorySize, LDS_BYTES) != hipSuccess) { fprintf(stderr, "kernel_launch: hipFuncSetAttribute failed\n"); grid = -1; return; }
        if (hipOccupancyMaxActiveBlocksPerMultiprocessor(&per_cu, (const void*)mk_fwd, NWAVES * 64, LDS_BYTES) != hipSuccess || per_cu < 1) {
            fprintf(stderr, "kernel_launch: occupancy query reports %d blocks per CU\n", per_cu); (void)hipGetLastError(); per_cu = 1; }
        grid = cus;
        fprintf(stderr, "kernel_launch: grid %d (cus %d, occupancy %d/CU)\n", grid, cus, per_cu);
    }
    if (grid < 0) return;
    if (hipMemsetAsync((char*)d_ws + WS_CTL, 0, CTL_ZERO_BYTES, stream) != hipSuccess) { fprintf(stderr, "kernel_launch: memset failed\n"); return; }
    KP a{};
    for (int i = 0; i < 26; ++i) a.in[i] = (const float*)d_in[i];
    a.out = (float*)d_out; a.ws = (unsigned char*)d_ws;
#if MK_ONE_LAUNCH
    a.ph_lo = 0; a.ph_hi = N_PHASES;
    hipLaunchKernelGGL(mk_fwd, dim3(grid), dim3(NWAVES * 64), LDS_BYTES, stream, a);
#else
    for (int k = 0; k < N_PHASES; ++k) { a.ph_lo = k; a.ph_hi = k + 1; hipLaunchKernelGGL(mk_fwd, dim3(grid), dim3(NWAVES * 64), LDS_BYTES, stream, a); }
#endif
    const hipError_t le = hipPeekAtLastError();
    if (le != hipSuccess) fprintf(stderr, "kernel_launch: launch failed: %s\n", hipGetErrorName(le));
}
```

```cpp
#include <hip/hip_runtime.h>
#include <cstdio>
#include <cstdint>
#define MK_ONE_LAUNCH 1
namespace pg8 {
#define PG8_LAS __attribute__((address_space(3)))
typedef unsigned short bf16_t;
typedef short bf16x8 __attribute__((ext_vector_type(8)));
typedef float f32x4 __attribute__((ext_vector_type(4)));
typedef unsigned u32x4 __attribute__((ext_vector_type(4)));
typedef unsigned u32x2 __attribute__((ext_vector_type(2)));
constexpr int BM = 256, BK = 64, HALF = 128, HTB = HALF * BK * 2  , STAGE_BYTES = 8 * HTB, NXCD = 8, WGM = 8;

__host__ __device__ __forceinline__ int lds_byte(int r, int c) { const int st = (r >> 4) * 2 + (c >> 5), rr = r & 15, cc = c & 31, ob = rr * 64 + cc * 2; return st * 1024 + (ob ^ (((ob >> 9) & 1) << 5)); }
__host__ __device__ __forceinline__ void stage_rc(int b, int& R, int& C) { const int st = b / 1024, sb = b % 1024, swz = sb ^ (((sb >> 9) & 1) << 5); R = (st >> 1) * 16 + swz / 64; C = (st & 1) * 32 + (swz % 64) / 2; }
__host__ __device__ __forceinline__ int perm32(int rho) { const int n = rho >> 4, i = rho & 15; return 8 * (i >> 2) + 4 * n + (i & 3); }
__host__ __device__ __forceinline__ int amap_row(int R) { return 128 * (R >> 6) + 8 * (R & 15) + ((R >> 4) & 3); }

struct Unit { int pm, pn; };
struct Gemm { const bf16_t* A; const bf16_t* Bt; int K, lda, ldb; };

struct StaticOrder {
    int nM, nN, nwg, G, c;
    __host__ __device__ void init(int M, int N, int G_, int c_) { nM = M / BM; nN = N / BM; nwg = nM * nN; G = G_; c = c_; }
    __host__ __device__ bool next(int i, Unit& u) const {
        const long L = (long)i * G + c; if (L >= nwg) return false;
        int wgid = (int)L; { const int q = nwg / NXCD, r = nwg % NXCD, xcd = wgid % NXCD, off = wgid / NXCD; wgid = (xcd < r ? xcd * (q + 1) : r * (q + 1) + (xcd - r) * q) + off; }
        const int nig = WGM * nN, gid = wgid / nig, fm = gid * WGM, gsz = (nM - fm) < WGM ? (nM - fm) : WGM;
        u.pm = fm + ((wgid % nig) % gsz); u.pn = (wgid % nig) / gsz; return true;
    }
    __device__ __forceinline__ void a_ready(const Unit&) const {}
    __device__ __forceinline__ void done(const Unit&) const {}
};
struct StripOrder {
    int pm0, pn, cnt;
    __device__ __forceinline__ bool next(int i, Unit& u) const { if (i >= cnt) return false; u.pm = pm0 + i; u.pn = pn; return true; }
    __device__ __forceinline__ void a_ready(const Unit&) const {}
    __device__ __forceinline__ void done(const Unit&) const {}
};

__device__ __forceinline__ unsigned cvt_pk_bf16(float lo, float hi) { unsigned r; asm volatile("v_cvt_pk_bf16_f32 %0, %1, %2" : "=v"(r) : "v"(lo), "v"(hi)); return r; }

template <class Epi, class Sched, bool ALIGN_EPI = false, bool SP2 = false>
__device__ __forceinline__ void gemm_phase(PG8_LAS unsigned char* lds, const Gemm g, const Sched& S, const Epi& E) {
    const int tid = threadIdx.x, wid = __builtin_amdgcn_readfirstlane(tid >> 6), lane = tid & 63, wr = wid >> 2, wc = wid & 3, fr = lane & 15, fq = lane >> 4;
    const int K = g.K, nt = K / BK;
    unsigned voffA[2], voffB[2];
#pragma unroll
    for (int i = 0; i < 2; ++i) { int R, C; stage_rc(tid * 16 + i * 8192, R, C); const int Rb = Epi::PERM ? ((R & ~31) + perm32(R & 31)) : R; const int Ra = Epi::AMAP ? amap_row(R) : R;
        voffA[i] = (unsigned)(Ra * g.lda + C) * 2u; voffB[i] = (unsigned)(Rb * g.ldb + C) * 2u; }
    const size_t kstep = (size_t)(BK * 2);
    const size_t hstepA = Epi::AMAP ? (size_t)4 * g.lda * 2 : (size_t)HALF * g.lda * 2;
    const size_t hstepB = (size_t)HALF * g.ldb * 2;
    const size_t tstepA = (size_t)BM * g.lda * 2, tstepB = (size_t)BM * g.ldb * 2;
    const unsigned ldsw = (unsigned)wid * 1024u;
    const int aoff = lds_byte(wr * 64 + fr, fq * 8), boff = lds_byte(wc * 32 + fr, fq * 8);
#define PG8_SA(b, h) (((b) * 2 + (h)) * HTB)
#define PG8_SB(b, h) ((4 + (b) * 2 + (h)) * HTB)
#define PG8_STAGE(bufoff, gbase, voff) do { _Pragma("unroll") for (int _i = 0; _i < 2; ++_i) \
        __builtin_amdgcn_global_load_lds((const unsigned*)((const char*)(gbase) + (voff)[_i]), (PG8_LAS unsigned*)(lds + (bufoff) + ldsw + _i * 8192), 16, 0, 0); } while (0)
#define PG8_LDA(dst, b, h) do { _Pragma("unroll") for (int m = 0; m < 4; ++m) _Pragma("unroll") for (int k = 0; k < 2; ++k) dst[m][k] = *(const PG8_LAS bf16x8*)(lds + PG8_SA(b, h) + aoff + m * 2048 + k * 1024); } while (0)
#define PG8_LDB(dst, b, h) do { _Pragma("unroll") for (int n = 0; n < 2; ++n) _Pragma("unroll") for (int k = 0; k < 2; ++k) dst[n][k] = *(const PG8_LAS bf16x8*)(lds + PG8_SB(b, h) + boff + n * 2048 + k * 1024); } while (0)
#define PG8_MMA(ai, bj, At, Bt) do { __builtin_amdgcn_s_setprio(1); _Pragma("unroll") for (int m = 0; m < 4; ++m) _Pragma("unroll") for (int n = 0; n < 2; ++n) _Pragma("unroll") for (int k = 0; k < 2; ++k) \
        acc[ai][bj][m][n] = __builtin_amdgcn_mfma_f32_16x16x32_bf16(Bt[n][k], At[m][k], acc[ai][bj][m][n], 0, 0, 0); __builtin_amdgcn_s_setprio(0); } while (0)
#define PG8_WAIT_V(n) asm volatile("s_waitcnt vmcnt(" #n ")" ::: "memory")
#define PG8_WAIT_L(n) asm volatile("s_waitcnt lgkmcnt(" #n ")" ::: "memory")
#define PG8_BAR __builtin_amdgcn_s_barrier()
#define PG8_SCHED __builtin_amdgcn_sched_barrier(0)
    Unit cur, nxt; int ui = 0;
    if (!S.next(0, cur)) return;
    f32x4 acc[2][2][4][2];
#pragma unroll
    for (int a = 0; a < 2; ++a)
#pragma unroll
        for (int b = 0; b < 2; ++b)
#pragma unroll
            for (int m = 0; m < 4; ++m)
#pragma unroll
                for (int n = 0; n < 2; ++n) acc[a][b][m][n] = (f32x4){0.f, 0.f, 0.f, 0.f};
    bf16x8 At[4][2], B0[2][2], B1[2][2];
    const char* cA = (const char*)g.A + (size_t)cur.pm * tstepA; const char* cB = (const char*)g.Bt + (size_t)cur.pn * tstepB;
    S.a_ready(cur);
    if constexpr (SP2) {
        PG8_STAGE(PG8_SB(0, 0), cB, voffB); PG8_STAGE(PG8_SB(0, 1), cB + hstepB, voffB); PG8_STAGE(PG8_SA(0, 0), cA, voffA); PG8_STAGE(PG8_SA(0, 1), cA + hstepA, voffA);
        if (wr == 1) PG8_BAR;
        PG8_WAIT_V(2); PG8_BAR;
        PG8_STAGE(PG8_SB(1, 0), cB + kstep, voffB); PG8_STAGE(PG8_SA(1, 0), cA + kstep, voffA); PG8_STAGE(PG8_SB(1, 1), cB + hstepB + kstep, voffB);
        PG8_WAIT_V(6); PG8_BAR;
    } else {
        PG8_STAGE(PG8_SB(0, 0), cB, voffB); PG8_STAGE(PG8_SA(0, 0), cA, voffA); PG8_STAGE(PG8_SB(0, 1), cB + hstepB, voffB); PG8_STAGE(PG8_SA(0, 1), cA + hstepA, voffA);
        if (wr == 1) PG8_BAR;
        PG8_WAIT_V(4); PG8_BAR;
        PG8_STAGE(PG8_SB(1, 0), cB + kstep, voffB); PG8_STAGE(PG8_SA(1, 0), cA + kstep, voffA); PG8_STAGE(PG8_SB(1, 1), cB + hstepB + kstep, voffB);
        PG8_WAIT_V(6); PG8_BAR;
    }
    for (;;) {
        const bool has_next = S.next(ui + 1, nxt);
        const char* nA = has_next ? (const char*)g.A + (size_t)nxt.pm * tstepA : cA; const char* nB = has_next ? (const char*)g.Bt + (size_t)nxt.pn * tstepB : cB;
        for (int t = 0; t < nt; t += 2) {
            const bool last = (t == nt - 2);
            const char* a1 = cA + (size_t)(t + 1) * kstep;
            const char* a2 = last ? nA : cA + (size_t)(t + 2) * kstep; const char* b2 = last ? nB : cB + (size_t)(t + 2) * kstep;
            const char* a3 = a2 + kstep; const char* b3 = b2 + kstep;
            if (last && has_next) S.a_ready(nxt);
            if constexpr (Epi::MID) { if (t == (nt >> 1)) E.template mid<2, 2>(acc, cur, 0, 0, wr, wc, fr, fq); }
            if constexpr (SP2) {
            PG8_LDB(B0, 0, 0); PG8_LDB(B1, 0, 1); PG8_SCHED; PG8_LDA(At, 0, 0); PG8_STAGE(PG8_SA(1, 1), a1 + hstepA, voffA);
            PG8_WAIT_V(8); PG8_WAIT_L(0); PG8_BAR; PG8_MMA(0, 0, At, B0); PG8_MMA(0, 1, At, B1); PG8_BAR; PG8_SCHED;
            PG8_LDA(At, 0, 1); PG8_STAGE(PG8_SB(0, 0), b2, voffB); PG8_STAGE(PG8_SB(0, 1), b2 + hstepB, voffB); PG8_STAGE(PG8_SA(0, 0), a2, voffA);
            PG8_WAIT_V(8); PG8_WAIT_L(0); PG8_BAR; PG8_MMA(1, 0, At, B0); PG8_MMA(1, 1, At, B1); PG8_BAR; PG8_SCHED;
            PG8_LDB(B0, 1, 0); PG8_LDB(B1, 1, 1); PG8_SCHED; PG8_LDA(At, 1, 0); PG8_STAGE(PG8_SA(0, 1), a2 + hstepA, voffA);
            PG8_WAIT_V(8); PG8_WAIT_L(0); PG8_BAR; PG8_MMA(0, 0, At, B0); PG8_MMA(0, 1, At, B1); PG8_BAR; PG8_SCHED;
            PG8_LDA(At, 1, 1); PG8_STAGE(PG8_SB(1, 0), b3, voffB); PG8_STAGE(PG8_SB(1, 1), b3 + hstepB, voffB); PG8_STAGE(PG8_SA(1, 0), a3, voffA);
            PG8_WAIT_V(8); PG8_WAIT_L(0); PG8_BAR; PG8_MMA(1, 0, At, B0); PG8_MMA(1, 1, At, B1); PG8_BAR; PG8_SCHED;
            } else {
            PG8_LDB(B0, 0, 0); PG8_SCHED; PG8_LDA(At, 0, 0); PG8_STAGE(PG8_SA(1, 1), a1 + hstepA, voffA);
            PG8_WAIT_L(8); PG8_BAR; PG8_WAIT_L(0); PG8_MMA(0, 0, At, B0); PG8_BAR; PG8_SCHED;
            PG8_LDB(B1, 0, 1); PG8_STAGE(PG8_SB(0, 0), b2, voffB);
            PG8_BAR; PG8_WAIT_L(0); PG8_MMA(0, 1, At, B1); PG8_BAR;
            PG8_LDA(At, 0, 1); PG8_STAGE(PG8_SA(0, 0), a2, voffA);
            PG8_BAR; PG8_WAIT_L(0); PG8_MMA(1, 0, At, B0); PG8_BAR; PG8_SCHED;
            PG8_STAGE(PG8_SB(0, 1), b2 + hstepB, voffB);
            PG8_WAIT_V(6); PG8_BAR; PG8_MMA(1, 1, At, B1); PG8_BAR;
            PG8_LDB(B0, 1, 0); PG8_SCHED; PG8_LDA(At, 1, 0); PG8_STAGE(PG8_SA(0, 1), a2 + hstepA, voffA);
            PG8_WAIT_L(8); PG8_BAR; PG8_WAIT_L(0); PG8_MMA(0, 0, At, B0); PG8_BAR; PG8_SCHED;
            PG8_LDB(B1, 1, 1); PG8_STAGE(PG8_SB(1, 0), b3, voffB);
            PG8_BAR; PG8_WAIT_L(0); PG8_MMA(0, 1, At, B1); PG8_BAR;
            PG8_LDA(At, 1, 1); PG8_STAGE(PG8_SA(1, 0), a3, voffA);
            PG8_BAR; PG8_WAIT_L(0); PG8_MMA(1, 0, At, B0); PG8_BAR; PG8_SCHED;
            PG8_STAGE(PG8_SB(1, 1), b3 + hstepB, voffB);
            PG8_WAIT_V(6); PG8_BAR; PG8_MMA(1, 1, At, B1); PG8_BAR;
            }
        }
        if constexpr (ALIGN_EPI) { if (wr == 0) PG8_BAR; }
        E.template run<2, 2>(acc, cur, 0, 0, wr, wc, fr, fq); S.done(cur);
        if (!has_next) break;
#pragma unroll
        for (int a = 0; a < 2; ++a)
#pragma unroll
            for (int b = 0; b < 2; ++b)
#pragma unroll
                for (int m = 0; m < 4; ++m)
#pragma unroll
                    for (int n = 0; n < 2; ++n) acc[a][b][m][n] = (f32x4){0.f, 0.f, 0.f, 0.f};
        cur = nxt; cA = nA; cB = nB; ++ui;
        if constexpr (ALIGN_EPI) { if (wr == 1) PG8_BAR; }
    }
    PG8_WAIT_V(0);
    if constexpr (!ALIGN_EPI) { if (wr == 0) PG8_BAR; }
    PG8_BAR;
#undef PG8_SA
#undef PG8_SB
#undef PG8_STAGE
#undef PG8_LDA
#undef PG8_LDB
#undef PG8_MMA
#undef PG8_WAIT_V
#undef PG8_WAIT_L
#undef PG8_BAR
#undef PG8_SCHED
}

template <int NB, class Epi>
__device__ __forceinline__ void sub_gemm(PG8_LAS unsigned char* lds, const Gemm g, int pm, int pn, int ai0, int bj0, const Epi& E) {
    int tid_ = threadIdx.x; asm volatile("" : "+v"(tid_));
    const int tid = tid_, wid = __builtin_amdgcn_readfirstlane(tid >> 6), lane = tid & 63, wr = wid >> 2, wc = wid & 3, fr = lane & 15, fq = lane >> 4;
    const int nt = g.K / BK;
    unsigned voffA[2], voffB[2];
#pragma unroll
    for (int i = 0; i < 2; ++i) { int R, C; stage_rc(tid * 16 + i * 8192, R, C); const int Rb = Epi::PERM ? ((R & ~31) + perm32(R & 31)) : R;
        voffA[i] = (unsigned)(R * g.lda + C) * 2u; voffB[i] = (unsigned)(Rb * g.ldb + C) * 2u; }
    const size_t kstep = (size_t)(BK * 2), hstepB = (size_t)HALF * g.ldb * 2;
    const unsigned ldsw = (unsigned)wid * 1024u;
    const int aoff = lds_byte(wr * 64 + fr, fq * 8), boff = lds_byte(wc * 32 + fr, fq * 8);
    const char* cA = (const char*)g.A + ((size_t)pm * BM + (size_t)ai0 * HALF) * g.lda * 2; const char* cB = (const char*)g.Bt + ((size_t)pn * BM + (size_t)bj0 * HALF) * g.ldb * 2;
#define SG_BUF(b, j) ((b) * 3 * HTB + (j) * HTB)
#define SG_STAGE(bufoff, gbase, voff) do { _Pragma("unroll") for (int _i = 0; _i < 2; ++_i) \
        __builtin_amdgcn_global_load_lds((const unsigned*)((const char*)(gbase) + (voff)[_i]), (PG8_LAS unsigned*)(lds + (bufoff) + ldsw + _i * 8192), 16, 0, 0); } while (0)
    f32x4 acc[1][NB][4][2];
#pragma unroll
    for (int b = 0; b < NB; ++b)
#pragma unroll
        for (int m = 0; m < 4; ++m)
#pragma unroll
            for (int n = 0; n < 2; ++n) acc[0][b][m][n] = (f32x4){0.f, 0.f, 0.f, 0.f};
    SG_STAGE(SG_BUF(0, 0), cA, voffA);
#pragma unroll
    for (int j = 0; j < NB; ++j) SG_STAGE(SG_BUF(0, 1 + j), cB + j * hstepB, voffB);
#pragma unroll 1
    for (int t = 0; t < nt; ++t) {
        const int cur = t & 1;
        if constexpr (Epi::MID) { if (t == (nt >> 1)) E.template mid<1, NB>(acc, Unit{pm, pn}, ai0 * HALF, bj0 * HALF, wr, wc, fr, fq); }
        if (t + 1 < nt) {
            SG_STAGE(SG_BUF(cur ^ 1, 0), cA + (size_t)(t + 1) * kstep, voffA);
#pragma unroll
            for (int j = 0; j < NB; ++j) SG_STAGE(SG_BUF(cur ^ 1, 1 + j), cB + j * hstepB + (size_t)(t + 1) * kstep, voffB);
            if constexpr (NB == 1) asm volatile("s_waitcnt vmcnt(4)" ::: "memory"); else asm volatile("s_waitcnt vmcnt(6)" ::: "memory");
        } else asm volatile("s_waitcnt vmcnt(0)" ::: "memory");
        __builtin_amdgcn_s_barrier();
        bf16x8 At[4][2], Bf[NB][2][2];
#pragma unroll
        for (int m = 0; m < 4; ++m)
#pragma unroll
            for (int k = 0; k < 2; ++k) At[m][k] = *(const PG8_LAS bf16x8*)(lds + SG_BUF(cur, 0) + aoff + m * 2048 + k * 1024);
#pragma unroll
        for (int j = 0; j < NB; ++j)
#pragma unroll
            for (int n = 0; n < 2; ++n)
#pragma unroll
                for (int k = 0; k < 2; ++k) Bf[j][n][k] = *(const PG8_LAS bf16x8*)(lds + SG_BUF(cur, 1 + j) + boff + n * 2048 + k * 1024);
        asm volatile("s_waitcnt lgkmcnt(0)" ::: "memory"); __builtin_amdgcn_sched_barrier(0);
#pragma unroll
        for (int j = 0; j < NB; ++j)
#pragma unroll
            for (int m = 0; m < 4; ++m)
#pragma unroll
                for (int n = 0; n < 2; ++n)
#pragma unroll
                    for (int k = 0; k < 2; ++k) acc[0][j][m][n] = __builtin_amdgcn_mfma_f32_16x16x32_bf16(Bf[j][n][k], At[m][k], acc[0][j][m][n], 0, 0, 0);
        __builtin_amdgcn_s_barrier();
    }
    E.template run<1, NB>(acc, Unit{pm, pn}, ai0 * HALF, bj0 * HALF, wr, wc, fr, fq);
#undef SG_BUF
#undef SG_STAGE
}
}
constexpr int NWAVES = 8;
constexpr int DM = 1024, NBATCH = 8, SEQ = 4096, SBATCH = 16, SSEQ = 16, PAST = 2048;
constexpr int MP = NBATCH * SEQ, MS = SBATCH * SSEQ, M = MP + MS, NTILE = M / 256, STILE = MP / 256;
constexpr int DIN = 4096, DFF = 3072, DUP = 6144;
constexpr float EPS = 1e-6f;
constexpr size_t OFF_Y = 0, OFF_HP = (size_t)M * DM, OFF_LCP = OFF_HP + NBATCH * DM, OFF_PLP = OFF_LCP + NBATCH * 3 * DM, OFF_FCP = OFF_PLP + NBATCH * 15 * DM,
                 OFF_HS = OFF_FCP + NBATCH * 2 * DUP, OFF_LCS = OFF_HS + SBATCH * DM, OFF_PLS = OFF_LCS + SBATCH * 3 * DM, OFF_FCS = OFF_PLS + SBATCH * 15 * DM,
                 OUT_TOTAL = OFF_FCS + SBATCH * 2 * DUP;
constexpr size_t MiB = 1u << 20;
constexpr size_t WS_CTL = 0, CTL_ZERO_BYTES = 64 * 1024;
constexpr size_t WS_WIN = 1 * MiB, WS_WCAT = 9 * MiB, WS_WOUT = 13 * MiB, WS_WUP = 15 * MiB, WS_WDN = 27 * MiB, WS_WG = 33 * MiB;
constexpr size_t WS_SSQ = 33 * MiB + 512 * 1024, WS_SSQ2 = 37 * MiB + 768 * 1024, WS_SUMM = WS_SSQ;
static_assert(WS_SSQ + (size_t)M * 128 <= WS_SSQ2 && WS_SSQ2 + (size_t)M * 128 <= 42 * MiB, "ssq map");
constexpr size_t WS_R0 = 42 * MiB, WS_R1 = 107 * MiB, WS_R2 = 236 * MiB, WS_R3 = 365 * MiB, WS_END = 494 * MiB;
static_assert((size_t)M * DM * 2 <= WS_R1 - WS_R0 && (size_t)M * 2048 * 2 <= WS_R2 - WS_R1 && (size_t)M * 2048 * 2 <= WS_R3 - WS_R2 && (size_t)M * 2048 * 2 <= WS_END - WS_R3 && (size_t)M * DFF * 2 <= WS_END - WS_R2, "ws map");
constexpr int CW_BAR = 1024;
constexpr int RING_BYTES = 131072;
constexpr int MISC_OFF = RING_BYTES, RS_OFF = RING_BYTES + 512, EDGE_START_OFF = RS_OFF + 4096, EDGE_MID_OFF = EDGE_START_OFF + 2048, EDGE_PREV_OFF = EDGE_MID_OFF + 2048;
constexpr int LDS_BYTES = 147456;
static_assert(EDGE_PREV_OFF + 2048 <= LDS_BYTES, "LDS map");

#define GAS __attribute__((address_space(1)))
#define LAS __attribute__((address_space(3)))
typedef unsigned short bf16;
typedef unsigned v4u __attribute__((ext_vector_type(4)));
typedef unsigned v2u __attribute__((ext_vector_type(2)));
typedef float f32x4 __attribute__((ext_vector_type(4)));
typedef short bf16x8 __attribute__((ext_vector_type(8)));
#define LDS_WAIT() asm volatile("s_waitcnt lgkmcnt(0)" ::: "memory")
#define VM_WAIT() asm volatile("s_waitcnt vmcnt(0)" ::: "memory")
__device__ __forceinline__ unsigned f2bf(float f) { unsigned u = __builtin_bit_cast(unsigned, f); return (u + 0x7fffu + ((u >> 16) & 1u)) >> 16; }
__device__ __forceinline__ unsigned pk2(float lo, float hi) { return f2bf(lo) | (f2bf(hi) << 16); }
__device__ __forceinline__ float bflo(unsigned w) { return __builtin_bit_cast(float, w << 16); }
__device__ __forceinline__ float bfhi(unsigned w) { return __builtin_bit_cast(float, w & 0xffff0000u); }
__device__ __forceinline__ float sigmoidf_fast(float x) { return __builtin_amdgcn_rcpf(1.0f + __builtin_amdgcn_exp2f(-1.4426950408889634f * x)); }
__device__ __forceinline__ float gelu_tanh(float g) { const float z = g * (1.0f + 0.044715f * g * g); return g * __builtin_amdgcn_rcpf(1.0f + __builtin_amdgcn_exp2f(-2.302208198f * z)); }
__device__ __forceinline__ float wave_sum(float v) {
#pragma unroll
    for (int o = 1; o < 64; o <<= 1) v += __shfl_xor(v, o);
    return v;
}

#define XB_TMO      128
#define XB_XCNT(j)  (256  + 64 * (j))
#define XB_XSUB(j)  (1280 + 64 * (j))
#define XB_XGEN(j)  (2304 + 64 * (j))
#define XB_TOP      3328
#define XB_TOPGEN   3392
#define XCD_BAR_WORDS 3456
#define XB_SPIN_CAP (1u << 20)
static_assert((CW_BAR + XCD_BAR_WORDS) * 4 <= (int)CTL_ZERO_BYTES, "barrier words inside the memset region");
__device__ __forceinline__ unsigned xb_ld(unsigned* p)              { return __hip_atomic_load(p, __ATOMIC_RELAXED, __HIP_MEMORY_SCOPE_AGENT); }
__device__ __forceinline__ unsigned xb_add(unsigned* p, unsigned v) { return __hip_atomic_fetch_add(p, v, __ATOMIC_RELAXED, __HIP_MEMORY_SCOPE_AGENT); }
__device__ __forceinline__ unsigned xb_xcc_id() { return (unsigned)__builtin_amdgcn_s_getreg((3 << 11) | 20) & 0xFu; }
#define XB_SPIN(cond, bar) do { unsigned _sp = 0; while (cond) { __builtin_amdgcn_s_sleep(1); \
    if ((++_sp & 255u) == 0u) { if (xb_ld(&(bar)[XB_TMO])) break; if (_sp > XB_SPIN_CAP) { atomicAdd(&(bar)[XB_TMO], 1u); break; } } } } while (0)
struct XcdBarrier { unsigned* bar; unsigned x; volatile LAS unsigned* st; };
__device__ __forceinline__ XcdBarrier xcd_barrier_post(unsigned* bar, volatile LAS unsigned* st) {
    XcdBarrier b; b.bar = bar; b.x = xb_xcc_id(); b.st = st;
    if (threadIdx.x == 0) (void)xb_add(&bar[XB_XCNT(b.x)], 1u);
    return b;
}
__device__ __forceinline__ void xcd_barrier_complete(unsigned* bar, unsigned x, unsigned& nloc, unsigned& nx) {
    const unsigned G = gridDim.x * gridDim.y * gridDim.z;
    unsigned sum, cnt, mine, sp = 0u;
    for (;;) {
        sum = 0u; cnt = 0u; mine = 0u;
#pragma unroll
        for (unsigned j = 0; j < 16; ++j) { const unsigned c = xb_ld(&bar[XB_XCNT(j)]); sum += c; cnt += (c > 0u) ? 1u : 0u; mine = (j == x) ? c : mine; }
        if (sum == G) break;
        __builtin_amdgcn_s_sleep(1);
        if ((++sp & 255u) == 0u) { if (xb_ld(&bar[XB_TMO])) break; if (sp > XB_SPIN_CAP) { atomicAdd(&bar[XB_TMO], 1u); break; } }
    }
    nloc = mine > 0u ? mine : 1u; nx = cnt > 0u ? cnt : 1u;
}
__device__ __forceinline__ void xcd_barrier(const XcdBarrier& b) {
    asm volatile("s_waitcnt vmcnt(0)" ::: "memory");
    __syncthreads();
    if (threadIdx.x == 0) {
        unsigned* bar = b.bar;
        __builtin_amdgcn_s_waitcnt(0);
        unsigned nloc = b.st[0], nx = b.st[1];
        if (nloc == 0u) { xcd_barrier_complete(bar, b.x, nloc, nx); b.st[0] = nloc; b.st[1] = nx; }
        const unsigned old = xb_add(&bar[XB_XSUB(b.x)], 1u);
        const unsigned gen = old / nloc;
        if (old + 1u == (gen + 1u) * nloc) {
            __builtin_amdgcn_fence(__ATOMIC_RELEASE, "agent");
            asm volatile("s_waitcnt vmcnt(0)" ::: "memory");
            const unsigned og = xb_add(&bar[XB_TOP], 1u);
            const unsigned tg = og / nx;
            if (og + 1u == (tg + 1u) * nx) xb_add(&bar[XB_TOPGEN], 1u);
            else XB_SPIN(xb_ld(&bar[XB_TOPGEN]) == tg, bar);
            __builtin_amdgcn_fence(__ATOMIC_ACQUIRE, "agent");
            xb_add(&bar[XB_XGEN(b.x)], 1u);
            asm volatile("s_waitcnt vmcnt(0)" ::: "memory");
        } else {
            XB_SPIN(xb_ld(&bar[XB_XGEN(b.x)]) == gen, bar);
            __builtin_amdgcn_fence(__ATOMIC_ACQUIRE, "agent");
            asm volatile("s_waitcnt vmcnt(0)" ::: "memory");
        }
    }
    __syncthreads();
}

struct KP {
    const float* in[26];
    float* out; unsigned char* ws;
    int ph_lo, ph_hi;
};
enum { I_XP = 0, I_XS, I_STH, I_STLC, I_STPOOL, I_STFFN, I_NMIX, I_WIN, I_CLW, I_CLB, I_WRA, I_BRA, I_WIX, I_BIX, I_LAM, I_WPOOL, I_PSCALE, I_WBRL, I_WBRP, I_WOUT, I_NFFN, I_WUP, I_CFW, I_CFB, I_WDN, I_NFIN };

using pg8::Unit;
struct EpiZ {
    static constexpr bool PERM = true, AMAP = false, MID = false;
    bf16* ZR; bf16* G;
    template <int NA, int NB> __device__ __forceinline__ void run(const f32x4 (&acc)[NA][NB][4][2], const Unit& u, int rowoff, int coloff, int wr, int wc, int fr, int fq) const {
        const int row0 = u.pm * 256 + rowoff + wr * 64 + fr; const bool gate = u.pn >= 8;
        bf16* base = gate ? G : ZR; const int col0 = (u.pn & 7) * 256 + coloff + wc * 32 + 8 * fq;
#pragma unroll
        for (int ai = 0; ai < NA; ++ai)
#pragma unroll
            for (int m = 0; m < 4; ++m) { bf16* rowp = base + (size_t)(row0 + ai * 128 + m * 16) * 2048 + col0;
#pragma unroll
                for (int bj = 0; bj < NB; ++bj) { f32x4 v0 = acc[ai][bj][m][0], v1 = acc[ai][bj][m][1];
                    if (gate) {
#pragma unroll
                        for (int j = 0; j < 4; ++j) { v0[j] = sigmoidf_fast(v0[j]); v1[j] = sigmoidf_fast(v1[j]); } }
                    v4u w; w.x = pg8::cvt_pk_bf16(v0[0], v0[1]); w.y = pg8::cvt_pk_bf16(v0[2], v0[3]); w.z = pg8::cvt_pk_bf16(v1[0], v1[1]); w.w = pg8::cvt_pk_bf16(v1[2], v1[3]);
                    *(v4u*)(rowp + bj * 128) = w; } }
    }
};
struct EpiBr {
    static constexpr bool PERM = true, AMAP = false, MID = true;
    const bf16* G; bf16* MG;
    template <int NA, int NB> __device__ __forceinline__ void mid(f32x4 (&acc)[NA][NB][4][2], const Unit& u, int rowoff, int coloff, int wr, int wc, int fr, int fq) const {
        int pm_ = u.pm, pn_ = u.pn; asm volatile("" : "+s"(pm_), "+s"(pn_));
        const int row0 = pm_ * 256 + rowoff + wr * 64 + fr, col0 = pn_ * 256 + coloff + wc * 32 + 8 * fq;
#pragma unroll
        for (int ai = 0; ai < NA; ++ai)
#pragma unroll
            for (int m = 0; m < 4; ++m) { const size_t row = (size_t)(row0 + ai * 128 + m * 16);
#pragma unroll
                for (int bj = 0; bj < NB; ++bj) { const int col = col0 + bj * 128;
                    const v4u ga = *(const v4u*)(G + row * 2048 + col), gb = *(const v4u*)(G + row * 2048 + 1024 + col);
                    const float a_[8] = {bflo(ga.x), bfhi(ga.x), bflo(ga.y), bfhi(ga.y), bflo(ga.z), bfhi(ga.z), bflo(ga.w), bfhi(ga.w)};
                    const float b_[8] = {bflo(gb.x), bfhi(gb.x), bflo(gb.y), bfhi(gb.y), bflo(gb.z), bfhi(gb.z), bflo(gb.w), bfhi(gb.w)};
#pragma unroll
                    for (int e = 0; e < 4; ++e) { acc[ai][bj][m][0][e] *= a_[e] * __builtin_amdgcn_rcpf(fmaxf(b_[e], 1e-30f)); acc[ai][bj][m][1][e] *= a_[4 + e] * __builtin_amdgcn_rcpf(fmaxf(b_[4 + e], 1e-30f)); } } }
    }
    template <int NA, int NB> __device__ __forceinline__ void run(const f32x4 (&acc)[NA][NB][4][2], const Unit& u, int rowoff, int coloff, int wr, int wc, int fr, int fq) const {
        const int row0 = u.pm * 256 + rowoff + wr * 64 + fr, col0 = u.pn * 256 + coloff + wc * 32 + 8 * fq;
#pragma unroll
        for (int ai = 0; ai < NA; ++ai)
#pragma unroll
            for (int m = 0; m < 4; ++m) { const size_t row = (size_t)(row0 + ai * 128 + m * 16);
#pragma unroll
                for (int bj = 0; bj < NB; ++bj) { const int col = col0 + bj * 128;
                    const v4u gw = *(const v4u*)(G + row * 2048 + 1024 + col);
                    const f32x4 g0 = {bflo(gw.x), bfhi(gw.x), bflo(gw.y), bfhi(gw.y)}, g1 = {bflo(gw.z), bfhi(gw.z), bflo(gw.w), bfhi(gw.w)};
                    const f32x4 v0 = acc[ai][bj][m][0] * g0, v1 = acc[ai][bj][m][1] * g1;
                    v4u w; w.x = pg8::cvt_pk_bf16(v0[0], v0[1]); w.y = pg8::cvt_pk_bf16(v0[2], v0[3]); w.z = pg8::cvt_pk_bf16(v1[0], v1[1]); w.w = pg8::cvt_pk_bf16(v1[2], v1[3]);
                    *(v4u*)(MG + row * 1024 + col) = w; } }
    }
};
template <bool DOWN> struct EpiRes {
    static constexpr bool PERM = true, AMAP = false, MID = false;
    const float* xp; const float* xs; float* Y; bf16* XG2; const float* g2; float* SSQ;
    template <int NA, int NB> __device__ __forceinline__ void run(const f32x4 (&acc)[NA][NB][4][2], const Unit& u, int rowoff, int coloff, int wr, int wc, int fr, int fq) const {
        const int row0 = u.pm * 256 + rowoff + wr * 64 + fr, col0 = u.pn * 256 + coloff + wc * 32 + 8 * fq;
        const float* xb = DOWN ? (const float*)Y : (u.pm < STILE ? xp : xs - (size_t)MP * DM);
        f32x4 gg[NB][2];
        if (!DOWN) {
#pragma unroll
            for (int bj = 0; bj < NB; ++bj) { gg[bj][0] = *(const f32x4*)(g2 + col0 + bj * 128); gg[bj][1] = *(const f32x4*)(g2 + col0 + bj * 128 + 4); } }
#pragma unroll
        for (int ai = 0; ai < NA; ++ai)
#pragma unroll
            for (int m = 0; m < 4; ++m) { const size_t row = (size_t)(row0 + ai * 128 + m * 16);
#pragma unroll
                for (int bj = 0; bj < NB; ++bj) { const size_t off = row * 1024 + col0 + bj * 128;
                    f32x4 v0 = acc[ai][bj][m][0] + *(const f32x4*)(xb + off), v1 = acc[ai][bj][m][1] + *(const f32x4*)(xb + off + 4);
                    *(f32x4*)(Y + off) = v0; *(f32x4*)(Y + off + 4) = v1;
                    float s = (v0[0] * v0[0] + v0[1] * v0[1]) + (v0[2] * v0[2] + v0[3] * v0[3]) + (v1[0] * v1[0] + v1[1] * v1[1]) + (v1[2] * v1[2] + v1[3] * v1[3]);
                    if (!DOWN) { v0 *= gg[bj][0]; v1 *= gg[bj][1];
                        v4u w; w.x = pg8::cvt_pk_bf16(v0[0], v0[1]); w.y = pg8::cvt_pk_bf16(v0[2], v0[3]); w.z = pg8::cvt_pk_bf16(v1[0], v1[1]); w.w = pg8::cvt_pk_bf16(v1[2], v1[3]);
                        *(v4u*)(XG2 + off) = w; }
                    s += __shfl_xor(s, 16); s += __shfl_xor(s, 32);
                    if (fq == 0) SSQ[row * 32 + u.pn * 8 + ((coloff >> 7) + bj) * 4 + wc] = s; } }
    }
};
__device__ __forceinline__ float row_rs(const float* SSQ, size_t row) {
    const f32x4* q = (const f32x4*)(SSQ + row * 32); float s = 0.f;
#pragma unroll
    for (int k = 0; k < 8; ++k) { const f32x4 a = q[k]; s += (a[0] + a[1]) + (a[2] + a[3]); }
    return 1.0f / sqrtf(s * (1.f / DM) + EPS);
}
struct EpiUpS {
    static constexpr bool PERM = true, AMAP = false, MID = false;
    bf16* ACT; const float* cw; const float* cb; const float* stf; float* ofs; const float* SSQ;
    template <int NA, int NB> __device__ __forceinline__ void run(const f32x4 (&acc)[NA][NB][4][2], const Unit& u, int rowoff, int coloff, int wr, int wc, int fr, int fq) const {
        static_assert(NA == 1 && NB == 2, "sample FFN epilogue works on half sub-units");
        int pn_ = u.pn, ro_ = rowoff, fr_ = fr, fq_ = fq, wr_ = wr, wc_ = wc; asm volatile("" : "+s"(pn_), "+s"(ro_), "+v"(fr_), "+v"(fq_), "+s"(wr_), "+s"(wc_));
        const int cbase = 32 * wc_ + 8 * fq_, gcol = 128 * pn_ + cbase;
#pragma unroll
        for (int m = 0; m < 4; ++m) {
            asm volatile("" ::: "memory");
            const int lrow = ro_ + wr_ * 64 + m * 16 + fr_, seq = lrow >> 4; const size_t row = (size_t)MP + lrow;
            const float rs = row_rs(SSQ, row);
            unsigned pk[4];
#pragma unroll
            for (int n = 0; n < 2; ++n) { f32x4 gc;
#pragma unroll
                for (int bj = 0; bj < 2; ++bj) { const int oc = bj * DFF + gcol + 4 * n;
                    const f32x4 w0 = *(const f32x4*)(cw + oc), w1 = *(const f32x4*)(cw + DUP + oc), w2 = *(const f32x4*)(cw + 2 * DUP + oc), bb = *(const f32x4*)(cb + oc);
                    const f32x4 h = acc[0][bj][m][n] * rs; f32x4 hm1, hm2;
#pragma unroll
                    for (int e = 0; e < 4; ++e) { hm1[e] = __shfl_up(h[e], 1, 16); hm2[e] = __shfl_up(h[e], 2, 16); }
                    if (fr_ < 2) { const f32x4 s1 = *(const f32x4*)(stf + (size_t)(seq * 2 + 1) * DUP + oc); if (fr_ == 0) { hm1 = s1; hm2 = *(const f32x4*)(stf + (size_t)(seq * 2 + 0) * DUP + oc); } else hm2 = s1; }
                    if (fr_ >= 14) *(f32x4*)(ofs + (size_t)(seq * 2 + (fr_ - 14)) * DUP + oc) = h;
                    const f32x4 c = bb + w0 * hm2 + w1 * hm1 + w2 * h;
                    if (bj == 0) gc = c;
                    else { f32x4 a;
#pragma unroll
                        for (int e = 0; e < 4; ++e) a[e] = gelu_tanh(gc[e]) * c[e];
                        pk[2 * n] = pg8::cvt_pk_bf16(a[0], a[1]); pk[2 * n + 1] = pg8::cvt_pk_bf16(a[2], a[3]); } } }
            v4u w; w.x = pk[0]; w.y = pk[1]; w.z = pk[2]; w.w = pk[3];
            *(v4u*)(ACT + row * DFF + gcol) = w;
        }
    }
};
struct EpiUp {
    static constexpr bool PERM = true, AMAP = true, MID = false;
    bf16* ACT; const float* cw; const float* cb; const float* stf; float* ofp; float* ofs; LAS unsigned char* lx; int pm0;
    template <int NA, int NB> __device__ __forceinline__ void run(const f32x4 (&acc)[NA][NB][4][2], const Unit& u, int, int, int wr, int wc, int fr, int fq) const {
        int pm_ = u.pm, pn_ = u.pn, fr_ = fr, fq_ = fq; asm volatile("" : "+s"(pm_), "+s"(pn_), "+v"(fr_), "+v"(fq_));
        const bool samp = (pm_ == STILE); const int j = pm_ - pm0;
        const LAS float* RS = (const LAS float*)(lx + RS_OFF) + j * 256 + 128 * wr + 8 * fr_;
        const f32x4 rsa = *(const LAS f32x4*)RS, rsb = *(const LAS f32x4*)(RS + 4);
        const float rs[8] = {rsa[0], rsa[1], rsa[2], rsa[3], rsb[0], rsb[1], rsb[2], rsb[3]};
        const int cbase = 32 * wc + 8 * fq_, gcol = 128 * pn_ + cbase;
        const LAS float* Ein = (const LAS float*)(lx + (wr == 0 ? (j == 0 ? EDGE_START_OFF : EDGE_PREV_OFF) : EDGE_MID_OFF));
        LAS float* Eout = (LAS float*)(lx + (wr == 0 ? EDGE_MID_OFF : EDGE_PREV_OFF));
        const int seq = samp ? (8 * wr + (fr_ >> 1)) : (pm_ >> 4);
        const bool lastp = (!samp) && ((pm_ & 15) == 15) && wr == 1 && fr_ == 15;
        bf16* ap = ACT + (size_t)(pm_ * 256 + 128 * wr + 8 * fr_) * DFF + gcol;
#pragma unroll
        for (int n = 0; n < 2; ++n) {
            f32x4 gc[8];
#pragma unroll
            for (int bj = 0; bj < 2; ++bj) {
                const int cc = bj * 128 + cbase + 4 * n, oc = bj * DFF + gcol + 4 * n;
                const f32x4 w0 = *(const f32x4*)(cw + oc), w1 = *(const f32x4*)(cw + DUP + oc), w2 = *(const f32x4*)(cw + 2 * DUP + oc), bb = *(const f32x4*)(cb + oc);
                const f32x4 h6 = acc[1][bj][2][n] * rs[6], h7 = acc[1][bj][3][n] * rs[7];
                f32x4 hm1, hm2;
#pragma unroll
                for (int e = 0; e < 4; ++e) { hm1[e] = __shfl_up(h7[e], 1, 16); hm2[e] = __shfl_up(h6[e], 1, 16); }
                if (!samp) {
                    if (fr_ == 0) { hm2 = *(const LAS f32x4*)(Ein + cc); hm1 = *(const LAS f32x4*)(Ein + 256 + cc); }
                    if (fr_ == 15) { *(LAS f32x4*)(Eout + cc) = h6; *(LAS f32x4*)(Eout + 256 + cc) = h7; }
                    if (lastp) { *(f32x4*)(ofp + (size_t)(seq * 2 + 0) * DUP + oc) = h6; *(f32x4*)(ofp + (size_t)(seq * 2 + 1) * DUP + oc) = h7; }
                } else {
                    if (!(fr_ & 1)) { hm2 = *(const f32x4*)(stf + (size_t)(seq * 2 + 0) * DUP + oc); hm1 = *(const f32x4*)(stf + (size_t)(seq * 2 + 1) * DUP + oc); }
                    else { *(f32x4*)(ofs + (size_t)(seq * 2 + 0) * DUP + oc) = h6; *(f32x4*)(ofs + (size_t)(seq * 2 + 1) * DUP + oc) = h7; }
                }
                f32x4 p2 = hm2, p1 = hm1;
#pragma unroll
                for (int q = 0; q < 8; ++q) {
                    const f32x4 hq = (q == 6) ? h6 : (q == 7) ? h7 : acc[q >> 2][bj][q & 3][n] * rs[q];
                    const f32x4 c = bb + w0 * p2 + w1 * p1 + w2 * hq;
                    p2 = p1; p1 = hq;
                    if (bj == 0) gc[q] = c;
                    else { f32x4 a;
#pragma unroll
                        for (int e = 0; e < 4; ++e) a[e] = gelu_tanh(gc[q][e]) * c[e];
                        v2u w; w.x = pg8::cvt_pk_bf16(a[0], a[1]); w.y = pg8::cvt_pk_bf16(a[2], a[3]);
                        *(v2u*)(ap + (size_t)q * DFF + 4 * n) = w; }
                }
            }
        }
        LDS_WAIT();
    }
};
template <class RowMap>
__device__ __forceinline__ void p0_transpose_item(const float* W, int ldw, int k0, int n0, bf16* WT, size_t ldt, int kcol0, RowMap drow, const float* kscale, LAS float* scr, int lane) {
#pragma unroll 8
    for (int i = 0; i < 32; ++i) { const int kk = 2 * i + (lane >> 5); float v = W[(size_t)(k0 + kk) * ldw + n0 + (lane & 31)]; if (kscale) v *= kscale[k0 + kk]; scr[kk * 33 + (lane & 31)] = v; }
    LDS_WAIT(); asm volatile("" ::: "memory");
    const int c = lane & 7;
#pragma unroll
    for (int j = 0; j < 4; ++j) { const int n = (lane >> 3) + 8 * j; const LAS float* s = scr + (8 * c) * 33 + n;
        v4u o; o.x = pk2(s[0 * 33], s[1 * 33]); o.y = pk2(s[2 * 33], s[3 * 33]); o.z = pk2(s[4 * 33], s[5 * 33]); o.w = pk2(s[6 * 33], s[7 * 33]);
        *(v4u*)(WT + (size_t)drow(n0 + n) * ldt + kcol0 + k0 + 8 * c) = o; }
    LDS_WAIT(); asm volatile("" ::: "memory");
}
struct RowId { __device__ __forceinline__ int operator()(int n) const { return n; } };
struct RowUp { __device__ __forceinline__ int operator()(int n) const { const int half = n >= DFF ? 1 : 0, c = n - half * DFF; return (c >> 7) * 256 + half * 128 + (c & 127); } };

__device__ __forceinline__ void p0_prologue(const KP& p, LAS unsigned char* lds, int vcu, int G, int wave, int lane) {
    LAS float* scr = (LAS float*)(lds + wave * 16384);
    const int gw = vcu * NWAVES + wave, NGW = G * NWAVES;
    unsigned char* ws = p.ws;
    bf16* Win_t = (bf16*)(ws + WS_WIN); bf16* Wcat_t = (bf16*)(ws + WS_WCAT); bf16* Wout_t = (bf16*)(ws + WS_WOUT); bf16* Wup_t = (bf16*)(ws + WS_WUP); bf16* Wdn_t = (bf16*)(ws + WS_WDN); bf16* Wg_t = (bf16*)(ws + WS_WG);
    constexpr int I_IN = (DM / 64) * (DIN / 32), I_UP = (DM / 64) * (DUP / 32), I_SQ = (DM / 64) * (DM / 32), I_DN = (DFF / 64) * (DM / 32), I_G = 32 * 2;
    constexpr int NITEMS = I_IN + I_UP + 2 * I_SQ + I_DN + I_G;
    for (int it = gw; it < NITEMS; it += NGW) {
        int r = it;
        if (r < I_IN) { const int nblk = DIN / 32; p0_transpose_item(p.in[I_WIN], DIN, 64 * (r / nblk), 32 * (r % nblk), Win_t, DM, 0, RowId(), nullptr, scr, lane); continue; } r -= I_IN;
        if (r < I_UP) { const int nblk = DUP / 32; p0_transpose_item(p.in[I_WUP], DUP, 64 * (r / nblk), 32 * (r % nblk), Wup_t, DM, 0, RowUp(), nullptr, scr, lane); continue; } r -= I_UP;
        if (r < I_SQ) { const int nblk = DM / 32; p0_transpose_item(p.in[I_WBRL], DM, 64 * (r / nblk), 32 * (r % nblk), Wcat_t, 2048, 0, RowId(), nullptr, scr, lane); continue; } r -= I_SQ;
        if (r < I_SQ) { const int nblk = DM / 32; p0_transpose_item(p.in[I_WOUT], DM, 64 * (r / nblk), 32 * (r % nblk), Wout_t, DM, 0, RowId(), nullptr, scr, lane); continue; } r -= I_SQ;
        if (r < I_DN) { const int nblk = DM / 32; p0_transpose_item(p.in[I_WDN], DM, 64 * (r / nblk), 32 * (r % nblk), Wdn_t, DFF, 0, RowId(), nullptr, scr, lane); continue; } r -= I_DN;
        { const int mat = r >> 1, nb = r & 1; const float* W = (mat < 16 ? p.in[I_WRA] : p.in[I_WIX]) + (size_t)(mat & 15) * 4096;
          p0_transpose_item(W, 64, 0, 32 * nb, Wg_t + (size_t)mat * 4096, 64, 0, RowId(), nullptr, scr, lane); }
    }
    {
        const float* wpool = p.in[I_WPOOL]; const float* psc = p.in[I_PSCALE]; const float* wbp = p.in[I_WBRP];
        for (int it = gw; it < 4 * 32 * 16; it += NGW) {
            const int g = it >> 9, kc = (it >> 4) & 31, nc = it & 15; const int nn = nc * 64 + lane;
            float a[8];
#pragma unroll
            for (int i = 0; i < 8; ++i) a[i] = 0.f;
            const float* wp = wpool + (size_t)(g * 256 + kc * 8) * 256;
            for (int j = 0; j < 256; j += 4) {
                float b[4];
#pragma unroll
                for (int jj = 0; jj < 4; ++jj) b[jj] = wbp[(size_t)(256 * g + j + jj) * DM + nn] * psc[256 * g + j + jj];
#pragma unroll
                for (int i = 0; i < 8; ++i) { const f32x4 w = *(const f32x4*)(wp + i * 256 + j); a[i] += w[0] * b[0] + w[1] * b[1] + w[2] * b[2] + w[3] * b[3]; }
            }
            v4u o; o.x = pk2(a[0], a[1]); o.y = pk2(a[2], a[3]); o.z = pk2(a[4], a[5]); o.w = pk2(a[6], a[7]);
            *(v4u*)(Wcat_t + (size_t)nn * 2048 + 1024 + 256 * g + kc * 8) = o;
        }
    }
    {
        bf16* XN = (bf16*)(ws + WS_R0); const float* g1 = p.in[I_NMIX];
        f32x4 gv[4];
#pragma unroll
        for (int j = 0; j < 4; ++j) gv[j] = *((const f32x4*)g1 + lane + 64 * j);
        for (int m = gw; m < M; m += NGW) {
            const float* xrow = m < MP ? p.in[I_XP] + (size_t)m * DM : p.in[I_XS] + (size_t)(m - MP) * DM;
            const f32x4* xr = (const f32x4*)xrow + lane; f32x4 v[4]; float s = 0.f;
#pragma unroll
            for (int j = 0; j < 4; ++j) { v[j] = xr[64 * j]; s += (v[j][0] * v[j][0] + v[j][1] * v[j][1]) + (v[j][2] * v[j][2] + v[j][3] * v[j][3]); }
            const float rstd = 1.0f / sqrtf(wave_sum(s) * (1.f / DM) + EPS);
            v2u* o8 = (v2u*)(XN + (size_t)m * DM) + lane;
#pragma unroll
            for (int j = 0; j < 4; ++j) { const f32x4 y = v[j] * rstd * gv[j]; v2u o; o.x = pk2(y[0], y[1]); o.y = pk2(y[2], y[3]); o8[64 * j] = o; }
        }
    }
}

constexpr int XR_OFF = 0, XR_BYTES = 16 * 19 * 128, SEG_OFF = 40960, CIN_OFF = 45056;
template <bool FINAL>
__device__ __forceinline__ void lru_unit(const KP& p, LAS unsigned char* lds, int pm, int n, int tid, int lane, int wave) {
    constexpr bool samp = true;
    const bf16* ZR = (const bf16*)(p.ws + WS_R1); const bf16* Wg_t = (const bf16*)(p.ws + WS_WG);
    typedef float f32x2v __attribute__((ext_vector_type(2)));
    f32x2v* SUMM = (f32x2v*)(p.ws + WS_SUMM);
    bf16* HP = (bf16*)(p.ws + WS_R3);
    LAS unsigned char* XR = lds + XR_OFF; LAS f32x2v* SEG = (LAS f32x2v*)(lds + SEG_OFF); LAS float* CIN = (LAS float*)(lds + CIN_OFF);
    const int t0 = samp ? 0 : 256 * (pm & 15);
    __syncthreads();
    for (int idx = tid; idx < 304 * 8; idx += NWAVES * 64) {
        const int row = idx >> 3, ck = idx & 7, g = row / 19, k = row - g * 19, tt = 16 * g + k - 3;
        v4u v = {0u, 0u, 0u, 0u};
        if (!samp) { if (t0 + tt >= 0) v = *(const v4u*)(ZR + (size_t)(pm * 256 + tt) * 2048 + n * 64 + ck * 8); }
        else if (k < 3) { const float* s = p.in[I_STLC] + (size_t)(g * 3 + k) * DM + n * 64 + ck * 8; const f32x4 a = *(const f32x4*)s, b = *(const f32x4*)(s + 4);
            v.x = pk2(a[0], a[1]); v.y = pk2(a[2], a[3]); v.z = pk2(b[0], b[1]); v.w = pk2(b[2], b[3]); }
        else v = *(const v4u*)(ZR + (size_t)(MP + 16 * g + k - 3) * 2048 + n * 64 + ck * 8);
        *(LAS v4u*)(XR + row * 128 + ck * 16) = v;
    }
    if (FINAL && !samp && tid < 64) {
        const int npre = pm & 15; f32x2v sv[15];
#pragma unroll
        for (int k = 0; k < 15; ++k) sv[k] = (k < npre) ? SUMM[(size_t)(pm - npre + k) * DM + n * 64 + tid] : (f32x2v){1.f, 0.f};
        float c = 0.f;
#pragma unroll
        for (int k = 0; k < 15; ++k) c = sv[k].y + sv[k].x * c;
        CIN[tid] = c;
    }
    __syncthreads();
    const int i16 = lane & 15, fq = lane >> 4;
    const float* cwl = p.in[I_CLW]; const float* cbl = p.in[I_CLB];
    bf16x8 fa[2][2];
#pragma unroll
    for (int ks = 0; ks < 2; ++ks) {
        const int ch0 = 32 * ks + 8 * fq; f32x4 w[4][2], bb[2];
#pragma unroll
        for (int tp = 0; tp < 4; ++tp) { w[tp][0] = *(const f32x4*)(cwl + tp * DM + n * 64 + ch0); w[tp][1] = *(const f32x4*)(cwl + tp * DM + n * 64 + ch0 + 4); }
        bb[0] = *(const f32x4*)(cbl + n * 64 + ch0); bb[1] = *(const f32x4*)(cbl + n * 64 + ch0 + 4);
#pragma unroll
        for (int m = 0; m < 2; ++m) {
            const int tau = 8 * (i16 >> 2) + 4 * m + (i16 & 3), T = 32 * wave + tau, rb = (T >> 4) * 19 + (T & 15);
            f32x4 u0 = bb[0], u1 = bb[1];
#pragma unroll
            for (int tp = 0; tp < 4; ++tp) { const v4u x = *(const LAS v4u*)(XR + (rb + tp) * 128 + ch0 * 2);
                u0 += w[tp][0] * (f32x4){bflo(x.x), bfhi(x.x), bflo(x.y), bfhi(x.y)}; u1 += w[tp][1] * (f32x4){bflo(x.z), bfhi(x.z), bflo(x.w), bfhi(x.w)}; }
            v4u f; f.x = pk2(u0[0], u0[1]); f.y = pk2(u0[2], u0[3]); f.z = pk2(u1[0], u1[1]); f.w = pk2(u1[2], u1[3]);
            fa[m][ks] = __builtin_bit_cast(bf16x8, f);
        }
    }
    float hloc[4][8], pc[4][8], P8[4], H8[4];
    const int T0 = 32 * wave + 8 * fq, rb0 = (T0 >> 4) * 19 + (T0 & 15);
#pragma unroll
    for (int nb = 0; nb < 4; ++nb) {
        const int ch = 16 * nb + i16, gch = n * 64 + ch;
        f32x4 aR[2] = {{0.f, 0.f, 0.f, 0.f}, {0.f, 0.f, 0.f, 0.f}}, aI[2] = {{0.f, 0.f, 0.f, 0.f}, {0.f, 0.f, 0.f, 0.f}};
#pragma unroll
        for (int ks = 0; ks < 2; ++ks) {
            const bf16x8 bR = *(const bf16x8*)(Wg_t + (size_t)(n * 64 + ch) * 64 + 8 * fq + 32 * ks);
            const bf16x8 bI = *(const bf16x8*)(Wg_t + (size_t)((16 + n) * 64 + ch) * 64 + 8 * fq + 32 * ks);
#pragma unroll
            for (int m = 0; m < 2; ++m) { aR[m] = __builtin_amdgcn_mfma_f32_16x16x32_bf16(fa[m][ks], bR, aR[m], 0, 0, 0); aI[m] = __builtin_amdgcn_mfma_f32_16x16x32_bf16(fa[m][ks], bI, aI[m], 0, 0, 0); }
        }
        float x[11];
#pragma unroll
        for (int r = 0; r < 11; ++r) x[r] = __builtin_bit_cast(float, (unsigned)(*(const LAS unsigned short*)(XR + (rb0 + r) * 128 + ch * 2)) << 16);
        const float c0 = cwl[gch], c1 = cwl[DM + gch], c2 = cwl[2 * DM + gch], c3 = cwl[3 * DM + gch], cbv = cbl[gch];
        const float bra = p.in[I_BRA][gch], bix = p.in[I_BIX][gch], lam = p.in[I_LAM][gch];
        const float zz = -lam, sp = fmaxf(zz, 0.f) + log1pf(expf(-fabsf(zz))), c8 = -8.0f * sp;
        float hl = 0.f, P = 1.f;
#pragma unroll
        for (int q = 0; q < 8; ++q) {
            const float u = cbv + c0 * x[q] + c1 * x[q + 1] + c2 * x[q + 2] + c3 * x[q + 3];
            const float r = sigmoidf_fast(aR[q >> 2][q & 3] + bra), ig = sigmoidf_fast(aI[q >> 2][q & 3] + bix);
            const float la = r * c8, a = __builtin_amdgcn_exp2f(la * 1.4426950408889634f);
            const float x2 = 2.0f * la, em_small = -x2 * (1.0f + x2 * (0.5f + x2 * (0.16666667f + x2 * 0.041666668f))), em = (x2 > -0.05f) ? em_small : (1.0f - a * a);
            const float b = sqrtf(em) * ig * u;
            hl = a * hl + b; P = P * a;
            hloc[nb][q] = hl; pc[nb][q] = P;
        }
        P8[nb] = P; H8[nb] = hl;
    }
    float Pf[4][4], Hf[4][4];
#pragma unroll
    for (int nb = 0; nb < 4; ++nb)
#pragma unroll
        for (int f = 0; f < 4; ++f) { Pf[nb][f] = __shfl(P8[nb], i16 + 16 * f); Hf[nb][f] = __shfl(H8[nb], i16 + 16 * f); }
    if (!samp) {
        if (fq == 0) {
#pragma unroll
            for (int nb = 0; nb < 4; ++nb) { float hw = 0.f, pw = 1.f;
#pragma unroll
                for (int f = 0; f < 4; ++f) { hw = Hf[nb][f] + Pf[nb][f] * hw; pw *= Pf[nb][f]; }
                SEG[wave * 64 + 16 * nb + i16] = (f32x2v){pw, hw}; }
        }
        __syncthreads();
        if (!FINAL) {
            if (tid < 64) { float hu = 0.f, pu = 1.f;
#pragma unroll
                for (int w = 0; w < 8; ++w) { const f32x2v s = SEG[w * 64 + tid]; hu = s.y + s.x * hu; pu *= s.x; }
                SUMM[(size_t)pm * DM + n * 64 + tid] = (f32x2v){pu, hu}; }
            return;
        }
    }
#pragma unroll
    for (int nb = 0; nb < 4; ++nb) {
        const int ch = 16 * nb + i16, gch = n * 64 + ch;
        float c;
        if (!samp) {
            c = CIN[ch];
#pragma unroll
            for (int w = 0; w < 8; ++w) { const f32x2v s = SEG[w * 64 + ch]; if (w < wave) c = s.y + s.x * c; }
#pragma unroll
            for (int f = 0; f < 4; ++f) if (f < fq) c = Hf[nb][f] + Pf[nb][f] * c;
        } else {
            const int sq = 2 * wave + (fq >> 1);
            c = p.in[I_STH][(size_t)sq * DM + gch];
            if (fq & 1) { const float pp = (fq == 1) ? Pf[nb][0] : Pf[nb][2], hh = (fq == 1) ? Hf[nb][0] : Hf[nb][2]; c = hh + pp * c; }
        }
        bf16* hp = HP + (size_t)(pm * 256 + T0) * 2048 + gch; float hlast = 0.f;
#pragma unroll
        for (int q = 0; q < 8; ++q) { const float h = hloc[nb][q] + pc[nb][q] * c; hp[(size_t)q * 2048] = (bf16)f2bf(h); hlast = h; }
        if (!samp) { if ((pm & 15) == 15 && wave == 7 && fq == 3) p.out[OFF_HP + (size_t)(pm >> 4) * DM + gch] = hlast; }
        else if (fq & 1) p.out[OFF_HS + (size_t)(2 * wave + (fq >> 1)) * DM + gch] = hlast;
    }
}

constexpr int XL_BYTES = 33280, XL_SEG = 2 * XL_BYTES, XL_CW = XL_SEG + 4096;
__device__ __forceinline__ void lru_task(const KP& p, LAS unsigned char* lds, int s, int n, int hf, int tid, int lane, int wave) {
    const bf16* ZR = (const bf16*)(p.ws + WS_R1); const bf16* Wg_t = (const bf16*)(p.ws + WS_WG); bf16* HP = (bf16*)(p.ws + WS_R3);
    typedef float f32x2v __attribute__((ext_vector_type(2)));
    LAS f32x2v* SEG = (LAS f32x2v*)(lds + XL_SEG); LAS float* CW = (LAS float*)(lds + XL_CW);
    const int i16 = lane & 15, fq = lane >> 4;
    const float* cwl = p.in[I_CLW]; const float* cbl = p.in[I_CLB];
    const size_t rowbase = (size_t)s * SEQ;
    __syncthreads();
    if (tid < 320) { const int tp = tid >> 6, c = tid & 63; CW[tid] = tp < 4 ? cwl[tp * DM + n * 64 + c] : cbl[n * 64 + c]; }
    for (int idx = tid; idx < 259 * 8; idx += NWAVES * 64) { const int row = idx >> 3, ck = idx & 7; v4u v = {0u, 0u, 0u, 0u};
        if (row >= 3) v = *(const v4u*)(ZR + (rowbase + row - 3) * 2048 + n * 64 + ck * 8);
        *(LAS v4u*)(lds + row * 128 + ck * 16) = v; }
    bf16x8 bR[2][2], bI[2][2]; float c0[2], c1[2], c2[2], c3[2], cbv[2], bra[2], bix[2], c8[2], cin[2];
#pragma unroll
    for (int b2 = 0; b2 < 2; ++b2) { const int ch = 16 * (2 * hf + b2) + i16, gch = n * 64 + ch;
#pragma unroll
        for (int ks = 0; ks < 2; ++ks) { bR[b2][ks] = *(const bf16x8*)(Wg_t + (size_t)(n * 64 + ch) * 64 + 8 * fq + 32 * ks); bI[b2][ks] = *(const bf16x8*)(Wg_t + (size_t)((16 + n) * 64 + ch) * 64 + 8 * fq + 32 * ks); }
        c0[b2] = cwl[gch]; c1[b2] = cwl[DM + gch]; c2[b2] = cwl[2 * DM + gch]; c3[b2] = cwl[3 * DM + gch]; cbv[b2] = cbl[gch];
        bra[b2] = p.in[I_BRA][gch]; bix[b2] = p.in[I_BIX][gch];
        const float zz = -p.in[I_LAM][gch]; c8[b2] = -8.0f * (fmaxf(zz, 0.f) + log1pf(expf(-fabsf(zz)))) * 1.4426950408889634f;
        cin[b2] = 0.f; }
    __syncthreads();
    for (int tt = 0; tt < 16; ++tt) {
        LAS unsigned char* XR = lds + (tt & 1) * XL_BYTES; LAS unsigned char* XN_ = lds + ((tt + 1) & 1) * XL_BYTES;
        v4u pf[5];
        if (tt < 15) {
#pragma unroll
            for (int k = 0; k < 5; ++k) { const int idx = tid + k * (NWAVES * 64); if (idx < 259 * 8) pf[k] = *(const v4u*)(ZR + (rowbase + 256 * (tt + 1) - 3 + (idx >> 3)) * 2048 + n * 64 + (idx & 7) * 8); } }
        bf16x8 fa[2][2];
#pragma unroll
        for (int ks = 0; ks < 2; ++ks) { const int ch0 = 32 * ks + 8 * fq; f32x4 w[4][2], bb[2];
#pragma unroll
            for (int tp = 0; tp < 4; ++tp) { w[tp][0] = *(const LAS f32x4*)(CW + tp * 64 + ch0); w[tp][1] = *(const LAS f32x4*)(CW + tp * 64 + ch0 + 4); }
            bb[0] = *(const LAS f32x4*)(CW + 256 + ch0); bb[1] = *(const LAS f32x4*)(CW + 256 + ch0 + 4);
#pragma unroll
            for (int m = 0; m < 2; ++m) { const int rb = 32 * wave + 8 * (i16 >> 2) + 4 * m + (i16 & 3); f32x4 u0 = bb[0], u1 = bb[1];
#pragma unroll
                for (int tp = 0; tp < 4; ++tp) { const v4u x = *(const LAS v4u*)(XR + (rb + tp) * 128 + ch0 * 2);
                    u0 += w[tp][0] * (f32x4){bflo(x.x), bfhi(x.x), bflo(x.y), bfhi(x.y)}; u1 += w[tp][1] * (f32x4){bflo(x.z), bfhi(x.z), bflo(x.w), bfhi(x.w)}; }
                v4u f; f.x = pg8::cvt_pk_bf16(u0[0], u0[1]); f.y = pg8::cvt_pk_bf16(u0[2], u0[3]); f.z = pg8::cvt_pk_bf16(u1[0], u1[1]); f.w = pg8::cvt_pk_bf16(u1[2], u1[3]);
                fa[m][ks] = __builtin_bit_cast(bf16x8, f); } }
        float hloc[2][8], pc[2][8], P8[2], H8[2];
        const int rb0 = 32 * wave + 8 * fq;
#pragma unroll
        for (int b2 = 0; b2 < 2; ++b2) { const int ch = 16 * (2 * hf + b2) + i16;
            f32x4 aR[2] = {{0.f, 0.f, 0.f, 0.f}, {0.f, 0.f, 0.f, 0.f}}, aI[2] = {{0.f, 0.f, 0.f, 0.f}, {0.f, 0.f, 0.f, 0.f}};
#pragma unroll
            for (int ks = 0; ks < 2; ++ks)
#pragma unroll
                for (int m = 0; m < 2; ++m) { aR[m] = __builtin_amdgcn_mfma_f32_16x16x32_bf16(fa[m][ks], bR[b2][ks], aR[m], 0, 0, 0); aI[m] = __builtin_amdgcn_mfma_f32_16x16x32_bf16(fa[m][ks], bI[b2][ks], aI[m], 0, 0, 0); }
            float x[11];
#pragma unroll
            for (int r = 0; r < 11; ++r) x[r] = __builtin_bit_cast(float, (unsigned)(*(const LAS unsigned short*)(XR + (rb0 + r) * 128 + ch * 2)) << 16);
            float hl = 0.f, P = 1.f;
#pragma unroll
            for (int q = 0; q < 8; ++q) {
                const float u = cbv[b2] + c0[b2] * x[q] + c1[b2] * x[q + 1] + c2[b2] * x[q + 2] + c3[b2] * x[q + 3];
                const float r = sigmoidf_fast(aR[q >> 2][q & 3] + bra[b2]), ig = sigmoidf_fast(aI[q >> 2][q & 3] + bix[b2]);
                const float a = __builtin_amdgcn_exp2f(r * c8[b2]);
                const float b = __builtin_amdgcn_sqrtf(fmaxf(__builtin_fmaf(-a, a, 1.0f), 0.f)) * ig * u;
                hl = __builtin_fmaf(a, hl, b); P = P * a; hloc[b2][q] = hl; pc[b2][q] = P; }
            P8[b2] = P; H8[b2] = hl; }
        float Pf[2][4], Hf[2][4];
#pragma unroll
        for (int b2 = 0; b2 < 2; ++b2)
#pragma unroll
            for (int f = 0; f < 4; ++f) { Pf[b2][f] = __shfl(P8[b2], i16 + 16 * f); Hf[b2][f] = __shfl(H8[b2], i16 + 16 * f); }
        if (fq == 0) {
#pragma unroll
            for (int b2 = 0; b2 < 2; ++b2) { float hw = 0.f, pw = 1.f;
#pragma unroll
                for (int f = 0; f < 4; ++f) { hw = __builtin_fmaf(Pf[b2][f], hw, Hf[b2][f]); pw *= Pf[b2][f]; }
                SEG[(tt & 1) * 256 + wave * 32 + 16 * b2 + i16] = (f32x2v){pw, hw}; } }
        if (tt < 15) {
#pragma unroll
            for (int k = 0; k < 5; ++k) { const int idx = tid + k * (NWAVES * 64); if (idx < 259 * 8) *(LAS v4u*)(XN_ + (idx >> 3) * 128 + (idx & 7) * 16) = pf[k]; } }
        LDS_WAIT(); __syncthreads();
#pragma unroll
        for (int b2 = 0; b2 < 2; ++b2) { const int ch = 16 * (2 * hf + b2) + i16, gch = n * 64 + ch;
            float c = cin[b2], call = cin[b2];
#pragma unroll
            for (int w = 0; w < 8; ++w) { const f32x2v sg = SEG[(tt & 1) * 256 + w * 32 + 16 * b2 + i16]; call = __builtin_fmaf(sg.x, call, sg.y); if (w < wave) c = __builtin_fmaf(sg.x, c, sg.y); }
            cin[b2] = call;
#pragma unroll
            for (int f = 0; f < 4; ++f) if (f < fq) c = __builtin_fmaf(Pf[b2][f], c, Hf[b2][f]);
            bf16* hp = HP + (rowbase + 256 * tt + rb0) * 2048 + gch; float hlast = 0.f;
#pragma unroll
            for (int q = 0; q < 8; ++q) { const float h = __builtin_fmaf(pc[b2][q], c, hloc[b2][q]); hp[(size_t)q * 2048] = (bf16)f2bf(h); hlast = h; }
            if (tt == 15 && wave == 7 && fq == 3) p.out[OFF_HP + (size_t)s * DM + gch] = hlast; }
    }
}

__device__ __forceinline__ void pool_load8(const KP& p, const bf16* ZR, int pm, int tt, int run, int ch, float (&v)[8]) {
    const bool samp = (pm == STILE);
    if (!samp) {
        if (256 * (pm & 15) + tt < 0) {
#pragma unroll
            for (int e = 0; e < 8; ++e) v[e] = 0.f;
            return; }
        const v4u w = *(const v4u*)(ZR + (size_t)(pm * 256 + tt) * 2048 + 1024 + ch);
        v[0] = bflo(w.x); v[1] = bfhi(w.x); v[2] = bflo(w.y); v[3] = bfhi(w.y); v[4] = bflo(w.z); v[5] = bfhi(w.z); v[6] = bflo(w.w); v[7] = bfhi(w.w);
    } else {
        const int tl = tt - 16 * run;
        if (tl < 0) { const float* s = p.in[I_STPOOL] + (size_t)(run * 15 + 15 + tl) * DM + ch; const f32x4 a = *(const f32x4*)s, b = *(const f32x4*)(s + 4);
            v[0] = a[0]; v[1] = a[1]; v[2] = a[2]; v[3] = a[3]; v[4] = b[0]; v[5] = b[1]; v[6] = b[2]; v[7] = b[3]; }
        else { const v4u w = *(const v4u*)(ZR + (size_t)(MP + tt) * 2048 + 1024 + ch);
            v[0] = bflo(w.x); v[1] = bfhi(w.x); v[2] = bflo(w.y); v[3] = bfhi(w.y); v[4] = bflo(w.z); v[5] = bfhi(w.z); v[6] = bflo(w.w); v[7] = bfhi(w.w); }
    }
}
__device__ __forceinline__ void pool_unit(const KP& p, int pm, int g, int tid) {
    const bf16* ZR = (const bf16*)(p.ws + WS_R1); bf16* HP = (bf16*)(p.ws + WS_R3);
    const bool samp = (pm == STILE);
    const int oct = tid & 31, run = tid >> 5, ch = 256 * g + 8 * oct, w = 2 << g, tf = 16 * run;
    const int pos0 = samp ? PAST : 256 * (pm & 15) + tf;
    float s[8];
#pragma unroll
    for (int e = 0; e < 8; ++e) s[e] = 0.f;
    for (int k = 1; k < w; ++k) { float v[8]; pool_load8(p, ZR, pm, tf - k, run, ch, v);
#pragma unroll
        for (int e = 0; e < 8; ++e) s[e] += v[e]; }
    for (int i = 0; i < 16; ++i) {
        float v[8], o[8]; pool_load8(p, ZR, pm, tf + i, run, ch, v);
        const int cnt = min(pos0 + i + 1, w); const float inv = 1.0f / (float)cnt;
#pragma unroll
        for (int e = 0; e < 8; ++e) { s[e] += v[e]; o[e] = s[e] * inv - v[e]; }
        v4u ow; ow.x = pk2(o[0], o[1]); ow.y = pk2(o[2], o[3]); ow.z = pk2(o[4], o[5]); ow.w = pk2(o[6], o[7]);
        *(v4u*)(HP + (size_t)(pm * 256 + tf + i) * 2048 + 1024 + ch) = ow;
        float vo[8]; pool_load8(p, ZR, pm, tf + i - w + 1, run, ch, vo);
#pragma unroll
        for (int e = 0; e < 8; ++e) s[e] -= vo[e];
    }
}
__device__ __forceinline__ void state_copy(const KP& p, int gtid, int gthreads) {
    const bf16* ZR = (const bf16*)(p.ws + WS_R1);
    constexpr int N1 = NBATCH * 3 * DM, N2 = NBATCH * 15 * DM, N3 = SBATCH * 3 * DM, N4 = SBATCH * 15 * DM;
    for (int i = gtid; i < N1 + N2 + N3 + N4; i += gthreads) {
        int r = i; size_t row, col; float* dst;
        if (r < N1) { const int b = r / (3 * DM), k = (r / DM) % 3, c = r % DM; row = (size_t)b * SEQ + SEQ - 3 + k; col = c; dst = p.out + OFF_LCP + r; }
        else if ((r -= N1) < N2) { const int b = r / (15 * DM), k = (r / DM) % 15, c = r % DM; row = (size_t)b * SEQ + SEQ - 15 + k; col = 1024 + c; dst = p.out + OFF_PLP + r; }
        else if ((r -= N2) < N3) { const int b = r / (3 * DM), k = (r / DM) % 3, c = r % DM; row = (size_t)MP + b * SSEQ + SSEQ - 3 + k; col = c; dst = p.out + OFF_LCS + r; }
        else { r -= N3; const int b = r / (15 * DM), k = (r / DM) % 15, c = r % DM; row = (size_t)MP + b * SSEQ + SSEQ - 15 + k; col = 1024 + c; dst = p.out + OFF_PLS + r; }
        *dst = __builtin_bit_cast(float, (unsigned)ZR[row * 2048 + col] << 16);
    }
}

__device__ __forceinline__ void strip_pre(const KP& p, LAS unsigned char* lds, int pm0, int pn, int cnt, int tid, int lane, int wave) {
    const float* SSQ = (const float*)(p.ws + WS_SSQ); const bf16* XG2 = (const bf16*)(p.ws + WS_R1); const bf16* Wup_t = (const bf16*)(p.ws + WS_WUP);
    LAS float* RS = (LAS float*)(lds + RS_OFF); LAS float* ES = (LAS float*)(lds + EDGE_START_OFF);
    __syncthreads();
    for (int i = tid; i < cnt * 256; i += NWAVES * 64) RS[i] = row_rs(SSQ, (size_t)pm0 * 256 + i);
    if (pm0 != STILE && (pm0 & 15) != 0) {
        float xa[2][16], rsh[2];
#pragma unroll
        for (int r = 0; r < 2; ++r) { const size_t row = (size_t)pm0 * 256 - 2 + r;
            const v4u w0 = *(const v4u*)(XG2 + row * DM + 16 * lane), w1 = *(const v4u*)(XG2 + row * DM + 16 * lane + 8);
            xa[r][0] = bflo(w0.x); xa[r][1] = bfhi(w0.x); xa[r][2] = bflo(w0.y); xa[r][3] = bfhi(w0.y); xa[r][4] = bflo(w0.z); xa[r][5] = bfhi(w0.z); xa[r][6] = bflo(w0.w); xa[r][7] = bfhi(w0.w);
            xa[r][8] = bflo(w1.x); xa[r][9] = bfhi(w1.x); xa[r][10] = bflo(w1.y); xa[r][11] = bfhi(w1.y); xa[r][12] = bflo(w1.z); xa[r][13] = bfhi(w1.z); xa[r][14] = bflo(w1.w); xa[r][15] = bfhi(w1.w);
            rsh[r] = row_rs(SSQ, row); }
        for (int c = 0; c < 32; ++c) { const int tc = 32 * wave + c; const bf16* wr_ = Wup_t + (size_t)(256 * pn + tc) * DM + 16 * lane;
            const v4u w0 = *(const v4u*)wr_, w1 = *(const v4u*)(wr_ + 8);
            const float wv[16] = {bflo(w0.x), bfhi(w0.x), bflo(w0.y), bfhi(w0.y), bflo(w0.z), bfhi(w0.z), bflo(w0.w), bfhi(w0.w), bflo(w1.x), bfhi(w1.x), bflo(w1.y), bfhi(w1.y), bflo(w1.z), bfhi(w1.z), bflo(w1.w), bfhi(w1.w)};
            float p0 = 0.f, p1 = 0.f;
#pragma unroll
            for (int e = 0; e < 16; ++e) { p0 += xa[0][e] * wv[e]; p1 += xa[1][e] * wv[e]; }
            p0 = wave_sum(p0); p1 = wave_sum(p1);
            if (lane == 0) { ES[tc] = p0 * rsh[0]; ES[256 + tc] = p1 * rsh[1]; } }
    } else { ES[tid] = 0.f; }
    __syncthreads();
}

__device__ __forceinline__ void final_norm(const KP& p, int gw, int NGW, int lane) {
    const float* SSQ2 = (const float*)(p.ws + WS_SSQ2); const float* gf = p.in[I_NFIN];
    f32x4 gv[4];
#pragma unroll
    for (int j = 0; j < 4; ++j) gv[j] = *((const f32x4*)gf + lane + 64 * j);
    for (int m = gw; m < M; m += NGW) {
        const float sv = (lane < 32) ? SSQ2[(size_t)m * 32 + lane] : 0.f;
        const float rstd = 1.0f / sqrtf(wave_sum(sv) * (1.f / DM) + EPS);
        f32x4* yr = (f32x4*)(p.out + OFF_Y + (size_t)m * DM) + lane;
#pragma unroll
        for (int j = 0; j < 4; ++j) { const f32x4 v = yr[64 * j]; yr[64 * j] = v * rstd * gv[j]; }
    }
}
#ifndef MK_ONE_LAUNCH
#define MK_ONE_LAUNCH 1
#endif
#ifndef PG8_SP2
#define PG8_SP2 false
#endif
constexpr int N_PHASES = 10;
__global__ void __launch_bounds__(NWAVES * 64, 2) mk_fwd(KP p) {
    extern __shared__ __attribute__((aligned(16))) unsigned char lds_raw[];
    LAS unsigned char* lds = (LAS unsigned char*)lds_raw;
    const int tid = threadIdx.x, lane = tid & 63, wave = __builtin_amdgcn_readfirstlane(tid >> 6);
    const int G = gridDim.x, bx = blockIdx.x, vcu = (G % 8 == 0) ? (bx % 8) * (G / 8) + bx / 8 : bx;
    volatile LAS unsigned* MISC = (volatile LAS unsigned*)(lds + MISC_OFF);
    if (tid < 32) MISC[tid] = 0u;
    __syncthreads();
    unsigned* ctl = (unsigned*)(p.ws + WS_CTL);
    const int lo = p.ph_lo, hi = p.ph_hi;
    XcdBarrier bar; bar.bar = ctl + CW_BAR; bar.x = 0; bar.st = MISC + 8;
    if (hi - lo > 1) bar = xcd_barrier_post(ctl + CW_BAR, MISC + 8);
#ifndef PH_MASK
#define PH_MASK 0x3ff
#endif
#define IN(k) (((PH_MASK >> (k)) & 1) && lo <= (k) && (k) < hi)
#ifndef REP_MASK
#define REP_MASK 0
#endif
#define PH(k) if (IN(k)) for (int rep_ = 0; rep_ <= ((REP_MASK >> (k)) & 1); ++rep_)
#define REPBAR() do { if (rep_) xcd_barrier(bar); } while (0)
#define SEAM(k) do { if (IN(k) && IN((k) + 1)) xcd_barrier(bar); } while (0)
    unsigned char* ws = p.ws;
    bf16* XN = (bf16*)(ws + WS_R0); bf16* MG = (bf16*)(ws + WS_R0); bf16* ZR = (bf16*)(ws + WS_R1); bf16* XG2 = (bf16*)(ws + WS_R1);
    bf16* GT = (bf16*)(ws + WS_R2); bf16* HP = (bf16*)(ws + WS_R3); bf16* ACT = (bf16*)(ws + WS_R2);
    bf16* Win_t = (bf16*)(ws + WS_WIN); bf16* Wcat_t = (bf16*)(ws + WS_WCAT); bf16* Wout_t = (bf16*)(ws + WS_WOUT); bf16* Wup_t = (bf16*)(ws + WS_WUP); bf16* Wdn_t = (bf16*)(ws + WS_WDN);
    float* SSQ = (float*)(ws + WS_SSQ); float* SSQ2 = (float*)(ws + WS_SSQ2);
    float* Y = p.out + OFF_Y;

    PH(0) { REPBAR(); p0_prologue(p, lds, vcu, G, wave, lane); }
    SEAM(0);
    PH(1) { REPBAR();
        pg8::Gemm g{XN, Win_t, DM, DM, DM}; pg8::StaticOrder S; S.init(MP, DIN, G, bx);
        EpiZ E{ZR, GT};
        pg8::gemm_phase<EpiZ, pg8::StaticOrder, false, PG8_SP2>(lds, g, S, E);
        for (int su = bx; su < 64; su += G) pg8::sub_gemm<1>(lds, g, STILE, su >> 2, (su >> 1) & 1, su & 1, E);
    }
    SEAM(1);
    PH(2) { REPBAR();
        state_copy(p, bx * NWAVES * 64 + tid, G * NWAVES * 64);
        for (int t = bx; t < NBATCH * 32; t += G) lru_task(p, lds, t >> 5, (t >> 1) & 15, t & 1, tid, lane, wave);
        for (int L = bx; L < 16 + NTILE * 4; L += G) {
            if (L < 16) lru_unit<true>(p, lds, STILE, L, tid, lane, wave);
            else { const int r = L - 16; pool_unit(p, r >> 2, r & 3, tid); }
        }
    }
    if (IN(2) && IN(4)) xcd_barrier(bar);
    PH(4) { REPBAR();
        pg8::Gemm g{HP, Wcat_t, 2048, 2048, 2048}; pg8::StaticOrder S; S.init(MP, DM, G, bx);
        EpiBr E{GT, MG};
        pg8::gemm_phase<EpiBr, pg8::StaticOrder, false, PG8_SP2>(lds, g, S, E);
        for (int su = bx; su < 16; su += G) pg8::sub_gemm<1>(lds, g, STILE, su >> 2, (su >> 1) & 1, su & 1, E);
    }
    if (IN(4) && IN(6)) xcd_barrier(bar);
    PH(6) { REPBAR();
        pg8::Gemm g{MG, Wout_t, DM, DM, DM}; pg8::StaticOrder S; S.init(MP, DM, G, bx);
        EpiRes<false> E{p.in[I_XP], p.in[I_XS], Y, XG2, p.in[I_NFFN], SSQ};
        pg8::gemm_phase<EpiRes<false>, pg8::StaticOrder, false, PG8_SP2>(lds, g, S, E);
        for (int su = bx; su < 16; su += G) pg8::sub_gemm<1>(lds, g, STILE, su >> 2, (su >> 1) & 1, su & 1, E);
    }
    SEAM(6);
    PH(7) { REPBAR();
        pg8::Gemm g{XG2, Wup_t, DM, DM, DM};
        for (int sidx = vcu; sidx < 768; sidx += G) {
            const int rg = sidx >> 8, v = sidx & 255, x = v >> 5, w = v & 31, pm0 = 4 * (4 * x + (w >> 3)), pn = 8 * rg + (w & 7);
            strip_pre(p, lds, pm0, pn, 4, tid, lane, wave);
            pg8::StripOrder S{pm0, pn, 4};
            EpiUp E{ACT, p.in[I_CFW], p.in[I_CFB], p.in[I_STFFN], p.out + OFF_FCP, p.out + OFF_FCS, lds, pm0};
            pg8::gemm_phase<EpiUp, pg8::StripOrder, false, PG8_SP2>(lds, g, S, E);
        }
        { EpiUpS ES{ACT, p.in[I_CFW], p.in[I_CFB], p.in[I_STFFN], p.out + OFF_FCS, SSQ};
          for (int su = bx; su < 48; su += G) pg8::sub_gemm<2>(lds, g, STILE, su >> 1, su & 1, 0, ES); }
    }
    SEAM(7);
    PH(8) { REPBAR();
        pg8::Gemm g{ACT, Wdn_t, DFF, DFF, DFF}; pg8::StaticOrder S; S.init(MP, DM, G, bx);
        EpiRes<true> E{nullptr, nullptr, Y, nullptr, nullptr, SSQ2};
        pg8::gemm_phase<EpiRes<true>, pg8::StaticOrder, false, PG8_SP2>(lds, g, S, E);
        for (int su = bx; su < 16; su += G) pg8::sub_gemm<1>(lds, g, STILE, su >> 2, (su >> 1) & 1, su & 1, E);
    }
    SEAM(8);
    PH(9) { REPBAR(); final_norm(p, vcu * NWAVES + wave, G * NWAVES, lane); }
#undef IN
#undef SEAM
}

extern "C" void kernel_launch(void* const* d_in, const int* in_sizes, int n_in, void* d_out, int out_size, void* d_ws, size_t ws_size, hipStream_t stream) {
    static int grid = 0;
    if (grid == 0) {
        if (n_in != 26 || in_sizes[0] != MP * DM || (size_t)out_size != OUT_TOTAL || ws_size < WS_END) {
            fprintf(stderr, "kernel_launch: unexpected shapes: n_in %d in0 %d out %d ws %zu (need %zu)\n", n_in, n_in > 0 ? in_sizes[0] : -1, out_size, ws_size, (size_t)WS_END); grid = -1; return; }
        int dev = 0, cus = 0, per_cu = 0;
        if (hipGetDevice(&dev) != hipSuccess || hipDeviceGetAttribute(&cus, hipDeviceAttributeMultiprocessorCount, dev) != hipSuccess) { fprintf(stderr, "kernel_launch: device query failed\n"); grid = -1; return; }
        if (hipFuncSetAttribute((const void*)mk_fwd, hipFuncAttributeMaxDynamicSharedMemorySize, LDS_BYTES) != hipSuccess) { fprintf(stderr, "kernel_launch: hipFuncSetAttribute failed\n"); grid = -1; return; }
        if (hipOccupancyMaxActiveBlocksPerMultiprocessor(&per_cu, (const void*)mk_fwd, NWAVES * 64, LDS_BYTES) != hipSuccess || per_cu < 1) {
            fprintf(stderr, "kernel_launch: occupancy query reports %d blocks per CU\n", per_cu); (void)hipGetLastError(); per_cu = 1; }
        grid = cus;
        fprintf(stderr, "kernel_launch: grid %d (cus %d, occupancy %d/CU)\n", grid, cus, per_cu);
    }
    if (grid < 0) return;
    if (hipMemsetAsync((char*)d_ws + WS_CTL, 0, CTL_ZERO_BYTES, stream) != hipSuccess) { fprintf(stderr, "kernel_launch: memset failed\n"); return; }
    KP a{};
    for (int i = 0; i < 26; ++i) a.in[i] = (const float*)d_in[i];
    a.out = (float*)d_out; a.ws = (unsigned char*)d_ws;
#if MK_ONE_LAUNCH
    a.ph_lo = 0; a.ph_hi = N_PHASES;
    hipLaunchKernelGGL(mk_fwd, dim3(grid), dim3(NWAVES * 64), LDS_BYTES, stream, a);
#else
    for (int k = 0; k < N_PHASES; ++k) { a.ph_lo = k; a.ph_hi = k + 1; hipLaunchKernelGGL(mk_fwd, dim3(grid), dim3(NWAVES * 64), LDS_BYTES, stream, a); }
#endif
    const hipError_t le = hipPeekAtLastError();
    if (le != hipSuccess) fprintf(stderr, "kernel_launch: launch failed: %s\n", hipGetErrorName(le));
}
```

```cpp
#include <hip/hip_runtime.h>
#include <cstdio>
#include <cstdint>
#define MK_ONE_LAUNCH 1
namespace pg8 {
#define PG8_LAS __attribute__((address_space(3)))
typedef unsigned short bf16_t;
typedef short bf16x8 __attribute__((ext_vector_type(8)));
typedef float f32x4 __attribute__((ext_vector_type(4)));
typedef unsigned u32x4 __attribute__((ext_vector_type(4)));
typedef unsigned u32x2 __attribute__((ext_vector_type(2)));
constexpr int BM = 256, BK = 64, HALF = 128, HTB = HALF * BK * 2  , STAGE_BYTES = 8 * HTB, NXCD = 8, WGM = 8;

__host__ __device__ __forceinline__ int lds_byte(int r, int c) { const int st = (r >> 4) * 2 + (c >> 5), rr = r & 15, cc = c & 31, ob = rr * 64 + cc * 2; return st * 1024 + (ob ^ (((ob >> 9) & 1) << 5)); }
__host__ __device__ __forceinline__ void stage_rc(int b, int& R, int& C) { const int st = b / 1024, sb = b % 1024, swz = sb ^ (((sb >> 9) & 1) << 5); R = (st >> 1) * 16 + swz / 64; C = (st & 1) * 32 + (swz % 64) / 2; }
__host__ __device__ __forceinline__ int perm32(int rho) { const int n = rho >> 4, i = rho & 15; return 8 * (i >> 2) + 4 * n + (i & 3); }
__host__ __device__ __forceinline__ int amap_row(int R) { return 128 * (R >> 6) + 8 * (R & 15) + ((R >> 4) & 3); }

struct Unit { int pm, pn; };
struct Gemm { const bf16_t* A; const bf16_t* Bt; int K, lda, ldb; };

struct StaticOrder {
    int nM, nN, nwg, G, c;
    __host__ __device__ void init(int M, int N, int G_, int c_) { nM = M / BM; nN = N / BM; nwg = nM * nN; G = G_; c = c_; }
    __host__ __device__ bool next(int i, Unit& u) const {
        const long L = (long)i * G + c; if (L >= nwg) return false;
        int wgid = (int)L; { const int q = nwg / NXCD, r = nwg % NXCD, xcd = wgid % NXCD, off = wgid / NXCD; wgid = (xcd < r ? xcd * (q + 1) : r * (q + 1) + (xcd - r) * q) + off; }
        const int nig = WGM * nN, gid = wgid / nig, fm = gid * WGM, gsz = (nM - fm) < WGM ? (nM - fm) : WGM;
        u.pm = fm + ((wgid % nig) % gsz); u.pn = (wgid % nig) / gsz; return true;
    }
    __device__ __forceinline__ void a_ready(const Unit&) const {}
    __device__ __forceinline__ void done(const Unit&) const {}
};
struct StripOrder {
    int pm0, pn, cnt;
    __device__ __forceinline__ bool next(int i, Unit& u) const { if (i >= cnt) return false; u.pm = pm0 + i; u.pn = pn; return true; }
    __device__ __forceinline__ void a_ready(const Unit&) const {}
    __device__ __forceinline__ void done(const Unit&) const {}
};

__device__ __forceinline__ unsigned cvt_pk_bf16(float lo, float hi) { unsigned r; asm volatile("v_cvt_pk_bf16_f32 %0, %1, %2" : "=v"(r) : "v"(lo), "v"(hi)); return r; }

template <class Epi, class Sched, bool ALIGN_EPI = false, bool SP2 = false>
__device__ __forceinline__ void gemm_phase(PG8_LAS unsigned char* lds, const Gemm g, const Sched& S, const Epi& E) {
    const int tid = threadIdx.x, wid = __builtin_amdgcn_readfirstlane(tid >> 6), lane = tid & 63, wr = wid >> 2, wc = wid & 3, fr = lane & 15, fq = lane >> 4;
    const int K = g.K, nt = K / BK;
    unsigned voffA[2], voffB[2];
#pragma unroll
    for (int i = 0; i < 2; ++i) { int R, C; stage_rc(tid * 16 + i * 8192, R, C); const int Rb = Epi::PERM ? ((R & ~31) + perm32(R & 31)) : R; const int Ra = Epi::AMAP ? amap_row(R) : R;
        voffA[i] = (unsigned)(Ra * g.lda + C) * 2u; voffB[i] = (unsigned)(Rb * g.ldb + C) * 2u; }
    const size_t kstep = (size_t)(BK * 2);
    const size_t hstepA = Epi::AMAP ? (size_t)4 * g.lda * 2 : (size_t)HALF * g.lda * 2;
    const size_t hstepB = (size_t)HALF * g.ldb * 2;
    const size_t tstepA = (size_t)BM * g.lda * 2, tstepB = (size_t)BM * g.ldb * 2;
    const unsigned ldsw = (unsigned)wid * 1024u;
    const int aoff = lds_byte(wr * 64 + fr, fq * 8), boff = lds_byte(wc * 32 + fr, fq * 8);
#define PG8_SA(b, h) (((b) * 2 + (h)) * HTB)
#define PG8_SB(b, h) ((4 + (b) * 2 + (h)) * HTB)
#define PG8_STAGE(bufoff, gbase, voff) do { _Pragma("unroll") for (int _i = 0; _i < 2; ++_i) \
        __builtin_amdgcn_global_load_lds((const unsigned*)((const char*)(gbase) + (voff)[_i]), (PG8_LAS unsigned*)(lds + (bufoff) + ldsw + _i * 8192), 16, 0, 0); } while (0)
#define PG8_LDA(dst, b, h) do { _Pragma("unroll") for (int m = 0; m < 4; ++m) _Pragma("unroll") for (int k = 0; k < 2; ++k) dst[m][k] = *(const PG8_LAS bf16x8*)(lds + PG8_SA(b, h) + aoff + m * 2048 + k * 1024); } while (0)
#define PG8_LDB(dst, b, h) do { _Pragma("unroll") for (int n = 0; n < 2; ++n) _Pragma("unroll") for (int k = 0; k < 2; ++k) dst[n][k] = *(const PG8_LAS bf16x8*)(lds + PG8_SB(b, h) + boff + n * 2048 + k * 1024); } while (0)
#define PG8_MMA(ai, bj, At, Bt) do { __builtin_amdgcn_s_setprio(1); _Pragma("unroll") for (int m = 0; m < 4; ++m) _Pragma("unroll") for (int n = 0; n < 2; ++n) _Pragma("unroll") for (int k = 0; k < 2; ++k) \
        acc[ai][bj][m][n] = __builtin_amdgcn_mfma_f32_16x16x32_bf16(Bt[n][k], At[m][k], acc[ai][bj][m][n], 0, 0, 0); __builtin_amdgcn_s_setprio(0); } while (0)
#define PG8_WAIT_V(n) asm volatile("s_waitcnt vmcnt(" #n ")" ::: "memory")
#define PG8_WAIT_L(n) asm volatile("s_waitcnt lgkmcnt(" #n ")" ::: "memory")
#define PG8_BAR __builtin_amdgcn_s_barrier()
#define PG8_SCHED __builtin_amdgcn_sched_barrier(0)
    Unit cur, nxt; int ui = 0;
    if (!S.next(0, cur)) return;
    f32x4 acc[2][2][4][2];
#pragma unroll
    for (int a = 0; a < 2; ++a)
#pragma unroll
        for (int b = 0; b < 2; ++b)
#pragma unroll
            for (int m = 0; m < 4; ++m)
#pragma unroll
                for (int n = 0; n < 2; ++n) acc[a][b][m][n] = (f32x4){0.f, 0.f, 0.f, 0.f};
    bf16x8 At[4][2], B0[2][2], B1[2][2];
    const char* cA = (const char*)g.A + (size_t)cur.pm * tstepA; const char* cB = (const char*)g.Bt + (size_t)cur.pn * tstepB;
    S.a_ready(cur);
    if constexpr (SP2) {
        PG8_STAGE(PG8_SB(0, 0), cB, voffB); PG8_STAGE(PG8_SB(0, 1), cB + hstepB, voffB); PG8_STAGE(PG8_SA(0, 0), cA, voffA); PG8_STAGE(PG8_SA(0, 1), cA + hstepA, voffA);
        if (wr == 1) PG8_BAR;
        PG8_WAIT_V(2); PG8_BAR;
        PG8_STAGE(PG8_SB(1, 0), cB + kstep, voffB); PG8_STAGE(PG8_SA(1, 0), cA + kstep, voffA); PG8_STAGE(PG8_SB(1, 1), cB + hstepB + kstep, voffB);
        PG8_WAIT_V(6); PG8_BAR;
    } else {
        PG8_STAGE(PG8_SB(0, 0), cB, voffB); PG8_STAGE(PG8_SA(0, 0), cA, voffA); PG8_STAGE(PG8_SB(0, 1), cB + hstepB, voffB); PG8_STAGE(PG8_SA(0, 1), cA + hstepA, voffA);
        if (wr == 1) PG8_BAR;
        PG8_WAIT_V(4); PG8_BAR;
        PG8_STAGE(PG8_SB(1, 0), cB + kstep, voffB); PG8_STAGE(PG8_SA(1, 0), cA + kstep, voffA); PG8_STAGE(PG8_SB(1, 1), cB + hstepB + kstep, voffB);
        PG8_WAIT_V(6); PG8_BAR;
    }
    for (;;) {
        const bool has_next = S.next(ui + 1, nxt);
        const char* nA = has_next ? (const char*)g.A + (size_t)nxt.pm * tstepA : cA; const char* nB = has_next ? (const char*)g.Bt + (size_t)nxt.pn * tstepB : cB;
        for (int t = 0; t < nt; t += 2) {
            const bool last = (t == nt - 2);
            const char* a1 = cA + (size_t)(t + 1) * kstep;
            const char* a2 = last ? nA : cA + (size_t)(t + 2) * kstep; const char* b2 = last ? nB : cB + (size_t)(t + 2) * kstep;
            const char* a3 = a2 + kstep; const char* b3 = b2 + kstep;
            if (last && has_next) S.a_ready(nxt);
            if constexpr (Epi::MID) { if (t == (nt >> 1)) E.template mid<2, 2>(acc, cur, 0, 0, wr, wc, fr, fq); }
            if constexpr (SP2) {
            PG8_LDB(B0, 0, 0); PG8_LDB(B1, 0, 1); PG8_SCHED; PG8_LDA(At, 0, 0); PG8_STAGE(PG8_SA(1, 1), a1 + hstepA, voffA);
            PG8_WAIT_V(8); PG8_WAIT_L(0); PG8_BAR; PG8_MMA(0, 0, At, B0); PG8_MMA(0, 1, At, B1); PG8_BAR; PG8_SCHED;
            PG8_LDA(At, 0, 1); PG8_STAGE(PG8_SB(0, 0), b2, voffB); PG8_STAGE(PG8_SB(0, 1), b2 + hstepB, voffB); PG8_STAGE(PG8_SA(0, 0), a2, voffA);
            PG8_WAIT_V(8); PG8_WAIT_L(0); PG8_BAR; PG8_MMA(1, 0, At, B0); PG8_MMA(1, 1, At, B1); PG8_BAR; PG8_SCHED;
            PG8_LDB(B0, 1, 0); PG8_LDB(B1, 1, 1); PG8_SCHED; PG8_LDA(At, 1, 0); PG8_STAGE(PG8_SA(0, 1), a2 + hstepA, voffA);
            PG8_WAIT_V(8); PG8_WAIT_L(0); PG8_BAR; PG8_MMA(0, 0, At, B0); PG8_MMA(0, 1, At, B1); PG8_BAR; PG8_SCHED;
            PG8_LDA(At, 1, 1); PG8_STAGE(PG8_SB(1, 0), b3, voffB); PG8_STAGE(PG8_SB(1, 1), b3 + hstepB, voffB); PG8_STAGE(PG8_SA(1, 0), a3, voffA);
            PG8_WAIT_V(8); PG8_WAIT_L(0); PG8_BAR; PG8_MMA(1, 0, At, B0); PG8_MMA(1, 1, At, B1); PG8_BAR; PG8_SCHED;
            } else {
            PG8_LDB(B0, 0, 0); PG8_SCHED; PG8_LDA(At, 0, 0); PG8_STAGE(PG8_SA(1, 1), a1 + hstepA, voffA);
            PG8_WAIT_L(8); PG8_BAR; PG8_WAIT_L(0); PG8_MMA(0, 0, At, B0); PG8_BAR; PG8_SCHED;
            PG8_LDB(B1, 0, 1); PG8_STAGE(PG8_SB(0, 0), b2, voffB);
            PG8_BAR; PG8_WAIT_L(0); PG8_MMA(0, 1, At, B1); PG8_BAR;
            PG8_LDA(At, 0, 1); PG8_STAGE(PG8_SA(0, 0), a2, voffA);
            PG8_BAR; PG8_WAIT_L(0); PG8_MMA(1, 0, At, B0); PG8_BAR; PG8_SCHED;
            PG8_STAGE(PG8_SB(0, 1), b2 + hstepB, voffB);
            PG8_WAIT_V(6); PG8_BAR; PG8_MMA(1, 1, At, B1); PG8_BAR;
            PG8_LDB(B0, 1, 0); PG8_SCHED; PG8_LDA(At, 1, 0); PG8_STAGE(PG8_SA(0, 1), a2 + hstepA, voffA);
            PG8_WAIT_L(8); PG8_BAR; PG8_WAIT_L(0); PG8_MMA(0, 0, At, B0); PG8_BAR; PG8_SCHED;
            PG8_LDB(B1, 1, 1); PG8_STAGE(PG8_SB(1, 0), b3, voffB);
            PG8_BAR; PG8_WAIT_L(0); PG8_MMA(0, 1, At, B1); PG8_BAR;
            PG8_LDA(At, 1, 1); PG8_STAGE(PG8_SA(1, 0), a3, voffA);
            PG8_BAR; PG8_WAIT_L(0); PG8_MMA(1, 0, At, B0); PG8_BAR; PG8_SCHED;
            PG8_STAGE(PG8_SB(1, 1), b3 + hstepB, voffB);
            PG8_WAIT_V(6); PG8_BAR; PG8_MMA(1, 1, At, B1); PG8_BAR;
            }
        }
        if constexpr (ALIGN_EPI) { if (wr == 0) PG8_BAR; }
        E.template run<2, 2>(acc, cur, 0, 0, wr, wc, fr, fq); S.done(cur);
        if (!has_next) break;
#pragma unroll
        for (int a = 0; a < 2; ++a)
#pragma unroll
            for (int b = 0; b < 2; ++b)
#pragma unroll
                for (int m = 0; m < 4; ++m)
#pragma unroll
                    for (int n = 0; n < 2; ++n) acc[a][b][m][n] = (f32x4){0.f, 0.f, 0.f, 0.f};
        cur = nxt; cA = nA; cB = nB; ++ui;
        if constexpr (ALIGN_EPI) { if (wr == 1) PG8_BAR; }
    }
    PG8_WAIT_V(0);
    if constexpr (!ALIGN_EPI) { if (wr == 0) PG8_BAR; }
    PG8_BAR;
#undef PG8_SA
#undef PG8_SB
#undef PG8_STAGE
#undef PG8_LDA
#undef PG8_LDB
#undef PG8_MMA
#undef PG8_WAIT_V
#undef PG8_WAIT_L
#undef PG8_BAR
#undef PG8_SCHED
}

template <int NB, class Epi>
__device__ __forceinline__ void sub_gemm(PG8_LAS unsigned char* lds, const Gemm g, int pm, int pn, int ai0, int bj0, const Epi& E) {
    int tid_ = threadIdx.x; asm volatile("" : "+v"(tid_));
    const int tid = tid_, wid = __builtin_amdgcn_readfirstlane(tid >> 6), lane = tid & 63, wr = wid >> 2, wc = wid & 3, fr = lane & 15, fq = lane >> 4;
    const int nt = g.K / BK;
    unsigned voffA[2], voffB[2];
#pragma unroll
    for (int i = 0; i < 2; ++i) { int R, C; stage_rc(tid * 16 + i * 8192, R, C); const int Rb = Epi::PERM ? ((R & ~31) + perm32(R & 31)) : R;
        voffA[i] = (unsigned)(R * g.lda + C) * 2u; voffB[i] = (unsigned)(Rb * g.ldb + C) * 2u; }
    const size_t kstep = (size_t)(BK * 2), hstepB = (size_t)HALF * g.ldb * 2;
    const unsigned ldsw = (unsigned)wid * 1024u;
    const int aoff = lds_byte(wr * 64 + fr, fq * 8), boff = lds_byte(wc * 32 + fr, fq * 8);
    const char* cA = (const char*)g.A + ((size_t)pm * BM + (size_t)ai0 * HALF) * g.lda * 2; const char* cB = (const char*)g.Bt + ((size_t)pn * BM + (size_t)bj0 * HALF) * g.ldb * 2;
#define SG_BUF(b, j) ((b) * 3 * HTB + (j) * HTB)
#define SG_STAGE(bufoff, gbase, voff) do { _Pragma("unroll") for (int _i = 0; _i < 2; ++_i) \
        __builtin_amdgcn_global_load_lds((const unsigned*)((const char*)(gbase) + (voff)[_i]), (PG8_LAS unsigned*)(lds + (bufoff) + ldsw + _i * 8192), 16, 0, 0); } while (0)
    f32x4 acc[1][NB][4][2];
#pragma unroll
    for (int b = 0; b < NB; ++b)
#pragma unroll
        for (int m = 0; m < 4; ++m)
#pragma unroll
            for (int n = 0; n < 2; ++n) acc[0][b][m][n] = (f32x4){0.f, 0.f, 0.f, 0.f};
    SG_STAGE(SG_BUF(0, 0), cA, voffA);
#pragma unroll
    for (int j = 0; j < NB; ++j) SG_STAGE(SG_BUF(0, 1 + j), cB + j * hstepB, voffB);
#pragma unroll 1
    for (int t = 0; t < nt; ++t) {
        const int cur = t & 1;
        if constexpr (Epi::MID) { if (t == (nt >> 1)) E.template mid<1, NB>(acc, Unit{pm, pn}, ai0 * HALF, bj0 * HALF, wr, wc, fr, fq); }
        if (t + 1 < nt) {
            SG_STAGE(SG_BUF(cur ^ 1, 0), cA + (size_t)(t + 1) * kstep, voffA);
#pragma unroll
            for (int j = 0; j < NB; ++j) SG_STAGE(SG_BUF(cur ^ 1, 1 + j), cB + j * hstepB + (size_t)(t + 1) * kstep, voffB);
            if constexpr (NB == 1) asm volatile("s_waitcnt vmcnt(4)" ::: "memory"); else asm volatile("s_waitcnt vmcnt(6)" ::: "memory");
        } else asm volatile("s_waitcnt vmcnt(0)" ::: "memory");
        __builtin_amdgcn_s_barrier();
        bf16x8 At[4][2], Bf[NB][2][2];
#pragma unroll
        for (int m = 0; m < 4; ++m)
#pragma unroll
            for (int k = 0; k < 2; ++k) At[m][k] = *(const PG8_LAS bf16x8*)(lds + SG_BUF(cur, 0) + aoff + m * 2048 + k * 1024);
#pragma unroll
        for (int j = 0; j < NB; ++j)
#pragma unroll
            for (int n = 0; n < 2; ++n)
#pragma unroll
                for (int k = 0; k < 2; ++k) Bf[j][n][k] = *(const PG8_LAS bf16x8*)(lds + SG_BUF(cur, 1 + j) + boff + n * 2048 + k * 1024);
        asm volatile("s_waitcnt lgkmcnt(0)" ::: "memory"); __builtin_amdgcn_sched_barrier(0);
#pragma unroll
        for (int j = 0; j < NB; ++j)
#pragma unroll
            for (int m = 0; m < 4; ++m)
#pragma unroll
                for (int n = 0; n < 2; ++n)
#pragma unroll
                    for (int k = 0; k < 2; ++k) acc[0][j][m][n] = __builtin_amdgcn_mfma_f32_16x16x32_bf16(Bf[j][n][k], At[m][k], acc[0][j][m][n], 0, 0, 0);
        __builtin_amdgcn_s_barrier();
    }
    E.template run<1, NB>(acc, Unit{pm, pn}, ai0 * HALF, bj0 * HALF, wr, wc, fr, fq);
#undef SG_BUF
#undef SG_STAGE
}
}
constexpr int NWAVES = 8;
constexpr int DM = 1024, NBATCH = 8, SEQ = 4096, SBATCH = 16, SSEQ = 16, PAST = 2048;
constexpr int MP = NBATCH * SEQ, MS = SBATCH * SSEQ, M = MP + MS, NTILE = M / 256, STILE = MP / 256;
constexpr int DIN = 4096, DFF = 3072, DUP = 6144;
constexpr float EPS = 1e-6f;
constexpr size_t OFF_Y = 0, OFF_HP = (size_t)M * DM, OFF_LCP = OFF_HP + NBATCH * DM, OFF_PLP = OFF_LCP + NBATCH * 3 * DM, OFF_FCP = OFF_PLP + NBATCH * 15 * DM,
                 OFF_HS = OFF_FCP + NBATCH * 2 * DUP, OFF_LCS = OFF_HS + SBATCH * DM, OFF_PLS = OFF_LCS + SBATCH * 3 * DM, OFF_FCS = OFF_PLS + SBATCH * 15 * DM,
                 OUT_TOTAL = OFF_FCS + SBATCH * 2 * DUP;
constexpr size_t MiB = 1u << 20;
constexpr size_t WS_CTL = 0, CTL_ZERO_BYTES = 64 * 1024;
constexpr size_t WS_WIN = 1 * MiB, WS_WCAT = 9 * MiB, WS_WOUT = 13 * MiB, WS_WUP = 15 * MiB, WS_WDN = 27 * MiB, WS_WG = 33 * MiB;
constexpr size_t WS_SSQ = 33 * MiB + 512 * 1024, WS_SSQ2 = 37 * MiB + 768 * 1024, WS_SUMM = WS_SSQ;
static_assert(WS_SSQ + (size_t)M * 128 <= WS_SSQ2 && WS_SSQ2 + (size_t)M * 128 <= 42 * MiB, "ssq map");
constexpr size_t WS_R0 = 42 * MiB, WS_R1 = 107 * MiB, WS_R2 = 236 * MiB, WS_R3 = 365 * MiB, WS_WBP = 494 * MiB, WS_WPOOL = 496 * MiB, WS_END = 497 * MiB;
static_assert((size_t)M * DM * 2 <= WS_R1 - WS_R0 && (size_t)M * 2048 * 2 <= WS_R2 - WS_R1 && (size_t)M * 2048 * 2 <= WS_R3 - WS_R2 && (size_t)M * 2048 * 2 <= WS_END - WS_R3 && (size_t)M * DFF * 2 <= WS_END - WS_R2, "ws map");
constexpr int CW_BAR = 1024, CW_PANEL = 8192;
constexpr int RING_BYTES = 131072;
constexpr int MISC_OFF = RING_BYTES, RS_OFF = RING_BYTES + 512, EDGE_START_OFF = RS_OFF + 4096, EDGE_MID_OFF = EDGE_START_OFF + 2048, EDGE_PREV_OFF = EDGE_MID_OFF + 2048;
constexpr int LDS_BYTES = 147456;
static_assert(EDGE_PREV_OFF + 2048 <= LDS_BYTES, "LDS map");

#define GAS __attribute__((address_space(1)))
#define LAS __attribute__((address_space(3)))
typedef unsigned short bf16;
typedef unsigned v4u __attribute__((ext_vector_type(4)));
typedef unsigned v2u __attribute__((ext_vector_type(2)));
typedef float f32x4 __attribute__((ext_vector_type(4)));
typedef short bf16x8 __attribute__((ext_vector_type(8)));
#define LDS_WAIT() asm volatile("s_waitcnt lgkmcnt(0)" ::: "memory")
#define VM_WAIT() asm volatile("s_waitcnt vmcnt(0)" ::: "memory")
__device__ __forceinline__ unsigned f2bf(float f) { unsigned u = __builtin_bit_cast(unsigned, f); return (u + 0x7fffu + ((u >> 16) & 1u)) >> 16; }
__device__ __forceinline__ unsigned pk2(float lo, float hi) { return f2bf(lo) | (f2bf(hi) << 16); }
__device__ __forceinline__ float bflo(unsigned w) { return __builtin_bit_cast(float, w << 16); }
__device__ __forceinline__ float bfhi(unsigned w) { return __builtin_bit_cast(float, w & 0xffff0000u); }
__device__ __forceinline__ float sigmoidf_fast(float x) { return __builtin_amdgcn_rcpf(1.0f + __builtin_amdgcn_exp2f(-1.4426950408889634f * x)); }
__device__ __forceinline__ float gelu_tanh(float g) { const float z = g * (1.0f + 0.044715f * g * g); return g * __builtin_amdgcn_rcpf(1.0f + __builtin_amdgcn_exp2f(-2.302208198f * z)); }
__device__ __forceinline__ float wave_sum(float v) {
#pragma unroll
    for (int o = 1; o < 64; o <<= 1) v += __shfl_xor(v, o);
    return v;
}

#define XB_TMO      128
#define XB_XCNT(j)  (256  + 64 * (j))
#define XB_XSUB(j)  (1280 + 64 * (j))
#define XB_XGEN(j)  (2304 + 64 * (j))
#define XB_TOP      3328
#define XB_TOPGEN   3392
#define XCD_BAR_WORDS 3456
#define XB_SPIN_CAP (1u << 20)
static_assert((CW_BAR + XCD_BAR_WORDS) <= CW_PANEL && (CW_PANEL + 32 * 132) * 4 <= (int)CTL_ZERO_BYTES, "control words inside the memset region");
__device__ __forceinline__ unsigned xb_ld(unsigned* p)              { return __hip_atomic_load(p, __ATOMIC_RELAXED, __HIP_MEMORY_SCOPE_AGENT); }
__device__ __forceinline__ unsigned xb_add(unsigned* p, unsigned v) { return __hip_atomic_fetch_add(p, v, __ATOMIC_RELAXED, __HIP_MEMORY_SCOPE_AGENT); }
__device__ __forceinline__ unsigned xb_xcc_id() { return (unsigned)__builtin_amdgcn_s_getreg((3 << 11) | 20) & 0xFu; }
#define XB_SPIN(cond, bar) do { unsigned _sp = 0; while (cond) { __builtin_amdgcn_s_sleep(1); \
    if ((++_sp & 255u) == 0u) { if (xb_ld(&(bar)[XB_TMO])) break; if (_sp > XB_SPIN_CAP) { atomicAdd(&(bar)[XB_TMO], 1u); break; } } } } while (0)
struct XcdBarrier { unsigned* bar; unsigned x; volatile LAS unsigned* st; };
__device__ __forceinline__ XcdBarrier xcd_barrier_post(unsigned* bar, volatile LAS unsigned* st) {
    XcdBarrier b; b.bar = bar; b.x = xb_xcc_id(); b.st = st;
    if (threadIdx.x == 0) (void)xb_add(&bar[XB_XCNT(b.x)], 1u);
    return b;
}
__device__ __forceinline__ void xcd_barrier_complete(unsigned* bar, unsigned x, unsigned& nloc, unsigned& nx) {
    const unsigned G = gridDim.x * gridDim.y * gridDim.z;
    unsigned sum, cnt, mine, sp = 0u;
    for (;;) {
        sum = 0u; cnt = 0u; mine = 0u;
#pragma unroll
        for (unsigned j = 0; j < 16; ++j) { const unsigned c = xb_ld(&bar[XB_XCNT(j)]); sum += c; cnt += (c > 0u) ? 1u : 0u; mine = (j == x) ? c : mine; }
        if (sum == G) break;
        __builtin_amdgcn_s_sleep(1);
        if ((++sp & 255u) == 0u) { if (xb_ld(&bar[XB_TMO])) break; if (sp > XB_SPIN_CAP) { atomicAdd(&bar[XB_TMO], 1u); break; } }
    }
    nloc = mine > 0u ? mine : 1u; nx = cnt > 0u ? cnt : 1u;
}
__device__ __forceinline__ void xcd_barrier(const XcdBarrier& b) {
    asm volatile("s_waitcnt vmcnt(0)" ::: "memory");
    __syncthreads();
    if (threadIdx.x == 0) {
        unsigned* bar = b.bar;
        __builtin_amdgcn_s_waitcnt(0);
        unsigned nloc = b.st[0], nx = b.st[1];
        if (nloc == 0u) { xcd_barrier_complete(bar, b.x, nloc, nx); b.st[0] = nloc; b.st[1] = nx; }
        const unsigned old = xb_add(&bar[XB_XSUB(b.x)], 1u);
        const unsigned gen = old / nloc;
        if (old + 1u == (gen + 1u) * nloc) {
            __builtin_amdgcn_fence(__ATOMIC_RELEASE, "agent");
            asm volatile("s_waitcnt vmcnt(0)" ::: "memory");
            const unsigned og = xb_add(&bar[XB_TOP], 1u);
            const unsigned tg = og / nx;
            if (og + 1u == (tg + 1u) * nx) xb_add(&bar[XB_TOPGEN], 1u);
            else XB_SPIN(xb_ld(&bar[XB_TOPGEN]) == tg, bar);
            __builtin_amdgcn_fence(__ATOMIC_ACQUIRE, "agent");
            xb_add(&bar[XB_XGEN(b.x)], 1u);
            asm volatile("s_waitcnt vmcnt(0)" ::: "memory");
        } else {
            XB_SPIN(xb_ld(&bar[XB_XGEN(b.x)]) == gen, bar);
            __builtin_amdgcn_fence(__ATOMIC_ACQUIRE, "agent");
            asm volatile("s_waitcnt vmcnt(0)" ::: "memory");
        }
    }
    __syncthreads();
}

struct KP {
    const float* in[26];
    float* out; unsigned char* ws;
    int ph_lo, ph_hi;
};
enum { I_XP = 0, I_XS, I_STH, I_STLC, I_STPOOL, I_STFFN, I_NMIX, I_WIN, I_CLW, I_CLB, I_WRA, I_BRA, I_WIX, I_BIX, I_LAM, I_WPOOL, I_PSCALE, I_WBRL, I_WBRP, I_WOUT, I_NFFN, I_WUP, I_CFW, I_CFB, I_WDN, I_NFIN };

using pg8::Unit;
struct EpiZ {
    static constexpr bool PERM = true, AMAP = false, MID = false;
    bf16* ZR; bf16* G;
    template <int NA, int NB> __device__ __forceinline__ void run(f32x4 (&acc)[NA][NB][4][2], const Unit& u, int rowoff, int coloff, int wr, int wc, int fr, int fq) const {
        const int row0 = u.pm * 256 + rowoff + wr * 64 + fr; const bool gate = u.pn >= 8;
        bf16* base = gate ? G : ZR; const int col0 = (u.pn & 7) * 256 + coloff + wc * 32 + 8 * fq;
#pragma unroll
        for (int ai = 0; ai < NA; ++ai)
#pragma unroll
            for (int m = 0; m < 4; ++m) { bf16* rowp = base + (size_t)(row0 + ai * 128 + m * 16) * 2048 + col0;
#pragma unroll
                for (int bj = 0; bj < NB; ++bj) { f32x4 v0 = acc[ai][bj][m][0], v1 = acc[ai][bj][m][1];
                    if (gate) {
#pragma unroll
                        for (int j = 0; j < 4; ++j) { v0[j] = sigmoidf_fast(v0[j]); v1[j] = sigmoidf_fast(v1[j]); } }
                    v4u w; w.x = pg8::cvt_pk_bf16(v0[0], v0[1]); w.y = pg8::cvt_pk_bf16(v0[2], v0[3]); w.z = pg8::cvt_pk_bf16(v1[0], v1[1]); w.w = pg8::cvt_pk_bf16(v1[2], v1[3]);
                    *(v4u*)(rowp + bj * 128) = w; } }
    }
};
struct EpiBr {
    static constexpr bool PERM = true, AMAP = false, MID = true;
    const bf16* G; bf16* MG;
    template <int NA, int NB> __device__ __forceinline__ void mid(f32x4 (&acc)[NA][NB][4][2], const Unit& u, int rowoff, int coloff, int wr, int wc, int fr, int fq) const {
        int pm_ = u.pm, pn_ = u.pn; asm volatile("" : "+s"(pm_), "+s"(pn_));
        const int row0 = pm_ * 256 + rowoff + wr * 64 + fr, col0 = pn_ * 256 + coloff + wc * 32 + 8 * fq;
#pragma unroll
        for (int ai = 0; ai < NA; ++ai)
#pragma unroll
            for (int m = 0; m < 4; ++m) { const size_t row = (size_t)(row0 + ai * 128 + m * 16);
#pragma unroll
                for (int bj = 0; bj < NB; ++bj) { const int col = col0 + bj * 128;
                    const v4u ga = *(const v4u*)(G + row * 2048 + col), gb = *(const v4u*)(G + row * 2048 + 1024 + col);
                    const float a_[8] = {bflo(ga.x), bfhi(ga.x), bflo(ga.y), bfhi(ga.y), bflo(ga.z), bfhi(ga.z), bflo(ga.w), bfhi(ga.w)};
                    const float b_[8] = {bflo(gb.x), bfhi(gb.x), bflo(gb.y), bfhi(gb.y), bflo(gb.z), bfhi(gb.z), bflo(gb.w), bfhi(gb.w)};
#pragma unroll
                    for (int e = 0; e < 4; ++e) { acc[ai][bj][m][0][e] *= a_[e] * __builtin_amdgcn_rcpf(fmaxf(b_[e], 1e-30f)); acc[ai][bj][m][1][e] *= a_[4 + e] * __builtin_amdgcn_rcpf(fmaxf(b_[4 + e], 1e-30f)); } } }
    }
    template <int NA, int NB> __device__ __forceinline__ void run(f32x4 (&acc)[NA][NB][4][2], const Unit& u, int rowoff, int coloff, int wr, int wc, int fr, int fq) const {
        const int row0 = u.pm * 256 + rowoff + wr * 64 + fr, col0 = u.pn * 256 + coloff + wc * 32 + 8 * fq;
#pragma unroll
        for (int ai = 0; ai < NA; ++ai)
#pragma unroll
            for (int m = 0; m < 4; ++m) { const size_t row = (size_t)(row0 + ai * 128 + m * 16);
#pragma unroll
                for (int bj = 0; bj < NB; ++bj) { const int col = col0 + bj * 128;
                    const v4u gw = *(const v4u*)(G + row * 2048 + 1024 + col);
                    const f32x4 g0 = {bflo(gw.x), bfhi(gw.x), bflo(gw.y), bfhi(gw.y)}, g1 = {bflo(gw.z), bfhi(gw.z), bflo(gw.w), bfhi(gw.w)};
                    const f32x4 v0 = acc[ai][bj][m][0] * g0, v1 = acc[ai][bj][m][1] * g1;
                    v4u w; w.x = pg8::cvt_pk_bf16(v0[0], v0[1]); w.y = pg8::cvt_pk_bf16(v0[2], v0[3]); w.z = pg8::cvt_pk_bf16(v1[0], v1[1]); w.w = pg8::cvt_pk_bf16(v1[2], v1[3]);
                    *(v4u*)(MG + row * 1024 + col) = w; } }
    }
};
template <bool DOWN> struct EpiRes {
    static constexpr bool PERM = true, AMAP = false, MID = false;
    const float* xp; const float* xs; float* Y; bf16* XG2; const float* g2; float* SSQ;
    template <int NA, int NB> __device__ __forceinline__ void run(f32x4 (&acc)[NA][NB][4][2], const Unit& u, int rowoff, int coloff, int wr, int wc, int fr, int fq) const {
        const int row0 = u.pm * 256 + rowoff + wr * 64 + fr, col0 = u.pn * 256 + coloff + wc * 32 + 8 * fq;
        const float* xb = DOWN ? (const float*)Y : (u.pm < STILE ? xp : xs - (size_t)MP * DM);
        f32x4 gg[NB][2];
        if (!DOWN) {
#pragma unroll
            for (int bj = 0; bj < NB; ++bj) { gg[bj][0] = *(const f32x4*)(g2 + col0 + bj * 128); gg[bj][1] = *(const f32x4*)(g2 + col0 + bj * 128 + 4); } }
#pragma unroll
        for (int ai = 0; ai < NA; ++ai)
#pragma unroll
            for (int m = 0; m < 4; ++m) { const size_t row = (size_t)(row0 + ai * 128 + m * 16);
#pragma unroll
                for (int bj = 0; bj < NB; ++bj) { const size_t off = row * 1024 + col0 + bj * 128;
                    f32x4 v0 = acc[ai][bj][m][0] + *(const f32x4*)(xb + off), v1 = acc[ai][bj][m][1] + *(const f32x4*)(xb + off + 4);
                    *(f32x4*)(Y + off) = v0; *(f32x4*)(Y + off + 4) = v1;
                    float s = (v0[0] * v0[0] + v0[1] * v0[1]) + (v0[2] * v0[2] + v0[3] * v0[3]) + (v1[0] * v1[0] + v1[1] * v1[1]) + (v1[2] * v1[2] + v1[3] * v1[3]);
                    if (!DOWN) { v0 *= gg[bj][0]; v1 *= gg[bj][1];
                        v4u w; w.x = pg8::cvt_pk_bf16(v0[0], v0[1]); w.y = pg8::cvt_pk_bf16(v0[2], v0[3]); w.z = pg8::cvt_pk_bf16(v1[0], v1[1]); w.w = pg8::cvt_pk_bf16(v1[2], v1[3]);
                        *(v4u*)(XG2 + off) = w; }
                    s += __shfl_xor(s, 16); s += __shfl_xor(s, 32);
                    if (fq == 0) SSQ[row * 32 + u.pn * 8 + ((coloff >> 7) + bj) * 4 + wc] = s; } }
    }
};
__device__ __forceinline__ float row_rs(const float* SSQ, size_t row) {
    const f32x4* q = (const f32x4*)(SSQ + row * 32); float s = 0.f;
#pragma unroll
    for (int k = 0; k < 8; ++k) { const f32x4 a = q[k]; s += (a[0] + a[1]) + (a[2] + a[3]); }
    return 1.0f / sqrtf(s * (1.f / DM) + EPS);
}
struct EpiFinal {
    static constexpr bool PERM = true, AMAP = false, MID = false;
    float* Y; const float* gf; float* XS; unsigned* cnt; unsigned* tmo;
    template <int NA, int NB> __device__ __forceinline__ void run(f32x4 (&acc)[NA][NB][4][2], const Unit& u, int rowoff, int coloff, int wr, int wc, int fr, int fq) const {
        const int row0 = u.pm * 256 + rowoff + wr * 64 + fr, col0 = u.pn * 256 + coloff + wc * 32 + 8 * fq;
#pragma unroll
        for (int ai = 0; ai < NA; ++ai)
#pragma unroll
            for (int m = 0; m < 4; ++m) { const size_t row = (size_t)(row0 + ai * 128 + m * 16);
#pragma unroll
                for (int bj = 0; bj < NB; ++bj) { const size_t off = row * 1024 + col0 + bj * 128;
                    acc[ai][bj][m][0] += *(const f32x4*)(Y + off); acc[ai][bj][m][1] += *(const f32x4*)(Y + off + 4);
                    const f32x4 v0 = acc[ai][bj][m][0], v1 = acc[ai][bj][m][1];
                    float s = (v0[0] * v0[0] + v0[1] * v0[1]) + (v0[2] * v0[2] + v0[3] * v0[3]) + (v1[0] * v1[0] + v1[1] * v1[1]) + (v1[2] * v1[2] + v1[3] * v1[3]);
                    s += __shfl_xor(s, 16); s += __shfl_xor(s, 32);
                    if (fq == 0) __hip_atomic_store(XS + row * 32 + u.pn * 8 + ((coloff >> 7) + bj) * 4 + wc, s, __ATOMIC_RELAXED, __HIP_MEMORY_SCOPE_AGENT); } }
        asm volatile("s_waitcnt vmcnt(0)" ::: "memory");
        unsigned* c = cnt + 32 * ((NA == 2) ? u.pm : (STILE + (rowoff >> 7)));
        const unsigned want = (NA == 2) ? 32u : 64u;
        if ((threadIdx.x & 63) == 0) __hip_atomic_fetch_add(c, 1u, __ATOMIC_RELAXED, __HIP_MEMORY_SCOPE_AGENT);
        { unsigned sp = 0;
          while ((unsigned)__builtin_amdgcn_readfirstlane(__hip_atomic_load(c, __ATOMIC_RELAXED, __HIP_MEMORY_SCOPE_AGENT)) < want) {
              __builtin_amdgcn_s_sleep(2);
              if ((++sp & 255u) == 0u) { if (__builtin_amdgcn_readfirstlane(__hip_atomic_load(tmo, __ATOMIC_RELAXED, __HIP_MEMORY_SCOPE_AGENT)) != 0u) break; if (sp > (1u << 20)) { if ((threadIdx.x & 63) == 0) atomicAdd(tmo, 1u); break; } } } }
        f32x4 gg[NB][2];
#pragma unroll
        for (int bj = 0; bj < NB; ++bj) { gg[bj][0] = *(const f32x4*)(gf + col0 + bj * 128); gg[bj][1] = *(const f32x4*)(gf + col0 + bj * 128 + 4); }
#pragma unroll
        for (int ai = 0; ai < NA; ++ai)
#pragma unroll
            for (int m = 0; m < 4; ++m) { const size_t row = (size_t)(row0 + ai * 128 + m * 16); float t = 0.f;
#pragma unroll
                for (int k = 0; k < 8; ++k) t += __hip_atomic_load(XS + row * 32 + fq * 8 + k, __ATOMIC_RELAXED, __HIP_MEMORY_SCOPE_AGENT);
                t += __shfl_xor(t, 16); t += __shfl_xor(t, 32);
                const float rs = 1.0f / sqrtf(t * (1.f / DM) + EPS);
#pragma unroll
                for (int bj = 0; bj < NB; ++bj) { const size_t off = row * 1024 + col0 + bj * 128;
                    *(f32x4*)(Y + off) = acc[ai][bj][m][0] * rs * gg[bj][0]; *(f32x4*)(Y + off + 4) = acc[ai][bj][m][1] * rs * gg[bj][1]; } }
    }
};
struct EpiW {
    static constexpr bool PERM = true, AMAP = false, MID = false;
    bf16* O;
    template <int NA, int NB> __device__ __forceinline__ void run(f32x4 (&acc)[NA][NB][4][2], const Unit& u, int rowoff, int coloff, int wr, int wc, int fr, int fq) const {
        const int row0 = u.pm * 256 + rowoff + wr * 64 + fr, col0 = u.pn * 256 + coloff + wc * 32 + 8 * fq;
#pragma unroll
        for (int ai = 0; ai < NA; ++ai)
#pragma unroll
            for (int m = 0; m < 4; ++m)
#pragma unroll
                for (int bj = 0; bj < NB; ++bj) { const f32x4 v0 = acc[ai][bj][m][0], v1 = acc[ai][bj][m][1];
                    v4u w; w.x = pg8::cvt_pk_bf16(v0[0], v0[1]); w.y = pg8::cvt_pk_bf16(v0[2], v0[3]); w.z = pg8::cvt_pk_bf16(v1[0], v1[1]); w.w = pg8::cvt_pk_bf16(v1[2], v1[3]);
                    *(v4u*)(O + (size_t)(row0 + ai * 128 + m * 16) * 2048 + col0 + bj * 128) = w; }
    }
};
struct EpiUpS {
    static constexpr bool PERM = true, AMAP = false, MID = false;
    bf16* ACT; const float* cw; const float* cb; const float* stf; float* ofs; const float* SSQ;
    template <int NA, int NB> __device__ __forceinline__ void run(f32x4 (&acc)[NA][NB][4][2], const Unit& u, int rowoff, int coloff, int wr, int wc, int fr, int fq) const {
        static_assert(NA == 1 && NB == 2, "sample FFN epilogue works on half sub-units");
        int pn_ = u.pn, ro_ = rowoff, fr_ = fr, fq_ = fq, wr_ = wr, wc_ = wc; asm volatile("" : "+s"(pn_), "+s"(ro_), "+v"(fr_), "+v"(fq_), "+s"(wr_), "+s"(wc_));
        const int cbase = 32 * wc_ + 8 * fq_, gcol = 128 * pn_ + cbase;
#pragma unroll
        for (int m = 0; m < 4; ++m) {
            asm volatile("" ::: "memory");
            const int lrow = ro_ + wr_ * 64 + m * 16 + fr_, seq = lrow >> 4; const size_t row = (size_t)MP + lrow;
            const float rs = row_rs(SSQ, row);
            unsigned pk[4];
#pragma unroll
            for (int n = 0; n < 2; ++n) { f32x4 gc;
#pragma unroll
                for (int bj = 0; bj < 2; ++bj) { const int oc = bj * DFF + gcol + 4 * n;
                    const f32x4 w0 = *(const f32x4*)(cw + oc), w1 = *(const f32x4*)(cw + DUP + oc), w2 = *(const f32x4*)(cw + 2 * DUP + oc), bb = *(const f32x4*)(cb + oc);
                    const f32x4 h = acc[0][bj][m][n] * rs; f32x4 hm1, hm2;
#pragma unroll
                    for (int e = 0; e < 4; ++e) { hm1[e] = __shfl_up(h[e], 1, 16); hm2[e] = __shfl_up(h[e], 2, 16); }
                    if (fr_ < 2) { const f32x4 s1 = *(const f32x4*)(stf + (size_t)(seq * 2 + 1) * DUP + oc); if (fr_ == 0) { hm1 = s1; hm2 = *(const f32x4*)(stf + (size_t)(seq * 2 + 0) * DUP + oc); } else hm2 = s1; }
                    if (fr_ >= 14) *(f32x4*)(ofs + (size_t)(seq * 2 + (fr_ - 14)) * DUP + oc) = h;
                    const f32x4 c = bb + w0 * hm2 + w1 * hm1 + w2 * h;
                    if (bj == 0) gc = c;
                    else { f32x4 a;
#pragma unroll
                        for (int e = 0; e < 4; ++e) a[e] = gelu_tanh(gc[e]) * c[e];
                        pk[2 * n] = pg8::cvt_pk_bf16(a[0], a[1]); pk[2 * n + 1] = pg8::cvt_pk_bf16(a[2], a[3]); } } }
            v4u w; w.x = pk[0]; w.y = pk[1]; w.z = pk[2]; w.w = pk[3];
            *(v4u*)(ACT + row * DFF + gcol) = w;
        }
    }
};
struct EpiUp {
    static constexpr bool PERM = true, AMAP = true, MID = false;
    bf16* ACT; const float* cw; const float* cb; const float* stf; float* ofp; float* ofs; LAS unsigned char* lx; int pm0;
    template <int NA, int NB> __device__ __forceinline__ void run(f32x4 (&acc)[NA][NB][4][2], const Unit& u, int, int, int wr, int wc, int fr, int fq) const {
        int pm_ = u.pm, pn_ = u.pn, fr_ = fr, fq_ = fq; asm volatile("" : "+s"(pm_), "+s"(pn_), "+v"(fr_), "+v"(fq_));
        const bool samp = (pm_ == STILE); const int j = pm_ - pm0;
        const LAS float* RS = (const LAS float*)(lx + RS_OFF) + j * 256 + 128 * wr + 8 * fr_;
        const f32x4 rsa = *(const LAS f32x4*)RS, rsb = *(const LAS f32x4*)(RS + 4);
        const float rs[8] = {rsa[0], rsa[1], rsa[2], rsa[3], rsb[0], rsb[1], rsb[2], rsb[3]};
        const int cbase = 32 * wc + 8 * fq_, gcol = 128 * pn_ + cbase;
        const LAS float* Ein = (const LAS float*)(lx + (wr == 0 ? (j == 0 ? EDGE_START_OFF : EDGE_PREV_OFF) : EDGE_MID_OFF));
        LAS float* Eout = (LAS float*)(lx + (wr == 0 ? EDGE_MID_OFF : EDGE_PREV_OFF));
        const int seq = samp ? (8 * wr + (fr_ >> 1)) : (pm_ >> 4);
        const bool lastp = (!samp) && ((pm_ & 15) == 15) && wr == 1 && fr_ == 15;
        bf16* ap = ACT + (size_t)(pm_ * 256 + 128 * wr + 8 * fr_) * DFF + gcol;
#pragma unroll
        for (int n = 0; n < 2; ++n) {
            f32x4 gc[8];
#pragma unroll
            for (int bj = 0; bj < 2; ++bj) {
                const int cc = bj * 128 + cbase + 4 * n, oc = bj * DFF + gcol + 4 * n;
                const f32x4 w0 = *(const f32x4*)(cw + oc), w1 = *(const f32x4*)(cw + DUP + oc), w2 = *(const f32x4*)(cw + 2 * DUP + oc), bb = *(const f32x4*)(cb + oc);
                const f32x4 h6 = acc[1][bj][2][n] * rs[6], h7 = acc[1][bj][3][n] * rs[7];
                f32x4 hm1, hm2;
#pragma unroll
                for (int e = 0; e < 4; ++e) { hm1[e] = __shfl_up(h7[e], 1, 16); hm2[e] = __shfl_up(h6[e], 1, 16); }
                if (!samp) {
                    if (fr_ == 0) { hm2 = *(const LAS f32x4*)(Ein + cc); hm1 = *(const LAS f32x4*)(Ein + 256 + cc); }
                    if (fr_ == 15) { *(LAS f32x4*)(Eout + cc) = h6; *(LAS f32x4*)(Eout + 256 + cc) = h7; }
                    if (lastp) { *(f32x4*)(ofp + (size_t)(seq * 2 + 0) * DUP + oc) = h6; *(f32x4*)(ofp + (size_t)(seq * 2 + 1) * DUP + oc) = h7; }
                } else {
                    if (!(fr_ & 1)) { hm2 = *(const f32x4*)(stf + (size_t)(seq * 2 + 0) * DUP + oc); hm1 = *(const f32x4*)(stf + (size_t)(seq * 2 + 1) * DUP + oc); }
                    else { *(f32x4*)(ofs + (size_t)(seq * 2 + 0) * DUP + oc) = h6; *(f32x4*)(ofs + (size_t)(seq * 2 + 1) * DUP + oc) = h7; }
                }
                f32x4 p2 = hm2, p1 = hm1;
#pragma unroll
                for (int q = 0; q < 8; ++q) {
                    const f32x4 hq = (q == 6) ? h6 : (q == 7) ? h7 : acc[q >> 2][bj][q & 3][n] * rs[q];
                    const f32x4 c = bb + w0 * p2 + w1 * p1 + w2 * hq;
                    p2 = p1; p1 = hq;
                    if (bj == 0) gc[q] = c;
                    else { f32x4 a;
#pragma unroll
                        for (int e = 0; e < 4; ++e) a[e] = gelu_tanh(gc[q][e]) * c[e];
                        v2u w; w.x = pg8::cvt_pk_bf16(a[0], a[1]); w.y = pg8::cvt_pk_bf16(a[2], a[3]);
                        *(v2u*)(ap + (size_t)q * DFF + 4 * n) = w; }
                }
            }
        }
        LDS_WAIT();
    }
};
template <class RowMap>
__device__ __forceinline__ void p0_transpose_item(const float* W, int ldw, int k0, int n0, bf16* WT, size_t ldt, int kcol0, RowMap drow, const float* kscale, LAS float* scr, int lane) {
#pragma unroll 8
    for (int i = 0; i < 32; ++i) { const int kk = 2 * i + (lane >> 5); float v = W[(size_t)(k0 + kk) * ldw + n0 + (lane & 31)]; if (kscale) v *= kscale[k0 + kk]; scr[kk * 33 + (lane & 31)] = v; }
    LDS_WAIT(); asm volatile("" ::: "memory");
    const int c = lane & 7;
#pragma unroll
    for (int j = 0; j < 4; ++j) { const int n = (lane >> 3) + 8 * j; const LAS float* s = scr + (8 * c) * 33 + n;
        v4u o; o.x = pk2(s[0 * 33], s[1 * 33]); o.y = pk2(s[2 * 33], s[3 * 33]); o.z = pk2(s[4 * 33], s[5 * 33]); o.w = pk2(s[6 * 33], s[7 * 33]);
        *(v4u*)(WT + (size_t)drow(n0 + n) * ldt + kcol0 + k0 + 8 * c) = o; }
    LDS_WAIT(); asm volatile("" ::: "memory");
}
struct RowId { __device__ __forceinline__ int operator()(int n) const { return n; } };
struct RowUp { __device__ __forceinline__ int operator()(int n) const { const int half = n >= DFF ? 1 : 0, c = n - half * DFF; return (c >> 7) * 256 + half * 128 + (c & 127); } };

__device__ __forceinline__ void p0_prologue(const KP& p, LAS unsigned char* lds, int vcu, int G, int wave, int lane) {
    LAS float* scr = (LAS float*)(lds + wave * 16384);
    const int gw = vcu * NWAVES + wave, NGW = G * NWAVES;
    unsigned char* ws = p.ws;
    bf16* Win_t = (bf16*)(ws + WS_WIN); bf16* Wg_t = (bf16*)(ws + WS_WG); bf16* Wbp_t = (bf16*)(ws + WS_WBP); bf16* Wpool_b = (bf16*)(ws + WS_WPOOL);
    constexpr int I_IN = (DM / 64) * (DIN / 32), I_SQ = (DM / 64) * (DM / 32), I_G = 32 * 2, I_PC = 4 * 256 * 256 / 512;
    constexpr int NITEMS = I_IN + I_SQ + I_G + I_PC;
    for (int it = gw; it < NITEMS; it += NGW) {
        int r = it;
        if (r < I_IN) { const int nblk = DIN / 32; p0_transpose_item(p.in[I_WIN], DIN, 64 * (r / nblk), 32 * (r % nblk), Win_t, DM, 0, RowId(), nullptr, scr, lane); continue; } r -= I_IN;
        if (r < I_SQ) { const int nblk = DM / 32; p0_transpose_item(p.in[I_WBRP], DM, 64 * (r / nblk), 32 * (r % nblk), Wbp_t, DM, 0, RowId(), p.in[I_PSCALE], scr, lane); continue; } r -= I_SQ;
        if (r < I_G) { const int mat = r >> 1, nb = r & 1; const float* W = (mat < 16 ? p.in[I_WRA] : p.in[I_WIX]) + (size_t)(mat & 15) * 4096;
          p0_transpose_item(W, 64, 0, 32 * nb, Wg_t + (size_t)mat * 4096, 64, 0, RowId(), nullptr, scr, lane); continue; } r -= I_G;
        { const float* s = p.in[I_WPOOL] + (size_t)r * 512 + lane * 8; const f32x4 a = *(const f32x4*)s, b = *(const f32x4*)(s + 4);
          v4u o; o.x = pk2(a[0], a[1]); o.y = pk2(a[2], a[3]); o.z = pk2(b[0], b[1]); o.w = pk2(b[2], b[3]); *(v4u*)(Wpool_b + (size_t)r * 512 + lane * 8) = o; }
    }
    {
        bf16* XN = (bf16*)(ws + WS_R0); const float* g1 = p.in[I_NMIX];
        f32x4 gv[4];
#pragma unroll
        for (int j = 0; j < 4; ++j) gv[j] = *((const f32x4*)g1 + lane + 64 * j);
        for (int m0 = gw; m0 < M; m0 += 2 * NGW) {
            f32x4 v[2][4]; float s[2];
#pragma unroll
            for (int r = 0; r < 2; ++r) { const int m = m0 + r * NGW; s[r] = 0.f;
                if (m < M) { const float* xrow = m < MP ? p.in[I_XP] + (size_t)m * DM : p.in[I_XS] + (size_t)(m - MP) * DM; const f32x4* xr = (const f32x4*)xrow + lane;
#pragma unroll
                    for (int j = 0; j < 4; ++j) v[r][j] = xr[64 * j]; } }
#pragma unroll
            for (int r = 0; r < 2; ++r) { const int m = m0 + r * NGW;
                if (m < M) {
#pragma unroll
                    for (int j = 0; j < 4; ++j) s[r] += (v[r][j][0] * v[r][j][0] + v[r][j][1] * v[r][j][1]) + (v[r][j][2] * v[r][j][2] + v[r][j][3] * v[r][j][3]);
                    const float rstd = 1.0f / sqrtf(wave_sum(s[r]) * (1.f / DM) + EPS);
                    v2u* o8 = (v2u*)(XN + (size_t)m * DM) + lane;
#pragma unroll
                    for (int j = 0; j < 4; ++j) { const f32x4 y = v[r][j] * rstd * gv[j]; v2u o; o.x = pk2(y[0], y[1]); o.y = pk2(y[2], y[3]); o8[64 * j] = o; } } }
        }
    }
}
__device__ __forceinline__ void p1_weights(const KP& p, LAS unsigned char* lds, int gw, int NGW, int wave, int lane) {
    LAS float* scr = (LAS float*)(lds + wave * 16384);
    unsigned char* ws = p.ws;
    bf16* Wcat_t = (bf16*)(ws + WS_WCAT); bf16* Wout_t = (bf16*)(ws + WS_WOUT); bf16* Wup_t = (bf16*)(ws + WS_WUP); bf16* Wdn_t = (bf16*)(ws + WS_WDN);
    constexpr int I_UP = (DM / 64) * (DUP / 32), I_SQ = (DM / 64) * (DM / 32), I_DN = (DFF / 64) * (DM / 32);
    for (int it = gw; it < I_UP + 2 * I_SQ + I_DN; it += NGW) {
        int r = it;
        if (r < I_SQ) { const int nblk = DM / 32; p0_transpose_item(p.in[I_WBRL], DM, 64 * (r / nblk), 32 * (r % nblk), Wcat_t, 2048, 0, RowId(), nullptr, scr, lane); continue; } r -= I_SQ;
        if (r < I_SQ) { const int nblk = DM / 32; p0_transpose_item(p.in[I_WOUT], DM, 64 * (r / nblk), 32 * (r % nblk), Wout_t, DM, 0, RowId(), nullptr, scr, lane); continue; } r -= I_SQ;
        if (r < I_UP) { const int nblk = DUP / 32; p0_transpose_item(p.in[I_WUP], DUP, 64 * (r / nblk), 32 * (r % nblk), Wup_t, DM, 0, RowUp(), nullptr, scr, lane); continue; } r -= I_UP;
        { const int nblk = DM / 32; p0_transpose_item(p.in[I_WDN], DM, 64 * (r / nblk), 32 * (r % nblk), Wdn_t, DFF, 0, RowId(), nullptr, scr, lane); }
    }
}

constexpr int XR_OFF = 0, XR_BYTES = 16 * 19 * 128, SEG_OFF = 40960, CIN_OFF = 45056;
template <bool FINAL>
__device__ __forceinline__ void lru_unit(const KP& p, LAS unsigned char* lds, int pm, int n, int tid, int lane, int wave) {
    constexpr bool samp = true;
    const bf16* ZR = (const bf16*)(p.ws + WS_R1); const bf16* Wg_t = (const bf16*)(p.ws + WS_WG);
    typedef float f32x2v __attribute__((ext_vector_type(2)));
    f32x2v* SUMM = (f32x2v*)(p.ws + WS_SUMM);
    bf16* HP = (bf16*)(p.ws + WS_R3);
    LAS unsigned char* XR = lds + XR_OFF; LAS f32x2v* SEG = (LAS f32x2v*)(lds + SEG_OFF); LAS float* CIN = (LAS float*)(lds + CIN_OFF);
    const int t0 = samp ? 0 : 256 * (pm & 15);
    __syncthreads();
    for (int idx = tid; idx < 304 * 8; idx += NWAVES * 64) {
        const int row = idx >> 3, ck = idx & 7, g = row / 19, k = row - g * 19, tt = 16 * g + k - 3;
        v4u v = {0u, 0u, 0u, 0u};
        if (!samp) { if (t0 + tt >= 0) v = *(const v4u*)(ZR + (size_t)(pm * 256 + tt) * 2048 + n * 64 + ck * 8); }
        else if (k < 3) { const float* s = p.in[I_STLC] + (size_t)(g * 3 + k) * DM + n * 64 + ck * 8; const f32x4 a = *(const f32x4*)s, b = *(const f32x4*)(s + 4);
            v.x = pk2(a[0], a[1]); v.y = pk2(a[2], a[3]); v.z = pk2(b[0], b[1]); v.w = pk2(b[2], b[3]); }
        else v = *(const v4u*)(ZR + (size_t)(MP + 16 * g + k - 3) * 2048 + n * 64 + ck * 8);
        *(LAS v4u*)(XR + row * 128 + ck * 16) = v;
    }
    if (FINAL && !samp && tid < 64) {
        const int npre = pm & 15; f32x2v sv[15];
#pragma unroll
        for (int k = 0; k < 15; ++k) sv[k] = (k < npre) ? SUMM[(size_t)(pm - npre + k) * DM + n * 64 + tid] : (f32x2v){1.f, 0.f};
        float c = 0.f;
#pragma unroll
        for (int k = 0; k < 15; ++k) c = sv[k].y + sv[k].x * c;
        CIN[tid] = c;
    }
    __syncthreads();
    const int i16 = lane & 15, fq = lane >> 4;
    const float* cwl = p.in[I_CLW]; const float* cbl = p.in[I_CLB];
    bf16x8 fa[2][2];
#pragma unroll
    for (int ks = 0; ks < 2; ++ks) {
        const int ch0 = 32 * ks + 8 * fq; f32x4 w[4][2], bb[2];
#pragma unroll
        for (int tp = 0; tp < 4; ++tp) { w[tp][0] = *(const f32x4*)(cwl + tp * DM + n * 64 + ch0); w[tp][1] = *(const f32x4*)(cwl + tp * DM + n * 64 + ch0 + 4); }
        bb[0] = *(const f32x4*)(cbl + n * 64 + ch0); bb[1] = *(const f32x4*)(cbl + n * 64 + ch0 + 4);
#pragma unroll
        for (int m = 0; m < 2; ++m) {
            const int tau = 8 * (i16 >> 2) + 4 * m + (i16 & 3), T = 32 * wave + tau, rb = (T >> 4) * 19 + (T & 15);
            f32x4 u0 = bb[0], u1 = bb[1];
#pragma unroll
            for (int tp = 0; tp < 4; ++tp) { const v4u x = *(const LAS v4u*)(XR + (rb + tp) * 128 + ch0 * 2);
                u0 += w[tp][0] * (f32x4){bflo(x.x), bfhi(x.x), bflo(x.y), bfhi(x.y)}; u1 += w[tp][1] * (f32x4){bflo(x.z), bfhi(x.z), bflo(x.w), bfhi(x.w)}; }
            v4u f; f.x = pk2(u0[0], u0[1]); f.y = pk2(u0[2], u0[3]); f.z = pk2(u1[0], u1[1]); f.w = pk2(u1[2], u1[3]);
            fa[m][ks] = __builtin_bit_cast(bf16x8, f);
        }
    }
    float hloc[4][8], pc[4][8], P8[4], H8[4];
    const int T0 = 32 * wave + 8 * fq, rb0 = (T0 >> 4) * 19 + (T0 & 15);
#pragma unroll
    for (int nb = 0; nb < 4; ++nb) {
        const int ch = 16 * nb + i16, gch = n * 64 + ch;
        f32x4 aR[2] = {{0.f, 0.f, 0.f, 0.f}, {0.f, 0.f, 0.f, 0.f}}, aI[2] = {{0.f, 0.f, 0.f, 0.f}, {0.f, 0.f, 0.f, 0.f}};
#pragma unroll
        for (int ks = 0; ks < 2; ++ks) {
            const bf16x8 bR = *(const bf16x8*)(Wg_t + (size_t)(n * 64 + ch) * 64 + 8 * fq + 32 * ks);
            const bf16x8 bI = *(const bf16x8*)(Wg_t + (size_t)((16 + n) * 64 + ch) * 64 + 8 * fq + 32 * ks);
#pragma unroll
            for (int m = 0; m < 2; ++m) { aR[m] = __builtin_amdgcn_mfma_f32_16x16x32_bf16(fa[m][ks], bR, aR[m], 0, 0, 0); aI[m] = __builtin_amdgcn_mfma_f32_16x16x32_bf16(fa[m][ks], bI, aI[m], 0, 0, 0); }
        }
        float x[11];
#pragma unroll
        for (int r = 0; r < 11; ++r) x[r] = __builtin_bit_cast(float, (unsigned)(*(const LAS unsigned short*)(XR + (rb0 + r) * 128 + ch * 2)) << 16);
        const float c0 = cwl[gch], c1 = cwl[DM + gch], c2 = cwl[2 * DM + gch], c3 = cwl[3 * DM + gch], cbv = cbl[gch];
        const float bra = p.in[I_BRA][gch], bix = p.in[I_BIX][gch], lam = p.in[I_LAM][gch];
        const float zz = -lam, sp = fmaxf(zz, 0.f) + log1pf(expf(-fabsf(zz))), c8 = -8.0f * sp;
        float hl = 0.f, P = 1.f;
#pragma unroll
        for (int q = 0; q < 8; ++q) {
            const float u = cbv + c0 * x[q] + c1 * x[q + 1] + c2 * x[q + 2] + c3 * x[q + 3];
            const float r = sigmoidf_fast(aR[q >> 2][q & 3] + bra), ig = sigmoidf_fast(aI[q >> 2][q & 3] + bix);
            const float la = r * c8, a = __builtin_amdgcn_exp2f(la * 1.4426950408889634f);
            const float x2 = 2.0f * la, em_small = -x2 * (1.0f + x2 * (0.5f + x2 * (0.16666667f + x2 * 0.041666668f))), em = (x2 > -0.05f) ? em_small : (1.0f - a * a);
            const float b = sqrtf(em) * ig * u;
            hl = a * hl + b; P = P * a;
            hloc[nb][q] = hl; pc[nb][q] = P;
        }
        P8[nb] = P; H8[nb] = hl;
    }
    float Pf[4][4], Hf[4][4];
#pragma unroll
    for (int nb = 0; nb < 4; ++nb)
#pragma unroll
        for (int f = 0; f < 4; ++f) { Pf[nb][f] = __shfl(P8[nb], i16 + 16 * f); Hf[nb][f] = __shfl(H8[nb], i16 + 16 * f); }
    if (!samp) {
        if (fq == 0) {
#pragma unroll
            for (int nb = 0; nb < 4; ++nb) { float hw = 0.f, pw = 1.f;
#pragma unroll
                for (int f = 0; f < 4; ++f) { hw = Hf[nb][f] + Pf[nb][f] * hw; pw *= Pf[nb][f]; }
                SEG[wave * 64 + 16 * nb + i16] = (f32x2v){pw, hw}; }
        }
        __syncthreads();
        if (!FINAL) {
            if (tid < 64) { float hu = 0.f, pu = 1.f;
#pragma unroll
                for (int w = 0; w < 8; ++w) { const f32x2v s = SEG[w * 64 + tid]; hu = s.y + s.x * hu; pu *= s.x; }
                SUMM[(size_t)pm * DM + n * 64 + tid] = (f32x2v){pu, hu}; }
            return;
        }
    }
#pragma unroll
    for (int nb = 0; nb < 4; ++nb) {
        const int ch = 16 * nb + i16, gch = n * 64 + ch;
        float c;
        if (!samp) {
            c = CIN[ch];
#pragma unroll
            for (int w = 0; w < 8; ++w) { const f32x2v s = SEG[w * 64 + ch]; if (w < wave) c = s.y + s.x * c; }
#pragma unroll
            for (int f = 0; f < 4; ++f) if (f < fq) c = Hf[nb][f] + Pf[nb][f] * c;
        } else {
            const int sq = 2 * wave + (fq >> 1);
            c = p.in[I_STH][(size_t)sq * DM + gch];
            if (fq & 1) { const float pp = (fq == 1) ? Pf[nb][0] : Pf[nb][2], hh = (fq == 1) ? Hf[nb][0] : Hf[nb][2]; c = hh + pp * c; }
        }
        bf16* hp = HP + (size_t)(pm * 256 + T0) * 2048 + gch; float hlast = 0.f;
#pragma unroll
        for (int q = 0; q < 8; ++q) { const float h = hloc[nb][q] + pc[nb][q] * c; hp[(size_t)q * 2048] = (bf16)f2bf(h); hlast = h; }
        if (!samp) { if ((pm & 15) == 15 && wave == 7 && fq == 3) p.out[OFF_HP + (size_t)(pm >> 4) * DM + gch] = hlast; }
        else if (fq & 1) p.out[OFF_HS + (size_t)(2 * wave + (fq >> 1)) * DM + gch] = hlast;
    }
}

constexpr int XL_BYTES = 33280, XL_SEG = 2 * XL_BYTES, XL_CW = XL_SEG + 4096;
__device__ __forceinline__ void lru_task(const KP& p, LAS unsigned char* lds, int s, int n, int hf, int tid, int lane, int wave) {
    const bf16* ZR = (const bf16*)(p.ws + WS_R1); const bf16* Wg_t = (const bf16*)(p.ws + WS_WG); bf16* HP = (bf16*)(p.ws + WS_R3);
    typedef float f32x2v __attribute__((ext_vector_type(2)));
    LAS f32x2v* SEG = (LAS f32x2v*)(lds + XL_SEG); LAS float* CW = (LAS float*)(lds + XL_CW);
    const int i16 = lane & 15, fq = lane >> 4;
    const float* cwl = p.in[I_CLW]; const float* cbl = p.in[I_CLB];
    const size_t rowbase = (size_t)s * SEQ;
    __syncthreads();
    if (tid < 320) { const int tp = tid >> 6, c = tid & 63; CW[tid] = tp < 4 ? cwl[tp * DM + n * 64 + c] : cbl[n * 64 + c]; }
    for (int idx = tid; idx < 259 * 8; idx += NWAVES * 64) { const int row = idx >> 3, ck = idx & 7; v4u v = {0u, 0u, 0u, 0u};
        if (row >= 3) v = *(const v4u*)(ZR + (rowbase + row - 3) * 2048 + n * 64 + ck * 8);
        *(LAS v4u*)(lds + row * 128 + ck * 16) = v; }
    bf16x8 bR[2][2], bI[2][2]; float c0[2], c1[2], c2[2], c3[2], cbv[2], bra[2], bix[2], c8[2], cin[2];
#pragma unroll
    for (int b2 = 0; b2 < 2; ++b2) { const int ch = 16 * (2 * hf + b2) + i16, gch = n * 64 + ch;
#pragma unroll
        for (int ks = 0; ks < 2; ++ks) { bR[b2][ks] = *(const bf16x8*)(Wg_t + (size_t)(n * 64 + ch) * 64 + 8 * fq + 32 * ks); bI[b2][ks] = *(const bf16x8*)(Wg_t + (size_t)((16 + n) * 64 + ch) * 64 + 8 * fq + 32 * ks); }
        c0[b2] = cwl[gch]; c1[b2] = cwl[DM + gch]; c2[b2] = cwl[2 * DM + gch]; c3[b2] = cwl[3 * DM + gch]; cbv[b2] = cbl[gch];
        bra[b2] = p.in[I_BRA][gch]; bix[b2] = p.in[I_BIX][gch];
        const float zz = -p.in[I_LAM][gch]; c8[b2] = -8.0f * (fmaxf(zz, 0.f) + log1pf(expf(-fabsf(zz)))) * 1.4426950408889634f;
        cin[b2] = 0.f; }
    __syncthreads();
    for (int tt = 0; tt < 16; ++tt) {
        LAS unsigned char* XR = lds + (tt & 1) * XL_BYTES; LAS unsigned char* XN_ = lds + ((tt + 1) & 1) * XL_BYTES;
        v4u pf[5];
        if (tt < 15) {
#pragma unroll
            for (int k = 0; k < 5; ++k) { const int idx = tid + k * (NWAVES * 64); if (idx < 259 * 8) pf[k] = *(const v4u*)(ZR + (rowbase + 256 * (tt + 1) - 3 + (idx >> 3)) * 2048 + n * 64 + (idx & 7) * 8); } }
        bf16x8 fa[2][2];
#pragma unroll
        for (int ks = 0; ks < 2; ++ks) { const int ch0 = 32 * ks + 8 * fq; f32x4 w[4][2], bb[2];
#pragma unroll
            for (int tp = 0; tp < 4; ++tp) { w[tp][0] = *(const LAS f32x4*)(CW + tp * 64 + ch0); w[tp][1] = *(const LAS f32x4*)(CW + tp * 64 + ch0 + 4); }
            bb[0] = *(const LAS f32x4*)(CW + 256 + ch0); bb[1] = *(const LAS f32x4*)(CW + 256 + ch0 + 4);
#pragma unroll
            for (int m = 0; m < 2; ++m) { const int rb = 32 * wave + 8 * (i16 >> 2) + 4 * m + (i16 & 3); f32x4 u0 = bb[0], u1 = bb[1];
#pragma unroll
                for (int tp = 0; tp < 4; ++tp) { const v4u x = *(const LAS v4u*)(XR + (rb + tp) * 128 + ch0 * 2);
                    u0 += w[tp][0] * (f32x4){bflo(x.x), bfhi(x.x), bflo(x.y), bfhi(x.y)}; u1 += w[tp][1] * (f32x4){bflo(x.z), bfhi(x.z), bflo(x.w), bfhi(x.w)}; }
                v4u f; f.x = pg8::cvt_pk_bf16(u0[0], u0[1]); f.y = pg8::cvt_pk_bf16(u0[2], u0[3]); f.z = pg8::cvt_pk_bf16(u1[0], u1[1]); f.w = pg8::cvt_pk_bf16(u1[2], u1[3]);
                fa[m][ks] = __builtin_bit_cast(bf16x8, f); } }
        float hloc[2][8], pc[2][8], P8[2], H8[2];
        const int rb0 = 32 * wave + 8 * fq;
#pragma unroll
        for (int b2 = 0; b2 < 2; ++b2) { const int ch = 16 * (2 * hf + b2) + i16;
            f32x4 aR[2] = {{0.f, 0.f, 0.f, 0.f}, {0.f, 0.f, 0.f, 0.f}}, aI[2] = {{0.f, 0.f, 0.f, 0.f}, {0.f, 0.f, 0.f, 0.f}};
#pragma unroll
            for (int ks = 0; ks < 2; ++ks)
#pragma unroll
                for (int m = 0; m < 2; ++m) { aR[m] = __builtin_amdgcn_mfma_f32_16x16x32_bf16(fa[m][ks], bR[b2][ks], aR[m], 0, 0, 0); aI[m] = __builtin_amdgcn_mfma_f32_16x16x32_bf16(fa[m][ks], bI[b2][ks], aI[m], 0, 0, 0); }
            float x[11];
#pragma unroll
            for (int r = 0; r < 11; ++r) x[r] = __builtin_bit_cast(float, (unsigned)(*(const LAS unsigned short*)(XR + (rb0 + r) * 128 + ch * 2)) << 16);
            float hl = 0.f, P = 1.f;
#pragma unroll
            for (int q = 0; q < 8; ++q) {
                const float u = cbv[b2] + c0[b2] * x[q] + c1[b2] * x[q + 1] + c2[b2] * x[q + 2] + c3[b2] * x[q + 3];
                const float r = sigmoidf_fast(aR[q >> 2][q & 3] + bra[b2]), ig = sigmoidf_fast(aI[q >> 2][q & 3] + bix[b2]);
                const float a = __builtin_amdgcn_exp2f(r * c8[b2]);
                const float b = __builtin_amdgcn_sqrtf(fmaxf(__builtin_fmaf(-a, a, 1.0f), 0.f)) * ig * u;
                hl = __builtin_fmaf(a, hl, b); P = P * a; hloc[b2][q] = hl; pc[b2][q] = P; }
            P8[b2] = P; H8[b2] = hl; }
        float Pf[2][4], Hf[2][4];
#pragma unroll
        for (int b2 = 0; b2 < 2; ++b2)
#pragma unroll
            for (int f = 0; f < 4; ++f) { Pf[b2][f] = __shfl(P8[b2], i16 + 16 * f); Hf[b2][f] = __shfl(H8[b2], i16 + 16 * f); }
        if (fq == 0) {
#pragma unroll
            for (int b2 = 0; b2 < 2; ++b2) { float hw = 0.f, pw = 1.f;
#pragma unroll
                for (int f = 0; f < 4; ++f) { hw = __builtin_fmaf(Pf[b2][f], hw, Hf[b2][f]); pw *= Pf[b2][f]; }
                SEG[(tt & 1) * 256 + wave * 32 + 16 * b2 + i16] = (f32x2v){pw, hw}; } }
        if (tt < 15) {
#pragma unroll
            for (int k = 0; k < 5; ++k) { const int idx = tid + k * (NWAVES * 64); if (idx < 259 * 8) *(LAS v4u*)(XN_ + (idx >> 3) * 128 + (idx & 7) * 16) = pf[k]; } }
        LDS_WAIT(); __syncthreads();
#pragma unroll
        for (int b2 = 0; b2 < 2; ++b2) { const int ch = 16 * (2 * hf + b2) + i16, gch = n * 64 + ch;
            float c = cin[b2], call = cin[b2];
#pragma unroll
            for (int w = 0; w < 8; ++w) { const f32x2v sg = SEG[(tt & 1) * 256 + w * 32 + 16 * b2 + i16]; call = __builtin_fmaf(sg.x, call, sg.y); if (w < wave) c = __builtin_fmaf(sg.x, c, sg.y); }
            cin[b2] = call;
#pragma unroll
            for (int f = 0; f < 4; ++f) if (f < fq) c = __builtin_fmaf(Pf[b2][f], c, Hf[b2][f]);
            bf16* hp = HP + (rowbase + 256 * tt + rb0) * 2048 + gch; float hlast = 0.f;
#pragma unroll
            for (int q = 0; q < 8; ++q) { const float h = __builtin_fmaf(pc[b2][q], c, hloc[b2][q]); hp[(size_t)q * 2048] = (bf16)f2bf(h); hlast = h; }
            if (tt == 15 && wave == 7 && fq == 3) p.out[OFF_HP + (size_t)s * DM + gch] = hlast; }
    }
}

__device__ __forceinline__ void pool_load8(const KP& p, const bf16* ZR, int pm, int tt, int run, int ch, float (&v)[8]) {
    const bool samp = (pm == STILE);
    if (!samp) {
        if (256 * (pm & 15) + tt < 0) {
#pragma unroll
            for (int e = 0; e < 8; ++e) v[e] = 0.f;
            return; }
        const v4u w = *(const v4u*)(ZR + (size_t)(pm * 256 + tt) * 2048 + 1024 + ch);
        v[0] = bflo(w.x); v[1] = bfhi(w.x); v[2] = bflo(w.y); v[3] = bfhi(w.y); v[4] = bflo(w.z); v[5] = bfhi(w.z); v[6] = bflo(w.w); v[7] = bfhi(w.w);
    } else {
        const int tl = tt - 16 * run;
        if (tl < 0) { const float* s = p.in[I_STPOOL] + (size_t)(run * 15 + 15 + tl) * DM + ch; const f32x4 a = *(const f32x4*)s, b = *(const f32x4*)(s + 4);
            v[0] = a[0]; v[1] = a[1]; v[2] = a[2]; v[3] = a[3]; v[4] = b[0]; v[5] = b[1]; v[6] = b[2]; v[7] = b[3]; }
        else { const v4u w = *(const v4u*)(ZR + (size_t)(MP + tt) * 2048 + 1024 + ch);
            v[0] = bflo(w.x); v[1] = bfhi(w.x); v[2] = bflo(w.y); v[3] = bfhi(w.y); v[4] = bflo(w.z); v[5] = bfhi(w.z); v[6] = bflo(w.w); v[7] = bfhi(w.w); }
    }
}
__device__ __forceinline__ void pool_unit(const KP& p, int pm, int g, int tid) {
    const bf16* ZR = (const bf16*)(p.ws + WS_R1); bf16* HP = (bf16*)(p.ws + WS_R3);
    const bool samp = (pm == STILE);
    const int oct = tid & 31, run = tid >> 5, ch = 256 * g + 8 * oct, w = 2 << g, tf = 16 * run;
    const int pos0 = samp ? PAST : 256 * (pm & 15) + tf;
    float s[8];
#pragma unroll
    for (int e = 0; e < 8; ++e) s[e] = 0.f;
    for (int k = 1; k < w; ++k) { float v[8]; pool_load8(p, ZR, pm, tf - k, run, ch, v);
#pragma unroll
        for (int e = 0; e < 8; ++e) s[e] += v[e]; }
    for (int i = 0; i < 16; ++i) {
        float v[8], o[8]; pool_load8(p, ZR, pm, tf + i, run, ch, v);
        const int cnt = min(pos0 + i + 1, w); const float inv = 1.0f / (float)cnt;
#pragma unroll
        for (int e = 0; e < 8; ++e) { s[e] += v[e]; o[e] = s[e] * inv - v[e]; }
        v4u ow; ow.x = pk2(o[0], o[1]); ow.y = pk2(o[2], o[3]); ow.z = pk2(o[4], o[5]); ow.w = pk2(o[6], o[7]);
        *(v4u*)(HP + (size_t)(pm * 256 + tf + i) * 2048 + 1024 + ch) = ow;
        float vo[8]; pool_load8(p, ZR, pm, tf + i - w + 1, run, ch, vo);
#pragma unroll
        for (int e = 0; e < 8; ++e) s[e] -= vo[e];
    }
}
__device__ __forceinline__ void state_copy(const KP& p, int gtid, int gthreads) {
    const bf16* ZR = (const bf16*)(p.ws + WS_R1);
    constexpr int N1 = NBATCH * 3 * DM, N2 = NBATCH * 15 * DM, N3 = SBATCH * 3 * DM, N4 = SBATCH * 15 * DM;
    for (int i = gtid; i < N1 + N2 + N3 + N4; i += gthreads) {
        int r = i; size_t row, col; float* dst;
        if (r < N1) { const int b = r / (3 * DM), k = (r / DM) % 3, c = r % DM; row = (size_t)b * SEQ + SEQ - 3 + k; col = c; dst = p.out + OFF_LCP + r; }
        else if ((r -= N1) < N2) { const int b = r / (15 * DM), k = (r / DM) % 15, c = r % DM; row = (size_t)b * SEQ + SEQ - 15 + k; col = 1024 + c; dst = p.out + OFF_PLP + r; }
        else if ((r -= N2) < N3) { const int b = r / (3 * DM), k = (r / DM) % 3, c = r % DM; row = (size_t)MP + b * SSEQ + SSEQ - 3 + k; col = c; dst = p.out + OFF_LCS + r; }
        else { r -= N3; const int b = r / (15 * DM), k = (r / DM) % 15, c = r % DM; row = (size_t)MP + b * SSEQ + SSEQ - 15 + k; col = 1024 + c; dst = p.out + OFF_PLS + r; }
        *dst = __builtin_bit_cast(float, (unsigned)ZR[row * 2048 + col] << 16);
    }
}

__device__ __forceinline__ void strip_pre(const KP& p, LAS unsigned char* lds, int pm0, int pn, int cnt, int tid, int lane, int wave) {
    const float* SSQ = (const float*)(p.ws + WS_SSQ); const bf16* XG2 = (const bf16*)(p.ws + WS_R1); const bf16* Wup_t = (const bf16*)(p.ws + WS_WUP);
    LAS float* RS = (LAS float*)(lds + RS_OFF); LAS float* ES = (LAS float*)(lds + EDGE_START_OFF);
    __syncthreads();
    for (int i = tid; i < cnt * 256; i += NWAVES * 64) RS[i] = row_rs(SSQ, (size_t)pm0 * 256 + i);
    if (pm0 != STILE && (pm0 & 15) != 0) {
        float xa[2][16], rsh[2];
#pragma unroll
        for (int r = 0; r < 2; ++r) { const size_t row = (size_t)pm0 * 256 - 2 + r;
            const v4u w0 = *(const v4u*)(XG2 + row * DM + 16 * lane), w1 = *(const v4u*)(XG2 + row * DM + 16 * lane + 8);
            xa[r][0] = bflo(w0.x); xa[r][1] = bfhi(w0.x); xa[r][2] = bflo(w0.y); xa[r][3] = bfhi(w0.y); xa[r][4] = bflo(w0.z); xa[r][5] = bfhi(w0.z); xa[r][6] = bflo(w0.w); xa[r][7] = bfhi(w0.w);
            xa[r][8] = bflo(w1.x); xa[r][9] = bfhi(w1.x); xa[r][10] = bflo(w1.y); xa[r][11] = bfhi(w1.y); xa[r][12] = bflo(w1.z); xa[r][13] = bfhi(w1.z); xa[r][14] = bflo(w1.w); xa[r][15] = bfhi(w1.w);
            rsh[r] = row_rs(SSQ, row); }
        for (int c = 0; c < 32; ++c) { const int tc = 32 * wave + c; const bf16* wr_ = Wup_t + (size_t)(256 * pn + tc) * DM + 16 * lane;
            const v4u w0 = *(const v4u*)wr_, w1 = *(const v4u*)(wr_ + 8);
            const float wv[16] = {bflo(w0.x), bfhi(w0.x), bflo(w0.y), bfhi(w0.y), bflo(w0.z), bfhi(w0.z), bflo(w0.w), bfhi(w0.w), bflo(w1.x), bfhi(w1.x), bflo(w1.y), bfhi(w1.y), bflo(w1.z), bfhi(w1.z), bflo(w1.w), bfhi(w1.w)};
            float p0 = 0.f, p1 = 0.f;
#pragma unroll
            for (int e = 0; e < 16; ++e) { p0 += xa[0][e] * wv[e]; p1 += xa[1][e] * wv[e]; }
            p0 = wave_sum(p0); p1 = wave_sum(p1);
            if (lane == 0) { ES[tc] = p0 * rsh[0]; ES[256 + tc] = p1 * rsh[1]; } }
    } else { ES[tid] = 0.f; }
    __syncthreads();
}

__device__ __forceinline__ void final_norm(const KP& p, int gw, int NGW, int lane) {
    const float* SSQ2 = (const float*)(p.ws + WS_SSQ2); const float* gf = p.in[I_NFIN];
    f32x4 gv[4];
#pragma unroll
    for (int j = 0; j < 4; ++j) gv[j] = *((const f32x4*)gf + lane + 64 * j);
    for (int m = gw; m < M; m += NGW) {
        const float sv = (lane < 32) ? SSQ2[(size_t)m * 32 + lane] : 0.f;
        const float rstd = 1.0f / sqrtf(wave_sum(sv) * (1.f / DM) + EPS);
        f32x4* yr = (f32x4*)(p.out + OFF_Y + (size_t)m * DM) + lane;
#pragma unroll
        for (int j = 0; j < 4; ++j) { const f32x4 v = yr[64 * j]; yr[64 * j] = v * rstd * gv[j]; }
    }
}
#ifndef MK_ONE_LAUNCH
#define MK_ONE_LAUNCH 1
#endif
#ifndef PG8_SP2
#define PG8_SP2 true
#endif
#ifndef PG8_ALIGN
#define PG8_ALIGN true
#endif
constexpr int N_PHASES = 10;
__global__ void __launch_bounds__(NWAVES * 64, 2) mk_fwd(KP p) {
    extern __shared__ __attribute__((aligned(16))) unsigned char lds_raw[];
    LAS unsigned char* lds = (LAS unsigned char*)lds_raw;
    const int tid = threadIdx.x, lane = tid & 63, wave = __builtin_amdgcn_readfirstlane(tid >> 6);
    const int G = gridDim.x, bx = blockIdx.x, vcu = (G % 8 == 0) ? (bx % 8) * (G / 8) + bx / 8 : bx;
    volatile LAS unsigned* MISC = (volatile LAS unsigned*)(lds + MISC_OFF);
    if (tid < 32) MISC[tid] = 0u;
    __syncthreads();
    unsigned* ctl = (unsigned*)(p.ws + WS_CTL);
    const int lo = p.ph_lo, hi = p.ph_hi;
    XcdBarrier bar; bar.bar = ctl + CW_BAR; bar.x = 0; bar.st = MISC + 8;
    if (hi - lo > 1) bar = xcd_barrier_post(ctl + CW_BAR, MISC + 8);
#ifndef PH_MASK
#define PH_MASK 0x3ff
#endif
#define IN(k) (((PH_MASK >> (k)) & 1) && lo <= (k) && (k) < hi)
#ifndef REP_MASK
#define REP_MASK 0
#endif
#define PH(k) if (IN(k)) for (int rep_ = 0; rep_ <= ((REP_MASK >> (k)) & 1); ++rep_)
#define REPBAR() do { if (rep_) xcd_barrier(bar); } while (0)
#define SEAM(k) do { if (IN(k) && IN((k) + 1)) xcd_barrier(bar); } while (0)
    unsigned char* ws = p.ws;
    bf16* XN = (bf16*)(ws + WS_R0); bf16* MG = (bf16*)(ws + WS_R0); bf16* ZR = (bf16*)(ws + WS_R1); bf16* XG2 = (bf16*)(ws + WS_R1);
    bf16* GT = (bf16*)(ws + WS_R2); bf16* HP = (bf16*)(ws + WS_R3); bf16* ACT = (bf16*)(ws + WS_R2);
    bf16* Win_t = (bf16*)(ws + WS_WIN); bf16* Wcat_t = (bf16*)(ws + WS_WCAT); bf16* Wout_t = (bf16*)(ws + WS_WOUT); bf16* Wup_t = (bf16*)(ws + WS_WUP); bf16* Wdn_t = (bf16*)(ws + WS_WDN);
    float* SSQ = (float*)(ws + WS_SSQ); float* SSQ2 = (float*)(ws + WS_SSQ2);
    float* Y = p.out + OFF_Y;

    PH(0) { REPBAR(); p0_prologue(p, lds, vcu, G, wave, lane); }
    SEAM(0);
    PH(1) { REPBAR();
        pg8::Gemm g{XN, Win_t, DM, DM, DM}; pg8::StaticOrder S; S.init(MP, DIN, G, bx);
        EpiZ E{ZR, GT};
        pg8::gemm_phase<EpiZ, pg8::StaticOrder, PG8_ALIGN, PG8_SP2>(lds, g, S, E);
        for (int su = bx; su < 64; su += G) pg8::sub_gemm<1>(lds, g, STILE, su >> 2, (su >> 1) & 1, su & 1, E);
        if (G > 64) { if (bx >= 64) p1_weights(p, lds, (bx - 64) * NWAVES + wave, (G - 64) * NWAVES, wave, lane); } else p1_weights(p, lds, bx * NWAVES + wave, G * NWAVES, wave, lane);
    }
    SEAM(1);
    PH(2) { REPBAR();
        state_copy(p, bx * NWAVES * 64 + tid, G * NWAVES * 64);
        for (int su = bx; su < 64; su += G) {
            const int g_ = su >> 4, q = su & 15; pg8::Gemm gw_{(const bf16*)(ws + WS_WBP) + 256 * g_, (const bf16*)(ws + WS_WPOOL) + (size_t)g_ * 65536, 256, DM, 256};
            EpiW EW{Wcat_t + 1024 + 256 * g_}; pg8::sub_gemm<1>(lds, gw_, q >> 2, 0, (q >> 1) & 1, q & 1, EW); }
        for (int t = bx; t < NBATCH * 32; t += G) lru_task(p, lds, t >> 5, (t >> 1) & 15, t & 1, tid, lane, wave);
        for (int L = bx; L < 16 + NTILE * 4; L += G) {
            if (L < 16) lru_unit<true>(p, lds, STILE, L, tid, lane, wave);
            else { const int r = L - 16; pool_unit(p, r >> 2, r & 3, tid); }
        }
    }
    if (IN(2) && IN(4)) xcd_barrier(bar);
    PH(4) { REPBAR();
        pg8::Gemm g{HP, Wcat_t, 2048, 2048, 2048}; pg8::StaticOrder S; S.init(MP, DM, G, bx);
        EpiBr E{GT, MG};
        pg8::gemm_phase<EpiBr, pg8::StaticOrder, PG8_ALIGN, PG8_SP2>(lds, g, S, E);
        for (int su = bx; su < 16; su += G) pg8::sub_gemm<1>(lds, g, STILE, su >> 2, (su >> 1) & 1, su & 1, E);
    }
    if (IN(4) && IN(6)) xcd_barrier(bar);
    PH(6) { REPBAR();
        pg8::Gemm g{MG, Wout_t, DM, DM, DM}; pg8::StaticOrder S; S.init(MP, DM, G, bx);
        EpiRes<false> E{p.in[I_XP], p.in[I_XS], Y, XG2, p.in[I_NFFN], SSQ};
        pg8::gemm_phase<EpiRes<false>, pg8::StaticOrder, PG8_ALIGN, PG8_SP2>(lds, g, S, E);
        for (int su = bx; su < 16; su += G) pg8::sub_gemm<1>(lds, g, STILE, su >> 2, (su >> 1) & 1, su & 1, E);
    }
    SEAM(6);
    PH(7) { REPBAR();
        pg8::Gemm g{XG2, Wup_t, DM, DM, DM};
        for (int sidx = vcu; sidx < 768; sidx += G) {
            const int rg = sidx >> 8, v = sidx & 255, x = v >> 5, w = v & 31, pm0 = 4 * (4 * x + (w >> 3)), pn = 8 * rg + (w & 7);
            strip_pre(p, lds, pm0, pn, 4, tid, lane, wave);
            pg8::StripOrder S{pm0, pn, 4};
            EpiUp E{ACT, p.in[I_CFW], p.in[I_CFB], p.in[I_STFFN], p.out + OFF_FCP, p.out + OFF_FCS, lds, pm0};
            pg8::gemm_phase<EpiUp, pg8::StripOrder, false, PG8_SP2>(lds, g, S, E);
        }
        { EpiUpS ES{ACT, p.in[I_CFW], p.in[I_CFB], p.in[I_STFFN], p.out + OFF_FCS, SSQ};
          for (int su = bx; su < 48; su += G) pg8::sub_gemm<2>(lds, g, STILE, su >> 1, su & 1, 0, ES); }
    }
    SEAM(7);
    const bool fuse_final = (G == 256);
    PH(8) { REPBAR();
        pg8::Gemm g{ACT, Wdn_t, DFF, DFF, DFF}; pg8::StaticOrder S; S.init(MP, DM, G, bx);
        if (fuse_final) {
            EpiFinal E{Y, p.in[I_NFIN], SSQ2, ctl + CW_PANEL, ctl + CW_BAR + XB_TMO};
            pg8::gemm_phase<EpiFinal, pg8::StaticOrder, true  , PG8_SP2>(lds, g, S, E);
            for (int su = bx; su < 16; su += G) pg8::sub_gemm<1>(lds, g, STILE, su >> 2, (su >> 1) & 1, su & 1, E);
        } else {
            EpiRes<true> E{nullptr, nullptr, Y, nullptr, nullptr, SSQ2};
            pg8::gemm_phase<EpiRes<true>, pg8::StaticOrder, PG8_ALIGN, PG8_SP2>(lds, g, S, E);
            for (int su = bx; su < 16; su += G) pg8::sub_gemm<1>(lds, g, STILE, su >> 2, (su >> 1) & 1, su & 1, E);
        }
    }
    if (!fuse_final) { SEAM(8);
        PH(9) { REPBAR(); final_norm(p, vcu * NWAVES + wave, G * NWAVES, lane); } }
#undef IN
#undef SEAM
}

extern "C" void kernel_launch(void* const* d_in, const int* in_sizes, int n_in, void* d_out, int out_size, void* d_ws, size_t ws_size, hipStream_t stream) {
    static int grid = 0;
    if (grid == 0) {
        if (n_in != 26 || in_sizes[0] != MP * DM || (size_t)out_size != OUT_TOTAL || ws_size < WS_END) {
            fprintf(stderr, "kernel_launch: unexpected shapes: n_in %d in0 %d out %d ws %zu (need %zu)\n", n_in, n_in > 0 ? in_sizes[0] : -1, out_size, ws_size, (size_t)WS_END); grid = -1; return; }
        int dev = 0, cus = 0, per_cu = 0;
        if (hipGetDevice(&dev) != hipSuccess || hipDeviceGetAttribute(&cus, hipDeviceAttributeMultiprocessorCount, dev) != hipSuccess) { fprintf(stderr, "kernel_launch: device query failed\n"); grid = -1; return; }
        if (hipFuncSetAttribute((const void*)mk_fwd, hipFuncAttributeMaxDynamicSharedMemorySize, LDS_BYTES) != hipSuccess) { fprintf(stderr, "kernel_launch: hipFuncSetAttribute failed\n"); grid = -1; return; }
        if (hipOccupancyMaxActiveBlocksPerMultiprocessor(&per_cu, (const void*)mk_fwd, NWAVES * 64, LDS_BYTES) != hipSuccess || per_cu < 1) {
            fprintf(stderr, "kernel_launch: occupancy query reports %d blocks per CU\n", per_cu); (void)hipGetLastError(); per_cu = 1; }
        grid = cus;
        fprintf(stderr, "kernel_launch: grid %d (cus %d, occupancy %d/CU)\n", grid, cus, per_cu);
    }
    if (grid < 0) return;
    if (hipMemsetAsync((char*)d_ws + WS_CTL, 0, CTL_ZERO_BYTES, stream) != hipSuccess) { fprintf(stderr, "kernel_launch: memset failed\n"); return; }
    KP a{};
    for (int i = 0; i < 26; ++i) a.in[i] = (const float*)d_in[i];
    a.out = (float*)d_out; a.ws = (unsigned char*)d_ws;
#if MK_ONE_LAUNCH
    a.ph_lo = 0; a.ph_hi = N_PHASES;
    hipLaunchKernelGGL(mk_fwd, dim3(grid), dim3(NWAVES * 64), LDS_BYTES, stream, a);
#else
    for (int k = 0; k < N_PHASES; ++k) { a.ph_lo = k; a.ph_hi = k + 1; hipLaunchKernelGGL(mk_fwd, dim3(grid), dim3(NWAVES * 64), LDS_BYTES, stream, a); }
#endif
    const hipError_t le = hipPeekAtLastError();
    if (le != hipSuccess) fprintf(stderr, "kernel_launch: launch failed: %s\n", hipGetErrorName(le));
}
```

```cpp
#include <hip/hip_runtime.h>
#include <cstdio>
#include <cstdint>
#define MK_ONE_LAUNCH 1
namespace pg8 {
#define PG8_LAS __attribute__((address_space(3)))
typedef unsigned short bf16_t;
typedef short bf16x8 __attribute__((ext_vector_type(8)));
typedef float f32x4 __attribute__((ext_vector_type(4)));
typedef unsigned u32x4 __attribute__((ext_vector_type(4)));
typedef unsigned u32x2 __attribute__((ext_vector_type(2)));
constexpr int BM = 256, BK = 64, HALF = 128, HTB = HALF * BK * 2  , STAGE_BYTES = 8 * HTB, NXCD = 8, WGM = 8;

__host__ __device__ __forceinline__ int lds_byte(int r, int c) { const int st = (r >> 4) * 2 + (c >> 5), rr = r & 15, cc = c & 31, ob = rr * 64 + cc * 2; return st * 1024 + (ob ^ (((ob >> 9) & 1) << 5)); }
__host__ __device__ __forceinline__ void stage_rc(int b, int& R, int& C) { const int st = b / 1024, sb = b % 1024, swz = sb ^ (((sb >> 9) & 1) << 5); R = (st >> 1) * 16 + swz / 64; C = (st & 1) * 32 + (swz % 64) / 2; }
__host__ __device__ __forceinline__ int perm32(int rho) { const int n = rho >> 4, i = rho & 15; return 8 * (i >> 2) + 4 * n + (i & 3); }
__host__ __device__ __forceinline__ int amap_row(int R) { return 128 * (R >> 6) + 8 * (R & 15) + ((R >> 4) & 3); }

struct Unit { int pm, pn; };
struct Gemm { const bf16_t* A; const bf16_t* Bt; int K, lda, ldb; };

struct StaticOrder {
    int nM, nN, nwg, G, c;
    __host__ __device__ void init(int M, int N, int G_, int c_) { nM = M / BM; nN = N / BM; nwg = nM * nN; G = G_; c = c_; }
    __host__ __device__ bool next(int i, Unit& u) const {
        const long L = (long)i * G + c; if (L >= nwg) return false;
        int wgid = (int)L; { const int q = nwg / NXCD, r = nwg % NXCD, xcd = wgid % NXCD, off = wgid / NXCD; wgid = (xcd < r ? xcd * (q + 1) : r * (q + 1) + (xcd - r) * q) + off; }
        const int nig = WGM * nN, gid = wgid / nig, fm = gid * WGM, gsz = (nM - fm) < WGM ? (nM - fm) : WGM;
        u.pm = fm + ((wgid % nig) % gsz); u.pn = (wgid % nig) / gsz; return true;
    }
    __device__ __forceinline__ void a_ready(const Unit&) const {}
    __device__ __forceinline__ void done(const Unit&) const {}
};
struct StripOrder {
    int pm0, pn, cnt;
    __device__ __forceinline__ bool next(int i, Unit& u) const { if (i >= cnt) return false; u.pm = pm0 + i; u.pn = pn; return true; }
    __device__ __forceinline__ void a_ready(const Unit&) const {}
    __device__ __forceinline__ void done(const Unit&) const {}
};

__device__ __forceinline__ unsigned cvt_pk_bf16(float lo, float hi) { unsigned r; asm volatile("v_cvt_pk_bf16_f32 %0, %1, %2" : "=v"(r) : "v"(lo), "v"(hi)); return r; }

template <class Epi, class Sched, bool ALIGN_EPI = false, bool SP2 = false>
__device__ __forceinline__ void gemm_phase(PG8_LAS unsigned char* lds, const Gemm g, const Sched& S, const Epi& E) {
    const int tid = threadIdx.x, wid = __builtin_amdgcn_readfirstlane(tid >> 6), lane = tid & 63, wr = wid >> 2, wc = wid & 3, fr = lane & 15, fq = lane >> 4;
    const int K = g.K, nt = K / BK;
    unsigned voffA[2], voffB[2];
#pragma unroll
    for (int i = 0; i < 2; ++i) { int R, C; stage_rc(tid * 16 + i * 8192, R, C); const int Rb = Epi::PERM ? ((R & ~31) + perm32(R & 31)) : R; const int Ra = Epi::AMAP ? amap_row(R) : R;
        voffA[i] = (unsigned)(Ra * g.lda + C) * 2u; voffB[i] = (unsigned)(Rb * g.ldb + C) * 2u; }
    const size_t kstep = (size_t)(BK * 2);
    const size_t hstepA = Epi::AMAP ? (size_t)4 * g.lda * 2 : (size_t)HALF * g.lda * 2;
    const size_t hstepB = (size_t)HALF * g.ldb * 2;
    const size_t tstepA = (size_t)BM * g.lda * 2, tstepB = (size_t)BM * g.ldb * 2;
    const unsigned ldsw = (unsigned)wid * 1024u;
    const int aoff = lds_byte(wr * 64 + fr, fq * 8), boff = lds_byte(wc * 32 + fr, fq * 8);
#define PG8_SA(b, h) (((b) * 2 + (h)) * HTB)
#define PG8_SB(b, h) ((4 + (b) * 2 + (h)) * HTB)
#define PG8_STAGE(bufoff, gbase, voff) do { _Pragma("unroll") for (int _i = 0; _i < 2; ++_i) \
        __builtin_amdgcn_global_load_lds((const unsigned*)((const char*)(gbase) + (voff)[_i]), (PG8_LAS unsigned*)(lds + (bufoff) + ldsw + _i * 8192), 16, 0, 0); } while (0)
#define PG8_LDA(dst, b, h) do { _Pragma("unroll") for (int m = 0; m < 4; ++m) _Pragma("unroll") for (int k = 0; k < 2; ++k) dst[m][k] = *(const PG8_LAS bf16x8*)(lds + PG8_SA(b, h) + aoff + m * 2048 + k * 1024); } while (0)
#define PG8_LDB(dst, b, h) do { _Pragma("unroll") for (int n = 0; n < 2; ++n) _Pragma("unroll") for (int k = 0; k < 2; ++k) dst[n][k] = *(const PG8_LAS bf16x8*)(lds + PG8_SB(b, h) + boff + n * 2048 + k * 1024); } while (0)
#define PG8_MMA(ai, bj, At, Bt) do { __builtin_amdgcn_s_setprio(1); _Pragma("unroll") for (int m = 0; m < 4; ++m) _Pragma("unroll") for (int n = 0; n < 2; ++n) _Pragma("unroll") for (int k = 0; k < 2; ++k) \
        acc[ai][bj][m][n] = __builtin_amdgcn_mfma_f32_16x16x32_bf16(Bt[n][k], At[m][k], acc[ai][bj][m][n], 0, 0, 0); __builtin_amdgcn_s_setprio(0); } while (0)
#define PG8_WAIT_V(n) asm volatile("s_waitcnt vmcnt(" #n ")" ::: "memory")
#define PG8_WAIT_L(n) asm volatile("s_waitcnt lgkmcnt(" #n ")" ::: "memory")
#define PG8_BAR __builtin_amdgcn_s_barrier()
#define PG8_SCHED __builtin_amdgcn_sched_barrier(0)
    Unit cur, nxt; int ui = 0;
    if (!S.next(0, cur)) return;
    f32x4 acc[2][2][4][2];
#pragma unroll
    for (int a = 0; a < 2; ++a)
#pragma unroll
        for (int b = 0; b < 2; ++b)
#pragma unroll
            for (int m = 0; m < 4; ++m)
#pragma unroll
                for (int n = 0; n < 2; ++n) acc[a][b][m][n] = (f32x4){0.f, 0.f, 0.f, 0.f};
    bf16x8 At[4][2], B0[2][2], B1[2][2];
    const char* cA = (const char*)g.A + (size_t)cur.pm * tstepA; const char* cB = (const char*)g.Bt + (size_t)cur.pn * tstepB;
    S.a_ready(cur);
    if constexpr (SP2) {
        PG8_STAGE(PG8_SB(0, 0), cB, voffB); PG8_STAGE(PG8_SB(0, 1), cB + hstepB, voffB); PG8_STAGE(PG8_SA(0, 0), cA, voffA); PG8_STAGE(PG8_SA(0, 1), cA + hstepA, voffA);
        if (wr == 1) PG8_BAR;
        PG8_WAIT_V(2); PG8_BAR;
        PG8_STAGE(PG8_SB(1, 0), cB + kstep, voffB); PG8_STAGE(PG8_SA(1, 0), cA + kstep, voffA); PG8_STAGE(PG8_SB(1, 1), cB + hstepB + kstep, voffB);
        PG8_WAIT_V(6); PG8_BAR;
    } else {
        PG8_STAGE(PG8_SB(0, 0), cB, voffB); PG8_STAGE(PG8_SA(0, 0), cA, voffA); PG8_STAGE(PG8_SB(0, 1), cB + hstepB, voffB); PG8_STAGE(PG8_SA(0, 1), cA + hstepA, voffA);
        if (wr == 1) PG8_BAR;
        PG8_WAIT_V(4); PG8_BAR;
        PG8_STAGE(PG8_SB(1, 0), cB + kstep, voffB); PG8_STAGE(PG8_SA(1, 0), cA + kstep, voffA); PG8_STAGE(PG8_SB(1, 1), cB + hstepB + kstep, voffB);
        PG8_WAIT_V(6); PG8_BAR;
    }
    for (;;) {
        const bool has_next = S.next(ui + 1, nxt);
        const char* nA = has_next ? (const char*)g.A + (size_t)nxt.pm * tstepA : cA; const char* nB = has_next ? (const char*)g.Bt + (size_t)nxt.pn * tstepB : cB;
        for (int t = 0; t < nt; t += 2) {
            const bool last = (t == nt - 2);
            const char* a1 = cA + (size_t)(t + 1) * kstep;
            const char* a2 = last ? nA : cA + (size_t)(t + 2) * kstep; const char* b2 = last ? nB : cB + (size_t)(t + 2) * kstep;
            const char* a3 = a2 + kstep; const char* b3 = b2 + kstep;
            if (last && has_next) S.a_ready(nxt);
            if constexpr (Epi::MID) { if (t == (nt >> 1)) E.template mid<2, 2>(acc, cur, 0, 0, wr, wc, fr, fq); }
            if constexpr (SP2) {
            PG8_LDB(B0, 0, 0); PG8_LDB(B1, 0, 1); PG8_SCHED; PG8_LDA(At, 0, 0); PG8_STAGE(PG8_SA(1, 1), a1 + hstepA, voffA);
            PG8_WAIT_V(8); PG8_WAIT_L(0); PG8_BAR; PG8_MMA(0, 0, At, B0); PG8_MMA(0, 1, At, B1); PG8_BAR; PG8_SCHED;
            PG8_LDA(At, 0, 1); PG8_STAGE(PG8_SB(0, 0), b2, voffB); PG8_STAGE(PG8_SB(0, 1), b2 + hstepB, voffB); PG8_STAGE(PG8_SA(0, 0), a2, voffA);
            PG8_WAIT_V(8); PG8_WAIT_L(0); PG8_BAR; PG8_MMA(1, 0, At, B0); PG8_MMA(1, 1, At, B1); PG8_BAR; PG8_SCHED;
            PG8_LDB(B0, 1, 0); PG8_LDB(B1, 1, 1); PG8_SCHED; PG8_LDA(At, 1, 0); PG8_STAGE(PG8_SA(0, 1), a2 + hstepA, voffA);
            PG8_WAIT_V(8); PG8_WAIT_L(0); PG8_BAR; PG8_MMA(0, 0, At, B0); PG8_MMA(0, 1, At, B1); PG8_BAR; PG8_SCHED;
            PG8_LDA(At, 1, 1); PG8_STAGE(PG8_SB(1, 0), b3, voffB); PG8_STAGE(PG8_SB(1, 1), b3 + hstepB, voffB); PG8_STAGE(PG8_SA(1, 0), a3, voffA);
            PG8_WAIT_V(8); PG8_WAIT_L(0); PG8_BAR; PG8_MMA(1, 0, At, B0); PG8_MMA(1, 1, At, B1); PG8_BAR; PG8_SCHED;
            } else {
            PG8_LDB(B0, 0, 0); PG8_SCHED; PG8_LDA(At, 0, 0); PG8_STAGE(PG8_SA(1, 1), a1 + hstepA, voffA);
            PG8_WAIT_L(8); PG8_BAR; PG8_WAIT_L(0); PG8_MMA(0, 0, At, B0); PG8_BAR; PG8_SCHED;
            PG8_LDB(B1, 0, 1); PG8_STAGE(PG8_SB(0, 0), b2, voffB);
            PG8_BAR; PG8_WAIT_L(0); PG8_MMA(0, 1, At, B1); PG8_BAR;
            PG8_LDA(At, 0, 1); PG8_STAGE(PG8_SA(0, 0), a2, voffA);
            PG8_BAR; PG8_WAIT_L(0); PG8_MMA(1, 0, At, B0); PG8_BAR; PG8_SCHED;
            PG8_STAGE(PG8_SB(0, 1), b2 + hstepB, voffB);
            PG8_WAIT_V(6); PG8_BAR; PG8_MMA(1, 1, At, B1); PG8_BAR;
            PG8_LDB(B0, 1, 0); PG8_SCHED; PG8_LDA(At, 1, 0); PG8_STAGE(PG8_SA(0, 1), a2 + hstepA, voffA);
            PG8_WAIT_L(8); PG8_BAR; PG8_WAIT_L(0); PG8_MMA(0, 0, At, B0); PG8_BAR; PG8_SCHED;
            PG8_LDB(B1, 1, 1); PG8_STAGE(PG8_SB(1, 0), b3, voffB);
            PG8_BAR; PG8_WAIT_L(0); PG8_MMA(0, 1, At, B1); PG8_BAR;
            PG8_LDA(At, 1, 1); PG8_STAGE(PG8_SA(1, 0), a3, voffA);
            PG8_BAR; PG8_WAIT_L(0); PG8_MMA(1, 0, At, B0); PG8_BAR; PG8_SCHED;
            PG8_STAGE(PG8_SB(1, 1), b3 + hstepB, voffB);
            PG8_WAIT_V(6); PG8_BAR; PG8_MMA(1, 1, At, B1); PG8_BAR;
            }
        }
        if constexpr (ALIGN_EPI) { if (wr == 0) PG8_BAR; }
        E.template run<2, 2>(acc, cur, 0, 0, wr, wc, fr, fq); S.done(cur);
        if (!has_next) break;
#pragma unroll
        for (int a = 0; a < 2; ++a)
#pragma unroll
            for (int b = 0; b < 2; ++b)
#pragma unroll
                for (int m = 0; m < 4; ++m)
#pragma unroll
                    for (int n = 0; n < 2; ++n) acc[a][b][m][n] = (f32x4){0.f, 0.f, 0.f, 0.f};
        cur = nxt; cA = nA; cB = nB; ++ui;
        if constexpr (ALIGN_EPI) { if (wr == 1) PG8_BAR; }
    }
    PG8_WAIT_V(0);
    if constexpr (!ALIGN_EPI) { if (wr == 0) PG8_BAR; }
    PG8_BAR;
#undef PG8_SA
#undef PG8_SB
#undef PG8_STAGE
#undef PG8_LDA
#undef PG8_LDB
#undef PG8_MMA
#undef PG8_WAIT_V
#undef PG8_WAIT_L
#undef PG8_BAR
#undef PG8_SCHED
}

template <int NB, class Epi>
__device__ __forceinline__ void sub_gemm(PG8_LAS unsigned char* lds, const Gemm g, int pm, int pn, int ai0, int bj0, const Epi& E) {
    int tid_ = threadIdx.x; asm volatile("" : "+v"(tid_));
    const int tid = tid_, wid = __builtin_amdgcn_readfirstlane(tid >> 6), lane = tid & 63, wr = wid >> 2, wc = wid & 3, fr = lane & 15, fq = lane >> 4;
    const int nt = g.K / BK;
    unsigned voffA[2], voffB[2];
#pragma unroll
    for (int i = 0; i < 2; ++i) { int R, C; stage_rc(tid * 16 + i * 8192, R, C); const int Rb = Epi::PERM ? ((R & ~31) + perm32(R & 31)) : R;
        voffA[i] = (unsigned)(R * g.lda + C) * 2u; voffB[i] = (unsigned)(Rb * g.ldb + C) * 2u; }
    const size_t kstep = (size_t)(BK * 2), hstepB = (size_t)HALF * g.ldb * 2;
    const unsigned ldsw = (unsigned)wid * 1024u;
    const int aoff = lds_byte(wr * 64 + fr, fq * 8), boff = lds_byte(wc * 32 + fr, fq * 8);
    const char* cA = (const char*)g.A + ((size_t)pm * BM + (size_t)ai0 * HALF) * g.lda * 2; const char* cB = (const char*)g.Bt + ((size_t)pn * BM + (size_t)bj0 * HALF) * g.ldb * 2;
#define SG_BUF(b, j) ((b) * 3 * HTB + (j) * HTB)
#define SG_STAGE(bufoff, gbase, voff) do { _Pragma("unroll") for (int _i = 0; _i < 2; ++_i) \
        __builtin_amdgcn_global_load_lds((const unsigned*)((const char*)(gbase) + (voff)[_i]), (PG8_LAS unsigned*)(lds + (bufoff) + ldsw + _i * 8192), 16, 0, 0); } while (0)
    f32x4 acc[1][NB][4][2];
#pragma unroll
    for (int b = 0; b < NB; ++b)
#pragma unroll
        for (int m = 0; m < 4; ++m)
#pragma unroll
            for (int n = 0; n < 2; ++n) acc[0][b][m][n] = (f32x4){0.f, 0.f, 0.f, 0.f};
    SG_STAGE(SG_BUF(0, 0), cA, voffA);
#pragma unroll
    for (int j = 0; j < NB; ++j) SG_STAGE(SG_BUF(0, 1 + j), cB + j * hstepB, voffB);
#pragma unroll 1
    for (int t = 0; t < nt; ++t) {
        const int cur = t & 1;
        if constexpr (Epi::MID) { if (t == (nt >> 1)) E.template mid<1, NB>(acc, Unit{pm, pn}, ai0 * HALF, bj0 * HALF, wr, wc, fr, fq); }
        if (t + 1 < nt) {
            SG_STAGE(SG_BUF(cur ^ 1, 0), cA + (size_t)(t + 1) * kstep, voffA);
#pragma unroll
            for (int j = 0; j < NB; ++j) SG_STAGE(SG_BUF(cur ^ 1, 1 + j), cB + j * hstepB + (size_t)(t + 1) * kstep, voffB);
            if constexpr (NB == 1) asm volatile("s_waitcnt vmcnt(4)" ::: "memory"); else asm volatile("s_waitcnt vmcnt(6)" ::: "memory");
        } else asm volatile("s_waitcnt vmcnt(0)" ::: "memory");
        __builtin_amdgcn_s_barrier();
        bf16x8 At[4][2], Bf[NB][2][2];
#pragma unroll
        for (int m = 0; m < 4; ++m)
#pragma unroll
            for (int k = 0; k < 2; ++k) At[m][k] = *(const PG8_LAS bf16x8*)(lds + SG_BUF(cur, 0) + aoff + m * 2048 + k * 1024);
#pragma unroll
        for (int j = 0; j < NB; ++j)
#pragma unroll
            for (int n = 0; n < 2; ++n)
#pragma unroll
                for (int k = 0; k < 2; ++k) Bf[j][n][k] = *(const PG8_LAS bf16x8*)(lds + SG_BUF(cur, 1 + j) + boff + n * 2048 + k * 1024);
        asm volatile("s_waitcnt lgkmcnt(0)" ::: "memory"); __builtin_amdgcn_sched_barrier(0);
#pragma unroll
        for (int j = 0; j < NB; ++j)
#pragma unroll
            for (int m = 0; m < 4; ++m)
#pragma unroll
                for (int n = 0; n < 2; ++n)
#pragma unroll
                    for (int k = 0; k < 2; ++k) acc[0][j][m][n] = __builtin_amdgcn_mfma_f32_16x16x32_bf16(Bf[j][n][k], At[m][k], acc[0][j][m][n], 0, 0, 0);
        __builtin_amdgcn_s_barrier();
    }
    E.template run<1, NB>(acc, Unit{pm, pn}, ai0 * HALF, bj0 * HALF, wr, wc, fr, fq);
#undef SG_BUF
#undef SG_STAGE
}
}
constexpr int NWAVES = 8;
constexpr int DM = 1024, NBATCH = 8, SEQ = 4096, SBATCH = 16, SSEQ = 16, PAST = 2048;
constexpr int MP = NBATCH * SEQ, MS = SBATCH * SSEQ, M = MP + MS, NTILE = M / 256, STILE = MP / 256;
constexpr int DIN = 4096, DFF = 3072, DUP = 6144;
constexpr float EPS = 1e-6f;
constexpr size_t OFF_Y = 0, OFF_HP = (size_t)M * DM, OFF_LCP = OFF_HP + NBATCH * DM, OFF_PLP = OFF_LCP + NBATCH * 3 * DM, OFF_FCP = OFF_PLP + NBATCH * 15 * DM,
                 OFF_HS = OFF_FCP + NBATCH * 2 * DUP, OFF_LCS = OFF_HS + SBATCH * DM, OFF_PLS = OFF_LCS + SBATCH * 3 * DM, OFF_FCS = OFF_PLS + SBATCH * 15 * DM,
                 OUT_TOTAL = OFF_FCS + SBATCH * 2 * DUP;
constexpr size_t MiB = 1u << 20;
constexpr size_t WS_CTL = 0, CTL_ZERO_BYTES = 64 * 1024;
constexpr size_t WS_WIN = 1 * MiB, WS_WCAT = 9 * MiB, WS_WOUT = 13 * MiB, WS_WUP = 15 * MiB, WS_WDN = 27 * MiB, WS_WG = 33 * MiB;
constexpr size_t WS_SSQ = 33 * MiB + 512 * 1024, WS_SSQ2 = 37 * MiB + 768 * 1024, WS_SUMM = WS_SSQ;
static_assert(WS_SSQ + (size_t)M * 128 <= WS_SSQ2 && WS_SSQ2 + (size_t)M * 128 <= 42 * MiB, "ssq map");
constexpr size_t WS_R0 = 42 * MiB, WS_R1 = 107 * MiB, WS_R2 = 236 * MiB, WS_R3 = 365 * MiB, WS_WBP = 494 * MiB, WS_WPOOL = 496 * MiB, WS_END = 497 * MiB;
static_assert((size_t)M * DM * 2 <= WS_R1 - WS_R0 && (size_t)M * 2048 * 2 <= WS_R2 - WS_R1 && (size_t)M * 2048 * 2 <= WS_R3 - WS_R2 && (size_t)M * 2048 * 2 <= WS_END - WS_R3 && (size_t)M * DFF * 2 <= WS_END - WS_R2, "ws map");
constexpr int CW_BAR = 1024, CW_PANEL = 8192;
constexpr int RING_BYTES = 131072;
constexpr int MISC_OFF = RING_BYTES, RS_OFF = RING_BYTES + 512, EDGE_START_OFF = RS_OFF + 4096, EDGE_MID_OFF = EDGE_START_OFF + 2048, EDGE_PREV_OFF = EDGE_MID_OFF + 2048;
constexpr int LDS_BYTES = 147456;
static_assert(EDGE_PREV_OFF + 2048 <= LDS_BYTES, "LDS map");

#define GAS __attribute__((address_space(1)))
#define LAS __attribute__((address_space(3)))
typedef unsigned short bf16;
typedef unsigned v4u __attribute__((ext_vector_type(4)));
typedef unsigned v2u __attribute__((ext_vector_type(2)));
typedef float f32x4 __attribute__((ext_vector_type(4)));
typedef short bf16x8 __attribute__((ext_vector_type(8)));
#define LDS_WAIT() asm volatile("s_waitcnt lgkmcnt(0)" ::: "memory")
#define VM_WAIT() asm volatile("s_waitcnt vmcnt(0)" ::: "memory")
__device__ __forceinline__ unsigned f2bf(float f) { unsigned u = __builtin_bit_cast(unsigned, f); return (u + 0x7fffu + ((u >> 16) & 1u)) >> 16; }
__device__ __forceinline__ unsigned pk2(float lo, float hi) { return f2bf(lo) | (f2bf(hi) << 16); }
__device__ __forceinline__ float bflo(unsigned w) { return __builtin_bit_cast(float, w << 16); }
__device__ __forceinline__ float bfhi(unsigned w) { return __builtin_bit_cast(float, w & 0xffff0000u); }
__device__ __forceinline__ float sigmoidf_fast(float x) { return __builtin_amdgcn_rcpf(1.0f + __builtin_amdgcn_exp2f(-1.4426950408889634f * x)); }
__device__ __forceinline__ float gelu_tanh(float g) { const float z = g * (1.0f + 0.044715f * g * g); return g * __builtin_amdgcn_rcpf(1.0f + __builtin_amdgcn_exp2f(-2.302208198f * z)); }
__device__ __forceinline__ float wave_sum(float v) {
#pragma unroll
    for (int o = 1; o < 64; o <<= 1) v += __shfl_xor(v, o);
    return v;
}

#define XB_TMO      128
#define XB_XCNT(j)  (256  + 64 * (j))
#define XB_XSUB(j)  (1280 + 64 * (j))
#define XB_XGEN(j)  (2304 + 64 * (j))
#define XB_TOP      3328
#define XB_TOPGEN   3392
#define XCD_BAR_WORDS 3456
#define XB_SPIN_CAP (1u << 20)
static_assert((CW_BAR + XCD_BAR_WORDS) <= CW_PANEL && (CW_PANEL + 32 * 132) * 4 <= (int)CTL_ZERO_BYTES, "control words inside the memset region");
__device__ __forceinline__ unsigned xb_ld(unsigned* p)              { return __hip_atomic_load(p, __ATOMIC_RELAXED, __HIP_MEMORY_SCOPE_AGENT); }
__device__ __forceinline__ unsigned xb_add(unsigned* p, unsigned v) { return __hip_atomic_fetch_add(p, v, __ATOMIC_RELAXED, __HIP_MEMORY_SCOPE_AGENT); }
__device__ __forceinline__ unsigned xb_xcc_id() { return (unsigned)__builtin_amdgcn_s_getreg((3 << 11) | 20) & 0xFu; }
#define XB_SPIN(cond, bar) do { unsigned _sp = 0; while (cond) { __builtin_amdgcn_s_sleep(1); \
    if ((++_sp & 255u) == 0u) { if (xb_ld(&(bar)[XB_TMO])) break; if (_sp > XB_SPIN_CAP) { atomicAdd(&(bar)[XB_TMO], 1u); break; } } } } while (0)
struct XcdBarrier { unsigned* bar; unsigned x; volatile LAS unsigned* st; };
__device__ __forceinline__ XcdBarrier xcd_barrier_post(unsigned* bar, volatile LAS unsigned* st) {
    XcdBarrier b; b.bar = bar; b.x = xb_xcc_id(); b.st = st;
    if (threadIdx.x == 0) (void)xb_add(&bar[XB_XCNT(b.x)], 1u);
    return b;
}
__device__ __forceinline__ void xcd_barrier_complete(unsigned* bar, unsigned x, unsigned& nloc, unsigned& nx) {
    const unsigned G = gridDim.x * gridDim.y * gridDim.z;
    unsigned sum, cnt, mine, sp = 0u;
    for (;;) {
        sum = 0u; cnt = 0u; mine = 0u;
#pragma unroll
        for (unsigned j = 0; j < 16; ++j) { const unsigned c = xb_ld(&bar[XB_XCNT(j)]); sum += c; cnt += (c > 0u) ? 1u : 0u; mine = (j == x) ? c : mine; }
        if (sum == G) break;
        __builtin_amdgcn_s_sleep(1);
        if ((++sp & 255u) == 0u) { if (xb_ld(&bar[XB_TMO])) break; if (sp > XB_SPIN_CAP) { atomicAdd(&bar[XB_TMO], 1u); break; } }
    }
    nloc = mine > 0u ? mine : 1u; nx = cnt > 0u ? cnt : 1u;
}
__device__ __forceinline__ void xcd_barrier(const XcdBarrier& b) {
    asm volatile("s_waitcnt vmcnt(0)" ::: "memory");
    __syncthreads();
    if (threadIdx.x == 0) {
        unsigned* bar = b.bar;
        __builtin_amdgcn_s_waitcnt(0);
        unsigned nloc = b.st[0], nx = b.st[1];
        if (nloc == 0u) { xcd_barrier_complete(bar, b.x, nloc, nx); b.st[0] = nloc; b.st[1] = nx; }
        const unsigned old = xb_add(&bar[XB_XSUB(b.x)], 1u);
        const unsigned gen = old / nloc;
        if (old + 1u == (gen + 1u) * nloc) {
            __builtin_amdgcn_fence(__ATOMIC_RELEASE, "agent");
            asm volatile("s_waitcnt vmcnt(0)" ::: "memory");
            const unsigned og = xb_add(&bar[XB_TOP], 1u);
            const unsigned tg = og / nx;
            if (og + 1u == (tg + 1u) * nx) xb_add(&bar[XB_TOPGEN], 1u);
            else XB_SPIN(xb_ld(&bar[XB_TOPGEN]) == tg, bar);
            __builtin_amdgcn_fence(__ATOMIC_ACQUIRE, "agent");
            xb_add(&bar[XB_XGEN(b.x)], 1u);
            asm volatile("s_waitcnt vmcnt(0)" ::: "memory");
        } else {
            XB_SPIN(xb_ld(&bar[XB_XGEN(b.x)]) == gen, bar);
            __builtin_amdgcn_fence(__ATOMIC_ACQUIRE, "agent");
            asm volatile("s_waitcnt vmcnt(0)" ::: "memory");
        }
    }
    __syncthreads();
}

struct KP {
    const float* in[26];
    float* out; unsigned char* ws;
    int ph_lo, ph_hi;
};
enum { I_XP = 0, I_XS, I_STH, I_STLC, I_STPOOL, I_STFFN, I_NMIX, I_WIN, I_CLW, I_CLB, I_WRA, I_BRA, I_WIX, I_BIX, I_LAM, I_WPOOL, I_PSCALE, I_WBRL, I_WBRP, I_WOUT, I_NFFN, I_WUP, I_CFW, I_CFB, I_WDN, I_NFIN };

using pg8::Unit;
struct EpiZ {
    static constexpr bool PERM = true, AMAP = false, MID = false;
    bf16* ZR; bf16* G;
    template <int NA, int NB> __device__ __forceinline__ void run(f32x4 (&acc)[NA][NB][4][2], const Unit& u, int rowoff, int coloff, int wr, int wc, int fr, int fq) const {
        const int row0 = u.pm * 256 + rowoff + wr * 64 + fr; const bool gate = u.pn >= 8;
        bf16* base = gate ? G : ZR; const int col0 = (u.pn & 7) * 256 + coloff + wc * 32 + 8 * fq;
#pragma unroll
        for (int ai = 0; ai < NA; ++ai)
#pragma unroll
            for (int m = 0; m < 4; ++m) { bf16* rowp = base + (size_t)(row0 + ai * 128 + m * 16) * 2048 + col0;
#pragma unroll
                for (int bj = 0; bj < NB; ++bj) { f32x4 v0 = acc[ai][bj][m][0], v1 = acc[ai][bj][m][1];
                    if (gate) {
#pragma unroll
                        for (int j = 0; j < 4; ++j) { v0[j] = sigmoidf_fast(v0[j]); v1[j] = sigmoidf_fast(v1[j]); } }
                    v4u w; w.x = pg8::cvt_pk_bf16(v0[0], v0[1]); w.y = pg8::cvt_pk_bf16(v0[2], v0[3]); w.z = pg8::cvt_pk_bf16(v1[0], v1[1]); w.w = pg8::cvt_pk_bf16(v1[2], v1[3]);
                    *(v4u*)(rowp + bj * 128) = w; } }
    }
};
struct EpiBr {
    static constexpr bool PERM = true, AMAP = false, MID = true;
    const bf16* G; bf16* MG;
    template <int NA, int NB> __device__ __forceinline__ void mid(f32x4 (&acc)[NA][NB][4][2], const Unit& u, int rowoff, int coloff, int wr, int wc, int fr, int fq) const {
        int pm_ = u.pm, pn_ = u.pn; asm volatile("" : "+s"(pm_), "+s"(pn_));
        const int row0 = pm_ * 256 + rowoff + wr * 64 + fr, col0 = pn_ * 256 + coloff + wc * 32 + 8 * fq;
#pragma unroll
        for (int ai = 0; ai < NA; ++ai)
#pragma unroll
            for (int m = 0; m < 4; ++m) { const size_t row = (size_t)(row0 + ai * 128 + m * 16);
#pragma unroll
                for (int bj = 0; bj < NB; ++bj) { const int col = col0 + bj * 128;
                    const v4u ga = *(const v4u*)(G + row * 2048 + col), gb = *(const v4u*)(G + row * 2048 + 1024 + col);
                    const float a_[8] = {bflo(ga.x), bfhi(ga.x), bflo(ga.y), bfhi(ga.y), bflo(ga.z), bfhi(ga.z), bflo(ga.w), bfhi(ga.w)};
                    const float b_[8] = {bflo(gb.x), bfhi(gb.x), bflo(gb.y), bfhi(gb.y), bflo(gb.z), bfhi(gb.z), bflo(gb.w), bfhi(gb.w)};
#pragma unroll
                    for (int e = 0; e < 4; ++e) { acc[ai][bj][m][0][e] *= a_[e] * __builtin_amdgcn_rcpf(fmaxf(b_[e], 1e-30f)); acc[ai][bj][m][1][e] *= a_[4 + e] * __builtin_amdgcn_rcpf(fmaxf(b_[4 + e], 1e-30f)); } } }
    }
    template <int NA, int NB> __device__ __forceinline__ void run(f32x4 (&acc)[NA][NB][4][2], const Unit& u, int rowoff, int coloff, int wr, int wc, int fr, int fq) const {
        const int row0 = u.pm * 256 + rowoff + wr * 64 + fr, col0 = u.pn * 256 + coloff + wc * 32 + 8 * fq;
#pragma unroll
        for (int ai = 0; ai < NA; ++ai)
#pragma unroll
            for (int m = 0; m < 4; ++m) { const size_t row = (size_t)(row0 + ai * 128 + m * 16);
#pragma unroll
                for (int bj = 0; bj < NB; ++bj) { const int col = col0 + bj * 128;
                    const v4u gw = *(const v4u*)(G + row * 2048 + 1024 + col);
                    const f32x4 g0 = {bflo(gw.x), bfhi(gw.x), bflo(gw.y), bfhi(gw.y)}, g1 = {bflo(gw.z), bfhi(gw.z), bflo(gw.w), bfhi(gw.w)};
                    const f32x4 v0 = acc[ai][bj][m][0] * g0, v1 = acc[ai][bj][m][1] * g1;
                    v4u w; w.x = pg8::cvt_pk_bf16(v0[0], v0[1]); w.y = pg8::cvt_pk_bf16(v0[2], v0[3]); w.z = pg8::cvt_pk_bf16(v1[0], v1[1]); w.w = pg8::cvt_pk_bf16(v1[2], v1[3]);
                    *(v4u*)(MG + row * 1024 + col) = w; } }
    }
};
template <bool DOWN> struct EpiRes {
    static constexpr bool PERM = true, AMAP = false, MID = false;
    const float* xp; const float* xs; float* Y; bf16* X1B; float* SSQ;
    template <int NA, int NB> __device__ __forceinline__ void run(f32x4 (&acc)[NA][NB][4][2], const Unit& u, int rowoff, int coloff, int wr, int wc, int fr, int fq) const {
        const int row0 = u.pm * 256 + rowoff + wr * 64 + fr, col0 = u.pn * 256 + coloff + wc * 32 + 8 * fq;
        const float* xb = (u.pm < STILE ? xp : xs - (size_t)MP * DM);
#pragma unroll
        for (int ai = 0; ai < NA; ++ai)
#pragma unroll
            for (int m = 0; m < 4; ++m) { const size_t row = (size_t)(row0 + ai * 128 + m * 16);
#pragma unroll
                for (int bj = 0; bj < NB; ++bj) { const size_t off = row * 1024 + col0 + bj * 128; f32x4 v0, v1;
                    if (!DOWN) { v0 = acc[ai][bj][m][0] + *(const f32x4*)(xb + off); v1 = acc[ai][bj][m][1] + *(const f32x4*)(xb + off + 4); }
                    else { const v4u w = *(const v4u*)(X1B + off); v0 = acc[ai][bj][m][0] + (f32x4){bflo(w.x), bfhi(w.x), bflo(w.y), bfhi(w.y)}; v1 = acc[ai][bj][m][1] + (f32x4){bflo(w.z), bfhi(w.z), bflo(w.w), bfhi(w.w)}; }
                    float s = (v0[0] * v0[0] + v0[1] * v0[1]) + (v0[2] * v0[2] + v0[3] * v0[3]) + (v1[0] * v1[0] + v1[1] * v1[1]) + (v1[2] * v1[2] + v1[3] * v1[3]);
                    if (!DOWN) { v4u w; w.x = pg8::cvt_pk_bf16(v0[0], v0[1]); w.y = pg8::cvt_pk_bf16(v0[2], v0[3]); w.z = pg8::cvt_pk_bf16(v1[0], v1[1]); w.w = pg8::cvt_pk_bf16(v1[2], v1[3]);
                        *(v4u*)(X1B + off) = w; }
                    else { *(f32x4*)(Y + off) = v0; *(f32x4*)(Y + off + 4) = v1; }
                    s += __shfl_xor(s, 16); s += __shfl_xor(s, 32);
                    if (fq == 0) SSQ[row * 32 + u.pn * 8 + ((coloff >> 7) + bj) * 4 + wc] = s; } }
    }
};
__device__ __forceinline__ float row_rs(const float* SSQ, size_t row) {
    const f32x4* q = (const f32x4*)(SSQ + row * 32); float s = 0.f;
#pragma unroll
    for (int k = 0; k < 8; ++k) { const f32x4 a = q[k]; s += (a[0] + a[1]) + (a[2] + a[3]); }
    return 1.0f / sqrtf(s * (1.f / DM) + EPS);
}
struct EpiFinal {
    static constexpr bool PERM = true, AMAP = false, MID = false;
    float* Y; const bf16* X1B; const float* gf; float* XS; unsigned* cnt; unsigned* tmo; LAS unsigned char* lx;
    template <int NA, int NB> __device__ __forceinline__ void run(f32x4 (&acc)[NA][NB][4][2], const Unit& u, int rowoff, int coloff, int wr, int wc, int fr, int fq) const {
        LAS float* P = (LAS float*)(lx + RS_OFF); LAS float* S = P + 2048;
        int tid = threadIdx.x, pm_ = u.pm, pn_ = u.pn, fr_ = fr, fq_ = fq, wr_ = wr, wc_ = wc;
        asm volatile("" : "+v"(tid), "+s"(pm_), "+s"(pn_), "+v"(fr_), "+v"(fq_), "+s"(wr_), "+s"(wc_));
        const int wid = tid >> 6, lane = tid & 63;
        const int lrow0 = rowoff + wr_ * 64 + fr_, col0 = pn_ * 256 + coloff + wc_ * 32 + 8 * fq_, bj0 = coloff >> 7;
#pragma unroll
        for (int ai = 0; ai < NA; ++ai)
#pragma unroll
            for (int m = 0; m < 4; ++m) { const int lrow = lrow0 + ai * 128 + m * 16; const size_t row = (size_t)pm_ * 256 + lrow;
#pragma unroll
                for (int bj = 0; bj < NB; ++bj) { const size_t off = row * 1024 + col0 + bj * 128;
                    { const v4u w = *(const v4u*)(X1B + off); acc[ai][bj][m][0] += (f32x4){bflo(w.x), bfhi(w.x), bflo(w.y), bfhi(w.y)}; acc[ai][bj][m][1] += (f32x4){bflo(w.z), bfhi(w.z), bflo(w.w), bfhi(w.w)}; }
                    const f32x4 v0 = acc[ai][bj][m][0], v1 = acc[ai][bj][m][1];
                    float s = (v0[0] * v0[0] + v0[1] * v0[1]) + (v0[2] * v0[2] + v0[3] * v0[3]) + (v1[0] * v1[0] + v1[1] * v1[1]) + (v1[2] * v1[2] + v1[3] * v1[3]);
                    s += __shfl_xor(s, 16); s += __shfl_xor(s, 32);
                    if (fq_ == 0) P[lrow * 8 + (bj0 + bj) * 4 + wc_] = s; } }
        asm volatile("s_waitcnt lgkmcnt(0)" ::: "memory"); __builtin_amdgcn_s_barrier(); asm volatile("" ::: "memory");
        constexpr int RPW = (NA == 2) ? 32 : 16;
        const int nslot = (NA == 2) ? 4 : 8, slot = (NA == 2) ? pn_ : 2 * pn_ + bj0;
        const int prow = rowoff + wid * RPW + (lane & (RPW - 1));
        float* xs = XS + (size_t)pm_ * 2048;
        if (lane < RPW) { const LAS float* pp = P + prow * 8 + (NA == 2 ? 0 : bj0 * 4); float t = (pp[0] + pp[1]) + (pp[2] + pp[3]); if (NA == 2) t += (pp[4] + pp[5]) + (pp[6] + pp[7]);
            __hip_atomic_store(xs + slot * 256 + prow, t, __ATOMIC_RELAXED, __HIP_MEMORY_SCOPE_AGENT); }
        asm volatile("s_waitcnt vmcnt(0)" ::: "memory");
        unsigned* c = cnt + 32 * ((NA == 2) ? pm_ : (STILE + (rowoff >> 7)));
        if (lane == 0) __hip_atomic_fetch_add(c, 1u, __ATOMIC_RELAXED, __HIP_MEMORY_SCOPE_AGENT);
        if (wid == 0) { const unsigned want = 8u * (unsigned)nslot; unsigned sp = 0;
            while ((unsigned)__builtin_amdgcn_readfirstlane(__hip_atomic_load(c, __ATOMIC_RELAXED, __HIP_MEMORY_SCOPE_AGENT)) < want) {
                __builtin_amdgcn_s_sleep(1);
                if ((++sp & 255u) == 0u) { if (__builtin_amdgcn_readfirstlane(__hip_atomic_load(tmo, __ATOMIC_RELAXED, __HIP_MEMORY_SCOPE_AGENT)) != 0u) break; if (sp > (1u << 20)) { if (lane == 0) atomicAdd(tmo, 1u); break; } } } }
        asm volatile("s_waitcnt vmcnt(0) lgkmcnt(0)" ::: "memory"); __builtin_amdgcn_s_barrier(); asm volatile("" ::: "memory");
        if (lane < RPW) { float t = 0.f;
#pragma unroll
            for (int k = 0; k < 8; ++k) if (k < nslot) t += __hip_atomic_load(xs + k * 256 + prow, __ATOMIC_RELAXED, __HIP_MEMORY_SCOPE_AGENT);
            S[prow] = 1.0f / sqrtf(t * (1.f / DM) + EPS); }
        asm volatile("s_waitcnt lgkmcnt(0)" ::: "memory"); __builtin_amdgcn_s_barrier(); asm volatile("" ::: "memory");
        f32x4 gg[NB][2];
#pragma unroll
        for (int bj = 0; bj < NB; ++bj) { gg[bj][0] = *(const f32x4*)(gf + col0 + bj * 128); gg[bj][1] = *(const f32x4*)(gf + col0 + bj * 128 + 4); }
#pragma unroll
        for (int ai = 0; ai < NA; ++ai)
#pragma unroll
            for (int m = 0; m < 4; ++m) { const int lrow = lrow0 + ai * 128 + m * 16; const size_t row = (size_t)pm_ * 256 + lrow; const float rs = S[lrow];
#pragma unroll
                for (int bj = 0; bj < NB; ++bj) { const size_t off = row * 1024 + col0 + bj * 128;
                    *(f32x4*)(Y + off) = acc[ai][bj][m][0] * rs * gg[bj][0]; *(f32x4*)(Y + off + 4) = acc[ai][bj][m][1] * rs * gg[bj][1]; } }
    }
};
struct EpiW {
    static constexpr bool PERM = true, AMAP = false, MID = false;
    bf16* O;
    template <int NA, int NB> __device__ __forceinline__ void run(f32x4 (&acc)[NA][NB][4][2], const Unit& u, int rowoff, int coloff, int wr, int wc, int fr, int fq) const {
        const int row0 = u.pm * 256 + rowoff + wr * 64 + fr, col0 = u.pn * 256 + coloff + wc * 32 + 8 * fq;
#pragma unroll
        for (int ai = 0; ai < NA; ++ai)
#pragma unroll
            for (int m = 0; m < 4; ++m)
#pragma unroll
                for (int bj = 0; bj < NB; ++bj) { const f32x4 v0 = acc[ai][bj][m][0], v1 = acc[ai][bj][m][1];
                    v4u w; w.x = pg8::cvt_pk_bf16(v0[0], v0[1]); w.y = pg8::cvt_pk_bf16(v0[2], v0[3]); w.z = pg8::cvt_pk_bf16(v1[0], v1[1]); w.w = pg8::cvt_pk_bf16(v1[2], v1[3]);
                    *(v4u*)(O + (size_t)(row0 + ai * 128 + m * 16) * 2048 + col0 + bj * 128) = w; }
    }
};
struct EpiUpS {
    static constexpr bool PERM = true, AMAP = false, MID = false;
    bf16* ACT; const float* cw; const float* cb; const float* stf; float* ofs; const float* SSQ;
    template <int NA, int NB> __device__ __forceinline__ void run(f32x4 (&acc)[NA][NB][4][2], const Unit& u, int rowoff, int coloff, int wr, int wc, int fr, int fq) const {
        static_assert(NA == 1 && NB == 2, "sample FFN epilogue works on half sub-units");
        int pn_ = u.pn, ro_ = rowoff, fr_ = fr, fq_ = fq, wr_ = wr, wc_ = wc; asm volatile("" : "+s"(pn_), "+s"(ro_), "+v"(fr_), "+v"(fq_), "+s"(wr_), "+s"(wc_));
        const int cbase = 32 * wc_ + 8 * fq_, gcol = 128 * pn_ + cbase;
#pragma unroll
        for (int m = 0; m < 4; ++m) {
            asm volatile("" ::: "memory");
            const int lrow = ro_ + wr_ * 64 + m * 16 + fr_, seq = lrow >> 4; const size_t row = (size_t)MP + lrow;
            const float rs = row_rs(SSQ, row);
            unsigned pk[4];
#pragma unroll
            for (int n = 0; n < 2; ++n) { f32x4 gc;
#pragma unroll
                for (int bj = 0; bj < 2; ++bj) { const int oc = bj * DFF + gcol + 4 * n;
                    const f32x4 w0 = *(const f32x4*)(cw + oc), w1 = *(const f32x4*)(cw + DUP + oc), w2 = *(const f32x4*)(cw + 2 * DUP + oc), bb = *(const f32x4*)(cb + oc);
                    const f32x4 h = acc[0][bj][m][n] * rs; f32x4 hm1, hm2;
#pragma unroll
                    for (int e = 0; e < 4; ++e) { hm1[e] = __shfl_up(h[e], 1, 16); hm2[e] = __shfl_up(h[e], 2, 16); }
                    if (fr_ < 2) { const f32x4 s1 = *(const f32x4*)(stf + (size_t)(seq * 2 + 1) * DUP + oc); if (fr_ == 0) { hm1 = s1; hm2 = *(const f32x4*)(stf + (size_t)(seq * 2 + 0) * DUP + oc); } else hm2 = s1; }
                    if (fr_ >= 14) *(f32x4*)(ofs + (size_t)(seq * 2 + (fr_ - 14)) * DUP + oc) = h;
                    const f32x4 c = bb + w0 * hm2 + w1 * hm1 + w2 * h;
                    if (bj == 0) gc = c;
                    else { f32x4 a;
#pragma unroll
                        for (int e = 0; e < 4; ++e) a[e] = gelu_tanh(gc[e]) * c[e];
                        pk[2 * n] = pg8::cvt_pk_bf16(a[0], a[1]); pk[2 * n + 1] = pg8::cvt_pk_bf16(a[2], a[3]); } } }
            v4u w; w.x = pk[0]; w.y = pk[1]; w.z = pk[2]; w.w = pk[3];
            *(v4u*)(ACT + row * DFF + gcol) = w;
        }
    }
};
struct EpiUp {
    static constexpr bool PERM = true, AMAP = true, MID = false;
    bf16* ACT; const float* cw; const float* cb; const float* stf; float* ofp; float* ofs; LAS unsigned char* lx; int pm0;
    template <int NA, int NB> __device__ __forceinline__ void run(f32x4 (&acc)[NA][NB][4][2], const Unit& u, int, int, int wr, int wc, int fr, int fq) const {
        int pm_ = u.pm, pn_ = u.pn, fr_ = fr, fq_ = fq; asm volatile("" : "+s"(pm_), "+s"(pn_), "+v"(fr_), "+v"(fq_));
        const bool samp = (pm_ == STILE); const int j = pm_ - pm0;
        const LAS float* RS = (const LAS float*)(lx + RS_OFF) + j * 256 + 128 * wr + 8 * fr_;
        const f32x4 rsa = *(const LAS f32x4*)RS, rsb = *(const LAS f32x4*)(RS + 4);
        const float rs[8] = {rsa[0], rsa[1], rsa[2], rsa[3], rsb[0], rsb[1], rsb[2], rsb[3]};
        const int cbase = 32 * wc + 8 * fq_, gcol = 128 * pn_ + cbase;
        const LAS float* Ein = (const LAS float*)(lx + (wr == 0 ? (j == 0 ? EDGE_START_OFF : EDGE_PREV_OFF) : EDGE_MID_OFF));
        LAS float* Eout = (LAS float*)(lx + (wr == 0 ? EDGE_MID_OFF : EDGE_PREV_OFF));
        const int seq = samp ? (8 * wr + (fr_ >> 1)) : (pm_ >> 4);
        const bool lastp = (!samp) && ((pm_ & 15) == 15) && wr == 1 && fr_ == 15;
        bf16* ap = ACT + (size_t)(pm_ * 256 + 128 * wr + 8 * fr_) * DFF + gcol;
#pragma unroll
        for (int n = 0; n < 2; ++n) {
            f32x4 gc[8];
#pragma unroll
            for (int bj = 0; bj < 2; ++bj) {
                const int cc = bj * 128 + cbase + 4 * n, oc = bj * DFF + gcol + 4 * n;
                const f32x4 w0 = *(const f32x4*)(cw + oc), w1 = *(const f32x4*)(cw + DUP + oc), w2 = *(const f32x4*)(cw + 2 * DUP + oc), bb = *(const f32x4*)(cb + oc);
                const f32x4 h6 = acc[1][bj][2][n] * rs[6], h7 = acc[1][bj][3][n] * rs[7];
                f32x4 hm1, hm2;
#pragma unroll
                for (int e = 0; e < 4; ++e) { hm1[e] = __shfl_up(h7[e], 1, 16); hm2[e] = __shfl_up(h6[e], 1, 16); }
                if (!samp) {
                    if (fr_ == 0) { hm2 = *(const LAS f32x4*)(Ein + cc); hm1 = *(const LAS f32x4*)(Ein + 256 + cc); }
                    if (fr_ == 15) { *(LAS f32x4*)(Eout + cc) = h6; *(LAS f32x4*)(Eout + 256 + cc) = h7; }
                    if (lastp) { *(f32x4*)(ofp + (size_t)(seq * 2 + 0) * DUP + oc) = h6; *(f32x4*)(ofp + (size_t)(seq * 2 + 1) * DUP + oc) = h7; }
                } else {
                    if (!(fr_ & 1)) { hm2 = *(const f32x4*)(stf + (size_t)(seq * 2 + 0) * DUP + oc); hm1 = *(const f32x4*)(stf + (size_t)(seq * 2 + 1) * DUP + oc); }
                    else { *(f32x4*)(ofs + (size_t)(seq * 2 + 0) * DUP + oc) = h6; *(f32x4*)(ofs + (size_t)(seq * 2 + 1) * DUP + oc) = h7; }
                }
                f32x4 p2 = hm2, p1 = hm1;
#pragma unroll
                for (int q = 0; q < 8; ++q) {
                    const f32x4 hq = (q == 6) ? h6 : (q == 7) ? h7 : acc[q >> 2][bj][q & 3][n] * rs[q];
                    const f32x4 c = bb + w0 * p2 + w1 * p1 + w2 * hq;
                    p2 = p1; p1 = hq;
                    if (bj == 0) gc[q] = c;
                    else { f32x4 a;
#pragma unroll
                        for (int e = 0; e < 4; ++e) a[e] = gelu_tanh(gc[q][e]) * c[e];
                        v2u w; w.x = pg8::cvt_pk_bf16(a[0], a[1]); w.y = pg8::cvt_pk_bf16(a[2], a[3]);
                        *(v2u*)(ap + (size_t)q * DFF + 4 * n) = w; }
                }
            }
        }
        LDS_WAIT();
    }
};
template <class RowMap>
__device__ __forceinline__ void p0_transpose_item(const float* W, int ldw, int k0, int n0, bf16* WT, size_t ldt, int kcol0, RowMap drow, const float* kscale, LAS float* scr, int lane) {
#pragma unroll 8
    for (int i = 0; i < 32; ++i) { const int kk = 2 * i + (lane >> 5); float v = W[(size_t)(k0 + kk) * ldw + n0 + (lane & 31)]; if (kscale) v *= kscale[k0 + kk]; scr[kk * 33 + (lane & 31)] = v; }
    LDS_WAIT(); asm volatile("" ::: "memory");
    const int c = lane & 7;
#pragma unroll
    for (int j = 0; j < 4; ++j) { const int n = (lane >> 3) + 8 * j; const LAS float* s = scr + (8 * c) * 33 + n;
        v4u o; o.x = pk2(s[0 * 33], s[1 * 33]); o.y = pk2(s[2 * 33], s[3 * 33]); o.z = pk2(s[4 * 33], s[5 * 33]); o.w = pk2(s[6 * 33], s[7 * 33]);
        *(v4u*)(WT + (size_t)drow(n0 + n) * ldt + kcol0 + k0 + 8 * c) = o; }
    LDS_WAIT(); asm volatile("" ::: "memory");
}
struct RowId { __device__ __forceinline__ int operator()(int n) const { return n; } };
struct RowUp { __device__ __forceinline__ int operator()(int n) const { const int half = n >= DFF ? 1 : 0, c = n - half * DFF; return (c >> 7) * 256 + half * 128 + (c & 127); } };

__device__ __forceinline__ void p0_prologue(const KP& p, LAS unsigned char* lds, int vcu, int G, int wave, int lane) {
    LAS float* scr = (LAS float*)(lds + wave * 16384);
    const int gw = vcu * NWAVES + wave, NGW = G * NWAVES;
    unsigned char* ws = p.ws;
    bf16* Win_t = (bf16*)(ws + WS_WIN); bf16* Wg_t = (bf16*)(ws + WS_WG); bf16* Wbp_t = (bf16*)(ws + WS_WBP); bf16* Wpool_b = (bf16*)(ws + WS_WPOOL);
    constexpr int I_IN = (DM / 64) * (DIN / 32), I_SQ = (DM / 64) * (DM / 32), I_G = 32 * 2, I_PC = 4 * 256 * 256 / 512;
    constexpr int NITEMS = I_IN + I_SQ + I_G + I_PC;
    for (int it = gw; it < NITEMS; it += NGW) {
        int r = it;
        if (r < I_IN) { const int nblk = DIN / 32; p0_transpose_item(p.in[I_WIN], DIN, 64 * (r / nblk), 32 * (r % nblk), Win_t, DM, 0, RowId(), nullptr, scr, lane); continue; } r -= I_IN;
        if (r < I_SQ) { const int nblk = DM / 32; p0_transpose_item(p.in[I_WBRP], DM, 64 * (r / nblk), 32 * (r % nblk), Wbp_t, DM, 0, RowId(), p.in[I_PSCALE], scr, lane); continue; } r -= I_SQ;
        if (r < I_G) { const int mat = r >> 1, nb = r & 1; const float* W = (mat < 16 ? p.in[I_WRA] : p.in[I_WIX]) + (size_t)(mat & 15) * 4096;
          p0_transpose_item(W, 64, 0, 32 * nb, Wg_t + (size_t)mat * 4096, 64, 0, RowId(), nullptr, scr, lane); continue; } r -= I_G;
        { const float* s = p.in[I_WPOOL] + (size_t)r * 512 + lane * 8; const f32x4 a = *(const f32x4*)s, b = *(const f32x4*)(s + 4);
          v4u o; o.x = pk2(a[0], a[1]); o.y = pk2(a[2], a[3]); o.z = pk2(b[0], b[1]); o.w = pk2(b[2], b[3]); *(v4u*)(Wpool_b + (size_t)r * 512 + lane * 8) = o; }
    }
    {
        bf16* XN = (bf16*)(ws + WS_R0); const float* g1 = p.in[I_NMIX];
        f32x4 gv[4];
#pragma unroll
        for (int j = 0; j < 4; ++j) gv[j] = *((const f32x4*)g1 + lane + 64 * j);
        for (int m0 = gw; m0 < M; m0 += 2 * NGW) {
            f32x4 v[2][4]; float s[2];
#pragma unroll
            for (int r = 0; r < 2; ++r) { const int m = m0 + r * NGW; s[r] = 0.f;
                if (m < M) { const float* xrow = m < MP ? p.in[I_XP] + (size_t)m * DM : p.in[I_XS] + (size_t)(m - MP) * DM; const f32x4* xr = (const f32x4*)xrow + lane;
#pragma unroll
                    for (int j = 0; j < 4; ++j) v[r][j] = xr[64 * j]; } }
#pragma unroll
            for (int r = 0; r < 2; ++r) { const int m = m0 + r * NGW;
                if (m < M) {
#pragma unroll
                    for (int j = 0; j < 4; ++j) s[r] += (v[r][j][0] * v[r][j][0] + v[r][j][1] * v[r][j][1]) + (v[r][j][2] * v[r][j][2] + v[r][j][3] * v[r][j][3]);
                    const float rstd = 1.0f / sqrtf(wave_sum(s[r]) * (1.f / DM) + EPS);
                    v2u* o8 = (v2u*)(XN + (size_t)m * DM) + lane;
#pragma unroll
                    for (int j = 0; j < 4; ++j) { const f32x4 y = v[r][j] * rstd * gv[j]; v2u o; o.x = pk2(y[0], y[1]); o.y = pk2(y[2], y[3]); o8[64 * j] = o; } } }
        }
    }
}
__device__ __forceinline__ void p1_weights(const KP& p, LAS unsigned char* lds, int gw, int NGW, int wave, int lane) {
    LAS float* scr = (LAS float*)(lds + wave * 16384);
    unsigned char* ws = p.ws;
    bf16* Wcat_t = (bf16*)(ws + WS_WCAT); bf16* Wout_t = (bf16*)(ws + WS_WOUT); bf16* Wup_t = (bf16*)(ws + WS_WUP); bf16* Wdn_t = (bf16*)(ws + WS_WDN);
    constexpr int I_UP = (DM / 64) * (DUP / 32), I_SQ = (DM / 64) * (DM / 32), I_DN = (DFF / 64) * (DM / 32);
    for (int it = gw; it < I_UP + 2 * I_SQ + I_DN; it += NGW) {
        int r = it;
        if (r < I_SQ) { const int nblk = DM / 32; p0_transpose_item(p.in[I_WBRL], DM, 64 * (r / nblk), 32 * (r % nblk), Wcat_t, 2048, 0, RowId(), nullptr, scr, lane); continue; } r -= I_SQ;
        if (r < I_SQ) { const int nblk = DM / 32; p0_transpose_item(p.in[I_WOUT], DM, 64 * (r / nblk), 32 * (r % nblk), Wout_t, DM, 0, RowId(), nullptr, scr, lane); continue; } r -= I_SQ;
        if (r < I_UP) { const int nblk = DUP / 32; p0_transpose_item(p.in[I_WUP], DUP, 64 * (r / nblk), 32 * (r % nblk), Wup_t, DM, 0, RowUp(), p.in[I_NFFN]  , scr, lane); continue; } r -= I_UP;
        { const int nblk = DM / 32; p0_transpose_item(p.in[I_WDN], DM, 64 * (r / nblk), 32 * (r % nblk), Wdn_t, DFF, 0, RowId(), nullptr, scr, lane); }
    }
}

constexpr int XR_OFF = 0, XR_BYTES = 16 * 19 * 128, SEG_OFF = 40960, CIN_OFF = 45056;
template <bool FINAL>
__device__ __forceinline__ void lru_unit(const KP& p, LAS unsigned char* lds, int pm, int n, int tid, int lane, int wave) {
    constexpr bool samp = true;
    const bf16* ZR = (const bf16*)(p.ws + WS_R1); const bf16* Wg_t = (const bf16*)(p.ws + WS_WG);
    typedef float f32x2v __attribute__((ext_vector_type(2)));
    f32x2v* SUMM = (f32x2v*)(p.ws + WS_SUMM);
    bf16* HP = (bf16*)(p.ws + WS_R3);
    LAS unsigned char* XR = lds + XR_OFF; LAS f32x2v* SEG = (LAS f32x2v*)(lds + SEG_OFF); LAS float* CIN = (LAS float*)(lds + CIN_OFF);
    const int t0 = samp ? 0 : 256 * (pm & 15);
    __syncthreads();
    for (int idx = tid; idx < 304 * 8; idx += NWAVES * 64) {
        const int row = idx >> 3, ck = idx & 7, g = row / 19, k = row - g * 19, tt = 16 * g + k - 3;
        v4u v = {0u, 0u, 0u, 0u};
        if (!samp) { if (t0 + tt >= 0) v = *(const v4u*)(ZR + (size_t)(pm * 256 + tt) * 2048 + n * 64 + ck * 8); }
        else if (k < 3) { const float* s = p.in[I_STLC] + (size_t)(g * 3 + k) * DM + n * 64 + ck * 8; const f32x4 a = *(const f32x4*)s, b = *(const f32x4*)(s + 4);
            v.x = pk2(a[0], a[1]); v.y = pk2(a[2], a[3]); v.z = pk2(b[0], b[1]); v.w = pk2(b[2], b[3]); }
        else v = *(const v4u*)(ZR + (size_t)(MP + 16 * g + k - 3) * 2048 + n * 64 + ck * 8);
        *(LAS v4u*)(XR + row * 128 + ck * 16) = v;
    }
    if (FINAL && !samp && tid < 64) {
        const int npre = pm & 15; f32x2v sv[15];
#pragma unroll
        for (int k = 0; k < 15; ++k) sv[k] = (k < npre) ? SUMM[(size_t)(pm - npre + k) * DM + n * 64 + tid] : (f32x2v){1.f, 0.f};
        float c = 0.f;
#pragma unroll
        for (int k = 0; k < 15; ++k) c = sv[k].y + sv[k].x * c;
        CIN[tid] = c;
    }
    __syncthreads();
    const int i16 = lane & 15, fq = lane >> 4;
    const float* cwl = p.in[I_CLW]; const float* cbl = p.in[I_CLB];
    bf16x8 fa[2][2];
#pragma unroll
    for (int ks = 0; ks < 2; ++ks) {
        const int ch0 = 32 * ks + 8 * fq; f32x4 w[4][2], bb[2];
#pragma unroll
        for (int tp = 0; tp < 4; ++tp) { w[tp][0] = *(const f32x4*)(cwl + tp * DM + n * 64 + ch0); w[tp][1] = *(const f32x4*)(cwl + tp * DM + n * 64 + ch0 + 4); }
        bb[0] = *(const f32x4*)(cbl + n * 64 + ch0); bb[1] = *(const f32x4*)(cbl + n * 64 + ch0 + 4);
#pragma unroll
        for (int m = 0; m < 2; ++m) {
            const int tau = 8 * (i16 >> 2) + 4 * m + (i16 & 3), T = 32 * wave + tau, rb = (T >> 4) * 19 + (T & 15);
            f32x4 u0 = bb[0], u1 = bb[1];
#pragma unroll
            for (int tp = 0; tp < 4; ++tp) { const v4u x = *(const LAS v4u*)(XR + (rb + tp) * 128 + ch0 * 2);
                u0 += w[tp][0] * (f32x4){bflo(x.x), bfhi(x.x), bflo(x.y), bfhi(x.y)}; u1 += w[tp][1] * (f32x4){bflo(x.z), bfhi(x.z), bflo(x.w), bfhi(x.w)}; }
            v4u f; f.x = pk2(u0[0], u0[1]); f.y = pk2(u0[2], u0[3]); f.z = pk2(u1[0], u1[1]); f.w = pk2(u1[2], u1[3]);
            fa[m][ks] = __builtin_bit_cast(bf16x8, f);
        }
    }
    float hloc[4][8], pc[4][8], P8[4], H8[4];
    const int T0 = 32 * wave + 8 * fq, rb0 = (T0 >> 4) * 19 + (T0 & 15);
#pragma unroll
    for (int nb = 0; nb < 4; ++nb) {
        const int ch = 16 * nb + i16, gch = n * 64 + ch;
        f32x4 aR[2] = {{0.f, 0.f, 0.f, 0.f}, {0.f, 0.f, 0.f, 0.f}}, aI[2] = {{0.f, 0.f, 0.f, 0.f}, {0.f, 0.f, 0.f, 0.f}};
#pragma unroll
        for (int ks = 0; ks < 2; ++ks) {
            const bf16x8 bR = *(const bf16x8*)(Wg_t + (size_t)(n * 64 + ch) * 64 + 8 * fq + 32 * ks);
            const bf16x8 bI = *(const bf16x8*)(Wg_t + (size_t)((16 + n) * 64 + ch) * 64 + 8 * fq + 32 * ks);
#pragma unroll
            for (int m = 0; m < 2; ++m) { aR[m] = __builtin_amdgcn_mfma_f32_16x16x32_bf16(fa[m][ks], bR, aR[m], 0, 0, 0); aI[m] = __builtin_amdgcn_mfma_f32_16x16x32_bf16(fa[m][ks], bI, aI[m], 0, 0, 0); }
        }
        float x[11];
#pragma unroll
        for (int r = 0; r < 11; ++r) x[r] = __builtin_bit_cast(float, (unsigned)(*(const LAS unsigned short*)(XR + (rb0 + r) * 128 + ch * 2)) << 16);
        const float c0 = cwl[gch], c1 = cwl[DM + gch], c2 = cwl[2 * DM + gch], c3 = cwl[3 * DM + gch], cbv = cbl[gch];
        const float bra = p.in[I_BRA][gch], bix = p.in[I_BIX][gch], lam = p.in[I_LAM][gch];
        const float zz = -lam, sp = fmaxf(zz, 0.f) + log1pf(expf(-fabsf(zz))), c8 = -8.0f * sp;
        float hl = 0.f, P = 1.f;
#pragma unroll
        for (int q = 0; q < 8; ++q) {
            const float u = cbv + c0 * x[q] + c1 * x[q + 1] + c2 * x[q + 2] + c3 * x[q + 3];
            const float r = sigmoidf_fast(aR[q >> 2][q & 3] + bra), ig = sigmoidf_fast(aI[q >> 2][q & 3] + bix);
            const float la = r * c8, a = __builtin_amdgcn_exp2f(la * 1.4426950408889634f);
            const float x2 = 2.0f * la, em_small = -x2 * (1.0f + x2 * (0.5f + x2 * (0.16666667f + x2 * 0.041666668f))), em = (x2 > -0.05f) ? em_small : (1.0f - a * a);
            const float b = sqrtf(em) * ig * u;
            hl = a * hl + b; P = P * a;
            hloc[nb][q] = hl; pc[nb][q] = P;
        }
        P8[nb] = P; H8[nb] = hl;
    }
    float Pf[4][4], Hf[4][4];
#pragma unroll
    for (int nb = 0; nb < 4; ++nb)
#pragma unroll
        for (int f = 0; f < 4; ++f) { Pf[nb][f] = __shfl(P8[nb], i16 + 16 * f); Hf[nb][f] = __shfl(H8[nb], i16 + 16 * f); }
    if (!samp) {
        if (fq == 0) {
#pragma unroll
            for (int nb = 0; nb < 4; ++nb) { float hw = 0.f, pw = 1.f;
#pragma unroll
                for (int f = 0; f < 4; ++f) { hw = Hf[nb][f] + Pf[nb][f] * hw; pw *= Pf[nb][f]; }
                SEG[wave * 64 + 16 * nb + i16] = (f32x2v){pw, hw}; }
        }
        __syncthreads();
        if (!FINAL) {
            if (tid < 64) { float hu = 0.f, pu = 1.f;
#pragma unroll
                for (int w = 0; w < 8; ++w) { const f32x2v s = SEG[w * 64 + tid]; hu = s.y + s.x * hu; pu *= s.x; }
                SUMM[(size_t)pm * DM + n * 64 + tid] = (f32x2v){pu, hu}; }
            return;
        }
    }
#pragma unroll
    for (int nb = 0; nb < 4; ++nb) {
        const int ch = 16 * nb + i16, gch = n * 64 + ch;
        float c;
        if (!samp) {
            c = CIN[ch];
#pragma unroll
            for (int w = 0; w < 8; ++w) { const f32x2v s = SEG[w * 64 + ch]; if (w < wave) c = s.y + s.x * c; }
#pragma unroll
            for (int f = 0; f < 4; ++f) if (f < fq) c = Hf[nb][f] + Pf[nb][f] * c;
        } else {
            const int sq = 2 * wave + (fq >> 1);
            c = p.in[I_STH][(size_t)sq * DM + gch];
            if (fq & 1) { const float pp = (fq == 1) ? Pf[nb][0] : Pf[nb][2], hh = (fq == 1) ? Hf[nb][0] : Hf[nb][2]; c = hh + pp * c; }
        }
        bf16* hp = HP + (size_t)(pm * 256 + T0) * 2048 + gch; float hlast = 0.f;
#pragma unroll
        for (int q = 0; q < 8; ++q) { const float h = hloc[nb][q] + pc[nb][q] * c; hp[(size_t)q * 2048] = (bf16)f2bf(h); hlast = h; }
        if (!samp) { if ((pm & 15) == 15 && wave == 7 && fq == 3) p.out[OFF_HP + (size_t)(pm >> 4) * DM + gch] = hlast; }
        else if (fq & 1) p.out[OFF_HS + (size_t)(2 * wave + (fq >> 1)) * DM + gch] = hlast;
    }
}

constexpr int XL_BYTES = 33280, XL_SEG = 2 * XL_BYTES, XL_CW = XL_SEG + 4096;
__device__ __forceinline__ void lru_task(const KP& p, LAS unsigned char* lds, int s, int n, int hf, int tid, int lane, int wave) {
    const bf16* ZR = (const bf16*)(p.ws + WS_R1); const bf16* Wg_t = (const bf16*)(p.ws + WS_WG); bf16* HP = (bf16*)(p.ws + WS_R3);
    typedef float f32x2v __attribute__((ext_vector_type(2)));
    LAS f32x2v* SEG = (LAS f32x2v*)(lds + XL_SEG); LAS float* CW = (LAS float*)(lds + XL_CW);
    const int i16 = lane & 15, fq = lane >> 4;
    const float* cwl = p.in[I_CLW]; const float* cbl = p.in[I_CLB];
    const size_t rowbase = (size_t)s * SEQ;
    __syncthreads();
    if (tid < 320) { const int tp = tid >> 6, c = tid & 63; CW[tid] = tp < 4 ? cwl[tp * DM + n * 64 + c] : cbl[n * 64 + c]; }
    for (int idx = tid; idx < 259 * 8; idx += NWAVES * 64) { const int row = idx >> 3, ck = idx & 7; v4u v = {0u, 0u, 0u, 0u};
        if (row >= 3) v = *(const v4u*)(ZR + (rowbase + row - 3) * 2048 + n * 64 + ck * 8);
        *(LAS v4u*)(lds + row * 128 + ck * 16) = v; }
    bf16x8 bR[2][2], bI[2][2]; float c0[2], c1[2], c2[2], c3[2], cbv[2], bra[2], bix[2], c8[2], cin[2];
#pragma unroll
    for (int b2 = 0; b2 < 2; ++b2) { const int ch = 16 * (2 * hf + b2) + i16, gch = n * 64 + ch;
#pragma unroll
        for (int ks = 0; ks < 2; ++ks) { bR[b2][ks] = *(const bf16x8*)(Wg_t + (size_t)(n * 64 + ch) * 64 + 8 * fq + 32 * ks); bI[b2][ks] = *(const bf16x8*)(Wg_t + (size_t)((16 + n) * 64 + ch) * 64 + 8 * fq + 32 * ks); }
        c0[b2] = cwl[gch]; c1[b2] = cwl[DM + gch]; c2[b2] = cwl[2 * DM + gch]; c3[b2] = cwl[3 * DM + gch]; cbv[b2] = cbl[gch];
        bra[b2] = p.in[I_BRA][gch]; bix[b2] = p.in[I_BIX][gch];
        const float zz = -p.in[I_LAM][gch]; c8[b2] = -8.0f * (fmaxf(zz, 0.f) + log1pf(expf(-fabsf(zz)))) * 1.4426950408889634f;
        cin[b2] = 0.f; }
    __syncthreads();
    for (int tt = 0; tt < 16; ++tt) {
        LAS unsigned char* XR = lds + (tt & 1) * XL_BYTES; LAS unsigned char* XN_ = lds + ((tt + 1) & 1) * XL_BYTES;
        v4u pf[5];
        if (tt < 15) {
#pragma unroll
            for (int k = 0; k < 5; ++k) { const int idx = tid + k * (NWAVES * 64); if (idx < 259 * 8) pf[k] = *(const v4u*)(ZR + (rowbase + 256 * (tt + 1) - 3 + (idx >> 3)) * 2048 + n * 64 + (idx & 7) * 8); } }
        bf16x8 fa[2][2];
#pragma unroll
        for (int ks = 0; ks < 2; ++ks) { const int ch0 = 32 * ks + 8 * fq; f32x4 w[4][2], bb[2];
#pragma unroll
            for (int tp = 0; tp < 4; ++tp) { w[tp][0] = *(const LAS f32x4*)(CW + tp * 64 + ch0); w[tp][1] = *(const LAS f32x4*)(CW + tp * 64 + ch0 + 4); }
            bb[0] = *(const LAS f32x4*)(CW + 256 + ch0); bb[1] = *(const LAS f32x4*)(CW + 256 + ch0 + 4);
#pragma unroll
            for (int m = 0; m < 2; ++m) { const int rb = 32 * wave + 8 * (i16 >> 2) + 4 * m + (i16 & 3); f32x4 u0 = bb[0], u1 = bb[1];
#pragma unroll
                for (int tp = 0; tp < 4; ++tp) { const v4u x = *(const LAS v4u*)(XR + (rb + tp) * 128 + ch0 * 2);
                    u0 += w[tp][0] * (f32x4){bflo(x.x), bfhi(x.x), bflo(x.y), bfhi(x.y)}; u1 += w[tp][1] * (f32x4){bflo(x.z), bfhi(x.z), bflo(x.w), bfhi(x.w)}; }
                v4u f; f.x = pg8::cvt_pk_bf16(u0[0], u0[1]); f.y = pg8::cvt_pk_bf16(u0[2], u0[3]); f.z = pg8::cvt_pk_bf16(u1[0], u1[1]); f.w = pg8::cvt_pk_bf16(u1[2], u1[3]);
                fa[m][ks] = __builtin_bit_cast(bf16x8, f); } }
        float hloc[2][8], pc[2][8], P8[2], H8[2];
        const int rb0 = 32 * wave + 8 * fq;
#pragma unroll
        for (int b2 = 0; b2 < 2; ++b2) { const int ch = 16 * (2 * hf + b2) + i16;
            f32x4 aR[2] = {{0.f, 0.f, 0.f, 0.f}, {0.f, 0.f, 0.f, 0.f}}, aI[2] = {{0.f, 0.f, 0.f, 0.f}, {0.f, 0.f, 0.f, 0.f}};
#pragma unroll
            for (int ks = 0; ks < 2; ++ks)
#pragma unroll
                for (int m = 0; m < 2; ++m) { aR[m] = __builtin_amdgcn_mfma_f32_16x16x32_bf16(fa[m][ks], bR[b2][ks], aR[m], 0, 0, 0); aI[m] = __builtin_amdgcn_mfma_f32_16x16x32_bf16(fa[m][ks], bI[b2][ks], aI[m], 0, 0, 0); }
            float x[11];
#pragma unroll
            for (int r = 0; r < 11; ++r) x[r] = __builtin_bit_cast(float, (unsigned)(*(const LAS unsigned short*)(XR + (rb0 + r) * 128 + ch * 2)) << 16);
            float hl = 0.f, P = 1.f;
#pragma unroll
            for (int q = 0; q < 8; ++q) {
                const float u = cbv[b2] + c0[b2] * x[q] + c1[b2] * x[q + 1] + c2[b2] * x[q + 2] + c3[b2] * x[q + 3];
                const float r = sigmoidf_fast(aR[q >> 2][q & 3] + bra[b2]), ig = sigmoidf_fast(aI[q >> 2][q & 3] + bix[b2]);
                const float a = __builtin_amdgcn_exp2f(r * c8[b2]);
                const float b = __builtin_amdgcn_sqrtf(fmaxf(__builtin_fmaf(-a, a, 1.0f), 0.f)) * ig * u;
                hl = __builtin_fmaf(a, hl, b); P = P * a; hloc[b2][q] = hl; pc[b2][q] = P; }
            P8[b2] = P; H8[b2] = hl; }
        float Pf[2][4], Hf[2][4];
#pragma unroll
        for (int b2 = 0; b2 < 2; ++b2)
#pragma unroll
            for (int f = 0; f < 4; ++f) { Pf[b2][f] = __shfl(P8[b2], i16 + 16 * f); Hf[b2][f] = __shfl(H8[b2], i16 + 16 * f); }
        if (fq == 0) {
#pragma unroll
            for (int b2 = 0; b2 < 2; ++b2) { float hw = 0.f, pw = 1.f;
#pragma unroll
                for (int f = 0; f < 4; ++f) { hw = __builtin_fmaf(Pf[b2][f], hw, Hf[b2][f]); pw *= Pf[b2][f]; }
                SEG[(tt & 1) * 256 + wave * 32 + 16 * b2 + i16] = (f32x2v){pw, hw}; } }
        if (tt < 15) {
#pragma unroll
            for (int k = 0; k < 5; ++k) { const int idx = tid + k * (NWAVES * 64); if (idx < 259 * 8) *(LAS v4u*)(XN_ + (idx >> 3) * 128 + (idx & 7) * 16) = pf[k]; } }
        LDS_WAIT(); __syncthreads();
#pragma unroll
        for (int b2 = 0; b2 < 2; ++b2) { const int ch = 16 * (2 * hf + b2) + i16, gch = n * 64 + ch;
            float c = cin[b2], call = cin[b2];
#pragma unroll
            for (int w = 0; w < 8; ++w) { const f32x2v sg = SEG[(tt & 1) * 256 + w * 32 + 16 * b2 + i16]; call = __builtin_fmaf(sg.x, call, sg.y); if (w < wave) c = __builtin_fmaf(sg.x, c, sg.y); }
            cin[b2] = call;
#pragma unroll
            for (int f = 0; f < 4; ++f) if (f < fq) c = __builtin_fmaf(Pf[b2][f], c, Hf[b2][f]);
            bf16* hp = HP + (rowbase + 256 * tt + rb0) * 2048 + gch; float hlast = 0.f;
#pragma unroll
            for (int q = 0; q < 8; ++q) { const float h = __builtin_fmaf(pc[b2][q], c, hloc[b2][q]); hp[(size_t)q * 2048] = (bf16)f2bf(h); hlast = h; }
            if (tt == 15 && wave == 7 && fq == 3) p.out[OFF_HP + (size_t)s * DM + gch] = hlast; }
    }
}

__device__ __forceinline__ void pool_load8(const KP& p, const bf16* ZR, int pm, int tt, int run, int ch, float (&v)[8]) {
    const bool samp = (pm == STILE);
    if (!samp) {
        if (256 * (pm & 15) + tt < 0) {
#pragma unroll
            for (int e = 0; e < 8; ++e) v[e] = 0.f;
            return; }
        const v4u w = *(const v4u*)(ZR + (size_t)(pm * 256 + tt) * 2048 + 1024 + ch);
        v[0] = bflo(w.x); v[1] = bfhi(w.x); v[2] = bflo(w.y); v[3] = bfhi(w.y); v[4] = bflo(w.z); v[5] = bfhi(w.z); v[6] = bflo(w.w); v[7] = bfhi(w.w);
    } else {
        const int tl = tt - 16 * run;
        if (tl < 0) { const float* s = p.in[I_STPOOL] + (size_t)(run * 15 + 15 + tl) * DM + ch; const f32x4 a = *(const f32x4*)s, b = *(const f32x4*)(s + 4);
            v[0] = a[0]; v[1] = a[1]; v[2] = a[2]; v[3] = a[3]; v[4] = b[0]; v[5] = b[1]; v[6] = b[2]; v[7] = b[3]; }
        else { const v4u w = *(const v4u*)(ZR + (size_t)(MP + tt) * 2048 + 1024 + ch);
            v[0] = bflo(w.x); v[1] = bfhi(w.x); v[2] = bflo(w.y); v[3] = bfhi(w.y); v[4] = bflo(w.z); v[5] = bfhi(w.z); v[6] = bflo(w.w); v[7] = bfhi(w.w); }
    }
}
__device__ __forceinline__ void pool_unit(const KP& p, int pm, int g, int tid) {
    const bf16* ZR = (const bf16*)(p.ws + WS_R1); bf16* HP = (bf16*)(p.ws + WS_R3);
    const bool samp = (pm == STILE);
    const int oct = tid & 31, run = tid >> 5, ch = 256 * g + 8 * oct, w = 2 << g, tf = 16 * run;
    const int pos0 = samp ? PAST : 256 * (pm & 15) + tf;
    float s[8];
#pragma unroll
    for (int e = 0; e < 8; ++e) s[e] = 0.f;
    for (int k = 1; k < w; ++k) { float v[8]; pool_load8(p, ZR, pm, tf - k, run, ch, v);
#pragma unroll
        for (int e = 0; e < 8; ++e) s[e] += v[e]; }
    for (int i = 0; i < 16; ++i) {
        float v[8], o[8]; pool_load8(p, ZR, pm, tf + i, run, ch, v);
        const int cnt = min(pos0 + i + 1, w); const float inv = 1.0f / (float)cnt;
#pragma unroll
        for (int e = 0; e < 8; ++e) { s[e] += v[e]; o[e] = s[e] * inv - v[e]; }
        v4u ow; ow.x = pk2(o[0], o[1]); ow.y = pk2(o[2], o[3]); ow.z = pk2(o[4], o[5]); ow.w = pk2(o[6], o[7]);
        *(v4u*)(HP + (size_t)(pm * 256 + tf + i) * 2048 + 1024 + ch) = ow;
        float vo[8]; pool_load8(p, ZR, pm, tf + i - w + 1, run, ch, vo);
#pragma unroll
        for (int e = 0; e < 8; ++e) s[e] -= vo[e];
    }
}
__device__ __forceinline__ void state_copy(const KP& p, int gtid, int gthreads) {
    const bf16* ZR = (const bf16*)(p.ws + WS_R1);
    constexpr int N1 = NBATCH * 3 * DM, N2 = NBATCH * 15 * DM, N3 = SBATCH * 3 * DM, N4 = SBATCH * 15 * DM;
    for (int i = gtid; i < N1 + N2 + N3 + N4; i += gthreads) {
        int r = i; size_t row, col; float* dst;
        if (r < N1) { const int b = r / (3 * DM), k = (r / DM) % 3, c = r % DM; row = (size_t)b * SEQ + SEQ - 3 + k; col = c; dst = p.out + OFF_LCP + r; }
        else if ((r -= N1) < N2) { const int b = r / (15 * DM), k = (r / DM) % 15, c = r % DM; row = (size_t)b * SEQ + SEQ - 15 + k; col = 1024 + c; dst = p.out + OFF_PLP + r; }
        else if ((r -= N2) < N3) { const int b = r / (3 * DM), k = (r / DM) % 3, c = r % DM; row = (size_t)MP + b * SSEQ + SSEQ - 3 + k; col = c; dst = p.out + OFF_LCS + r; }
        else { r -= N3; const int b = r / (15 * DM), k = (r / DM) % 15, c = r % DM; row = (size_t)MP + b * SSEQ + SSEQ - 15 + k; col = 1024 + c; dst = p.out + OFF_PLS + r; }
        *dst = __builtin_bit_cast(float, (unsigned)ZR[row * 2048 + col] << 16);
    }
}

__device__ __forceinline__ void strip_pre(const KP& p, LAS unsigned char* lds, int pm0, int pn, int cnt, int tid, int lane, int wave) {
    const float* SSQ = (const float*)(p.ws + WS_SSQ); const bf16* XG2 = (const bf16*)(p.ws + WS_R1); const bf16* Wup_t = (const bf16*)(p.ws + WS_WUP);
    LAS float* RS = (LAS float*)(lds + RS_OFF); LAS float* ES = (LAS float*)(lds + EDGE_START_OFF);
    __syncthreads();
    for (int i = tid; i < cnt * 256; i += NWAVES * 64) RS[i] = row_rs(SSQ, (size_t)pm0 * 256 + i);
    if (pm0 != STILE && (pm0 & 15) != 0) {
        float xa[2][16], rsh[2];
#pragma unroll
        for (int r = 0; r < 2; ++r) { const size_t row = (size_t)pm0 * 256 - 2 + r;
            const v4u w0 = *(const v4u*)(XG2 + row * DM + 16 * lane), w1 = *(const v4u*)(XG2 + row * DM + 16 * lane + 8);
            xa[r][0] = bflo(w0.x); xa[r][1] = bfhi(w0.x); xa[r][2] = bflo(w0.y); xa[r][3] = bfhi(w0.y); xa[r][4] = bflo(w0.z); xa[r][5] = bfhi(w0.z); xa[r][6] = bflo(w0.w); xa[r][7] = bfhi(w0.w);
            xa[r][8] = bflo(w1.x); xa[r][9] = bfhi(w1.x); xa[r][10] = bflo(w1.y); xa[r][11] = bfhi(w1.y); xa[r][12] = bflo(w1.z); xa[r][13] = bfhi(w1.z); xa[r][14] = bflo(w1.w); xa[r][15] = bfhi(w1.w);
            rsh[r] = row_rs(SSQ, row); }
        for (int c = 0; c < 32; ++c) { const int tc = 32 * wave + c; const bf16* wr_ = Wup_t + (size_t)(256 * pn + tc) * DM + 16 * lane;
            const v4u w0 = *(const v4u*)wr_, w1 = *(const v4u*)(wr_ + 8);
            const float wv[16] = {bflo(w0.x), bfhi(w0.x), bflo(w0.y), bfhi(w0.y), bflo(w0.z), bfhi(w0.z), bflo(w0.w), bfhi(w0.w), bflo(w1.x), bfhi(w1.x), bflo(w1.y), bfhi(w1.y), bflo(w1.z), bfhi(w1.z), bflo(w1.w), bfhi(w1.w)};
            float p0 = 0.f, p1 = 0.f;
#pragma unroll
            for (int e = 0; e < 16; ++e) { p0 += xa[0][e] * wv[e]; p1 += xa[1][e] * wv[e]; }
            p0 = wave_sum(p0); p1 = wave_sum(p1);
            if (lane == 0) { ES[tc] = p0 * rsh[0]; ES[256 + tc] = p1 * rsh[1]; } }
    } else { ES[tid] = 0.f; }
    __syncthreads();
}

__device__ __forceinline__ void final_norm(const KP& p, int gw, int NGW, int lane) {
    const float* SSQ2 = (const float*)(p.ws + WS_SSQ2); const float* gf = p.in[I_NFIN];
    f32x4 gv[4];
#pragma unroll
    for (int j = 0; j < 4; ++j) gv[j] = *((const f32x4*)gf + lane + 64 * j);
    for (int m = gw; m < M; m += NGW) {
        const float sv = (lane < 32) ? SSQ2[(size_t)m * 32 + lane] : 0.f;
        const float rstd = 1.0f / sqrtf(wave_sum(sv) * (1.f / DM) + EPS);
        f32x4* yr = (f32x4*)(p.out + OFF_Y + (size_t)m * DM) + lane;
#pragma unroll
        for (int j = 0; j < 4; ++j) { const f32x4 v = yr[64 * j]; yr[64 * j] = v * rstd * gv[j]; }
    }
}
#ifndef MK_ONE_LAUNCH
#define MK_ONE_LAUNCH 1
#endif
#ifndef PG8_SP2
#define PG8_SP2 true
#endif
#ifndef PG8_ALIGN
#define PG8_ALIGN true
#endif
#ifndef FUSE_FINAL
#define FUSE_FINAL 1
#endif
constexpr int N_PHASES = 10;
__global__ void __launch_bounds__(NWAVES * 64, 2) mk_fwd(KP p) {
    extern __shared__ __attribute__((aligned(16))) unsigned char lds_raw[];
    LAS unsigned char* lds = (LAS unsigned char*)lds_raw;
    const int tid = threadIdx.x, lane = tid & 63, wave = __builtin_amdgcn_readfirstlane(tid >> 6);
    const int G = gridDim.x, bx = blockIdx.x, vcu = (G % 8 == 0) ? (bx % 8) * (G / 8) + bx / 8 : bx;
    volatile LAS unsigned* MISC = (volatile LAS unsigned*)(lds + MISC_OFF);
    if (tid < 32) MISC[tid] = 0u;
    __syncthreads();
    unsigned* ctl = (unsigned*)(p.ws + WS_CTL);
    const int lo = p.ph_lo, hi = p.ph_hi;
    XcdBarrier bar; bar.bar = ctl + CW_BAR; bar.x = 0; bar.st = MISC + 8;
    if (hi - lo > 1) bar = xcd_barrier_post(ctl + CW_BAR, MISC + 8);
#ifndef PH_MASK
#define PH_MASK 0x3ff
#endif
#define IN(k) (((PH_MASK >> (k)) & 1) && lo <= (k) && (k) < hi)
#ifndef REP_MASK
#define REP_MASK 0
#endif
#define PH(k) if (IN(k)) for (int rep_ = 0; rep_ <= ((REP_MASK >> (k)) & 1); ++rep_)
#define REPBAR() do { if (rep_) xcd_barrier(bar); } while (0)
#define SEAM(k) do { if (IN(k) && IN((k) + 1)) xcd_barrier(bar); } while (0)
    unsigned char* ws = p.ws;
    bf16* XN = (bf16*)(ws + WS_R0); bf16* MG = (bf16*)(ws + WS_R0); bf16* ZR = (bf16*)(ws + WS_R1); bf16* XG2 = (bf16*)(ws + WS_R1);
    bf16* GT = (bf16*)(ws + WS_R2); bf16* HP = (bf16*)(ws + WS_R3); bf16* ACT = (bf16*)(ws + WS_R2);
    bf16* Win_t = (bf16*)(ws + WS_WIN); bf16* Wcat_t = (bf16*)(ws + WS_WCAT); bf16* Wout_t = (bf16*)(ws + WS_WOUT); bf16* Wup_t = (bf16*)(ws + WS_WUP); bf16* Wdn_t = (bf16*)(ws + WS_WDN);
    float* SSQ = (float*)(ws + WS_SSQ); float* SSQ2 = (float*)(ws + WS_SSQ2);
    float* Y = p.out + OFF_Y;

    PH(0) { REPBAR(); p0_prologue(p, lds, vcu, G, wave, lane); }
    SEAM(0);
    PH(1) { REPBAR();
        pg8::Gemm g{XN, Win_t, DM, DM, DM}; pg8::StaticOrder S; S.init(MP, DIN, G, bx);
        EpiZ E{ZR, GT};
        for (int su = bx; su < 64; su += G) pg8::sub_gemm<1>(lds, g, STILE, su >> 2, (su >> 1) & 1, su & 1, E);
        pg8::gemm_phase<EpiZ, pg8::StaticOrder, PG8_ALIGN, PG8_SP2>(lds, g, S, E);
        if (G > 64) { if (bx >= 64) p1_weights(p, lds, (bx - 64) * NWAVES + wave, (G - 64) * NWAVES, wave, lane); } else p1_weights(p, lds, bx * NWAVES + wave, G * NWAVES, wave, lane);
    }
    SEAM(1);
    PH(2) { REPBAR();
        state_copy(p, bx * NWAVES * 64 + tid, G * NWAVES * 64);
        for (int su = bx; su < 64; su += G) {
            const int g_ = su >> 4, q = su & 15; pg8::Gemm gw_{(const bf16*)(ws + WS_WBP) + 256 * g_, (const bf16*)(ws + WS_WPOOL) + (size_t)g_ * 65536, 256, DM, 256};
            EpiW EW{Wcat_t + 1024 + 256 * g_}; pg8::sub_gemm<1>(lds, gw_, q >> 2, 0, (q >> 1) & 1, q & 1, EW); }
        for (int t = bx; t < NBATCH * 32; t += G) lru_task(p, lds, t >> 5, (t >> 1) & 15, t & 1, tid, lane, wave);
        for (int L = bx; L < 16 + NTILE * 4; L += G) {
            if (L < 16) lru_unit<true>(p, lds, STILE, L, tid, lane, wave);
            else { const int r = L - 16; pool_unit(p, r >> 2, r & 3, tid); }
        }
    }
    if (IN(2) && IN(4)) xcd_barrier(bar);
    PH(4) { REPBAR();
        pg8::Gemm g{HP, Wcat_t, 2048, 2048, 2048}; pg8::StaticOrder S; S.init(MP, DM, G, bx);
        EpiBr E{GT, MG};
        pg8::gemm_phase<EpiBr, pg8::StaticOrder, PG8_ALIGN, PG8_SP2>(lds, g, S, E);
        for (int su = bx; su < 16; su += G) pg8::sub_gemm<1>(lds, g, STILE, su >> 2, (su >> 1) & 1, su & 1, E);
    }
    if (IN(4) && IN(6)) xcd_barrier(bar);
    PH(6) { REPBAR();
        pg8::Gemm g{MG, Wout_t, DM, DM, DM}; pg8::StaticOrder S; S.init(MP, DM, G, bx);
        EpiRes<false> E{p.in[I_XP], p.in[I_XS], Y, XG2, SSQ};
        pg8::gemm_phase<EpiRes<false>, pg8::StaticOrder, PG8_ALIGN, PG8_SP2>(lds, g, S, E);
        for (int su = bx; su < 16; su += G) pg8::sub_gemm<1>(lds, g, STILE, su >> 2, (su >> 1) & 1, su & 1, E);
    }
    SEAM(6);
    PH(7) { REPBAR();
        pg8::Gemm g{XG2, Wup_t, DM, DM, DM};
        { EpiUpS ES{ACT, p.in[I_CFW], p.in[I_CFB], p.in[I_STFFN], p.out + OFF_FCS, SSQ};
          for (int su = bx; su < 48; su += G) pg8::sub_gemm<2>(lds, g, STILE, su >> 1, su & 1, 0, ES); }
        for (int sidx = vcu; sidx < 768; sidx += G) {
            const int rg = sidx >> 8, v = sidx & 255, x = v >> 5, w = v & 31, pm0 = 4 * (4 * x + (w >> 3)), pn = 8 * rg + (w & 7);
            strip_pre(p, lds, pm0, pn, 4, tid, lane, wave);
            pg8::StripOrder S{pm0, pn, 4};
            EpiUp E{ACT, p.in[I_CFW], p.in[I_CFB], p.in[I_STFFN], p.out + OFF_FCP, p.out + OFF_FCS, lds, pm0};
            pg8::gemm_phase<EpiUp, pg8::StripOrder, false, PG8_SP2>(lds, g, S, E);
        }
    }
    SEAM(7);
    const bool fuse_final = (G == 256) && FUSE_FINAL;
    PH(8) { REPBAR();
        pg8::Gemm g{ACT, Wdn_t, DFF, DFF, DFF}; pg8::StaticOrder S; S.init(MP, DM, G, bx);
        if (fuse_final) {
            EpiFinal E{Y, XG2, p.in[I_NFIN], SSQ2, ctl + CW_PANEL, ctl + CW_BAR + XB_TMO, lds};
            pg8::gemm_phase<EpiFinal, pg8::StaticOrder, true  , PG8_SP2>(lds, g, S, E);
            for (int su = bx; su < 16; su += G) pg8::sub_gemm<1>(lds, g, STILE, su >> 2, (su >> 1) & 1, su & 1, E);
        } else {
            EpiRes<true> E{nullptr, nullptr, Y, XG2, SSQ2};
            pg8::gemm_phase<EpiRes<true>, pg8::StaticOrder, PG8_ALIGN, PG8_SP2>(lds, g, S, E);
            for (int su = bx; su < 16; su += G) pg8::sub_gemm<1>(lds, g, STILE, su >> 2, (su >> 1) & 1, su & 1, E);
        }
    }
    if (!fuse_final) { SEAM(8);
        PH(9) { REPBAR(); final_norm(p, vcu * NWAVES + wave, G * NWAVES, lane); } }
#undef IN
#undef SEAM
}

extern "C" void kernel_launch(void* const* d_in, const int* in_sizes, int n_in, void* d_out, int out_size, void* d_ws, size_t ws_size, hipStream_t stream) {
    static int grid = 0;
    if (grid == 0) {
        if (n_in != 26 || in_sizes[0] != MP * DM || (size_t)out_size != OUT_TOTAL || ws_size < WS_END) {
            fprintf(stderr, "kernel_launch: unexpected shapes: n_in %d in0 %d out %d ws %zu (need %zu)\n", n_in, n_in > 0 ? in_sizes[0] : -1, out_size, ws_size, (size_t)WS_END); grid = -1; return; }
        int dev = 0, cus = 0, per_cu = 0;
        if (hipGetDevice(&dev) != hipSuccess || hipDeviceGetAttribute(&cus, hipDeviceAttributeMultiprocessorCount, dev) != hipSuccess) { fprintf(stderr, "kernel_launch: device query failed\n"); grid = -1; return; }
        if (hipFuncSetAttribute((const void*)mk_fwd, hipFuncAttributeMaxDynamicSharedMemorySize, LDS_BYTES) != hipSuccess) { fprintf(stderr, "kernel_launch: hipFuncSetAttribute failed\n"); grid = -1; return; }
        if (hipOccupancyMaxActiveBlocksPerMultiprocessor(&per_cu, (const void*)mk_fwd, NWAVES * 64, LDS_BYTES) != hipSuccess || per_cu < 1) {
            fprintf(stderr, "kernel_launch: occupancy query reports %d blocks per CU\n", per_cu); (void)hipGetLastError(); per_cu = 1; }
        grid = cus;
        fprintf(stderr, "kernel_launch: grid %d (cus %d, occupancy %d/CU)\n", grid, cus, per_cu);
    }
    if (grid < 0) return;
    if (hipMemsetAsync((char*)d_ws + WS_CTL, 0, CTL_ZERO_BYTES, stream) != hipSuccess) { fprintf(stderr, "kernel_launch: memset failed\n"); return; }
    KP a{};
    for (int i = 0; i < 26; ++i) a.in[i] = (const float*)d_in[i];
    a.out = (float*)d_out; a.ws = (unsigned char*)d_ws;
#if MK_ONE_LAUNCH
    a.ph_lo = 0; a.ph_hi = N_PHASES;
    hipLaunchKernelGGL(mk_fwd, dim3(grid), dim3(NWAVES * 64), LDS_BYTES, stream, a);
#else
#ifndef PROBE_PHASE
#define PROBE_PHASE -1
#endif
    { const int phs[7] = {0, 1, 2, 4, 6, 7, 8};
      for (int i = 0; i < 7; ++i) { const int k = phs[i]; a.ph_lo = k; a.ph_hi = k + 1;
          for (int rep = 0; rep < (k == PROBE_PHASE ? 2 : 1); ++rep) hipLaunchKernelGGL(mk_fwd, dim3(grid), dim3(NWAVES * 64), LDS_BYTES, stream, a); } }
#endif
    const hipError_t le = hipPeekAtLastError();
    if (le != hipSuccess) fprintf(stderr, "kernel_launch: launch failed: %s\n", hipGetErrorName(le));
}
```

```cpp
#include <hip/hip_runtime.h>
#include <cstdio>
#include <cstdint>
#define MK_ONE_LAUNCH 1
namespace pg8 {
#define PG8_LAS __attribute__((address_space(3)))
typedef unsigned short bf16_t;
typedef short bf16x8 __attribute__((ext_vector_type(8)));
typedef float f32x4 __attribute__((ext_vector_type(4)));
typedef unsigned u32x4 __attribute__((ext_vector_type(4)));
typedef unsigned u32x2 __attribute__((ext_vector_type(2)));
constexpr int BM = 256, BK = 64, HALF = 128, HTB = HALF * BK * 2  , STAGE_BYTES = 8 * HTB, NXCD = 8, WGM = 8;

__host__ __device__ __forceinline__ int lds_byte(int r, int c) { const int st = (r >> 4) * 2 + (c >> 5), rr = r & 15, cc = c & 31, ob = rr * 64 + cc * 2; return st * 1024 + (ob ^ (((ob >> 9) & 1) << 5)); }
__host__ __device__ __forceinline__ void stage_rc(int b, int& R, int& C) { const int st = b / 1024, sb = b % 1024, swz = sb ^ (((sb >> 9) & 1) << 5); R = (st >> 1) * 16 + swz / 64; C = (st & 1) * 32 + (swz % 64) / 2; }
__host__ __device__ __forceinline__ int perm32(int rho) { const int n = rho >> 4, i = rho & 15; return 8 * (i >> 2) + 4 * n + (i & 3); }
__host__ __device__ __forceinline__ int amap_row(int R) { return 128 * (R >> 6) + 8 * (R & 15) + ((R >> 4) & 3); }

struct Unit { int pm, pn; };
struct Gemm { const bf16_t* A; const bf16_t* Bt; int K, lda, ldb; };

struct StaticOrder {
    int nM, nN, nwg, G, c;
    __host__ __device__ void init(int M, int N, int G_, int c_) { nM = M / BM; nN = N / BM; nwg = nM * nN; G = G_; c = c_; }
    __host__ __device__ bool next(int i, Unit& u) const {
        const long L = (long)i * G + c; if (L >= nwg) return false;
        int wgid = (int)L; { const int q = nwg / NXCD, r = nwg % NXCD, xcd = wgid % NXCD, off = wgid / NXCD; wgid = (xcd < r ? xcd * (q + 1) : r * (q + 1) + (xcd - r) * q) + off; }
        const int nig = WGM * nN, gid = wgid / nig, fm = gid * WGM, gsz = (nM - fm) < WGM ? (nM - fm) : WGM;
        u.pm = fm + ((wgid % nig) % gsz); u.pn = (wgid % nig) / gsz; return true;
    }
    __device__ __forceinline__ void a_ready(const Unit&) const {}
    __device__ __forceinline__ void done(const Unit&) const {}
};
struct StripOrder {
    int pm0, pn, cnt;
    __device__ __forceinline__ bool next(int i, Unit& u) const { if (i >= cnt) return false; u.pm = pm0 + i; u.pn = pn; return true; }
    __device__ __forceinline__ void a_ready(const Unit&) const {}
    __device__ __forceinline__ void done(const Unit&) const {}
};

__device__ __forceinline__ unsigned cvt_pk_bf16(float lo, float hi) { unsigned r; asm volatile("v_cvt_pk_bf16_f32 %0, %1, %2" : "=v"(r) : "v"(lo), "v"(hi)); return r; }

template <class Epi, class Sched, bool ALIGN_EPI = false, bool SP2 = false>
__device__ __forceinline__ void gemm_phase(PG8_LAS unsigned char* lds, const Gemm g, const Sched& S, const Epi& E) {
    const int tid = threadIdx.x, wid = __builtin_amdgcn_readfirstlane(tid >> 6), lane = tid & 63, wr = wid >> 2, wc = wid & 3, fr = lane & 15, fq = lane >> 4;
    const int K = g.K, nt = K / BK;
    unsigned voffA[2], voffB[2];
#pragma unroll
    for (int i = 0; i < 2; ++i) { int R, C; stage_rc(tid * 16 + i * 8192, R, C); const int Rb = Epi::PERM ? ((R & ~31) + perm32(R & 31)) : R; const int Ra = Epi::AMAP ? amap_row(R) : R;
        voffA[i] = (unsigned)(Ra * g.lda + C) * 2u; voffB[i] = (unsigned)(Rb * g.ldb + C) * 2u; }
    const size_t kstep = (size_t)(BK * 2);
    const size_t hstepA = Epi::AMAP ? (size_t)4 * g.lda * 2 : (size_t)HALF * g.lda * 2;
    const size_t hstepB = (size_t)HALF * g.ldb * 2;
    const size_t tstepA = (size_t)BM * g.lda * 2, tstepB = (size_t)BM * g.ldb * 2;
    const unsigned ldsw = (unsigned)wid * 1024u;
    const int aoff = lds_byte(wr * 64 + fr, fq * 8), boff = lds_byte(wc * 32 + fr, fq * 8);
#define PG8_SA(b, h) (((b) * 2 + (h)) * HTB)
#define PG8_SB(b, h) ((4 + (b) * 2 + (h)) * HTB)
#define PG8_STAGE(bufoff, gbase, voff) do { _Pragma("unroll") for (int _i = 0; _i < 2; ++_i) \
        __builtin_amdgcn_global_load_lds((const unsigned*)((const char*)(gbase) + (voff)[_i]), (PG8_LAS unsigned*)(lds + (bufoff) + ldsw + _i * 8192), 16, 0, 0); } while (0)
#define PG8_LDA(dst, b, h) do { _Pragma("unroll") for (int m = 0; m < 4; ++m) _Pragma("unroll") for (int k = 0; k < 2; ++k) dst[m][k] = *(const PG8_LAS bf16x8*)(lds + PG8_SA(b, h) + aoff + m * 2048 + k * 1024); } while (0)
#define PG8_LDB(dst, b, h) do { _Pragma("unroll") for (int n = 0; n < 2; ++n) _Pragma("unroll") for (int k = 0; k < 2; ++k) dst[n][k] = *(const PG8_LAS bf16x8*)(lds + PG8_SB(b, h) + boff + n * 2048 + k * 1024); } while (0)
#define PG8_MMA(ai, bj, At, Bt) do { __builtin_amdgcn_s_setprio(1); _Pragma("unroll") for (int m = 0; m < 4; ++m) _Pragma("unroll") for (int n = 0; n < 2; ++n) _Pragma("unroll") for (int k = 0; k < 2; ++k) \
        acc[ai][bj][m][n] = __builtin_amdgcn_mfma_f32_16x16x32_bf16(Bt[n][k], At[m][k], acc[ai][bj][m][n], 0, 0, 0); __builtin_amdgcn_s_setprio(0); } while (0)
#define PG8_WAIT_V(n) asm volatile("s_waitcnt vmcnt(" #n ")" ::: "memory")
#define PG8_WAIT_L(n) asm volatile("s_waitcnt lgkmcnt(" #n ")" ::: "memory")
#define PG8_BAR __builtin_amdgcn_s_barrier()
#define PG8_SCHED __builtin_amdgcn_sched_barrier(0)
    Unit cur, nxt; int ui = 0;
    if (!S.next(0, cur)) return;
    f32x4 acc[2][2][4][2];
#pragma unroll
    for (int a = 0; a < 2; ++a)
#pragma unroll
        for (int b = 0; b < 2; ++b)
#pragma unroll
            for (int m = 0; m < 4; ++m)
#pragma unroll
                for (int n = 0; n < 2; ++n) acc[a][b][m][n] = (f32x4){0.f, 0.f, 0.f, 0.f};
    bf16x8 At[4][2], B0[2][2], B1[2][2];
    const char* cA = (const char*)g.A + (size_t)cur.pm * tstepA; const char* cB = (const char*)g.Bt + (size_t)cur.pn * tstepB;
    S.a_ready(cur);
    if constexpr (SP2) {
        PG8_STAGE(PG8_SB(0, 0), cB, voffB); PG8_STAGE(PG8_SB(0, 1), cB + hstepB, voffB); PG8_STAGE(PG8_SA(0, 0), cA, voffA); PG8_STAGE(PG8_SA(0, 1), cA + hstepA, voffA);
        if (wr == 1) PG8_BAR;
        PG8_WAIT_V(2); PG8_BAR;
        PG8_STAGE(PG8_SB(1, 0), cB + kstep, voffB); PG8_STAGE(PG8_SA(1, 0), cA + kstep, voffA); PG8_STAGE(PG8_SB(1, 1), cB + hstepB + kstep, voffB);
        PG8_WAIT_V(6); PG8_BAR;
    } else {
        PG8_STAGE(PG8_SB(0, 0), cB, voffB); PG8_STAGE(PG8_SA(0, 0), cA, voffA); PG8_STAGE(PG8_SB(0, 1), cB + hstepB, voffB); PG8_STAGE(PG8_SA(0, 1), cA + hstepA, voffA);
        if (wr == 1) PG8_BAR;
        PG8_WAIT_V(4); PG8_BAR;
        PG8_STAGE(PG8_SB(1, 0), cB + kstep, voffB); PG8_STAGE(PG8_SA(1, 0), cA + kstep, voffA); PG8_STAGE(PG8_SB(1, 1), cB + hstepB + kstep, voffB);
        PG8_WAIT_V(6); PG8_BAR;
    }
    for (;;) {
        const bool has_next = S.next(ui + 1, nxt);
        const char* nA = has_next ? (const char*)g.A + (size_t)nxt.pm * tstepA : cA; const char* nB = has_next ? (const char*)g.Bt + (size_t)nxt.pn * tstepB : cB;
        for (int t = 0; t < nt; t += 2) {
            const bool last = (t == nt - 2);
            const char* a1 = cA + (size_t)(t + 1) * kstep;
            const char* a2 = last ? nA : cA + (size_t)(t + 2) * kstep; const char* b2 = last ? nB : cB + (size_t)(t + 2) * kstep;
            const char* a3 = a2 + kstep; const char* b3 = b2 + kstep;
            if (last && has_next) S.a_ready(nxt);
            if constexpr (Epi::MID) { if (t == (nt >> 1)) E.template mid<2, 2>(acc, cur, 0, 0, wr, wc, fr, fq); }
            if constexpr (SP2) {
            PG8_LDB(B0, 0, 0); PG8_LDB(B1, 0, 1); PG8_SCHED; PG8_LDA(At, 0, 0); PG8_STAGE(PG8_SA(1, 1), a1 + hstepA, voffA);
            PG8_WAIT_V(8); PG8_WAIT_L(0); PG8_BAR; PG8_MMA(0, 0, At, B0); PG8_MMA(0, 1, At, B1); PG8_BAR; PG8_SCHED;
            PG8_LDA(At, 0, 1); PG8_STAGE(PG8_SB(0, 0), b2, voffB); PG8_STAGE(PG8_SB(0, 1), b2 + hstepB, voffB); PG8_STAGE(PG8_SA(0, 0), a2, voffA);
            PG8_WAIT_V(8); PG8_WAIT_L(0); PG8_BAR; PG8_MMA(1, 0, At, B0); PG8_MMA(1, 1, At, B1); PG8_BAR; PG8_SCHED;
            PG8_LDB(B0, 1, 0); PG8_LDB(B1, 1, 1); PG8_SCHED; PG8_LDA(At, 1, 0); PG8_STAGE(PG8_SA(0, 1), a2 + hstepA, voffA);
            PG8_WAIT_V(8); PG8_WAIT_L(0); PG8_BAR; PG8_MMA(0, 0, At, B0); PG8_MMA(0, 1, At, B1); PG8_BAR; PG8_SCHED;
            PG8_LDA(At, 1, 1); PG8_STAGE(PG8_SB(1, 0), b3, voffB); PG8_STAGE(PG8_SB(1, 1), b3 + hstepB, voffB); PG8_STAGE(PG8_SA(1, 0), a3, voffA);
            PG8_WAIT_V(8); PG8_WAIT_L(0); PG8_BAR; PG8_MMA(1, 0, At, B0); PG8_MMA(1, 1, At, B1); PG8_BAR; PG8_SCHED;
            } else {
            PG8_LDB(B0, 0, 0); PG8_SCHED; PG8_LDA(At, 0, 0); PG8_STAGE(PG8_SA(1, 1), a1 + hstepA, voffA);
            PG8_WAIT_L(8); PG8_BAR; PG8_WAIT_L(0); PG8_MMA(0, 0, At, B0); PG8_BAR; PG8_SCHED;
            PG8_LDB(B1, 0, 1); PG8_STAGE(PG8_SB(0, 0), b2, voffB);
            PG8_BAR; PG8_WAIT_L(0); PG8_MMA(0, 1, At, B1); PG8_BAR;
            PG8_LDA(At, 0, 1); PG8_STAGE(PG8_SA(0, 0), a2, voffA);
            PG8_BAR; PG8_WAIT_L(0); PG8_MMA(1, 0, At, B0); PG8_BAR; PG8_SCHED;
            PG8_STAGE(PG8_SB(0, 1), b2 + hstepB, voffB);
            PG8_WAIT_V(6); PG8_BAR; PG8_MMA(1, 1, At, B1); PG8_BAR;
            PG8_LDB(B0, 1, 0); PG8_SCHED; PG8_LDA(At, 1, 0); PG8_STAGE(PG8_SA(0, 1), a2 + hstepA, voffA);
            PG8_WAIT_L(8); PG8_BAR; PG8_WAIT_L(0); PG8_MMA(0, 0, At, B0); PG8_BAR; PG8_SCHED;
            PG8_LDB(B1, 1, 1); PG8_STAGE(PG8_SB(1, 0), b3, voffB);
            PG8_BAR; PG8_WAIT_L(0); PG8_MMA(0, 1, At, B1); PG8_BAR;
            PG8_LDA(At, 1, 1); PG8_STAGE(PG8_SA(1, 0), a3, voffA);
            PG8_BAR; PG8_WAIT_L(0); PG8_MMA(1, 0, At, B0); PG8_BAR; PG8_SCHED;
            PG8_STAGE(PG8_SB(1, 1), b3 + hstepB, voffB);
            PG8_WAIT_V(6); PG8_BAR; PG8_MMA(1, 1, At, B1); PG8_BAR;
            }
        }
        if constexpr (ALIGN_EPI) { if (wr == 0) PG8_BAR; }
        E.template run<2, 2>(acc, cur, 0, 0, wr, wc, fr, fq); S.done(cur);
        if (!has_next) break;
#pragma unroll
        for (int a = 0; a < 2; ++a)
#pragma unroll
            for (int b = 0; b < 2; ++b)
#pragma unroll
                for (int m = 0; m < 4; ++m)
#pragma unroll
                    for (int n = 0; n < 2; ++n) acc[a][b][m][n] = (f32x4){0.f, 0.f, 0.f, 0.f};
        cur = nxt; cA = nA; cB = nB; ++ui;
        if constexpr (ALIGN_EPI) { if (wr == 1) PG8_BAR; }
    }
    PG8_WAIT_V(0);
    if constexpr (!ALIGN_EPI) { if (wr == 0) PG8_BAR; }
    PG8_BAR;
#undef PG8_SA
#undef PG8_SB
#undef PG8_STAGE
#undef PG8_LDA
#undef PG8_LDB
#undef PG8_MMA
#undef PG8_WAIT_V
#undef PG8_WAIT_L
#undef PG8_BAR
#undef PG8_SCHED
}

template <int NB, class Epi>
__device__ __forceinline__ void sub_gemm(PG8_LAS unsigned char* lds, const Gemm g, int pm, int pn, int ai0, int bj0, const Epi& E) {
    int tid_ = threadIdx.x; asm volatile("" : "+v"(tid_));
    const int tid = tid_, wid = __builtin_amdgcn_readfirstlane(tid >> 6), lane = tid & 63, wr = wid >> 2, wc = wid & 3, fr = lane & 15, fq = lane >> 4;
    const int nt = g.K / BK;
    unsigned voffA[2], voffB[2];
#pragma unroll
    for (int i = 0; i < 2; ++i) { int R, C; stage_rc(tid * 16 + i * 8192, R, C); const int Rb = Epi::PERM ? ((R & ~31) + perm32(R & 31)) : R;
        voffA[i] = (unsigned)(R * g.lda + C) * 2u; voffB[i] = (unsigned)(Rb * g.ldb + C) * 2u; }
    const size_t kstep = (size_t)(BK * 2), hstepB = (size_t)HALF * g.ldb * 2;
    const unsigned ldsw = (unsigned)wid * 1024u;
    const int aoff = lds_byte(wr * 64 + fr, fq * 8), boff = lds_byte(wc * 32 + fr, fq * 8);
    const char* cA = (const char*)g.A + ((size_t)pm * BM + (size_t)ai0 * HALF) * g.lda * 2; const char* cB = (const char*)g.Bt + ((size_t)pn * BM + (size_t)bj0 * HALF) * g.ldb * 2;
#define SG_BUF(b, j) ((b) * 3 * HTB + (j) * HTB)
#define SG_STAGE(bufoff, gbase, voff) do { _Pragma("unroll") for (int _i = 0; _i < 2; ++_i) \
        __builtin_amdgcn_global_load_lds((const unsigned*)((const char*)(gbase) + (voff)[_i]), (PG8_LAS unsigned*)(lds + (bufoff) + ldsw + _i * 8192), 16, 0, 0); } while (0)
    f32x4 acc[1][NB][4][2];
#pragma unroll
    for (int b = 0; b < NB; ++b)
#pragma unroll
        for (int m = 0; m < 4; ++m)
#pragma unroll
            for (int n = 0; n < 2; ++n) acc[0][b][m][n] = (f32x4){0.f, 0.f, 0.f, 0.f};
    SG_STAGE(SG_BUF(0, 0), cA, voffA);
#pragma unroll
    for (int j = 0; j < NB; ++j) SG_STAGE(SG_BUF(0, 1 + j), cB + j * hstepB, voffB);
#pragma unroll 1
    for (int t = 0; t < nt; ++t) {
        const int cur = t & 1;
        if constexpr (Epi::MID) { if (t == (nt >> 1)) E.template mid<1, NB>(acc, Unit{pm, pn}, ai0 * HALF, bj0 * HALF, wr, wc, fr, fq); }
        if (t + 1 < nt) {
            SG_STAGE(SG_BUF(cur ^ 1, 0), cA + (size_t)(t + 1) * kstep, voffA);
#pragma unroll
            for (int j = 0; j < NB; ++j) SG_STAGE(SG_BUF(cur ^ 1, 1 + j), cB + j * hstepB + (size_t)(t + 1) * kstep, voffB);
            if constexpr (NB == 1) asm volatile("s_waitcnt vmcnt(4)" ::: "memory"); else asm volatile("s_waitcnt vmcnt(6)" ::: "memory");
        } else asm volatile("s_waitcnt vmcnt(0)" ::: "memory");
        __builtin_amdgcn_s_barrier();
        bf16x8 At[4][2], Bf[NB][2][2];
#pragma unroll
        for (int m = 0; m < 4; ++m)
#pragma unroll
            for (int k = 0; k < 2; ++k) At[m][k] = *(const PG8_LAS bf16x8*)(lds + SG_BUF(cur, 0) + aoff + m * 2048 + k * 1024);
#pragma unroll
        for (int j = 0; j < NB; ++j)
#pragma unroll
            for (int n = 0; n < 2; ++n)
#pragma unroll
                for (int k = 0; k < 2; ++k) Bf[j][n][k] = *(const PG8_LAS bf16x8*)(lds + SG_BUF(cur, 1 + j) + boff + n * 2048 + k * 1024);
        asm volatile("s_waitcnt lgkmcnt(0)" ::: "memory"); __builtin_amdgcn_sched_barrier(0);
#pragma unroll
        for (int j = 0; j < NB; ++j)
#pragma unroll
            for (int m = 0; m < 4; ++m)
#pragma unroll
                for (int n = 0; n < 2; ++n)
#pragma unroll
                    for (int k = 0; k < 2; ++k) acc[0][j][m][n] = __builtin_amdgcn_mfma_f32_16x16x32_bf16(Bf[j][n][k], At[m][k], acc[0][j][m][n], 0, 0, 0);
        __builtin_amdgcn_s_barrier();
    }
    E.template run<1, NB>(acc, Unit{pm, pn}, ai0 * HALF, bj0 * HALF, wr, wc, fr, fq);
#undef SG_BUF
#undef SG_STAGE
}
}
constexpr int NWAVES = 8;
constexpr int DM = 1024, NBATCH = 8, SEQ = 4096, SBATCH = 16, SSEQ = 16, PAST = 2048;
constexpr int MP = NBATCH * SEQ, MS = SBATCH * SSEQ, M = MP + MS, NTILE = M / 256, STILE = MP / 256;
constexpr int DIN = 4096, DFF = 3072, DUP = 6144;
constexpr float EPS = 1e-6f;
constexpr size_t OFF_Y = 0, OFF_HP = (size_t)M * DM, OFF_LCP = OFF_HP + NBATCH * DM, OFF_PLP = OFF_LCP + NBATCH * 3 * DM, OFF_FCP = OFF_PLP + NBATCH * 15 * DM,
                 OFF_HS = OFF_FCP + NBATCH * 2 * DUP, OFF_LCS = OFF_HS + SBATCH * DM, OFF_PLS = OFF_LCS + SBATCH * 3 * DM, OFF_FCS = OFF_PLS + SBATCH * 15 * DM,
                 OUT_TOTAL = OFF_FCS + SBATCH * 2 * DUP;
constexpr size_t MiB = 1u << 20;
constexpr size_t WS_CTL = 0, CTL_ZERO_BYTES = 64 * 1024;
constexpr size_t WS_WIN = 1 * MiB, WS_WCAT = 9 * MiB, WS_WOUT = 13 * MiB, WS_WUP = 15 * MiB, WS_WDN = 27 * MiB, WS_WG = 33 * MiB;
constexpr size_t WS_SSQ = 33 * MiB + 512 * 1024, WS_SSQ2 = 37 * MiB + 768 * 1024, WS_SUMM = WS_SSQ;
static_assert(WS_SSQ + (size_t)M * 128 <= WS_SSQ2 && WS_SSQ2 + (size_t)M * 128 <= 42 * MiB, "ssq map");
constexpr size_t WS_R0 = 42 * MiB, WS_R1 = 107 * MiB, WS_R2 = 236 * MiB, WS_R3 = 365 * MiB, WS_WBP = 494 * MiB, WS_WPOOL = 496 * MiB, WS_HA = 497 * MiB, WS_HB = 499 * MiB, WS_END = 501 * MiB;
static_assert((size_t)M * DM * 2 <= WS_R1 - WS_R0 && (size_t)M * 2048 * 2 <= WS_R2 - WS_R1 && (size_t)M * 2048 * 2 <= WS_R3 - WS_R2 && (size_t)M * 2048 * 2 <= WS_END - WS_R3 && (size_t)M * DFF * 2 <= WS_END - WS_R2, "ws map");
constexpr int CW_BAR = 1024, CW_PANEL = 8192;
constexpr int RING_BYTES = 131072;
constexpr int MISC_OFF = RING_BYTES, RS_OFF = RING_BYTES + 512, EDGE_START_OFF = RS_OFF + 4096, EDGE_MID_OFF = EDGE_START_OFF + 2048, EDGE_PREV_OFF = EDGE_MID_OFF + 2048;
constexpr int CWL_OFF = EDGE_PREV_OFF + 4096;
constexpr int LDS_BYTES = 155648;
static_assert(CWL_OFF + 4096 <= LDS_BYTES, "LDS map");

#define GAS __attribute__((address_space(1)))
#define LAS __attribute__((address_space(3)))
typedef unsigned short bf16;
typedef unsigned v4u __attribute__((ext_vector_type(4)));
typedef unsigned v2u __attribute__((ext_vector_type(2)));
typedef float f32x4 __attribute__((ext_vector_type(4)));
typedef short bf16x8 __attribute__((ext_vector_type(8)));
#define LDS_WAIT() asm volatile("s_waitcnt lgkmcnt(0)" ::: "memory")
#define VM_WAIT() asm volatile("s_waitcnt vmcnt(0)" ::: "memory")
__device__ __forceinline__ unsigned f2bf(float f) { unsigned u = __builtin_bit_cast(unsigned, f); return (u + 0x7fffu + ((u >> 16) & 1u)) >> 16; }
__device__ __forceinline__ unsigned pk2(float lo, float hi) { return f2bf(lo) | (f2bf(hi) << 16); }
__device__ __forceinline__ float bflo(unsigned w) { return __builtin_bit_cast(float, w << 16); }
__device__ __forceinline__ float bfhi(unsigned w) { return __builtin_bit_cast(float, w & 0xffff0000u); }
__device__ __forceinline__ float sigmoidf_fast(float x) { return __builtin_amdgcn_rcpf(1.0f + __builtin_amdgcn_exp2f(-1.4426950408889634f * x)); }
__device__ __forceinline__ float gelu_tanh(float g) { const float z = g * (1.0f + 0.044715f * g * g); return g * __builtin_amdgcn_rcpf(1.0f + __builtin_amdgcn_exp2f(-2.302208198f * z)); }
__device__ __forceinline__ float dpp_shr1(float v) { return __builtin_bit_cast(float, __builtin_amdgcn_update_dpp(__builtin_bit_cast(int, v), __builtin_bit_cast(int, v), 0x111  , 0xf, 0xf, false)); }
__device__ __forceinline__ float wave_sum(float v) {
#pragma unroll
    for (int o = 1; o < 64; o <<= 1) v += __shfl_xor(v, o);
    return v;
}

#define XB_TMO      128
#define XB_XCNT(j)  (256  + 64 * (j))
#define XB_XSUB(j)  (1280 + 64 * (j))
#define XB_XGEN(j)  (2304 + 64 * (j))
#define XB_TOP      3328
#define XB_TOPGEN   3392
#define XCD_BAR_WORDS 3456
#define XB_SPIN_CAP (1u << 20)
static_assert((CW_BAR + XCD_BAR_WORDS) <= CW_PANEL && (CW_PANEL + 32 * 132) * 4 <= (int)CTL_ZERO_BYTES, "control words inside the memset region");
__device__ __forceinline__ unsigned xb_ld(unsigned* p)              { return __hip_atomic_load(p, __ATOMIC_RELAXED, __HIP_MEMORY_SCOPE_AGENT); }
__device__ __forceinline__ unsigned xb_add(unsigned* p, unsigned v) { return __hip_atomic_fetch_add(p, v, __ATOMIC_RELAXED, __HIP_MEMORY_SCOPE_AGENT); }
__device__ __forceinline__ unsigned xb_xcc_id() { return (unsigned)__builtin_amdgcn_s_getreg((3 << 11) | 20) & 0xFu; }
#define XB_SPIN(cond, bar) do { unsigned _sp = 0; while (cond) { __builtin_amdgcn_s_sleep(1); \
    if ((++_sp & 255u) == 0u) { if (xb_ld(&(bar)[XB_TMO])) break; if (_sp > XB_SPIN_CAP) { atomicAdd(&(bar)[XB_TMO], 1u); break; } } } } while (0)
struct XcdBarrier { unsigned* bar; unsigned x; volatile LAS unsigned* st; };
__device__ __forceinline__ XcdBarrier xcd_barrier_post(unsigned* bar, volatile LAS unsigned* st) {
    XcdBarrier b; b.bar = bar; b.x = xb_xcc_id(); b.st = st;
    if (threadIdx.x == 0) (void)xb_add(&bar[XB_XCNT(b.x)], 1u);
    return b;
}
__device__ __forceinline__ void xcd_barrier_complete(unsigned* bar, unsigned x, unsigned& nloc, unsigned& nx) {
    const unsigned G = gridDim.x * gridDim.y * gridDim.z;
    unsigned sum, cnt, mine, sp = 0u;
    for (;;) {
        sum = 0u; cnt = 0u; mine = 0u;
#pragma unroll
        for (unsigned j = 0; j < 16; ++j) { const unsigned c = xb_ld(&bar[XB_XCNT(j)]); sum += c; cnt += (c > 0u) ? 1u : 0u; mine = (j == x) ? c : mine; }
        if (sum == G) break;
        __builtin_amdgcn_s_sleep(1);
        if ((++sp & 255u) == 0u) { if (xb_ld(&bar[XB_TMO])) break; if (sp > XB_SPIN_CAP) { atomicAdd(&bar[XB_TMO], 1u); break; } }
    }
    nloc = mine > 0u ? mine : 1u; nx = cnt > 0u ? cnt : 1u;
}
__device__ __forceinline__ void xcd_barrier(const XcdBarrier& b) {
    asm volatile("s_waitcnt vmcnt(0)" ::: "memory");
    __syncthreads();
    if (threadIdx.x == 0) {
        unsigned* bar = b.bar;
        __builtin_amdgcn_s_waitcnt(0);
        unsigned nloc = b.st[0], nx = b.st[1];
        if (nloc == 0u) { xcd_barrier_complete(bar, b.x, nloc, nx); b.st[0] = nloc; b.st[1] = nx; }
        const unsigned old = xb_add(&bar[XB_XSUB(b.x)], 1u);
        const unsigned gen = old / nloc;
        if (old + 1u == (gen + 1u) * nloc) {
            __builtin_amdgcn_fence(__ATOMIC_RELEASE, "agent");
            asm volatile("s_waitcnt vmcnt(0)" ::: "memory");
            const unsigned og = xb_add(&bar[XB_TOP], 1u);
            const unsigned tg = og / nx;
            if (og + 1u == (tg + 1u) * nx) xb_add(&bar[XB_TOPGEN], 1u);
            else XB_SPIN(xb_ld(&bar[XB_TOPGEN]) == tg, bar);
            __builtin_amdgcn_fence(__ATOMIC_ACQUIRE, "agent");
            xb_add(&bar[XB_XGEN(b.x)], 1u);
            asm volatile("s_waitcnt vmcnt(0)" ::: "memory");
        } else {
            XB_SPIN(xb_ld(&bar[XB_XGEN(b.x)]) == gen, bar);
            __builtin_amdgcn_fence(__ATOMIC_ACQUIRE, "agent");
            asm volatile("s_waitcnt vmcnt(0)" ::: "memory");
        }
    }
    __syncthreads();
}

struct KP {
    const float* in[26];
    float* out; unsigned char* ws;
    int ph_lo, ph_hi;
};
enum { I_XP = 0, I_XS, I_STH, I_STLC, I_STPOOL, I_STFFN, I_NMIX, I_WIN, I_CLW, I_CLB, I_WRA, I_BRA, I_WIX, I_BIX, I_LAM, I_WPOOL, I_PSCALE, I_WBRL, I_WBRP, I_WOUT, I_NFFN, I_WUP, I_CFW, I_CFB, I_WDN, I_NFIN };

using pg8::Unit;
struct EpiZ {
    static constexpr bool PERM = true, AMAP = false, MID = false;
    bf16* ZR; bf16* G;
    template <int NA, int NB> __device__ __forceinline__ void run(f32x4 (&acc)[NA][NB][4][2], const Unit& u, int rowoff, int coloff, int wr, int wc, int fr, int fq) const {
        const int row0 = u.pm * 256 + rowoff + wr * 64 + fr; const bool gate = u.pn >= 8;
        bf16* base = gate ? G : ZR; const int col0 = (u.pn & 7) * 256 + coloff + wc * 32 + 8 * fq;
#pragma unroll
        for (int ai = 0; ai < NA; ++ai)
#pragma unroll
            for (int m = 0; m < 4; ++m) { bf16* rowp = base + (size_t)(row0 + ai * 128 + m * 16) * 2048 + col0;
#pragma unroll
                for (int bj = 0; bj < NB; ++bj) { f32x4 v0 = acc[ai][bj][m][0], v1 = acc[ai][bj][m][1];
                    if (gate) {
#pragma unroll
                        for (int j = 0; j < 4; ++j) { v0[j] = sigmoidf_fast(v0[j]); v1[j] = sigmoidf_fast(v1[j]); } }
                    v4u w; w.x = pg8::cvt_pk_bf16(v0[0], v0[1]); w.y = pg8::cvt_pk_bf16(v0[2], v0[3]); w.z = pg8::cvt_pk_bf16(v1[0], v1[1]); w.w = pg8::cvt_pk_bf16(v1[2], v1[3]);
                    *(v4u*)(rowp + bj * 128) = w; } }
    }
};
struct EpiBr {
    static constexpr bool PERM = true, AMAP = false, MID = true;
    const bf16* G; bf16* MG;
    template <int NA, int NB> __device__ __forceinline__ void mid(f32x4 (&acc)[NA][NB][4][2], const Unit& u, int rowoff, int coloff, int wr, int wc, int fr, int fq) const {
        int pm_ = u.pm, pn_ = u.pn; asm volatile("" : "+s"(pm_), "+s"(pn_));
        const int row0 = pm_ * 256 + rowoff + wr * 64 + fr, col0 = pn_ * 256 + coloff + wc * 32 + 8 * fq;
#pragma unroll
        for (int ai = 0; ai < NA; ++ai)
#pragma unroll
            for (int m = 0; m < 4; ++m) { const size_t row = (size_t)(row0 + ai * 128 + m * 16);
#pragma unroll
                for (int bj = 0; bj < NB; ++bj) { const int col = col0 + bj * 128;
                    const v4u ga = *(const v4u*)(G + row * 2048 + col), gb = *(const v4u*)(G + row * 2048 + 1024 + col);
                    const float a_[8] = {bflo(ga.x), bfhi(ga.x), bflo(ga.y), bfhi(ga.y), bflo(ga.z), bfhi(ga.z), bflo(ga.w), bfhi(ga.w)};
                    const float b_[8] = {bflo(gb.x), bfhi(gb.x), bflo(gb.y), bfhi(gb.y), bflo(gb.z), bfhi(gb.z), bflo(gb.w), bfhi(gb.w)};
#pragma unroll
                    for (int e = 0; e < 4; ++e) { acc[ai][bj][m][0][e] *= a_[e] * __builtin_amdgcn_rcpf(fmaxf(b_[e], 1e-30f)); acc[ai][bj][m][1][e] *= a_[4 + e] * __builtin_amdgcn_rcpf(fmaxf(b_[4 + e], 1e-30f)); } } }
    }
    template <int NA, int NB> __device__ __forceinline__ void run(f32x4 (&acc)[NA][NB][4][2], const Unit& u, int rowoff, int coloff, int wr, int wc, int fr, int fq) const {
        const int row0 = u.pm * 256 + rowoff + wr * 64 + fr, col0 = u.pn * 256 + coloff + wc * 32 + 8 * fq;
#pragma unroll
        for (int ai = 0; ai < NA; ++ai)
#pragma unroll
            for (int m = 0; m < 4; ++m) { const size_t row = (size_t)(row0 + ai * 128 + m * 16);
#pragma unroll
                for (int bj = 0; bj < NB; ++bj) { const int col = col0 + bj * 128;
                    const v4u gw = *(const v4u*)(G + row * 2048 + 1024 + col);
                    const f32x4 g0 = {bflo(gw.x), bfhi(gw.x), bflo(gw.y), bfhi(gw.y)}, g1 = {bflo(gw.z), bfhi(gw.z), bflo(gw.w), bfhi(gw.w)};
                    const f32x4 v0 = acc[ai][bj][m][0] * g0, v1 = acc[ai][bj][m][1] * g1;
                    v4u w; w.x = pg8::cvt_pk_bf16(v0[0], v0[1]); w.y = pg8::cvt_pk_bf16(v0[2], v0[3]); w.z = pg8::cvt_pk_bf16(v1[0], v1[1]); w.w = pg8::cvt_pk_bf16(v1[2], v1[3]);
                    *(v4u*)(MG + row * 1024 + col) = w; } }
    }
};
template <bool DOWN> struct EpiRes {
    static constexpr bool PERM = true, AMAP = false, MID = false;
    const float* xp; const float* xs; float* Y; bf16* X1B; float* SSQ;
    template <int NA, int NB> __device__ __forceinline__ void run(f32x4 (&acc)[NA][NB][4][2], const Unit& u, int rowoff, int coloff, int wr, int wc, int fr, int fq) const {
        const int row0 = u.pm * 256 + rowoff + wr * 64 + fr, col0 = u.pn * 256 + coloff + wc * 32 + 8 * fq;
        const float* xb = (u.pm < STILE ? xp : xs - (size_t)MP * DM);
#pragma unroll
        for (int ai = 0; ai < NA; ++ai)
#pragma unroll
            for (int m = 0; m < 4; ++m) { const size_t row = (size_t)(row0 + ai * 128 + m * 16);
#pragma unroll
                for (int bj = 0; bj < NB; ++bj) { const size_t off = row * 1024 + col0 + bj * 128; f32x4 v0, v1;
                    if (!DOWN) { v0 = acc[ai][bj][m][0] + *(const f32x4*)(xb + off); v1 = acc[ai][bj][m][1] + *(const f32x4*)(xb + off + 4); }
                    else { const v4u w = *(const v4u*)(X1B + off); v0 = acc[ai][bj][m][0] + (f32x4){bflo(w.x), bfhi(w.x), bflo(w.y), bfhi(w.y)}; v1 = acc[ai][bj][m][1] + (f32x4){bflo(w.z), bfhi(w.z), bflo(w.w), bfhi(w.w)}; }
                    float s = (v0[0] * v0[0] + v0[1] * v0[1]) + (v0[2] * v0[2] + v0[3] * v0[3]) + (v1[0] * v1[0] + v1[1] * v1[1]) + (v1[2] * v1[2] + v1[3] * v1[3]);
                    if (!DOWN) { v4u w; w.x = pg8::cvt_pk_bf16(v0[0], v0[1]); w.y = pg8::cvt_pk_bf16(v0[2], v0[3]); w.z = pg8::cvt_pk_bf16(v1[0], v1[1]); w.w = pg8::cvt_pk_bf16(v1[2], v1[3]);
                        *(v4u*)(X1B + off) = w; }
                    else { *(f32x4*)(Y + off) = v0; *(f32x4*)(Y + off + 4) = v1; }
                    s += __shfl_xor(s, 16); s += __shfl_xor(s, 32);
                    if (fq == 0) SSQ[row * 32 + u.pn * 8 + ((coloff >> 7) + bj) * 4 + wc] = s; } }
    }
};
__device__ __forceinline__ float row_rs(const float* SSQ, size_t row) {
    const f32x4* q = (const f32x4*)(SSQ + row * 32); float s = 0.f;
#pragma unroll
    for (int k = 0; k < 8; ++k) { const f32x4 a = q[k]; s += (a[0] + a[1]) + (a[2] + a[3]); }
    return 1.0f / sqrtf(s * (1.f / DM) + EPS);
}
struct EpiFinal {
    static constexpr bool PERM = true, AMAP = false, MID = false;
    float* Y; const bf16* X1B; const float* gf; float* XS; unsigned* cnt; unsigned* tmo; LAS unsigned char* lx;
    template <int NA, int NB> __device__ __forceinline__ void run(f32x4 (&acc)[NA][NB][4][2], const Unit& u, int rowoff, int coloff, int wr, int wc, int fr, int fq) const {
        LAS float* P = (LAS float*)(lx + RS_OFF); LAS float* S = P + 2048;
        int tid = threadIdx.x, pm_ = u.pm, pn_ = u.pn, fr_ = fr, fq_ = fq, wr_ = wr, wc_ = wc;
        asm volatile("" : "+v"(tid), "+s"(pm_), "+s"(pn_), "+v"(fr_), "+v"(fq_), "+s"(wr_), "+s"(wc_));
        const int wid = tid >> 6, lane = tid & 63;
        const int lrow0 = rowoff + wr_ * 64 + fr_, col0 = pn_ * 256 + coloff + wc_ * 32 + 8 * fq_, bj0 = coloff >> 7;
#pragma unroll
        for (int ai = 0; ai < NA; ++ai)
#pragma unroll
            for (int m = 0; m < 4; ++m) { const int lrow = lrow0 + ai * 128 + m * 16; const size_t row = (size_t)pm_ * 256 + lrow;
#pragma unroll
                for (int bj = 0; bj < NB; ++bj) { const size_t off = row * 1024 + col0 + bj * 128;
                    { const v4u w = *(const v4u*)(X1B + off); acc[ai][bj][m][0] += (f32x4){bflo(w.x), bfhi(w.x), bflo(w.y), bfhi(w.y)}; acc[ai][bj][m][1] += (f32x4){bflo(w.z), bfhi(w.z), bflo(w.w), bfhi(w.w)}; }
                    const f32x4 v0 = acc[ai][bj][m][0], v1 = acc[ai][bj][m][1];
                    float s = (v0[0] * v0[0] + v0[1] * v0[1]) + (v0[2] * v0[2] + v0[3] * v0[3]) + (v1[0] * v1[0] + v1[1] * v1[1]) + (v1[2] * v1[2] + v1[3] * v1[3]);
                    s += __shfl_xor(s, 16); s += __shfl_xor(s, 32);
                    if (fq_ == 0) P[lrow * 8 + (bj0 + bj) * 4 + wc_] = s; } }
        asm volatile("s_waitcnt lgkmcnt(0)" ::: "memory"); __builtin_amdgcn_s_barrier(); asm volatile("" ::: "memory");
        constexpr int RPW = (NA == 2) ? 32 : 16;
        const int nslot = (NA == 2) ? 4 : 8, slot = (NA == 2) ? pn_ : 2 * pn_ + bj0;
        const int prow = rowoff + wid * RPW + (lane & (RPW - 1));
        float* xs = XS + (size_t)pm_ * 2048;
        if (lane < RPW) { const LAS float* pp = P + prow * 8 + (NA == 2 ? 0 : bj0 * 4); float t = (pp[0] + pp[1]) + (pp[2] + pp[3]); if (NA == 2) t += (pp[4] + pp[5]) + (pp[6] + pp[7]);
            __hip_atomic_store(xs + slot * 256 + prow, t, __ATOMIC_RELAXED, __HIP_MEMORY_SCOPE_AGENT); }
        asm volatile("s_waitcnt vmcnt(0)" ::: "memory");
        unsigned* c = cnt + 32 * ((NA == 2) ? pm_ : (STILE + (rowoff >> 7)));
        if (lane == 0) __hip_atomic_fetch_add(c, 1u, __ATOMIC_RELAXED, __HIP_MEMORY_SCOPE_AGENT);
        if (wid == 0) { const unsigned want = 8u * (unsigned)nslot; unsigned sp = 0;
            while ((unsigned)__builtin_amdgcn_readfirstlane(__hip_atomic_load(c, __ATOMIC_RELAXED, __HIP_MEMORY_SCOPE_AGENT)) < want) {
                __builtin_amdgcn_s_sleep(1);
                if ((++sp & 255u) == 0u) { if (__builtin_amdgcn_readfirstlane(__hip_atomic_load(tmo, __ATOMIC_RELAXED, __HIP_MEMORY_SCOPE_AGENT)) != 0u) break; if (sp > (1u << 20)) { if (lane == 0) atomicAdd(tmo, 1u); break; } } } }
        asm volatile("s_waitcnt vmcnt(0) lgkmcnt(0)" ::: "memory"); __builtin_amdgcn_s_barrier(); asm volatile("" ::: "memory");
        if (lane < RPW) { float t = 0.f;
#pragma unroll
            for (int k = 0; k < 8; ++k) if (k < nslot) t += __hip_atomic_load(xs + k * 256 + prow, __ATOMIC_RELAXED, __HIP_MEMORY_SCOPE_AGENT);
            S[prow] = 1.0f / sqrtf(t * (1.f / DM) + EPS); }
        asm volatile("s_waitcnt lgkmcnt(0)" ::: "memory"); __builtin_amdgcn_s_barrier(); asm volatile("" ::: "memory");
        f32x4 gg[NB][2];
#pragma unroll
        for (int bj = 0; bj < NB; ++bj) { gg[bj][0] = *(const f32x4*)(gf + col0 + bj * 128); gg[bj][1] = *(const f32x4*)(gf + col0 + bj * 128 + 4); }
#pragma unroll
        for (int ai = 0; ai < NA; ++ai)
#pragma unroll
            for (int m = 0; m < 4; ++m) { const int lrow = lrow0 + ai * 128 + m * 16; const size_t row = (size_t)pm_ * 256 + lrow; const float rs = S[lrow];
#pragma unroll
                for (int bj = 0; bj < NB; ++bj) { const size_t off = row * 1024 + col0 + bj * 128;
                    *(f32x4*)(Y + off) = acc[ai][bj][m][0] * rs * gg[bj][0]; *(f32x4*)(Y + off + 4) = acc[ai][bj][m][1] * rs * gg[bj][1]; } }
    }
};
struct EpiW {
    static constexpr bool PERM = true, AMAP = false, MID = false;
    bf16* O;
    template <int NA, int NB> __device__ __forceinline__ void run(f32x4 (&acc)[NA][NB][4][2], const Unit& u, int rowoff, int coloff, int wr, int wc, int fr, int fq) const {
        const int row0 = u.pm * 256 + rowoff + wr * 64 + fr, col0 = u.pn * 256 + coloff + wc * 32 + 8 * fq;
#pragma unroll
        for (int ai = 0; ai < NA; ++ai)
#pragma unroll
            for (int m = 0; m < 4; ++m)
#pragma unroll
                for (int bj = 0; bj < NB; ++bj) { const f32x4 v0 = acc[ai][bj][m][0], v1 = acc[ai][bj][m][1];
                    v4u w; w.x = pg8::cvt_pk_bf16(v0[0], v0[1]); w.y = pg8::cvt_pk_bf16(v0[2], v0[3]); w.z = pg8::cvt_pk_bf16(v1[0], v1[1]); w.w = pg8::cvt_pk_bf16(v1[2], v1[3]);
                    *(v4u*)(O + (size_t)(row0 + ai * 128 + m * 16) * 2048 + col0 + bj * 128) = w; }
    }
};
template <bool AM> struct EpiNull {
    static constexpr bool PERM = true, AMAP = AM, MID = false;
    template <int NA, int NB> __device__ __forceinline__ void run(f32x4 (&acc)[NA][NB][4][2], const Unit&, int, int, int, int, int, int) const {
#pragma unroll
        for (int ai = 0; ai < NA; ++ai)
#pragma unroll
            for (int bj = 0; bj < NB; ++bj)
#pragma unroll
                for (int m = 0; m < 4; ++m) { asm volatile("" :: "v"(acc[ai][bj][m][0]), "v"(acc[ai][bj][m][1])); }
    }
};
struct EpiZScratch {
    static constexpr bool PERM = true, AMAP = false, MID = false;
    bf16* scr;
    template <int NA, int NB> __device__ __forceinline__ void run(f32x4 (&acc)[NA][NB][4][2], const Unit& u, int rowoff, int coloff, int wr, int wc, int fr, int fq) const {
        const int row0 = wr * 64 + fr, col0 = wc * 32 + 8 * fq;
#pragma unroll
        for (int ai = 0; ai < NA; ++ai)
#pragma unroll
            for (int m = 0; m < 4; ++m) { bf16* rowp = scr + (size_t)(row0 + ai * 128 + m * 16) * 256 + col0;
#pragma unroll
                for (int bj = 0; bj < NB; ++bj) { f32x4 v0 = acc[ai][bj][m][0], v1 = acc[ai][bj][m][1];
                    v4u w; w.x = pg8::cvt_pk_bf16(v0[0], v0[1]); w.y = pg8::cvt_pk_bf16(v0[2], v0[3]); w.z = pg8::cvt_pk_bf16(v1[0], v1[1]); w.w = pg8::cvt_pk_bf16(v1[2], v1[3]);
                    *(v4u*)(rowp + bj * 128) = w; } }
    }
};
struct EpiUpS {
    static constexpr bool PERM = true, AMAP = false, MID = false;
    bf16* ACT; const float* cw; const float* cb; const float* stf; float* ofs; const float* SSQ;
    template <int NA, int NB> __device__ __forceinline__ void run(f32x4 (&acc)[NA][NB][4][2], const Unit& u, int rowoff, int coloff, int wr, int wc, int fr, int fq) const {
        static_assert(NA == 1 && NB == 2, "sample FFN epilogue works on half sub-units");
        int pn_ = u.pn, ro_ = rowoff, fr_ = fr, fq_ = fq, wr_ = wr, wc_ = wc; asm volatile("" : "+s"(pn_), "+s"(ro_), "+v"(fr_), "+v"(fq_), "+s"(wr_), "+s"(wc_));
        const int cbase = 32 * wc_ + 8 * fq_, gcol = 128 * pn_ + cbase;
#pragma unroll
        for (int m = 0; m < 4; ++m) {
            asm volatile("" ::: "memory");
            const int lrow = ro_ + wr_ * 64 + m * 16 + fr_, seq = lrow >> 4; const size_t row = (size_t)MP + lrow;
            const float rs = row_rs(SSQ, row);
            unsigned pk[4];
#pragma unroll
            for (int n = 0; n < 2; ++n) { f32x4 gc;
#pragma unroll
                for (int bj = 0; bj < 2; ++bj) { const int oc = bj * DFF + gcol + 4 * n;
                    const f32x4 w0 = *(const f32x4*)(cw + oc), w1 = *(const f32x4*)(cw + DUP + oc), w2 = *(const f32x4*)(cw + 2 * DUP + oc), bb = *(const f32x4*)(cb + oc);
                    const f32x4 h = acc[0][bj][m][n] * rs; f32x4 hm1, hm2;
#pragma unroll
                    for (int e = 0; e < 4; ++e) { hm1[e] = __shfl_up(h[e], 1, 16); hm2[e] = __shfl_up(h[e], 2, 16); }
                    if (fr_ < 2) { const f32x4 s1 = *(const f32x4*)(stf + (size_t)(seq * 2 + 1) * DUP + oc); if (fr_ == 0) { hm1 = s1; hm2 = *(const f32x4*)(stf + (size_t)(seq * 2 + 0) * DUP + oc); } else hm2 = s1; }
                    if (fr_ >= 14) *(f32x4*)(ofs + (size_t)(seq * 2 + (fr_ - 14)) * DUP + oc) = h;
                    const f32x4 c = bb + w0 * hm2 + w1 * hm1 + w2 * h;
                    if (bj == 0) gc = c;
                    else { f32x4 a;
#pragma unroll
                        for (int e = 0; e < 4; ++e) a[e] = gelu_tanh(gc[e]) * c[e];
                        pk[2 * n] = pg8::cvt_pk_bf16(a[0], a[1]); pk[2 * n + 1] = pg8::cvt_pk_bf16(a[2], a[3]); } } }
            v4u w; w.x = pk[0]; w.y = pk[1]; w.z = pk[2]; w.w = pk[3];
            *(v4u*)(ACT + row * DFF + gcol) = w;
        }
    }
};
struct EpiUp {
    static constexpr bool PERM = true, AMAP = true, MID = false;
    bf16* ACT; const float* cw; const float* cb; const float* stf; float* ofp; float* ofs; LAS unsigned char* lx; int pm0; bf16* scr; float* HA; float* HB;
    template <int NA, int NB> __device__ __forceinline__ void run(f32x4 (&acc)[NA][NB][4][2], const Unit& u, int, int, int wr, int wc, int fr, int fq) const {
        int pm_ = u.pm, pn_ = u.pn, fr_ = fr, fq_ = fq; asm volatile("" : "+s"(pm_), "+s"(pn_), "+v"(fr_), "+v"(fq_));
        const bool samp = (pm_ == STILE); const int j = pm_ - pm0;
        const LAS float* RS = (const LAS float*)(lx + RS_OFF) + j * 256 + 128 * wr + 8 * fr_;
        const f32x4 rsa = *(const LAS f32x4*)RS, rsb = *(const LAS f32x4*)(RS + 4);
        const float rs[8] = {rsa[0], rsa[1], rsa[2], rsa[3], rsb[0], rsb[1], rsb[2], rsb[3]};
        const int cbase = 32 * wc + 8 * fq_, gcol = 128 * pn_ + cbase;
        const LAS float* Ein = (const LAS float*)(lx + (wr == 0 ? (j == 0 ? EDGE_START_OFF : EDGE_PREV_OFF + 2048 * (j & 1)) : EDGE_MID_OFF));
        LAS float* Eout = (LAS float*)(lx + (wr == 0 ? EDGE_MID_OFF : EDGE_PREV_OFF + 2048 * ((j + 1) & 1)));
        const int seq = samp ? (8 * wr + (fr_ >> 1)) : (pm_ >> 4);
        const bool lastp = (!samp) && !scr && ((pm_ & 15) == 15) && wr == 1 && fr_ == 15;
        if (!samp && fr_ == 15) {
#pragma unroll
            for (int n = 0; n < 2; ++n)
#pragma unroll
                for (int bj = 0; bj < 2; ++bj) { const int cc = bj * 128 + cbase + 4 * n;
                    *(LAS f32x4*)(Eout + cc) = acc[1][bj][2][n] * rs[6]; *(LAS f32x4*)(Eout + 256 + cc) = acc[1][bj][3][n] * rs[7]; } }
        asm volatile("s_waitcnt lgkmcnt(0)" ::: "memory"); __builtin_amdgcn_s_barrier(); asm volatile("" ::: "memory");
        const size_t astr = scr ? 128 : DFF;
        bf16* ap = scr ? scr + (size_t)(128 * wr + 8 * fr_) * 128 + cbase : ACT + (size_t)(pm_ * 256 + 128 * wr + 8 * fr_) * DFF + gcol;
#pragma unroll
        for (int n = 0; n < 2; ++n) {
            f32x4 gc[8];
#pragma unroll
            for (int bj = 0; bj < 2; ++bj) {
                const int cc = bj * 128 + cbase + 4 * n, oc = bj * DFF + gcol + 4 * n;
                const LAS float* cwl = (const LAS float*)(lx + CWL_OFF) + cc;
                const f32x4 w0 = *(const LAS f32x4*)cwl, w1 = *(const LAS f32x4*)(cwl + 256), w2 = *(const LAS f32x4*)(cwl + 512), bb = *(const LAS f32x4*)(cwl + 768);
                const f32x4 h6 = acc[1][bj][2][n] * rs[6], h7 = acc[1][bj][3][n] * rs[7];
                f32x4 hm1, hm2;
#pragma unroll
                for (int e = 0; e < 4; ++e) { hm1[e] = dpp_shr1(h7[e]); hm2[e] = dpp_shr1(h6[e]); }
                if (!samp) {
                    if (fr_ == 0) { hm2 = *(const LAS f32x4*)(Ein + cc); hm1 = *(const LAS f32x4*)(Ein + 256 + cc); }
                    if (lastp) { *(f32x4*)(ofp + (size_t)(seq * 2 + 0) * DUP + oc) = h6; *(f32x4*)(ofp + (size_t)(seq * 2 + 1) * DUP + oc) = h7; }
                    if (j == 3 && wr == 1 && fr_ == 15 && !scr) { float* ha = HA + ((size_t)((pm0 >> 2) + 1) * 24 + pn_) * 512 + cc; *(f32x4*)ha = h6; *(f32x4*)(ha + 256) = h7; }
                    if (j == 0 && wr == 0 && fr_ == 0 && !scr) { float* hb = HB + ((size_t)(pm0 >> 2) * 24 + pn_) * 512 + cc; *(f32x4*)hb = acc[0][bj][0][n] * rs[0]; *(f32x4*)(hb + 256) = acc[0][bj][1][n] * rs[1]; }
                } else {
                    if (!(fr_ & 1)) { hm2 = *(const f32x4*)(stf + (size_t)(seq * 2 + 0) * DUP + oc); hm1 = *(const f32x4*)(stf + (size_t)(seq * 2 + 1) * DUP + oc); }
                    else { *(f32x4*)(ofs + (size_t)(seq * 2 + 0) * DUP + oc) = h6; *(f32x4*)(ofs + (size_t)(seq * 2 + 1) * DUP + oc) = h7; }
                }
                f32x4 p2 = hm2, p1 = hm1;
#pragma unroll
                for (int q = 0; q < 8; ++q) {
                    const f32x4 hq = (q == 6) ? h6 : (q == 7) ? h7 : acc[q >> 2][bj][q & 3][n] * rs[q];
                    const f32x4 c = bb + w0 * p2 + w1 * p1 + w2 * hq;
                    p2 = p1; p1 = hq;
                    if (bj == 0) gc[q] = c;
                    else { f32x4 a;
#pragma unroll
                        for (int e = 0; e < 4; ++e) a[e] = gelu_tanh(gc[q][e]) * c[e];
                        v2u w; w.x = pg8::cvt_pk_bf16(a[0], a[1]); w.y = pg8::cvt_pk_bf16(a[2], a[3]);
                        *(v2u*)(ap + (size_t)q * astr + 4 * n) = w; }
                }
            }
        }
        LDS_WAIT();
    }
};
template <class RowMap>
__device__ __forceinline__ void p0_transpose_item(const float* W, int ldw, int k0, int n0, bf16* WT, size_t ldt, int kcol0, RowMap drow, const float* kscale, LAS float* scr, int lane) {
#pragma unroll 8
    for (int i = 0; i < 32; ++i) { const int kk = 2 * i + (lane >> 5); float v = W[(size_t)(k0 + kk) * ldw + n0 + (lane & 31)]; if (kscale) v *= kscale[k0 + kk]; scr[kk * 33 + (lane & 31)] = v; }
    LDS_WAIT(); asm volatile("" ::: "memory");
    const int c = lane & 7;
#pragma unroll
    for (int j = 0; j < 4; ++j) { const int n = (lane >> 3) + 8 * j; const LAS float* s = scr + (8 * c) * 33 + n;
        v4u o; o.x = pk2(s[0 * 33], s[1 * 33]); o.y = pk2(s[2 * 33], s[3 * 33]); o.z = pk2(s[4 * 33], s[5 * 33]); o.w = pk2(s[6 * 33], s[7 * 33]);
        *(v4u*)(WT + (size_t)drow(n0 + n) * ldt + kcol0 + k0 + 8 * c) = o; }
    LDS_WAIT(); asm volatile("" ::: "memory");
}
struct RowId { __device__ __forceinline__ int operator()(int n) const { return n; } };
struct RowUp { __device__ __forceinline__ int operator()(int n) const { const int half = n >= DFF ? 1 : 0, c = n - half * DFF; return (c >> 7) * 256 + half * 128 + (c & 127); } };

__device__ __forceinline__ void p0_prologue(const KP& p, LAS unsigned char* lds, int vcu, int G, int wave, int lane) {
    LAS float* scr = (LAS float*)(lds + wave * 16384);
    const int gw = vcu * NWAVES + wave, NGW = G * NWAVES;
    unsigned char* ws = p.ws;
    bf16* Win_t = (bf16*)(ws + WS_WIN); bf16* Wg_t = (bf16*)(ws + WS_WG); bf16* Wbp_t = (bf16*)(ws + WS_WBP); bf16* Wpool_b = (bf16*)(ws + WS_WPOOL);
    constexpr int I_IN = (DM / 64) * (DIN / 32), I_SQ = (DM / 64) * (DM / 32), I_G = 32 * 2, I_PC = 4 * 256 * 256 / 512;
    constexpr int NITEMS = I_IN + I_SQ + I_G + I_PC;
    for (int it = gw; it < NITEMS; it += NGW) {
        int r = it;
        if (r < I_IN) { const int nblk = DIN / 32; p0_transpose_item(p.in[I_WIN], DIN, 64 * (r / nblk), 32 * (r % nblk), Win_t, DM, 0, RowId(), nullptr, scr, lane); continue; } r -= I_IN;
        if (r < I_SQ) { const int nblk = DM / 32; p0_transpose_item(p.in[I_WBRP], DM, 64 * (r / nblk), 32 * (r % nblk), Wbp_t, DM, 0, RowId(), p.in[I_PSCALE], scr, lane); continue; } r -= I_SQ;
        if (r < I_G) { const int mat = r >> 1, nb = r & 1; const float* W = (mat < 16 ? p.in[I_WRA] : p.in[I_WIX]) + (size_t)(mat & 15) * 4096;
          p0_transpose_item(W, 64, 0, 32 * nb, Wg_t + (size_t)mat * 4096, 64, 0, RowId(), nullptr, scr, lane); continue; } r -= I_G;
        { const float* s = p.in[I_WPOOL] + (size_t)r * 512 + lane * 8; const f32x4 a = *(const f32x4*)s, b = *(const f32x4*)(s + 4);
          v4u o; o.x = pk2(a[0], a[1]); o.y = pk2(a[2], a[3]); o.z = pk2(b[0], b[1]); o.w = pk2(b[2], b[3]); *(v4u*)(Wpool_b + (size_t)r * 512 + lane * 8) = o; }
    }
    {
        bf16* XN = (bf16*)(ws + WS_R0); const float* g1 = p.in[I_NMIX];
        f32x4 gv[4];
#pragma unroll
        for (int j = 0; j < 4; ++j) gv[j] = *((const f32x4*)g1 + lane + 64 * j);
        for (int m0 = gw; m0 < M; m0 += 2 * NGW) {
            f32x4 v[2][4]; float s[2];
#pragma unroll
            for (int r = 0; r < 2; ++r) { const int m = m0 + r * NGW; s[r] = 0.f;
                if (m < M) { const float* xrow = m < MP ? p.in[I_XP] + (size_t)m * DM : p.in[I_XS] + (size_t)(m - MP) * DM; const f32x4* xr = (const f32x4*)xrow + lane;
#pragma unroll
                    for (int j = 0; j < 4; ++j) v[r][j] = xr[64 * j]; } }
#pragma unroll
            for (int r = 0; r < 2; ++r) { const int m = m0 + r * NGW;
                if (m < M) {
#pragma unroll
                    for (int j = 0; j < 4; ++j) s[r] += (v[r][j][0] * v[r][j][0] + v[r][j][1] * v[r][j][1]) + (v[r][j][2] * v[r][j][2] + v[r][j][3] * v[r][j][3]);
                    const float rstd = 1.0f / sqrtf(wave_sum(s[r]) * (1.f / DM) + EPS);
                    v2u* o8 = (v2u*)(XN + (size_t)m * DM) + lane;
#pragma unroll
                    for (int j = 0; j < 4; ++j) { const f32x4 y = v[r][j] * rstd * gv[j]; v2u o; o.x = pk2(y[0], y[1]); o.y = pk2(y[2], y[3]); o8[64 * j] = o; } } }
        }
    }
}
__device__ __forceinline__ void p1_weights(const KP& p, LAS unsigned char* lds, int gw, int NGW, int wave, int lane) {
    LAS float* scr = (LAS float*)(lds + wave * 16384);
    unsigned char* ws = p.ws;
    bf16* Wcat_t = (bf16*)(ws + WS_WCAT); bf16* Wout_t = (bf16*)(ws + WS_WOUT); bf16* Wup_t = (bf16*)(ws + WS_WUP); bf16* Wdn_t = (bf16*)(ws + WS_WDN);
    constexpr int I_UP = (DM / 64) * (DUP / 32), I_SQ = (DM / 64) * (DM / 32), I_DN = (DFF / 64) * (DM / 32);
    for (int it = gw; it < I_UP + 2 * I_SQ + I_DN; it += NGW) {
        int r = it;
        if (r < I_SQ) { const int nblk = DM / 32; p0_transpose_item(p.in[I_WBRL], DM, 64 * (r / nblk), 32 * (r % nblk), Wcat_t, 2048, 0, RowId(), nullptr, scr, lane); continue; } r -= I_SQ;
        if (r < I_SQ) { const int nblk = DM / 32; p0_transpose_item(p.in[I_WOUT], DM, 64 * (r / nblk), 32 * (r % nblk), Wout_t, DM, 0, RowId(), nullptr, scr, lane); continue; } r -= I_SQ;
        if (r < I_UP) { const int nblk = DUP / 32; p0_transpose_item(p.in[I_WUP], DUP, 64 * (r / nblk), 32 * (r % nblk), Wup_t, DM, 0, RowUp(), p.in[I_NFFN]  , scr, lane); continue; } r -= I_UP;
        { const int nblk = DM / 32; p0_transpose_item(p.in[I_WDN], DM, 64 * (r / nblk), 32 * (r % nblk), Wdn_t, DFF, 0, RowId(), nullptr, scr, lane); }
    }
}

constexpr int XR_OFF = 0, XR_BYTES = 16 * 19 * 128, SEG_OFF = 40960, CIN_OFF = 45056;
template <bool FINAL>
__device__ __forceinline__ void lru_unit(const KP& p, LAS unsigned char* lds, int pm, int n, int tid, int lane, int wave) {
    constexpr bool samp = true;
    const bf16* ZR = (const bf16*)(p.ws + WS_R1); const bf16* Wg_t = (const bf16*)(p.ws + WS_WG);
    typedef float f32x2v __attribute__((ext_vector_type(2)));
    f32x2v* SUMM = (f32x2v*)(p.ws + WS_SUMM);
    bf16* HP = (bf16*)(p.ws + WS_R3);
    LAS unsigned char* XR = lds + XR_OFF; LAS f32x2v* SEG = (LAS f32x2v*)(lds + SEG_OFF); LAS float* CIN = (LAS float*)(lds + CIN_OFF);
    const int t0 = samp ? 0 : 256 * (pm & 15);
    __syncthreads();
    for (int idx = tid; idx < 304 * 8; idx += NWAVES * 64) {
        const int row = idx >> 3, ck = idx & 7, g = row / 19, k = row - g * 19, tt = 16 * g + k - 3;
        v4u v = {0u, 0u, 0u, 0u};
        if (!samp) { if (t0 + tt >= 0) v = *(const v4u*)(ZR + (size_t)(pm * 256 + tt) * 2048 + n * 64 + ck * 8); }
        else if (k < 3) { const float* s = p.in[I_STLC] + (size_t)(g * 3 + k) * DM + n * 64 + ck * 8; const f32x4 a = *(const f32x4*)s, b = *(const f32x4*)(s + 4);
            v.x = pk2(a[0], a[1]); v.y = pk2(a[2], a[3]); v.z = pk2(b[0], b[1]); v.w = pk2(b[2], b[3]); }
        else v = *(const v4u*)(ZR + (size_t)(MP + 16 * g + k - 3) * 2048 + n * 64 + ck * 8);
        *(LAS v4u*)(XR + row * 128 + ck * 16) = v;
    }
    if (FINAL && !samp && tid < 64) {
        const int npre = pm & 15; f32x2v sv[15];
#pragma unroll
        for (int k = 0; k < 15; ++k) sv[k] = (k < npre) ? SUMM[(size_t)(pm - npre + k) * DM + n * 64 + tid] : (f32x2v){1.f, 0.f};
        float c = 0.f;
#pragma unroll
        for (int k = 0; k < 15; ++k) c = sv[k].y + sv[k].x * c;
        CIN[tid] = c;
    }
    __syncthreads();
    const int i16 = lane & 15, fq = lane >> 4;
    const float* cwl = p.in[I_CLW]; const float* cbl = p.in[I_CLB];
    bf16x8 fa[2][2];
#pragma unroll
    for (int ks = 0; ks < 2; ++ks) {
        const int ch0 = 32 * ks + 8 * fq; f32x4 w[4][2], bb[2];
#pragma unroll
        for (int tp = 0; tp < 4; ++tp) { w[tp][0] = *(const f32x4*)(cwl + tp * DM + n * 64 + ch0); w[tp][1] = *(const f32x4*)(cwl + tp * DM + n * 64 + ch0 + 4); }
        bb[0] = *(const f32x4*)(cbl + n * 64 + ch0); bb[1] = *(const f32x4*)(cbl + n * 64 + ch0 + 4);
#pragma unroll
        for (int m = 0; m < 2; ++m) {
            const int tau = 8 * (i16 >> 2) + 4 * m + (i16 & 3), T = 32 * wave + tau, rb = (T >> 4) * 19 + (T & 15);
            f32x4 u0 = bb[0], u1 = bb[1];
#pragma unroll
            for (int tp = 0; tp < 4; ++tp) { const v4u x = *(const LAS v4u*)(XR + (rb + tp) * 128 + ch0 * 2);
                u0 += w[tp][0] * (f32x4){bflo(x.x), bfhi(x.x), bflo(x.y), bfhi(x.y)}; u1 += w[tp][1] * (f32x4){bflo(x.z), bfhi(x.z), bflo(x.w), bfhi(x.w)}; }
            v4u f; f.x = pk2(u0[0], u0[1]); f.y = pk2(u0[2], u0[3]); f.z = pk2(u1[0], u1[1]); f.w = pk2(u1[2], u1[3]);
            fa[m][ks] = __builtin_bit_cast(bf16x8, f);
        }
    }
    float hloc[4][8], pc[4][8], P8[4], H8[4];
    const int T0 = 32 * wave + 8 * fq, rb0 = (T0 >> 4) * 19 + (T0 & 15);
#pragma unroll
    for (int nb = 0; nb < 4; ++nb) {
        const int ch = 16 * nb + i16, gch = n * 64 + ch;
        f32x4 aR[2] = {{0.f, 0.f, 0.f, 0.f}, {0.f, 0.f, 0.f, 0.f}}, aI[2] = {{0.f, 0.f, 0.f, 0.f}, {0.f, 0.f, 0.f, 0.f}};
#pragma unroll
        for (int ks = 0; ks < 2; ++ks) {
            const bf16x8 bR = *(const bf16x8*)(Wg_t + (size_t)(n * 64 + ch) * 64 + 8 * fq + 32 * ks);
            const bf16x8 bI = *(const bf16x8*)(Wg_t + (size_t)((16 + n) * 64 + ch) * 64 + 8 * fq + 32 * ks);
#pragma unroll
            for (int m = 0; m < 2; ++m) { aR[m] = __builtin_amdgcn_mfma_f32_16x16x32_bf16(fa[m][ks], bR, aR[m], 0, 0, 0); aI[m] = __builtin_amdgcn_mfma_f32_16x16x32_bf16(fa[m][ks], bI, aI[m], 0, 0, 0); }
        }
        float x[11];
#pragma unroll
        for (int r = 0; r < 11; ++r) x[r] = __builtin_bit_cast(float, (unsigned)(*(const LAS unsigned short*)(XR + (rb0 + r) * 128 + ch * 2)) << 16);
        const float c0 = cwl[gch], c1 = cwl[DM + gch], c2 = cwl[2 * DM + gch], c3 = cwl[3 * DM + gch], cbv = cbl[gch];
        const float bra = p.in[I_BRA][gch], bix = p.in[I_BIX][gch], lam = p.in[I_LAM][gch];
        const float zz = -lam, sp = fmaxf(zz, 0.f) + log1pf(expf(-fabsf(zz))), c8 = -8.0f * sp;
        float hl = 0.f, P = 1.f;
#pragma unroll
        for (int q = 0; q < 8; ++q) {
            const float u = cbv + c0 * x[q] + c1 * x[q + 1] + c2 * x[q + 2] + c3 * x[q + 3];
            const float r = sigmoidf_fast(aR[q >> 2][q & 3] + bra), ig = sigmoidf_fast(aI[q >> 2][q & 3] + bix);
            const float la = r * c8, a = __builtin_amdgcn_exp2f(la * 1.4426950408889634f);
            const float x2 = 2.0f * la, em_small = -x2 * (1.0f + x2 * (0.5f + x2 * (0.16666667f + x2 * 0.041666668f))), em = (x2 > -0.05f) ? em_small : (1.0f - a * a);
            const float b = sqrtf(em) * ig * u;
            hl = a * hl + b; P = P * a;
            hloc[nb][q] = hl; pc[nb][q] = P;
        }
        P8[nb] = P; H8[nb] = hl;
    }
    float Pf[4][4], Hf[4][4];
#pragma unroll
    for (int nb = 0; nb < 4; ++nb)
#pragma unroll
        for (int f = 0; f < 4; ++f) { Pf[nb][f] = __shfl(P8[nb], i16 + 16 * f); Hf[nb][f] = __shfl(H8[nb], i16 + 16 * f); }
    if (!samp) {
        if (fq == 0) {
#pragma unroll
            for (int nb = 0; nb < 4; ++nb) { float hw = 0.f, pw = 1.f;
#pragma unroll
                for (int f = 0; f < 4; ++f) { hw = Hf[nb][f] + Pf[nb][f] * hw; pw *= Pf[nb][f]; }
                SEG[wave * 64 + 16 * nb + i16] = (f32x2v){pw, hw}; }
        }
        __syncthreads();
        if (!FINAL) {
            if (tid < 64) { float hu = 0.f, pu = 1.f;
#pragma unroll
                for (int w = 0; w < 8; ++w) { const f32x2v s = SEG[w * 64 + tid]; hu = s.y + s.x * hu; pu *= s.x; }
                SUMM[(size_t)pm * DM + n * 64 + tid] = (f32x2v){pu, hu}; }
            return;
        }
    }
#pragma unroll
    for (int nb = 0; nb < 4; ++nb) {
        const int ch = 16 * nb + i16, gch = n * 64 + ch;
        float c;
        if (!samp) {
            c = CIN[ch];
#pragma unroll
            for (int w = 0; w < 8; ++w) { const f32x2v s = SEG[w * 64 + ch]; if (w < wave) c = s.y + s.x * c; }
#pragma unroll
            for (int f = 0; f < 4; ++f) if (f < fq) c = Hf[nb][f] + Pf[nb][f] * c;
        } else {
            const int sq = 2 * wave + (fq >> 1);
            c = p.in[I_STH][(size_t)sq * DM + gch];
            if (fq & 1) { const float pp = (fq == 1) ? Pf[nb][0] : Pf[nb][2], hh = (fq == 1) ? Hf[nb][0] : Hf[nb][2]; c = hh + pp * c; }
        }
        bf16* hp = HP + (size_t)(pm * 256 + T0) * 2048 + gch; float hlast = 0.f;
#pragma unroll
        for (int q = 0; q < 8; ++q) { const float h = hloc[nb][q] + pc[nb][q] * c; hp[(size_t)q * 2048] = (bf16)f2bf(h); hlast = h; }
        if (!samp) { if ((pm & 15) == 15 && wave == 7 && fq == 3) p.out[OFF_HP + (size_t)(pm >> 4) * DM + gch] = hlast; }
        else if (fq & 1) p.out[OFF_HS + (size_t)(2 * wave + (fq >> 1)) * DM + gch] = hlast;
    }
}

constexpr int XL_BYTES = 33280, XL_SEG = 2 * XL_BYTES, XL_CW = XL_SEG + 4096;
__device__ __forceinline__ void lru_task(const KP& p, LAS unsigned char* lds, int s, int n, int hf, int tid, int lane, int wave) {
    const bf16* ZR = (const bf16*)(p.ws + WS_R1); const bf16* Wg_t = (const bf16*)(p.ws + WS_WG); bf16* HP = (bf16*)(p.ws + WS_R3);
    typedef float f32x2v __attribute__((ext_vector_type(2)));
    LAS f32x2v* SEG = (LAS f32x2v*)(lds + XL_SEG); LAS float* CW = (LAS float*)(lds + XL_CW);
    const int i16 = lane & 15, fq = lane >> 4;
    const float* cwl = p.in[I_CLW]; const float* cbl = p.in[I_CLB];
    const size_t rowbase = (size_t)s * SEQ;
    __syncthreads();
    if (tid < 320) { const int tp = tid >> 6, c = tid & 63; CW[tid] = tp < 4 ? cwl[tp * DM + n * 64 + c] : cbl[n * 64 + c]; }
    for (int idx = tid; idx < 259 * 8; idx += NWAVES * 64) { const int row = idx >> 3, ck = idx & 7; v4u v = {0u, 0u, 0u, 0u};
        if (row >= 3) v = *(const v4u*)(ZR + (rowbase + row - 3) * 2048 + n * 64 + ck * 8);
        *(LAS v4u*)(lds + row * 128 + ck * 16) = v; }
    bf16x8 bR[2][2], bI[2][2]; float c0[2], c1[2], c2[2], c3[2], cbv[2], bra[2], bix[2], c8[2], cin[2];
#pragma unroll
    for (int b2 = 0; b2 < 2; ++b2) { const int ch = 16 * (2 * hf + b2) + i16, gch = n * 64 + ch;
#pragma unroll
        for (int ks = 0; ks < 2; ++ks) { bR[b2][ks] = *(const bf16x8*)(Wg_t + (size_t)(n * 64 + ch) * 64 + 8 * fq + 32 * ks); bI[b2][ks] = *(const bf16x8*)(Wg_t + (size_t)((16 + n) * 64 + ch) * 64 + 8 * fq + 32 * ks); }
        c0[b2] = cwl[gch]; c1[b2] = cwl[DM + gch]; c2[b2] = cwl[2 * DM + gch]; c3[b2] = cwl[3 * DM + gch]; cbv[b2] = cbl[gch];
        bra[b2] = p.in[I_BRA][gch]; bix[b2] = p.in[I_BIX][gch];
        const float zz = -p.in[I_LAM][gch]; c8[b2] = -8.0f * (fmaxf(zz, 0.f) + log1pf(expf(-fabsf(zz)))) * 1.4426950408889634f;
        cin[b2] = 0.f; }
    __syncthreads();
    for (int tt = 0; tt < 16; ++tt) {
        LAS unsigned char* XR = lds + (tt & 1) * XL_BYTES; LAS unsigned char* XN_ = lds + ((tt + 1) & 1) * XL_BYTES;
        v4u pf[5];
        if (tt < 15) {
#pragma unroll
            for (int k = 0; k < 5; ++k) { const int idx = tid + k * (NWAVES * 64); if (idx < 259 * 8) pf[k] = *(const v4u*)(ZR + (rowbase + 256 * (tt + 1) - 3 + (idx >> 3)) * 2048 + n * 64 + (idx & 7) * 8); } }
        bf16x8 fa[2][2];
#pragma unroll
        for (int ks = 0; ks < 2; ++ks) { const int ch0 = 32 * ks + 8 * fq; f32x4 w[4][2], bb[2];
#pragma unroll
            for (int tp = 0; tp < 4; ++tp) { w[tp][0] = *(const LAS f32x4*)(CW + tp * 64 + ch0); w[tp][1] = *(const LAS f32x4*)(CW + tp * 64 + ch0 + 4); }
            bb[0] = *(const LAS f32x4*)(CW + 256 + ch0); bb[1] = *(const LAS f32x4*)(CW + 256 + ch0 + 4);
#pragma unroll
            for (int m = 0; m < 2; ++m) { const int rb = 32 * wave + 8 * (i16 >> 2) + 4 * m + (i16 & 3); f32x4 u0 = bb[0], u1 = bb[1];
#pragma unroll
                for (int tp = 0; tp < 4; ++tp) { const v4u x = *(const LAS v4u*)(XR + (rb + tp) * 128 + ch0 * 2);
                    u0 += w[tp][0] * (f32x4){bflo(x.x), bfhi(x.x), bflo(x.y), bfhi(x.y)}; u1 += w[tp][1] * (f32x4){bflo(x.z), bfhi(x.z), bflo(x.w), bfhi(x.w)}; }
                v4u f; f.x = pg8::cvt_pk_bf16(u0[0], u0[1]); f.y = pg8::cvt_pk_bf16(u0[2], u0[3]); f.z = pg8::cvt_pk_bf16(u1[0], u1[1]); f.w = pg8::cvt_pk_bf16(u1[2], u1[3]);
                fa[m][ks] = __builtin_bit_cast(bf16x8, f); } }
        float hloc[2][8], pc[2][8], P8[2], H8[2];
        const int rb0 = 32 * wave + 8 * fq;
#pragma unroll
        for (int b2 = 0; b2 < 2; ++b2) { const int ch = 16 * (2 * hf + b2) + i16;
            f32x4 aR[2] = {{0.f, 0.f, 0.f, 0.f}, {0.f, 0.f, 0.f, 0.f}}, aI[2] = {{0.f, 0.f, 0.f, 0.f}, {0.f, 0.f, 0.f, 0.f}};
#pragma unroll
            for (int ks = 0; ks < 2; ++ks)
#pragma unroll
                for (int m = 0; m < 2; ++m) { aR[m] = __builtin_amdgcn_mfma_f32_16x16x32_bf16(fa[m][ks], bR[b2][ks], aR[m], 0, 0, 0); aI[m] = __builtin_amdgcn_mfma_f32_16x16x32_bf16(fa[m][ks], bI[b2][ks], aI[m], 0, 0, 0); }
            float x[11];
#pragma unroll
            for (int r = 0; r < 11; ++r) x[r] = __builtin_bit_cast(float, (unsigned)(*(const LAS unsigned short*)(XR + (rb0 + r) * 128 + ch * 2)) << 16);
            float hl = 0.f, P = 1.f;
#pragma unroll
            for (int q = 0; q < 8; ++q) {
                const float u = cbv[b2] + c0[b2] * x[q] + c1[b2] * x[q + 1] + c2[b2] * x[q + 2] + c3[b2] * x[q + 3];
                const float r = sigmoidf_fast(aR[q >> 2][q & 3] + bra[b2]), ig = sigmoidf_fast(aI[q >> 2][q & 3] + bix[b2]);
                const float a = __builtin_amdgcn_exp2f(r * c8[b2]);
                const float b = __builtin_amdgcn_sqrtf(fmaxf(__builtin_fmaf(-a, a, 1.0f), 0.f)) * ig * u;
                hl = __builtin_fmaf(a, hl, b); P = P * a; hloc[b2][q] = hl; pc[b2][q] = P; }
            P8[b2] = P; H8[b2] = hl; }
        float Pf[2][4], Hf[2][4];
#pragma unroll
        for (int b2 = 0; b2 < 2; ++b2)
#pragma unroll
            for (int f = 0; f < 4; ++f) { Pf[b2][f] = __shfl(P8[b2], i16 + 16 * f); Hf[b2][f] = __shfl(H8[b2], i16 + 16 * f); }
        if (fq == 0) {
#pragma unroll
            for (int b2 = 0; b2 < 2; ++b2) { float hw = 0.f, pw = 1.f;
#pragma unroll
                for (int f = 0; f < 4; ++f) { hw = __builtin_fmaf(Pf[b2][f], hw, Hf[b2][f]); pw *= Pf[b2][f]; }
                SEG[(tt & 1) * 256 + wave * 32 + 16 * b2 + i16] = (f32x2v){pw, hw}; } }
        if (tt < 15) {
#pragma unroll
            for (int k = 0; k < 5; ++k) { const int idx = tid + k * (NWAVES * 64); if (idx < 259 * 8) *(LAS v4u*)(XN_ + (idx >> 3) * 128 + (idx & 7) * 16) = pf[k]; } }
        LDS_WAIT(); __syncthreads();
#pragma unroll
        for (int b2 = 0; b2 < 2; ++b2) { const int ch = 16 * (2 * hf + b2) + i16, gch = n * 64 + ch;
            float c = cin[b2], call = cin[b2];
#pragma unroll
            for (int w = 0; w < 8; ++w) { const f32x2v sg = SEG[(tt & 1) * 256 + w * 32 + 16 * b2 + i16]; call = __builtin_fmaf(sg.x, call, sg.y); if (w < wave) c = __builtin_fmaf(sg.x, c, sg.y); }
            cin[b2] = call;
#pragma unroll
            for (int f = 0; f < 4; ++f) if (f < fq) c = __builtin_fmaf(Pf[b2][f], c, Hf[b2][f]);
            bf16* hp = HP + (rowbase + 256 * tt + rb0) * 2048 + gch; float hlast = 0.f;
#pragma unroll
            for (int q = 0; q < 8; ++q) { const float h = __builtin_fmaf(pc[b2][q], c, hloc[b2][q]); hp[(size_t)q * 2048] = (bf16)f2bf(h); hlast = h; }
            if (tt == 15 && wave == 7 && fq == 3) p.out[OFF_HP + (size_t)s * DM + gch] = hlast; }
    }
}

__device__ __forceinline__ void pool_load8(const KP& p, const bf16* ZR, int pm, int tt, int run, int ch, float (&v)[8]) {
    const bool samp = (pm == STILE);
    if (!samp) {
        if (256 * (pm & 15) + tt < 0) {
#pragma unroll
            for (int e = 0; e < 8; ++e) v[e] = 0.f;
            return; }
        const v4u w = *(const v4u*)(ZR + (size_t)(pm * 256 + tt) * 2048 + 1024 + ch);
        v[0] = bflo(w.x); v[1] = bfhi(w.x); v[2] = bflo(w.y); v[3] = bfhi(w.y); v[4] = bflo(w.z); v[5] = bfhi(w.z); v[6] = bflo(w.w); v[7] = bfhi(w.w);
    } else {
        const int tl = tt - 16 * run;
        if (tl < 0) { const float* s = p.in[I_STPOOL] + (size_t)(run * 15 + 15 + tl) * DM + ch; const f32x4 a = *(const f32x4*)s, b = *(const f32x4*)(s + 4);
            v[0] = a[0]; v[1] = a[1]; v[2] = a[2]; v[3] = a[3]; v[4] = b[0]; v[5] = b[1]; v[6] = b[2]; v[7] = b[3]; }
        else { const v4u w = *(const v4u*)(ZR + (size_t)(MP + tt) * 2048 + 1024 + ch);
            v[0] = bflo(w.x); v[1] = bfhi(w.x); v[2] = bflo(w.y); v[3] = bfhi(w.y); v[4] = bflo(w.z); v[5] = bfhi(w.z); v[6] = bflo(w.w); v[7] = bfhi(w.w); }
    }
}
__device__ __forceinline__ void pool_unit(const KP& p, int pm, int g, int tid) {
    const bf16* ZR = (const bf16*)(p.ws + WS_R1); bf16* HP = (bf16*)(p.ws + WS_R3);
    const bool samp = (pm == STILE);
    const int oct = tid & 31, run = tid >> 5, ch = 256 * g + 8 * oct, w = 2 << g, tf = 16 * run;
    const int pos0 = samp ? PAST : 256 * (pm & 15) + tf;
    float s[8];
#pragma unroll
    for (int e = 0; e < 8; ++e) s[e] = 0.f;
    for (int k = 1; k < w; ++k) { float v[8]; pool_load8(p, ZR, pm, tf - k, run, ch, v);
#pragma unroll
        for (int e = 0; e < 8; ++e) s[e] += v[e]; }
    for (int i = 0; i < 16; ++i) {
        float v[8], o[8]; pool_load8(p, ZR, pm, tf + i, run, ch, v);
        const int cnt = min(pos0 + i + 1, w); const float inv = 1.0f / (float)cnt;
#pragma unroll
        for (int e = 0; e < 8; ++e) { s[e] += v[e]; o[e] = s[e] * inv - v[e]; }
        v4u ow; ow.x = pk2(o[0], o[1]); ow.y = pk2(o[2], o[3]); ow.z = pk2(o[4], o[5]); ow.w = pk2(o[6], o[7]);
        *(v4u*)(HP + (size_t)(pm * 256 + tf + i) * 2048 + 1024 + ch) = ow;
        float vo[8]; pool_load8(p, ZR, pm, tf + i - w + 1, run, ch, vo);
#pragma unroll
        for (int e = 0; e < 8; ++e) s[e] -= vo[e];
    }
}
__device__ __forceinline__ void state_copy(const KP& p, int gtid, int gthreads) {
    const bf16* ZR = (const bf16*)(p.ws + WS_R1);
    constexpr int N1 = NBATCH * 3 * DM, N2 = NBATCH * 15 * DM, N3 = SBATCH * 3 * DM, N4 = SBATCH * 15 * DM;
    for (int i = gtid; i < N1 + N2 + N3 + N4; i += gthreads) {
        int r = i; size_t row, col; float* dst;
        if (r < N1) { const int b = r / (3 * DM), k = (r / DM) % 3, c = r % DM; row = (size_t)b * SEQ + SEQ - 3 + k; col = c; dst = p.out + OFF_LCP + r; }
        else if ((r -= N1) < N2) { const int b = r / (15 * DM), k = (r / DM) % 15, c = r % DM; row = (size_t)b * SEQ + SEQ - 15 + k; col = 1024 + c; dst = p.out + OFF_PLP + r; }
        else if ((r -= N2) < N3) { const int b = r / (3 * DM), k = (r / DM) % 3, c = r % DM; row = (size_t)MP + b * SSEQ + SSEQ - 3 + k; col = c; dst = p.out + OFF_LCS + r; }
        else { r -= N3; const int b = r / (15 * DM), k = (r / DM) % 15, c = r % DM; row = (size_t)MP + b * SSEQ + SSEQ - 15 + k; col = 1024 + c; dst = p.out + OFF_PLS + r; }
        *dst = __builtin_bit_cast(float, (unsigned)ZR[row * 2048 + col] << 16);
    }
}

template <int MODE = 0> __device__ __forceinline__ void strip_pre(const KP& p, LAS unsigned char* lds, int pm0, int pn, int cnt, int tid, int lane, int wave) {
    const float* SSQ = (const float*)(p.ws + WS_SSQ); const bf16* XG2 = (const bf16*)(p.ws + WS_R1); const bf16* Wup_t = (const bf16*)(p.ws + WS_WUP);
    LAS float* RS = (LAS float*)(lds + RS_OFF); LAS float* ES = (LAS float*)(lds + EDGE_START_OFF); LAS float* CWL = (LAS float*)(lds + CWL_OFF);
    __syncthreads();
#pragma unroll
    for (int k = 0; k < 2; ++k) { const int idx = tid + k * (NWAVES * 64), vec = idx >> 8, col = idx & 255, oc = (col >> 7) * DFF + 128 * pn + (col & 127);
        CWL[idx] = vec < 3 ? p.in[I_CFW][(size_t)vec * DUP + oc] : p.in[I_CFB][oc]; }
    if (MODE != 2) for (int i = tid; i < cnt * 256; i += NWAVES * 64) RS[i] = row_rs(SSQ, (size_t)pm0 * 256 + i);
    ES[tid] = 0.f;
    __syncthreads();
}

__device__ __forceinline__ void strip_fix(const KP& p, int gtid, int gthreads) {
    const float* HA = (const float*)(p.ws + WS_HA); const float* HB = (const float*)(p.ws + WS_HB); bf16* ACT = (bf16*)(p.ws + WS_R2);
    const float* cw = p.in[I_CFW]; const float* cb = p.in[I_CFB];
    for (int i = gtid; i < 32 * 24 * 128; i += gthreads) {
        const int c = i & 127, sp = i >> 7, pn = sp % 24, sr = sp / 24;
        if ((sr & 3) == 0) continue;
        const float* ha = HA + (size_t)sp * 512; const float* hb = HB + (size_t)sp * 512;
        float hg[4], hv[4];
        hg[0] = ha[c]; hg[1] = ha[256 + c]; hg[2] = hb[c]; hg[3] = hb[256 + c];
        hv[0] = ha[128 + c]; hv[1] = ha[384 + c]; hv[2] = hb[128 + c]; hv[3] = hb[384 + c];
        const int og = 128 * pn + c, ov = DFF + og;
        const float g0 = cw[og], g1 = cw[DUP + og], g2 = cw[2 * DUP + og], gb = cb[og], v0 = cw[ov], v1 = cw[DUP + ov], v2 = cw[2 * DUP + ov], vb = cb[ov];
#pragma unroll
        for (int t = 0; t < 2; ++t) { const float cg = gb + g0 * hg[t] + g1 * hg[t + 1] + g2 * hg[t + 2], cv = vb + v0 * hv[t] + v1 * hv[t + 1] + v2 * hv[t + 2];
            ACT[((size_t)sr * 1024 + t) * DFF + og] = (bf16)f2bf(gelu_tanh(cg) * cv); }
    }
}

__device__ __forceinline__ void final_norm(const KP& p, int gw, int NGW, int lane) {
    const float* SSQ2 = (const float*)(p.ws + WS_SSQ2); const float* gf = p.in[I_NFIN];
    f32x4 gv[4];
#pragma unroll
    for (int j = 0; j < 4; ++j) gv[j] = *((const f32x4*)gf + lane + 64 * j);
    for (int m = gw; m < M; m += NGW) {
        const float sv = (lane < 32) ? SSQ2[(size_t)m * 32 + lane] : 0.f;
        const float rstd = 1.0f / sqrtf(wave_sum(sv) * (1.f / DM) + EPS);
        f32x4* yr = (f32x4*)(p.out + OFF_Y + (size_t)m * DM) + lane;
#pragma unroll
        for (int j = 0; j < 4; ++j) { const f32x4 v = yr[64 * j]; yr[64 * j] = v * rstd * gv[j]; }
    }
}
#ifndef MK_ONE_LAUNCH
#define MK_ONE_LAUNCH 1
#endif
#ifndef PG8_SP2
#define PG8_SP2 true
#endif
#ifndef PG8_ALIGN
#define PG8_ALIGN true
#endif
#ifndef FUSE_FINAL
#define FUSE_FINAL 1
#endif
constexpr int N_PHASES = 11;
__global__ void __launch_bounds__(NWAVES * 64, 2) mk_fwd(KP p) {
    extern __shared__ __attribute__((aligned(16))) unsigned char lds_raw[];
    LAS unsigned char* lds = (LAS unsigned char*)lds_raw;
    const int tid = threadIdx.x, lane = tid & 63, wave = __builtin_amdgcn_readfirstlane(tid >> 6);
    const int G = gridDim.x, bx = blockIdx.x, vcu = (G % 8 == 0) ? (bx % 8) * (G / 8) + bx / 8 : bx;
    volatile LAS unsigned* MISC = (volatile LAS unsigned*)(lds + MISC_OFF);
    if (tid < 32) MISC[tid] = 0u;
    __syncthreads();
    unsigned* ctl = (unsigned*)(p.ws + WS_CTL);
    const int lo = p.ph_lo, hi = p.ph_hi;
    XcdBarrier bar; bar.bar = ctl + CW_BAR; bar.x = 0; bar.st = MISC + 8;
    if (hi - lo > 1) bar = xcd_barrier_post(ctl + CW_BAR, MISC + 8);
#ifndef PH_MASK
#define PH_MASK 0xfff
#endif
#define IN(k) (((PH_MASK >> (k)) & 1) && lo <= (k) && (k) < hi)
#ifndef REP_MASK
#define REP_MASK 0
#endif
#define PH(k) if (IN(k)) for (int rep_ = 0; rep_ <= ((REP_MASK >> (k)) & 1); ++rep_)
#define REPBAR() do { if (rep_) xcd_barrier(bar); } while (0)
#define SEAM(k) do { if (IN(k) && IN((k) + 1)) xcd_barrier(bar); } while (0)
    unsigned char* ws = p.ws;
    bf16* XN = (bf16*)(ws + WS_R0); bf16* MG = (bf16*)(ws + WS_R0); bf16* ZR = (bf16*)(ws + WS_R1); bf16* XG2 = (bf16*)(ws + WS_R1);
    bf16* GT = (bf16*)(ws + WS_R2); bf16* HP = (bf16*)(ws + WS_R3); bf16* ACT = (bf16*)(ws + WS_R2);
    bf16* Win_t = (bf16*)(ws + WS_WIN); bf16* Wcat_t = (bf16*)(ws + WS_WCAT); bf16* Wout_t = (bf16*)(ws + WS_WOUT); bf16* Wup_t = (bf16*)(ws + WS_WUP); bf16* Wdn_t = (bf16*)(ws + WS_WDN);
    float* SSQ = (float*)(ws + WS_SSQ); float* SSQ2 = (float*)(ws + WS_SSQ2);
    float* Y = p.out + OFF_Y;

    PH(0) { REPBAR(); p0_prologue(p, lds, vcu, G, wave, lane); }
    SEAM(0);
    PH(1) { REPBAR();
        pg8::Gemm g{XN, Win_t, DM, DM, DM}; pg8::StaticOrder S; S.init(MP, DIN, G, bx);
        EpiZ E{ZR, GT};
        for (int su = bx; su < 64; su += G) pg8::sub_gemm<1>(lds, g, STILE, su >> 2, (su >> 1) & 1, su & 1, E);
        pg8::gemm_phase<EpiZ, pg8::StaticOrder, PG8_ALIGN, PG8_SP2>(lds, g, S, E);
        if (G > 64) { if (bx >= 64) p1_weights(p, lds, (bx - 64) * NWAVES + wave, (G - 64) * NWAVES, wave, lane); } else p1_weights(p, lds, bx * NWAVES + wave, G * NWAVES, wave, lane);
    }
    SEAM(1);
    PH(2) { REPBAR();
        state_copy(p, bx * NWAVES * 64 + tid, G * NWAVES * 64);
        for (int su = bx; su < 64; su += G) {
            const int g_ = su >> 4, q = su & 15; pg8::Gemm gw_{(const bf16*)(ws + WS_WBP) + 256 * g_, (const bf16*)(ws + WS_WPOOL) + (size_t)g_ * 65536, 256, DM, 256};
            EpiW EW{Wcat_t + 1024 + 256 * g_}; pg8::sub_gemm<1>(lds, gw_, q >> 2, 0, (q >> 1) & 1, q & 1, EW); }
        for (int t = bx; t < NBATCH * 32; t += G) lru_task(p, lds, t >> 5, (t >> 1) & 15, t & 1, tid, lane, wave);
        for (int L = bx; L < 16 + NTILE * 4; L += G) {
            if (L < 16) lru_unit<true>(p, lds, STILE, L, tid, lane, wave);
            else { const int r = L - 16; pool_unit(p, r >> 2, r & 3, tid); }
        }
    }
    if (IN(2) && IN(4)) xcd_barrier(bar);
    PH(4) { REPBAR();
        pg8::Gemm g{HP, Wcat_t, 2048, 2048, 2048}; pg8::StaticOrder S; S.init(MP, DM, G, bx);
        EpiBr E{GT, MG};
        pg8::gemm_phase<EpiBr, pg8::StaticOrder, PG8_ALIGN, PG8_SP2>(lds, g, S, E);
        for (int su = bx; su < 16; su += G) pg8::sub_gemm<1>(lds, g, STILE, su >> 2, (su >> 1) & 1, su & 1, E);
    }
    if (IN(4) && IN(6)) xcd_barrier(bar);
    PH(6) { REPBAR();
        pg8::Gemm g{MG, Wout_t, DM, DM, DM}; pg8::StaticOrder S; S.init(MP, DM, G, bx);
        EpiRes<false> E{p.in[I_XP], p.in[I_XS], Y, XG2, SSQ};
        pg8::gemm_phase<EpiRes<false>, pg8::StaticOrder, PG8_ALIGN, PG8_SP2>(lds, g, S, E);
        for (int su = bx; su < 16; su += G) pg8::sub_gemm<1>(lds, g, STILE, su >> 2, (su >> 1) & 1, su & 1, E);
    }
    SEAM(6);
    PH(7) { REPBAR();
        pg8::Gemm g{XG2, Wup_t, DM, DM, DM};
        { EpiUpS ES{ACT, p.in[I_CFW], p.in[I_CFB], p.in[I_STFFN], p.out + OFF_FCS, SSQ};
          for (int su = bx; su < 48; su += G) pg8::sub_gemm<2>(lds, g, STILE, su >> 1, su & 1, 0, ES); }
        for (int sidx = vcu; sidx < 768; sidx += G) {
            const int rg = sidx >> 8, v = sidx & 255, x = v >> 5, w = v & 31, pm0 = 4 * (4 * x + (w >> 3)), pn = 8 * rg + (w & 7);
            strip_pre(p, lds, pm0, pn, 4, tid, lane, wave);
            pg8::StripOrder S{pm0, pn, 4};
            EpiUp E{ACT, p.in[I_CFW], p.in[I_CFB], p.in[I_STFFN], p.out + OFF_FCP, p.out + OFF_FCS, lds, pm0, nullptr, (float*)(ws + WS_HA), (float*)(ws + WS_HB)};
            pg8::gemm_phase<EpiUp, pg8::StripOrder, true, PG8_SP2>(lds, g, S, E);
        }
    }
    SEAM(7);
    PH(8) { REPBAR(); strip_fix(p, bx * NWAVES * 64 + tid, G * NWAVES * 64); }
    SEAM(8);
    const bool fuse_final = (G == 256) && FUSE_FINAL;
    PH(9) { REPBAR();
        pg8::Gemm g{ACT, Wdn_t, DFF, DFF, DFF}; pg8::StaticOrder S; S.init(MP, DM, G, bx);
        if (fuse_final) {
            EpiFinal E{Y, XG2, p.in[I_NFIN], SSQ2, ctl + CW_PANEL, ctl + CW_BAR + XB_TMO, lds};
            pg8::gemm_phase<EpiFinal, pg8::StaticOrder, true  , PG8_SP2>(lds, g, S, E);
            for (int su = bx; su < 16; su += G) pg8::sub_gemm<1>(lds, g, STILE, su >> 2, (su >> 1) & 1, su & 1, E);
        } else {
            EpiRes<true> E{nullptr, nullptr, Y, XG2, SSQ2};
            pg8::gemm_phase<EpiRes<true>, pg8::StaticOrder, PG8_ALIGN, PG8_SP2>(lds, g, S, E);
            for (int su = bx; su < 16; su += G) pg8::sub_gemm<1>(lds, g, STILE, su >> 2, (su >> 1) & 1, su & 1, E);
        }
    }
#ifndef EXP
#define EXP 0
#endif
#if EXP != 0
    if (lo == 11) {
#if EXP == 1
        pg8::Gemm g{XG2, Wup_t, DM, DM, DM};
        for (int sidx = vcu; sidx < 768; sidx += G) {
            const int rg = sidx >> 8, v = sidx & 255, x = v >> 5, w = v & 31, pm0 = 4 * (4 * x + (w >> 3)), pn = 8 * rg + (w & 7);
            pg8::StripOrder S{pm0, pn, 4}; EpiNull<true> E;
            pg8::gemm_phase<EpiNull<true>, pg8::StripOrder, true, PG8_SP2>(lds, g, S, E);
        }
#elif EXP == 2
        pg8::Gemm g{XN, Win_t, DM, DM, DM}; pg8::StaticOrder S; S.init(MP, DIN, G, bx); EpiNull<false> E;
        pg8::gemm_phase<EpiNull<false>, pg8::StaticOrder, PG8_ALIGN, PG8_SP2>(lds, g, S, E);
#elif EXP == 3
        pg8::Gemm g{XG2, Wup_t, DM, DM, DM}; pg8::StaticOrder S; S.init(MP, DUP, G, bx); EpiNull<true> E;
        pg8::gemm_phase<EpiNull<true>, pg8::StaticOrder, true, PG8_SP2>(lds, g, S, E);
#elif EXP == 5
        pg8::Gemm g{XN, Win_t, DM, DM, DM}; pg8::StaticOrder S; S.init(MP, DIN, G, bx); EpiZScratch E{HP + (size_t)bx * 65536};
        pg8::gemm_phase<EpiZScratch, pg8::StaticOrder, PG8_ALIGN, PG8_SP2>(lds, g, S, E);
#elif EXP == 6
        pg8::Gemm g{XG2, Wup_t, DM, DM, DM};
        for (int sidx = vcu; sidx < 768; sidx += G) {
            const int rg = sidx >> 8, v = sidx & 255, x = v >> 5, w = v & 31, pm0 = 4 * (4 * x + (w >> 3)), pn = 8 * rg + (w & 7);
            strip_pre(p, lds, pm0, pn, 4, tid, lane, wave);
            pg8::StripOrder S{pm0, pn, 4};
            EpiUp E{ACT, p.in[I_CFW], p.in[I_CFB], p.in[I_STFFN], p.out + OFF_FCP, p.out + OFF_FCS, lds, pm0, HP + (size_t)bx * 256 * 128, nullptr, nullptr};
            pg8::gemm_phase<EpiUp, pg8::StripOrder, true, PG8_SP2>(lds, g, S, E);
        }
#elif EXP == 7
        pg8::Gemm g{XG2, Wup_t, DM, DM, DM};
        for (int sidx = vcu; sidx < 768; sidx += G) {
            const int rg = sidx >> 8, v = sidx & 255, x = v >> 5, w = v & 31, pm0 = 4 * (4 * x + (w >> 3)), pn = 8 * rg + (w & 7);
            strip_pre(p, lds, pm0, pn, 4, tid, lane, wave);
            pg8::StripOrder S{pm0, pn, 4}; EpiNull<true> E;
            pg8::gemm_phase<EpiNull<true>, pg8::StripOrder, true, PG8_SP2>(lds, g, S, E);
        }
#elif EXP == 8 || EXP == 9
        pg8::Gemm g{XG2, Wup_t, DM, DM, DM};
        for (int sidx = vcu; sidx < 768; sidx += G) {
            const int rg = sidx >> 8, v = sidx & 255, x = v >> 5, w = v & 31, pm0 = 4 * (4 * x + (w >> 3)), pn = 8 * rg + (w & 7);
            strip_pre<EXP - 7>(p, lds, pm0, pn, 4, tid, lane, wave);
            pg8::StripOrder S{pm0, pn, 4}; EpiNull<true> E;
            pg8::gemm_phase<EpiNull<true>, pg8::StripOrder, true, PG8_SP2>(lds, g, S, E);
        }
#elif EXP == 4
        pg8::Gemm g{ACT, Wdn_t, DFF, DFF, DFF}; pg8::StaticOrder S; S.init(MP, DM, G, bx); EpiNull<false> E;
        pg8::gemm_phase<EpiNull<false>, pg8::StaticOrder, true, PG8_SP2>(lds, g, S, E);
#endif
    }
#endif
    if (!fuse_final) { SEAM(9);
        PH(10) { REPBAR(); final_norm(p, vcu * NWAVES + wave, G * NWAVES, lane); } }
#undef IN
#undef SEAM
}

extern "C" void kernel_launch(void* const* d_in, const int* in_sizes, int n_in, void* d_out, int out_size, void* d_ws, size_t ws_size, hipStream_t stream) {
    static int grid = 0;
    if (grid == 0) {
        if (n_in != 26 || in_sizes[0] != MP * DM || (size_t)out_size != OUT_TOTAL || ws_size < WS_END) {
            fprintf(stderr, "kernel_launch: unexpected shapes: n_in %d in0 %d out %d ws %zu (need %zu)\n", n_in, n_in > 0 ? in_sizes[0] : -1, out_size, ws_size, (size_t)WS_END); grid = -1; return; }
        int dev = 0, cus = 0, per_cu = 0;
        if (hipGetDevice(&dev) != hipSuccess || hipDeviceGetAttribute(&cus, hipDeviceAttributeMultiprocessorCount, dev) != hipSuccess) { fprintf(stderr, "kernel_launch: device query failed\n"); grid = -1; return; }
        if (hipFuncSetAttribute((const void*)mk_fwd, hipFuncAttributeMaxDynamicSharedMemorySize, LDS_BYTES) != hipSuccess) { fprintf(stderr, "kernel_launch: hipFuncSetAttribute failed\n"); grid = -1; return; }
        if (hipOccupancyMaxActiveBlocksPerMultiprocessor(&per_cu, (const void*)mk_fwd, NWAVES * 64, LDS_BYTES) != hipSuccess || per_cu < 1) {
            fprintf(stderr, "kernel_launch: occupancy query reports %d blocks per CU\n", per_cu); (void)hipGetLastError(); per_cu = 1; }
        grid = cus;
        fprintf(stderr, "kernel_launch: grid %d (cus %d, occupancy %d/CU)\n", grid, cus, per_cu);
    }
    if (grid < 0) return;
    if (hipMemsetAsync((char*)d_ws + WS_CTL, 0, CTL_ZERO_BYTES, stream) != hipSuccess) { fprintf(stderr, "kernel_launch: memset failed\n"); return; }
    KP a{};
    for (int i = 0; i < 26; ++i) a.in[i] = (const float*)d_in[i];
    a.out = (float*)d_out; a.ws = (unsigned char*)d_ws;
#if MK_ONE_LAUNCH
    a.ph_lo = 0; a.ph_hi = N_PHASES;
    hipLaunchKernelGGL(mk_fwd, dim3(grid), dim3(NWAVES * 64), LDS_BYTES, stream, a);
#else
#ifndef PROBE_PHASE
#define PROBE_PHASE -1
#endif
    { const int phs[10] = {0, 1, 2, 4, 6, 7, 8, 9, 10, 11};
      for (int i = 0; i < 10; ++i) { if (phs[i] == 10 && FUSE_FINAL) continue; if (phs[i] == 11 && EXP == 0) continue; const int k = phs[i]; a.ph_lo = k; a.ph_hi = k + 1;
          for (int rep = 0; rep < (k == PROBE_PHASE ? 2 : 1); ++rep) hipLaunchKernelGGL(mk_fwd, dim3(grid), dim3(NWAVES * 64), LDS_BYTES, stream, a); } }
#endif
    const hipError_t le = hipPeekAtLastError();
    if (le != hipSuccess) fprintf(stderr, "kernel_launch: launch failed: %s\n", hipGetErrorName(le));
}
```

```cpp
#include <hip/hip_runtime.h>
#include <cstdio>
#include <cstdint>
#define MK_ONE_LAUNCH 1
namespace pg8 {
#define PG8_LAS __attribute__((address_space(3)))
typedef unsigned short bf16_t;
typedef short bf16x8 __attribute__((ext_vector_type(8)));
typedef float f32x4 __attribute__((ext_vector_type(4)));
typedef unsigned u32x4 __attribute__((ext_vector_type(4)));
typedef unsigned u32x2 __attribute__((ext_vector_type(2)));
constexpr int BM = 256, BK = 64, HALF = 128, HTB = HALF * BK * 2  , STAGE_BYTES = 8 * HTB, NXCD = 8, WGM = 8;

__host__ __device__ __forceinline__ int lds_byte(int r, int c) { const int st = (r >> 4) * 2 + (c >> 5), rr = r & 15, cc = c & 31, ob = rr * 64 + cc * 2; return st * 1024 + (ob ^ (((ob >> 9) & 1) << 5)); }
__host__ __device__ __forceinline__ void stage_rc(int b, int& R, int& C) { const int st = b / 1024, sb = b % 1024, swz = sb ^ (((sb >> 9) & 1) << 5); R = (st >> 1) * 16 + swz / 64; C = (st & 1) * 32 + (swz % 64) / 2; }
__host__ __device__ __forceinline__ int perm32(int rho) { const int n = rho >> 4, i = rho & 15; return 8 * (i >> 2) + 4 * n + (i & 3); }
__host__ __device__ __forceinline__ int amap_row(int R) { return 128 * (R >> 6) + 8 * (R & 15) + ((R >> 4) & 3); }

struct Unit { int pm, pn; };
struct Gemm { const bf16_t* A; const bf16_t* Bt; int K, lda, ldb; };

struct StaticOrder {
    int nM, nN, nwg, G, c;
    __host__ __device__ void init(int M, int N, int G_, int c_) { nM = M / BM; nN = N / BM; nwg = nM * nN; G = G_; c = c_; }
    __host__ __device__ bool next(int i, Unit& u) const {
        const long L = (long)i * G + c; if (L >= nwg) return false;
        int wgid = (int)L; { const int q = nwg / NXCD, r = nwg % NXCD, xcd = wgid % NXCD, off = wgid / NXCD; wgid = (xcd < r ? xcd * (q + 1) : r * (q + 1) + (xcd - r) * q) + off; }
        const int nig = WGM * nN, gid = wgid / nig, fm = gid * WGM, gsz = (nM - fm) < WGM ? (nM - fm) : WGM;
        u.pm = fm + ((wgid % nig) % gsz); u.pn = (wgid % nig) / gsz; return true;
    }
    __device__ __forceinline__ void a_ready(const Unit&) const {}
    __device__ __forceinline__ void done(const Unit&) const {}
};
struct StripOrder {
    int pm0, pn, cnt;
    __device__ __forceinline__ bool next(int i, Unit& u) const { if (i >= cnt) return false; u.pm = pm0 + i; u.pn = pn; return true; }
    __device__ __forceinline__ void a_ready(const Unit&) const {}
    __device__ __forceinline__ void done(const Unit&) const {}
};

__device__ __forceinline__ unsigned cvt_pk_bf16(float lo, float hi) { unsigned r; asm volatile("v_cvt_pk_bf16_f32 %0, %1, %2" : "=v"(r) : "v"(lo), "v"(hi)); return r; }

template <class Epi, class Sched, bool ALIGN_EPI = false, bool SP2 = false>
__device__ __forceinline__ void gemm_phase(PG8_LAS unsigned char* lds, const Gemm g, const Sched& S, const Epi& E) {
    const int tid = threadIdx.x, wid = __builtin_amdgcn_readfirstlane(tid >> 6), lane = tid & 63, wr = wid >> 2, wc = wid & 3, fr = lane & 15, fq = lane >> 4;
    const int K = g.K, nt = K / BK;
    unsigned voffA[2], voffB[2];
#pragma unroll
    for (int i = 0; i < 2; ++i) { int R, C; stage_rc(tid * 16 + i * 8192, R, C); const int Rb = Epi::PERM ? ((R & ~31) + perm32(R & 31)) : R; const int Ra = Epi::AMAP ? amap_row(R) : R;
        voffA[i] = (unsigned)(Ra * g.lda + C) * 2u; voffB[i] = (unsigned)(Rb * g.ldb + C) * 2u; }
    const size_t kstep = (size_t)(BK * 2);
    const size_t hstepA = Epi::AMAP ? (size_t)4 * g.lda * 2 : (size_t)HALF * g.lda * 2;
    const size_t hstepB = (size_t)HALF * g.ldb * 2;
    const size_t tstepA = (size_t)BM * g.lda * 2, tstepB = (size_t)BM * g.ldb * 2;
    const unsigned ldsw = (unsigned)wid * 1024u;
    const int aoff = lds_byte(wr * 64 + fr, fq * 8), boff = lds_byte(wc * 32 + fr, fq * 8);
#define PG8_SA(b, h) (((b) * 2 + (h)) * HTB)
#define PG8_SB(b, h) ((4 + (b) * 2 + (h)) * HTB)
#define PG8_STAGE(bufoff, gbase, voff) do { _Pragma("unroll") for (int _i = 0; _i < 2; ++_i) \
        __builtin_amdgcn_global_load_lds((const unsigned*)((const char*)(gbase) + (voff)[_i]), (PG8_LAS unsigned*)(lds + (bufoff) + ldsw + _i * 8192), 16, 0, 0); } while (0)
#define PG8_LDA(dst, b, h) do { _Pragma("unroll") for (int m = 0; m < 4; ++m) _Pragma("unroll") for (int k = 0; k < 2; ++k) dst[m][k] = *(const PG8_LAS bf16x8*)(lds + PG8_SA(b, h) + aoff + m * 2048 + k * 1024); } while (0)
#define PG8_LDB(dst, b, h) do { _Pragma("unroll") for (int n = 0; n < 2; ++n) _Pragma("unroll") for (int k = 0; k < 2; ++k) dst[n][k] = *(const PG8_LAS bf16x8*)(lds + PG8_SB(b, h) + boff + n * 2048 + k * 1024); } while (0)
#define PG8_MMA(ai, bj, At, Bt) do { __builtin_amdgcn_s_setprio(1); _Pragma("unroll") for (int m = 0; m < 4; ++m) _Pragma("unroll") for (int n = 0; n < 2; ++n) _Pragma("unroll") for (int k = 0; k < 2; ++k) \
        acc[ai][bj][m][n] = __builtin_amdgcn_mfma_f32_16x16x32_bf16(Bt[n][k], At[m][k], acc[ai][bj][m][n], 0, 0, 0); __builtin_amdgcn_s_setprio(0); } while (0)
#define PG8_WAIT_V(n) asm volatile("s_waitcnt vmcnt(" #n ")" ::: "memory")
#define PG8_WAIT_L(n) asm volatile("s_waitcnt lgkmcnt(" #n ")" ::: "memory")
#define PG8_BAR __builtin_amdgcn_s_barrier()
#define PG8_SCHED __builtin_amdgcn_sched_barrier(0)
    Unit cur, nxt; int ui = 0;
    if (!S.next(0, cur)) return;
    f32x4 acc[2][2][4][2];
#pragma unroll
    for (int a = 0; a < 2; ++a)
#pragma unroll
        for (int b = 0; b < 2; ++b)
#pragma unroll
            for (int m = 0; m < 4; ++m)
#pragma unroll
                for (int n = 0; n < 2; ++n) acc[a][b][m][n] = (f32x4){0.f, 0.f, 0.f, 0.f};
    bf16x8 At[4][2], B0[2][2], B1[2][2];
    const char* cA = (const char*)g.A + (size_t)cur.pm * tstepA; const char* cB = (const char*)g.Bt + (size_t)cur.pn * tstepB;
    S.a_ready(cur);
    if constexpr (SP2) {
        PG8_STAGE(PG8_SB(0, 0), cB, voffB); PG8_STAGE(PG8_SB(0, 1), cB + hstepB, voffB); PG8_STAGE(PG8_SA(0, 0), cA, voffA); PG8_STAGE(PG8_SA(0, 1), cA + hstepA, voffA);
        if (wr == 1) PG8_BAR;
        PG8_WAIT_V(2); PG8_BAR;
        PG8_STAGE(PG8_SB(1, 0), cB + kstep, voffB); PG8_STAGE(PG8_SA(1, 0), cA + kstep, voffA); PG8_STAGE(PG8_SB(1, 1), cB + hstepB + kstep, voffB);
        PG8_WAIT_V(6); PG8_BAR;
    } else {
        PG8_STAGE(PG8_SB(0, 0), cB, voffB); PG8_STAGE(PG8_SA(0, 0), cA, voffA); PG8_STAGE(PG8_SB(0, 1), cB + hstepB, voffB); PG8_STAGE(PG8_SA(0, 1), cA + hstepA, voffA);
        if (wr == 1) PG8_BAR;
        PG8_WAIT_V(4); PG8_BAR;
        PG8_STAGE(PG8_SB(1, 0), cB + kstep, voffB); PG8_STAGE(PG8_SA(1, 0), cA + kstep, voffA); PG8_STAGE(PG8_SB(1, 1), cB + hstepB + kstep, voffB);
        PG8_WAIT_V(6); PG8_BAR;
    }
    for (;;) {
        const bool has_next = S.next(ui + 1, nxt);
        const char* nA = has_next ? (const char*)g.A + (size_t)nxt.pm * tstepA : cA; const char* nB = has_next ? (const char*)g.Bt + (size_t)nxt.pn * tstepB : cB;
        for (int t = 0; t < nt; t += 2) {
            const bool last = (t == nt - 2);
            const char* a1 = cA + (size_t)(t + 1) * kstep;
            const char* a2 = last ? nA : cA + (size_t)(t + 2) * kstep; const char* b2 = last ? nB : cB + (size_t)(t + 2) * kstep;
            const char* a3 = a2 + kstep; const char* b3 = b2 + kstep;
            if (last && has_next) S.a_ready(nxt);
            if constexpr (Epi::MID) { if (t == (nt >> 1)) E.template mid<2, 2>(acc, cur, 0, 0, wr, wc, fr, fq); }
            if constexpr (SP2) {
            PG8_LDB(B0, 0, 0); PG8_LDB(B1, 0, 1); PG8_SCHED; PG8_LDA(At, 0, 0); PG8_STAGE(PG8_SA(1, 1), a1 + hstepA, voffA);
            PG8_WAIT_V(8); PG8_WAIT_L(0); PG8_BAR; PG8_MMA(0, 0, At, B0); PG8_MMA(0, 1, At, B1); PG8_BAR; PG8_SCHED;
            PG8_LDA(At, 0, 1); PG8_STAGE(PG8_SB(0, 0), b2, voffB); PG8_STAGE(PG8_SB(0, 1), b2 + hstepB, voffB); PG8_STAGE(PG8_SA(0, 0), a2, voffA);
            PG8_WAIT_V(8); PG8_WAIT_L(0); PG8_BAR; PG8_MMA(1, 0, At, B0); PG8_MMA(1, 1, At, B1); PG8_BAR; PG8_SCHED;
            PG8_LDB(B0, 1, 0); PG8_LDB(B1, 1, 1); PG8_SCHED; PG8_LDA(At, 1, 0); PG8_STAGE(PG8_SA(0, 1), a2 + hstepA, voffA);
            PG8_WAIT_V(8); PG8_WAIT_L(0); PG8_BAR; PG8_MMA(0, 0, At, B0); PG8_MMA(0, 1, At, B1); PG8_BAR; PG8_SCHED;
            PG8_LDA(At, 1, 1); PG8_STAGE(PG8_SB(1, 0), b3, voffB); PG8_STAGE(PG8_SB(1, 1), b3 + hstepB, voffB); PG8_STAGE(PG8_SA(1, 0), a3, voffA);
            PG8_WAIT_V(8); PG8_WAIT_L(0); PG8_BAR; PG8_MMA(1, 0, At, B0); PG8_MMA(1, 1, At, B1); PG8_BAR; PG8_SCHED;
            } else {
            PG8_LDB(B0, 0, 0); PG8_SCHED; PG8_LDA(At, 0, 0); PG8_STAGE(PG8_SA(1, 1), a1 + hstepA, voffA);
            PG8_WAIT_L(8); PG8_BAR; PG8_WAIT_L(0); PG8_MMA(0, 0, At, B0); PG8_BAR; PG8_SCHED;
            PG8_LDB(B1, 0, 1); PG8_STAGE(PG8_SB(0, 0), b2, voffB);
            PG8_BAR; PG8_WAIT_L(0); PG8_MMA(0, 1, At, B1); PG8_BAR;
            PG8_LDA(At, 0, 1); PG8_STAGE(PG8_SA(0, 0), a2, voffA);
            PG8_BAR; PG8_WAIT_L(0); PG8_MMA(1, 0, At, B0); PG8_BAR; PG8_SCHED;
            PG8_STAGE(PG8_SB(0, 1), b2 + hstepB, voffB);
            PG8_WAIT_V(6); PG8_BAR; PG8_MMA(1, 1, At, B1); PG8_BAR;
            PG8_LDB(B0, 1, 0); PG8_SCHED; PG8_LDA(At, 1, 0); PG8_STAGE(PG8_SA(0, 1), a2 + hstepA, voffA);
            PG8_WAIT_L(8); PG8_BAR; PG8_WAIT_L(0); PG8_MMA(0, 0, At, B0); PG8_BAR; PG8_SCHED;
            PG8_LDB(B1, 1, 1); PG8_STAGE(PG8_SB(1, 0), b3, voffB);
            PG8_BAR; PG8_WAIT_L(0); PG8_MMA(0, 1, At, B1); PG8_BAR;
            PG8_LDA(At, 1, 1); PG8_STAGE(PG8_SA(1, 0), a3, voffA);
            PG8_BAR; PG8_WAIT_L(0); PG8_MMA(1, 0, At, B0); PG8_BAR; PG8_SCHED;
            PG8_STAGE(PG8_SB(1, 1), b3 + hstepB, voffB);
            PG8_WAIT_V(6); PG8_BAR; PG8_MMA(1, 1, At, B1); PG8_BAR;
            }
        }
        if constexpr (ALIGN_EPI) { if (wr == 0) PG8_BAR; }
        E.template run<2, 2>(acc, cur, 0, 0, wr, wc, fr, fq); S.done(cur);
        if (!has_next) break;
#pragma unroll
        for (int a = 0; a < 2; ++a)
#pragma unroll
            for (int b = 0; b < 2; ++b)
#pragma unroll
                for (int m = 0; m < 4; ++m)
#pragma unroll
                    for (int n = 0; n < 2; ++n) acc[a][b][m][n] = (f32x4){0.f, 0.f, 0.f, 0.f};
        cur = nxt; cA = nA; cB = nB; ++ui;
        if constexpr (ALIGN_EPI) { if (wr == 1) PG8_BAR; }
    }
    PG8_WAIT_V(0);
    if constexpr (!ALIGN_EPI) { if (wr == 0) PG8_BAR; }
    PG8_BAR;
#undef PG8_SA
#undef PG8_SB
#undef PG8_STAGE
#undef PG8_LDA
#undef PG8_LDB
#undef PG8_MMA
#undef PG8_WAIT_V
#undef PG8_WAIT_L
#undef PG8_BAR
#undef PG8_SCHED
}

template <int NB, class Epi>
__device__ __forceinline__ void sub_gemm(PG8_LAS unsigned char* lds, const Gemm g, int pm, int pn, int ai0, int bj0, const Epi& E) {
    int tid_ = threadIdx.x; asm volatile("" : "+v"(tid_));
    const int tid = tid_, wid = __builtin_amdgcn_readfirstlane(tid >> 6), lane = tid & 63, wr = wid >> 2, wc = wid & 3, fr = lane & 15, fq = lane >> 4;
    const int nt = g.K / BK;
    unsigned voffA[2], voffB[2];
#pragma unroll
    for (int i = 0; i < 2; ++i) { int R, C; stage_rc(tid * 16 + i * 8192, R, C); const int Rb = Epi::PERM ? ((R & ~31) + perm32(R & 31)) : R;
        voffA[i] = (unsigned)(R * g.lda + C) * 2u; voffB[i] = (unsigned)(Rb * g.ldb + C) * 2u; }
    const size_t kstep = (size_t)(BK * 2), hstepB = (size_t)HALF * g.ldb * 2;
    const unsigned ldsw = (unsigned)wid * 1024u;
    const int aoff = lds_byte(wr * 64 + fr, fq * 8), boff = lds_byte(wc * 32 + fr, fq * 8);
    const char* cA = (const char*)g.A + ((size_t)pm * BM + (size_t)ai0 * HALF) * g.lda * 2; const char* cB = (const char*)g.Bt + ((size_t)pn * BM + (size_t)bj0 * HALF) * g.ldb * 2;
#define SG_BUF(b, j) ((b) * 3 * HTB + (j) * HTB)
#define SG_STAGE(bufoff, gbase, voff) do { _Pragma("unroll") for (int _i = 0; _i < 2; ++_i) \
        __builtin_amdgcn_global_load_lds((const unsigned*)((const char*)(gbase) + (voff)[_i]), (PG8_LAS unsigned*)(lds + (bufoff) + ldsw + _i * 8192), 16, 0, 0); } while (0)
    f32x4 acc[1][NB][4][2];
#pragma unroll
    for (int b = 0; b < NB; ++b)
#pragma unroll
        for (int m = 0; m < 4; ++m)
#pragma unroll
            for (int n = 0; n < 2; ++n) acc[0][b][m][n] = (f32x4){0.f, 0.f, 0.f, 0.f};
    SG_STAGE(SG_BUF(0, 0), cA, voffA);
#pragma unroll
    for (int j = 0; j < NB; ++j) SG_STAGE(SG_BUF(0, 1 + j), cB + j * hstepB, voffB);
#pragma unroll 1
    for (int t = 0; t < nt; ++t) {
        const int cur = t & 1;
        if constexpr (Epi::MID) { if (t == (nt >> 1)) E.template mid<1, NB>(acc, Unit{pm, pn}, ai0 * HALF, bj0 * HALF, wr, wc, fr, fq); }
        if (t + 1 < nt) {
            SG_STAGE(SG_BUF(cur ^ 1, 0), cA + (size_t)(t + 1) * kstep, voffA);
#pragma unroll
            for (int j = 0; j < NB; ++j) SG_STAGE(SG_BUF(cur ^ 1, 1 + j), cB + j * hstepB + (size_t)(t + 1) * kstep, voffB);
            if constexpr (NB == 1) asm volatile("s_waitcnt vmcnt(4)" ::: "memory"); else asm volatile("s_waitcnt vmcnt(6)" ::: "memory");
        } else asm volatile("s_waitcnt vmcnt(0)" ::: "memory");
        __builtin_amdgcn_s_barrier();
        bf16x8 At[4][2], Bf[NB][2][2];
#pragma unroll
        for (int m = 0; m < 4; ++m)
#pragma unroll
            for (int k = 0; k < 2; ++k) At[m][k] = *(const PG8_LAS bf16x8*)(lds + SG_BUF(cur, 0) + aoff + m * 2048 + k * 1024);
#pragma unroll
        for (int j = 0; j < NB; ++j)
#pragma unroll
            for (int n = 0; n < 2; ++n)
#pragma unroll
                for (int k = 0; k < 2; ++k) Bf[j][n][k] = *(const PG8_LAS bf16x8*)(lds + SG_BUF(cur, 1 + j) + boff + n * 2048 + k * 1024);
        asm volatile("s_waitcnt lgkmcnt(0)" ::: "memory"); __builtin_amdgcn_sched_barrier(0);
#pragma unroll
        for (int j = 0; j < NB; ++j)
#pragma unroll
            for (int m = 0; m < 4; ++m)
#pragma unroll
                for (int n = 0; n < 2; ++n)
#pragma unroll
                    for (int k = 0; k < 2; ++k) acc[0][j][m][n] = __builtin_amdgcn_mfma_f32_16x16x32_bf16(Bf[j][n][k], At[m][k], acc[0][j][m][n], 0, 0, 0);
        __builtin_amdgcn_s_barrier();
    }
    E.template run<1, NB>(acc, Unit{pm, pn}, ai0 * HALF, bj0 * HALF, wr, wc, fr, fq);
#undef SG_BUF
#undef SG_STAGE
}
}
constexpr int NWAVES = 8;
constexpr int DM = 1024, NBATCH = 8, SEQ = 4096, SBATCH = 16, SSEQ = 16, PAST = 2048;
constexpr int MP = NBATCH * SEQ, MS = SBATCH * SSEQ, M = MP + MS, NTILE = M / 256, STILE = MP / 256;
constexpr int DIN = 4096, DFF = 3072, DUP = 6144;
constexpr float EPS = 1e-6f;
constexpr size_t OFF_Y = 0, OFF_HP = (size_t)M * DM, OFF_LCP = OFF_HP + NBATCH * DM, OFF_PLP = OFF_LCP + NBATCH * 3 * DM, OFF_FCP = OFF_PLP + NBATCH * 15 * DM,
                 OFF_HS = OFF_FCP + NBATCH * 2 * DUP, OFF_LCS = OFF_HS + SBATCH * DM, OFF_PLS = OFF_LCS + SBATCH * 3 * DM, OFF_FCS = OFF_PLS + SBATCH * 15 * DM,
                 OUT_TOTAL = OFF_FCS + SBATCH * 2 * DUP;
constexpr size_t MiB = 1u << 20;
constexpr size_t WS_CTL = 0, CTL_ZERO_BYTES = 64 * 1024;
constexpr size_t WS_WIN = 1 * MiB, WS_WCAT = 9 * MiB, WS_WOUT = 13 * MiB, WS_WUP = 15 * MiB, WS_WDN = 27 * MiB, WS_WG = 33 * MiB;
constexpr size_t WS_SSQ = 33 * MiB + 512 * 1024, WS_SSQ2 = 37 * MiB + 768 * 1024, WS_SUMM = WS_SSQ;
static_assert(WS_SSQ + (size_t)M * 128 <= WS_SSQ2 && WS_SSQ2 + (size_t)M * 128 <= 42 * MiB, "ssq map");
constexpr size_t WS_R0 = 42 * MiB, WS_R1 = 107 * MiB, WS_R2 = 236 * MiB, WS_R3 = 365 * MiB, WS_WBP = 494 * MiB, WS_WPOOL = 496 * MiB, WS_HA = 497 * MiB, WS_HB = 499 * MiB, WS_END = 501 * MiB;
static_assert((size_t)M * DM * 2 <= WS_R1 - WS_R0 && (size_t)M * 2048 * 2 <= WS_R2 - WS_R1 && (size_t)M * 2048 * 2 <= WS_R3 - WS_R2 && (size_t)M * 2048 * 2 <= WS_END - WS_R3 && (size_t)M * DFF * 2 <= WS_END - WS_R2, "ws map");
constexpr int CW_BAR = 1024, CW_PANEL = 8192;
constexpr int RING_BYTES = 131072;
constexpr int MISC_OFF = RING_BYTES, RS_OFF = RING_BYTES + 512, EDGE_START_OFF = RS_OFF + 4096, EDGE_MID_OFF = EDGE_START_OFF + 2048, EDGE_PREV_OFF = EDGE_MID_OFF + 2048;
constexpr int CWL_OFF = EDGE_PREV_OFF + 4096;
constexpr int LDS_BYTES = 155648;
static_assert(CWL_OFF + 4096 <= LDS_BYTES, "LDS map");

#define GAS __attribute__((address_space(1)))
#define LAS __attribute__((address_space(3)))
typedef unsigned short bf16;
typedef unsigned v4u __attribute__((ext_vector_type(4)));
typedef unsigned v2u __attribute__((ext_vector_type(2)));
typedef float f32x4 __attribute__((ext_vector_type(4)));
typedef short bf16x8 __attribute__((ext_vector_type(8)));
#define LDS_WAIT() asm volatile("s_waitcnt lgkmcnt(0)" ::: "memory")
#define VM_WAIT() asm volatile("s_waitcnt vmcnt(0)" ::: "memory")
__device__ __forceinline__ unsigned f2bf(float f) { unsigned u = __builtin_bit_cast(unsigned, f); return (u + 0x7fffu + ((u >> 16) & 1u)) >> 16; }
__device__ __forceinline__ unsigned pk2(float lo, float hi) { return f2bf(lo) | (f2bf(hi) << 16); }
__device__ __forceinline__ float bflo(unsigned w) { return __builtin_bit_cast(float, w << 16); }
__device__ __forceinline__ float bfhi(unsigned w) { return __builtin_bit_cast(float, w & 0xffff0000u); }
__device__ __forceinline__ float sigmoidf_fast(float x) { return __builtin_amdgcn_rcpf(1.0f + __builtin_amdgcn_exp2f(-1.4426950408889634f * x)); }
__device__ __forceinline__ float gelu_tanh(float g) { const float z = g * (1.0f + 0.044715f * g * g); return g * __builtin_amdgcn_rcpf(1.0f + __builtin_amdgcn_exp2f(-2.302208198f * z)); }
__device__ __forceinline__ float dpp_shr1(float v) { return __builtin_bit_cast(float, __builtin_amdgcn_update_dpp(__builtin_bit_cast(int, v), __builtin_bit_cast(int, v), 0x111  , 0xf, 0xf, false)); }
__device__ __forceinline__ float wave_sum(float v) {
#pragma unroll
    for (int o = 1; o < 64; o <<= 1) v += __shfl_xor(v, o);
    return v;
}

#define XB_TMO      128
#define XB_XCNT(j)  (256  + 64 * (j))
#define XB_XSUB(j)  (1280 + 64 * (j))
#define XB_XGEN(j)  (2304 + 64 * (j))
#define XB_TOP      3328
#define XB_TOPGEN   3392
#define XCD_BAR_WORDS 3456
#define XB_SPIN_CAP (1u << 20)
static_assert((CW_BAR + XCD_BAR_WORDS) <= CW_PANEL && (CW_PANEL + 32 * 132) * 4 <= (int)CTL_ZERO_BYTES, "control words inside the memset region");
__device__ __forceinline__ unsigned xb_ld(unsigned* p)              { return __hip_atomic_load(p, __ATOMIC_RELAXED, __HIP_MEMORY_SCOPE_AGENT); }
__device__ __forceinline__ unsigned xb_add(unsigned* p, unsigned v) { return __hip_atomic_fetch_add(p, v, __ATOMIC_RELAXED, __HIP_MEMORY_SCOPE_AGENT); }
__device__ __forceinline__ unsigned xb_xcc_id() { return (unsigned)__builtin_amdgcn_s_getreg((3 << 11) | 20) & 0xFu; }
#define XB_SPIN(cond, bar) do { unsigned _sp = 0; while (cond) { __builtin_amdgcn_s_sleep(1); \
    if ((++_sp & 255u) == 0u) { if (xb_ld(&(bar)[XB_TMO])) break; if (_sp > XB_SPIN_CAP) { atomicAdd(&(bar)[XB_TMO], 1u); break; } } } } while (0)
struct XcdBarrier { unsigned* bar; unsigned x; volatile LAS unsigned* st; };
__device__ __forceinline__ XcdBarrier xcd_barrier_post(unsigned* bar, volatile LAS unsigned* st) {
    XcdBarrier b; b.bar = bar; b.x = xb_xcc_id(); b.st = st;
    if (threadIdx.x == 0) (void)xb_add(&bar[XB_XCNT(b.x)], 1u);
    return b;
}
__device__ __forceinline__ void xcd_barrier_complete(unsigned* bar, unsigned x, unsigned& nloc, unsigned& nx) {
    const unsigned G = gridDim.x * gridDim.y * gridDim.z;
    unsigned sum, cnt, mine, sp = 0u;
    for (;;) {
        sum = 0u; cnt = 0u; mine = 0u;
#pragma unroll
        for (unsigned j = 0; j < 16; ++j) { const unsigned c = xb_ld(&bar[XB_XCNT(j)]); sum += c; cnt += (c > 0u) ? 1u : 0u; mine = (j == x) ? c : mine; }
        if (sum == G) break;
        __builtin_amdgcn_s_sleep(1);
        if ((++sp & 255u) == 0u) { if (xb_ld(&bar[XB_TMO])) break; if (sp > XB_SPIN_CAP) { atomicAdd(&bar[XB_TMO], 1u); break; } }
    }
    nloc = mine > 0u ? mine : 1u; nx = cnt > 0u ? cnt : 1u;
}
__device__ __forceinline__ void xcd_barrier(const XcdBarrier& b) {
    asm volatile("s_waitcnt vmcnt(0)" ::: "memory");
    __syncthreads();
    if (threadIdx.x == 0) {
        unsigned* bar = b.bar;
        __builtin_amdgcn_s_waitcnt(0);
        unsigned nloc = b.st[0], nx = b.st[1];
        if (nloc == 0u) { xcd_barrier_complete(bar, b.x, nloc, nx); b.st[0] = nloc; b.st[1] = nx; }
        const unsigned old = xb_add(&bar[XB_XSUB(b.x)], 1u);
        const unsigned gen = old / nloc;
        if (old + 1u == (gen + 1u) * nloc) {
            __builtin_amdgcn_fence(__ATOMIC_RELEASE, "agent");
            asm volatile("s_waitcnt vmcnt(0)" ::: "memory");
            const unsigned og = xb_add(&bar[XB_TOP], 1u);
            const unsigned tg = og / nx;
            if (og + 1u == (tg + 1u) * nx) xb_add(&bar[XB_TOPGEN], 1u);
            else XB_SPIN(xb_ld(&bar[XB_TOPGEN]) == tg, bar);
            __builtin_amdgcn_fence(__ATOMIC_ACQUIRE, "agent");
            xb_add(&bar[XB_XGEN(b.x)], 1u);
            asm volatile("s_waitcnt vmcnt(0)" ::: "memory");
        } else {
            XB_SPIN(xb_ld(&bar[XB_XGEN(b.x)]) == gen, bar);
            __builtin_amdgcn_fence(__ATOMIC_ACQUIRE, "agent");
            asm volatile("s_waitcnt vmcnt(0)" ::: "memory");
        }
    }
    __syncthreads();
}

struct KP {
    const float* in[26];
    float* out; unsigned char* ws;
    int ph_lo, ph_hi;
};
enum { I_XP = 0, I_XS, I_STH, I_STLC, I_STPOOL, I_STFFN, I_NMIX, I_WIN, I_CLW, I_CLB, I_WRA, I_BRA, I_WIX, I_BIX, I_LAM, I_WPOOL, I_PSCALE, I_WBRL, I_WBRP, I_WOUT, I_NFFN, I_WUP, I_CFW, I_CFB, I_WDN, I_NFIN };

using pg8::Unit;
struct EpiZ {
    static constexpr bool PERM = true, AMAP = false, MID = false;
    bf16* ZR; bf16* G;
    template <int NA, int NB> __device__ __forceinline__ void run(f32x4 (&acc)[NA][NB][4][2], const Unit& u, int rowoff, int coloff, int wr, int wc, int fr, int fq) const {
        const int row0 = u.pm * 256 + rowoff + wr * 64 + fr; const bool gate = u.pn >= 8;
        bf16* base = gate ? G : ZR; const int col0 = (u.pn & 7) * 256 + coloff + wc * 32 + 8 * fq;
#pragma unroll
        for (int ai = 0; ai < NA; ++ai)
#pragma unroll
            for (int m = 0; m < 4; ++m) { bf16* rowp = base + (size_t)(row0 + ai * 128 + m * 16) * 2048 + col0;
#pragma unroll
                for (int bj = 0; bj < NB; ++bj) { f32x4 v0 = acc[ai][bj][m][0], v1 = acc[ai][bj][m][1];
                    if (gate) {
#pragma unroll
                        for (int j = 0; j < 4; ++j) { v0[j] = sigmoidf_fast(v0[j]); v1[j] = sigmoidf_fast(v1[j]); } }
                    v4u w; w.x = pg8::cvt_pk_bf16(v0[0], v0[1]); w.y = pg8::cvt_pk_bf16(v0[2], v0[3]); w.z = pg8::cvt_pk_bf16(v1[0], v1[1]); w.w = pg8::cvt_pk_bf16(v1[2], v1[3]);
                    *(v4u*)(rowp + bj * 128) = w; } }
    }
};
struct EpiBr {
    static constexpr bool PERM = true, AMAP = false, MID = true;
    const bf16* G; bf16* MG;
    template <int NA, int NB> __device__ __forceinline__ void mid(f32x4 (&acc)[NA][NB][4][2], const Unit& u, int rowoff, int coloff, int wr, int wc, int fr, int fq) const {
        int pm_ = u.pm, pn_ = u.pn; asm volatile("" : "+s"(pm_), "+s"(pn_));
        const int row0 = pm_ * 256 + rowoff + wr * 64 + fr, col0 = pn_ * 256 + coloff + wc * 32 + 8 * fq;
#pragma unroll
        for (int ai = 0; ai < NA; ++ai)
#pragma unroll
            for (int m = 0; m < 4; ++m) { const size_t row = (size_t)(row0 + ai * 128 + m * 16);
#pragma unroll
                for (int bj = 0; bj < NB; ++bj) { const int col = col0 + bj * 128;
                    const v4u ga = *(const v4u*)(G + row * 2048 + col), gb = *(const v4u*)(G + row * 2048 + 1024 + col);
                    const float a_[8] = {bflo(ga.x), bfhi(ga.x), bflo(ga.y), bfhi(ga.y), bflo(ga.z), bfhi(ga.z), bflo(ga.w), bfhi(ga.w)};
                    const float b_[8] = {bflo(gb.x), bfhi(gb.x), bflo(gb.y), bfhi(gb.y), bflo(gb.z), bfhi(gb.z), bflo(gb.w), bfhi(gb.w)};
#pragma unroll
                    for (int e = 0; e < 4; ++e) { acc[ai][bj][m][0][e] *= a_[e] * __builtin_amdgcn_rcpf(fmaxf(b_[e], 1e-30f)); acc[ai][bj][m][1][e] *= a_[4 + e] * __builtin_amdgcn_rcpf(fmaxf(b_[4 + e], 1e-30f)); } } }
    }
    template <int NA, int NB> __device__ __forceinline__ void run(f32x4 (&acc)[NA][NB][4][2], const Unit& u, int rowoff, int coloff, int wr, int wc, int fr, int fq) const {
        const int row0 = u.pm * 256 + rowoff + wr * 64 + fr, col0 = u.pn * 256 + coloff + wc * 32 + 8 * fq;
#pragma unroll
        for (int ai = 0; ai < NA; ++ai)
#pragma unroll
            for (int m = 0; m < 4; ++m) { const size_t row = (size_t)(row0 + ai * 128 + m * 16);
#pragma unroll
                for (int bj = 0; bj < NB; ++bj) { const int col = col0 + bj * 128;
                    const v4u gw = *(const v4u*)(G + row * 2048 + 1024 + col);
                    const f32x4 g0 = {bflo(gw.x), bfhi(gw.x), bflo(gw.y), bfhi(gw.y)}, g1 = {bflo(gw.z), bfhi(gw.z), bflo(gw.w), bfhi(gw.w)};
                    const f32x4 v0 = acc[ai][bj][m][0] * g0, v1 = acc[ai][bj][m][1] * g1;
                    v4u w; w.x = pg8::cvt_pk_bf16(v0[0], v0[1]); w.y = pg8::cvt_pk_bf16(v0[2], v0[3]); w.z = pg8::cvt_pk_bf16(v1[0], v1[1]); w.w = pg8::cvt_pk_bf16(v1[2], v1[3]);
                    *(v4u*)(MG + row * 1024 + col) = w; } }
    }
};
template <bool DOWN> struct EpiRes {
    static constexpr bool PERM = true, AMAP = false, MID = false;
    const float* xp; const float* xs; float* Y; bf16* X1B; float* SSQ;
    template <int NA, int NB> __device__ __forceinline__ void run(f32x4 (&acc)[NA][NB][4][2], const Unit& u, int rowoff, int coloff, int wr, int wc, int fr, int fq) const {
        const int row0 = u.pm * 256 + rowoff + wr * 64 + fr, col0 = u.pn * 256 + coloff + wc * 32 + 8 * fq;
        const float* xb = (u.pm < STILE ? xp : xs - (size_t)MP * DM);
#pragma unroll
        for (int ai = 0; ai < NA; ++ai)
#pragma unroll
            for (int m = 0; m < 4; ++m) { const size_t row = (size_t)(row0 + ai * 128 + m * 16);
#pragma unroll
                for (int bj = 0; bj < NB; ++bj) { const size_t off = row * 1024 + col0 + bj * 128; f32x4 v0, v1;
                    if (!DOWN) { v0 = acc[ai][bj][m][0] + *(const f32x4*)(xb + off); v1 = acc[ai][bj][m][1] + *(const f32x4*)(xb + off + 4); }
                    else { const v4u w = *(const v4u*)(X1B + off); v0 = acc[ai][bj][m][0] + (f32x4){bflo(w.x), bfhi(w.x), bflo(w.y), bfhi(w.y)}; v1 = acc[ai][bj][m][1] + (f32x4){bflo(w.z), bfhi(w.z), bflo(w.w), bfhi(w.w)}; }
                    float s = (v0[0] * v0[0] + v0[1] * v0[1]) + (v0[2] * v0[2] + v0[3] * v0[3]) + (v1[0] * v1[0] + v1[1] * v1[1]) + (v1[2] * v1[2] + v1[3] * v1[3]);
                    if (!DOWN) { v4u w; w.x = pg8::cvt_pk_bf16(v0[0], v0[1]); w.y = pg8::cvt_pk_bf16(v0[2], v0[3]); w.z = pg8::cvt_pk_bf16(v1[0], v1[1]); w.w = pg8::cvt_pk_bf16(v1[2], v1[3]);
                        *(v4u*)(X1B + off) = w; }
                    else { *(f32x4*)(Y + off) = v0; *(f32x4*)(Y + off + 4) = v1; }
                    s += __shfl_xor(s, 16); s += __shfl_xor(s, 32);
                    if (fq == 0) SSQ[row * 32 + u.pn * 8 + ((coloff >> 7) + bj) * 4 + wc] = s; } }
    }
};
__device__ __forceinline__ float row_rs(const float* SSQ, size_t row) {
    const f32x4* q = (const f32x4*)(SSQ + row * 32); float s = 0.f;
#pragma unroll
    for (int k = 0; k < 8; ++k) { const f32x4 a = q[k]; s += (a[0] + a[1]) + (a[2] + a[3]); }
    return 1.0f / sqrtf(s * (1.f / DM) + EPS);
}
struct EpiFinal {
    static constexpr bool PERM = true, AMAP = false, MID = false;
    float* Y; const bf16* X1B; const float* gf; float* XS; unsigned* cnt; unsigned* tmo; LAS unsigned char* lx;
    template <int NA, int NB> __device__ __forceinline__ void run(f32x4 (&acc)[NA][NB][4][2], const Unit& u, int rowoff, int coloff, int wr, int wc, int fr, int fq) const {
        LAS float* P = (LAS float*)(lx + RS_OFF); LAS float* S = P + 2048;
        int tid = threadIdx.x, pm_ = u.pm, pn_ = u.pn, fr_ = fr, fq_ = fq, wr_ = wr, wc_ = wc;
        asm volatile("" : "+v"(tid), "+s"(pm_), "+s"(pn_), "+v"(fr_), "+v"(fq_), "+s"(wr_), "+s"(wc_));
        const int wid = tid >> 6, lane = tid & 63;
        const int lrow0 = rowoff + wr_ * 64 + fr_, col0 = pn_ * 256 + coloff + wc_ * 32 + 8 * fq_, bj0 = coloff >> 7;
#pragma unroll
        for (int ai = 0; ai < NA; ++ai)
#pragma unroll
            for (int m = 0; m < 4; ++m) { const int lrow = lrow0 + ai * 128 + m * 16; const size_t row = (size_t)pm_ * 256 + lrow;
#pragma unroll
                for (int bj = 0; bj < NB; ++bj) { const size_t off = row * 1024 + col0 + bj * 128;
                    { const v4u w = *(const v4u*)(X1B + off); acc[ai][bj][m][0] += (f32x4){bflo(w.x), bfhi(w.x), bflo(w.y), bfhi(w.y)}; acc[ai][bj][m][1] += (f32x4){bflo(w.z), bfhi(w.z), bflo(w.w), bfhi(w.w)}; }
                    const f32x4 v0 = acc[ai][bj][m][0], v1 = acc[ai][bj][m][1];
                    float s = (v0[0] * v0[0] + v0[1] * v0[1]) + (v0[2] * v0[2] + v0[3] * v0[3]) + (v1[0] * v1[0] + v1[1] * v1[1]) + (v1[2] * v1[2] + v1[3] * v1[3]);
                    s += __shfl_xor(s, 16); s += __shfl_xor(s, 32);
                    if (fq_ == 0) P[lrow * 8 + (bj0 + bj) * 4 + wc_] = s; } }
        asm volatile("s_waitcnt lgkmcnt(0)" ::: "memory"); __builtin_amdgcn_s_barrier(); asm volatile("" ::: "memory");
        constexpr int RPW = (NA == 2) ? 32 : 16;
        const int nslot = (NA == 2) ? 4 : 8, slot = (NA == 2) ? pn_ : 2 * pn_ + bj0;
        const int prow = rowoff + wid * RPW + (lane & (RPW - 1));
        float* xs = XS + (size_t)pm_ * 2048;
        if (lane < RPW) { const LAS float* pp = P + prow * 8 + (NA == 2 ? 0 : bj0 * 4); float t = (pp[0] + pp[1]) + (pp[2] + pp[3]); if (NA == 2) t += (pp[4] + pp[5]) + (pp[6] + pp[7]);
            __hip_atomic_store(xs + slot * 256 + prow, t, __ATOMIC_RELAXED, __HIP_MEMORY_SCOPE_AGENT); }
        asm volatile("s_waitcnt vmcnt(0)" ::: "memory");
        unsigned* c = cnt + 32 * ((NA == 2) ? pm_ : (STILE + (rowoff >> 7)));
        if (lane == 0) __hip_atomic_fetch_add(c, 1u, __ATOMIC_RELAXED, __HIP_MEMORY_SCOPE_AGENT);
        if (wid == 0) { const unsigned want = 8u * (unsigned)nslot; unsigned sp = 0;
            while ((unsigned)__builtin_amdgcn_readfirstlane(__hip_atomic_load(c, __ATOMIC_RELAXED, __HIP_MEMORY_SCOPE_AGENT)) < want) {
                __builtin_amdgcn_s_sleep(1);
                if ((++sp & 255u) == 0u) { if (__builtin_amdgcn_readfirstlane(__hip_atomic_load(tmo, __ATOMIC_RELAXED, __HIP_MEMORY_SCOPE_AGENT)) != 0u) break; if (sp > (1u << 20)) { if (lane == 0) atomicAdd(tmo, 1u); break; } } } }
        asm volatile("s_waitcnt vmcnt(0) lgkmcnt(0)" ::: "memory"); __builtin_amdgcn_s_barrier(); asm volatile("" ::: "memory");
        if (lane < RPW) { float t = 0.f;
#pragma unroll
            for (int k = 0; k < 8; ++k) if (k < nslot) t += __hip_atomic_load(xs + k * 256 + prow, __ATOMIC_RELAXED, __HIP_MEMORY_SCOPE_AGENT);
            S[prow] = 1.0f / sqrtf(t * (1.f / DM) + EPS); }
        asm volatile("s_waitcnt lgkmcnt(0)" ::: "memory"); __builtin_amdgcn_s_barrier(); asm volatile("" ::: "memory");
        f32x4 gg[NB][2];
#pragma unroll
        for (int bj = 0; bj < NB; ++bj) { gg[bj][0] = *(const f32x4*)(gf + col0 + bj * 128); gg[bj][1] = *(const f32x4*)(gf + col0 + bj * 128 + 4); }
#pragma unroll
        for (int ai = 0; ai < NA; ++ai)
#pragma unroll
            for (int m = 0; m < 4; ++m) { const int lrow = lrow0 + ai * 128 + m * 16; const size_t row = (size_t)pm_ * 256 + lrow; const float rs = S[lrow];
#pragma unroll
                for (int bj = 0; bj < NB; ++bj) { const size_t off = row * 1024 + col0 + bj * 128;
                    *(f32x4*)(Y + off) = acc[ai][bj][m][0] * rs * gg[bj][0]; *(f32x4*)(Y + off + 4) = acc[ai][bj][m][1] * rs * gg[bj][1]; } }
    }
};
struct EpiW {
    static constexpr bool PERM = true, AMAP = false, MID = false;
    bf16* O;
    template <int NA, int NB> __device__ __forceinline__ void run(f32x4 (&acc)[NA][NB][4][2], const Unit& u, int rowoff, int coloff, int wr, int wc, int fr, int fq) const {
        const int row0 = u.pm * 256 + rowoff + wr * 64 + fr, col0 = u.pn * 256 + coloff + wc * 32 + 8 * fq;
#pragma unroll
        for (int ai = 0; ai < NA; ++ai)
#pragma unroll
            for (int m = 0; m < 4; ++m)
#pragma unroll
                for (int bj = 0; bj < NB; ++bj) { const f32x4 v0 = acc[ai][bj][m][0], v1 = acc[ai][bj][m][1];
                    v4u w; w.x = pg8::cvt_pk_bf16(v0[0], v0[1]); w.y = pg8::cvt_pk_bf16(v0[2], v0[3]); w.z = pg8::cvt_pk_bf16(v1[0], v1[1]); w.w = pg8::cvt_pk_bf16(v1[2], v1[3]);
                    *(v4u*)(O + (size_t)(row0 + ai * 128 + m * 16) * 2048 + col0 + bj * 128) = w; }
    }
};
template <bool AM> struct EpiNull {
    static constexpr bool PERM = true, AMAP = AM, MID = false;
    template <int NA, int NB> __device__ __forceinline__ void run(f32x4 (&acc)[NA][NB][4][2], const Unit&, int, int, int, int, int, int) const {
#pragma unroll
        for (int ai = 0; ai < NA; ++ai)
#pragma unroll
            for (int bj = 0; bj < NB; ++bj)
#pragma unroll
                for (int m = 0; m < 4; ++m) { asm volatile("" :: "v"(acc[ai][bj][m][0]), "v"(acc[ai][bj][m][1])); }
    }
};
struct EpiZScratch {
    static constexpr bool PERM = true, AMAP = false, MID = false;
    bf16* scr;
    template <int NA, int NB> __device__ __forceinline__ void run(f32x4 (&acc)[NA][NB][4][2], const Unit& u, int rowoff, int coloff, int wr, int wc, int fr, int fq) const {
        const int row0 = wr * 64 + fr, col0 = wc * 32 + 8 * fq;
#pragma unroll
        for (int ai = 0; ai < NA; ++ai)
#pragma unroll
            for (int m = 0; m < 4; ++m) { bf16* rowp = scr + (size_t)(row0 + ai * 128 + m * 16) * 256 + col0;
#pragma unroll
                for (int bj = 0; bj < NB; ++bj) { f32x4 v0 = acc[ai][bj][m][0], v1 = acc[ai][bj][m][1];
                    v4u w; w.x = pg8::cvt_pk_bf16(v0[0], v0[1]); w.y = pg8::cvt_pk_bf16(v0[2], v0[3]); w.z = pg8::cvt_pk_bf16(v1[0], v1[1]); w.w = pg8::cvt_pk_bf16(v1[2], v1[3]);
                    *(v4u*)(rowp + bj * 128) = w; } }
    }
};
struct EpiUpS {
    static constexpr bool PERM = true, AMAP = false, MID = false;
    bf16* ACT; const float* cw; const float* cb; const float* stf; float* ofs; const float* SSQ;
    template <int NA, int NB> __device__ __forceinline__ void run(f32x4 (&acc)[NA][NB][4][2], const Unit& u, int rowoff, int coloff, int wr, int wc, int fr, int fq) const {
        static_assert(NA == 1 && NB == 2, "sample FFN epilogue works on half sub-units");
        int pn_ = u.pn, ro_ = rowoff, fr_ = fr, fq_ = fq, wr_ = wr, wc_ = wc; asm volatile("" : "+s"(pn_), "+s"(ro_), "+v"(fr_), "+v"(fq_), "+s"(wr_), "+s"(wc_));
        const int cbase = 32 * wc_ + 8 * fq_, gcol = 128 * pn_ + cbase;
#pragma unroll
        for (int m = 0; m < 4; ++m) {
            asm volatile("" ::: "memory");
            const int lrow = ro_ + wr_ * 64 + m * 16 + fr_, seq = lrow >> 4; const size_t row = (size_t)MP + lrow;
            const float rs = row_rs(SSQ, row);
            unsigned pk[4];
#pragma unroll
            for (int n = 0; n < 2; ++n) { f32x4 gc;
#pragma unroll
                for (int bj = 0; bj < 2; ++bj) { const int oc = bj * DFF + gcol + 4 * n;
                    const f32x4 w0 = *(const f32x4*)(cw + oc), w1 = *(const f32x4*)(cw + DUP + oc), w2 = *(const f32x4*)(cw + 2 * DUP + oc), bb = *(const f32x4*)(cb + oc);
                    const f32x4 h = acc[0][bj][m][n] * rs; f32x4 hm1, hm2;
#pragma unroll
                    for (int e = 0; e < 4; ++e) { hm1[e] = __shfl_up(h[e], 1, 16); hm2[e] = __shfl_up(h[e], 2, 16); }
                    if (fr_ < 2) { const f32x4 s1 = *(const f32x4*)(stf + (size_t)(seq * 2 + 1) * DUP + oc); if (fr_ == 0) { hm1 = s1; hm2 = *(const f32x4*)(stf + (size_t)(seq * 2 + 0) * DUP + oc); } else hm2 = s1; }
                    if (fr_ >= 14) *(f32x4*)(ofs + (size_t)(seq * 2 + (fr_ - 14)) * DUP + oc) = h;
                    const f32x4 c = bb + w0 * hm2 + w1 * hm1 + w2 * h;
                    if (bj == 0) gc = c;
                    else { f32x4 a;
#pragma unroll
                        for (int e = 0; e < 4; ++e) a[e] = gelu_tanh(gc[e]) * c[e];
                        pk[2 * n] = pg8::cvt_pk_bf16(a[0], a[1]); pk[2 * n + 1] = pg8::cvt_pk_bf16(a[2], a[3]); } } }
            v4u w; w.x = pk[0]; w.y = pk[1]; w.z = pk[2]; w.w = pk[3];
            *(v4u*)(ACT + row * DFF + gcol) = w;
        }
    }
};
struct EpiUp {
    static constexpr bool PERM = true, AMAP = true, MID = false;
    bf16* ACT; const float* cw; const float* cb; const float* stf; float* ofp; float* ofs; LAS unsigned char* lx; int pm0; bf16* scr; float* HA; float* HB;
    template <int NA, int NB> __device__ __forceinline__ void run(f32x4 (&acc)[NA][NB][4][2], const Unit& u, int, int, int wr, int wc, int fr, int fq) const {
        int pm_ = u.pm, pn_ = u.pn, fr_ = fr, fq_ = fq; asm volatile("" : "+s"(pm_), "+s"(pn_), "+v"(fr_), "+v"(fq_));
        const bool samp = (pm_ == STILE); const int j = pm_ - pm0;
        const LAS float* RS = (const LAS float*)(lx + RS_OFF) + j * 256 + 128 * wr + 8 * fr_;
        const f32x4 rsa = *(const LAS f32x4*)RS, rsb = *(const LAS f32x4*)(RS + 4);
        const float rs[8] = {rsa[0], rsa[1], rsa[2], rsa[3], rsb[0], rsb[1], rsb[2], rsb[3]};
        const int cbase = 32 * wc + 8 * fq_, gcol = 128 * pn_ + cbase;
        const LAS float* Ein = (const LAS float*)(lx + (wr == 0 ? (j == 0 ? EDGE_START_OFF : EDGE_PREV_OFF + 2048 * (j & 1)) : EDGE_MID_OFF));
        LAS float* Eout = (LAS float*)(lx + (wr == 0 ? EDGE_MID_OFF : EDGE_PREV_OFF + 2048 * ((j + 1) & 1)));
        const int seq = samp ? (8 * wr + (fr_ >> 1)) : (pm_ >> 4);
        const bool lastp = (!samp) && !scr && ((pm_ & 15) == 15) && wr == 1 && fr_ == 15;
        if (!samp && fr_ == 15) {
#pragma unroll
            for (int n = 0; n < 2; ++n)
#pragma unroll
                for (int bj = 0; bj < 2; ++bj) { const int cc = bj * 128 + cbase + 4 * n;
                    *(LAS f32x4*)(Eout + cc) = acc[1][bj][2][n] * rs[6]; *(LAS f32x4*)(Eout + 256 + cc) = acc[1][bj][3][n] * rs[7]; } }
        asm volatile("s_waitcnt lgkmcnt(0)" ::: "memory"); __builtin_amdgcn_s_barrier(); asm volatile("" ::: "memory");
        const size_t astr = scr ? 128 : DFF;
        bf16* ap = scr ? scr + (size_t)(128 * wr + 8 * fr_) * 128 + cbase : ACT + (size_t)(pm_ * 256 + 128 * wr + 8 * fr_) * DFF + gcol;
#pragma unroll
        for (int n = 0; n < 2; ++n) {
            f32x4 gc[8];
#pragma unroll
            for (int bj = 0; bj < 2; ++bj) {
                const int cc = bj * 128 + cbase + 4 * n, oc = bj * DFF + gcol + 4 * n;
                const LAS float* cwl = (const LAS float*)(lx + CWL_OFF) + cc;
                const f32x4 w0 = *(const LAS f32x4*)cwl, w1 = *(const LAS f32x4*)(cwl + 256), w2 = *(const LAS f32x4*)(cwl + 512), bb = *(const LAS f32x4*)(cwl + 768);
                const f32x4 h6 = acc[1][bj][2][n] * rs[6], h7 = acc[1][bj][3][n] * rs[7];
                f32x4 hm1, hm2;
#pragma unroll
                for (int e = 0; e < 4; ++e) { hm1[e] = dpp_shr1(h7[e]); hm2[e] = dpp_shr1(h6[e]); }
                if (!samp) {
                    if (fr_ == 0) { hm2 = *(const LAS f32x4*)(Ein + cc); hm1 = *(const LAS f32x4*)(Ein + 256 + cc); }
                    if (lastp) { *(f32x4*)(ofp + (size_t)(seq * 2 + 0) * DUP + oc) = h6; *(f32x4*)(ofp + (size_t)(seq * 2 + 1) * DUP + oc) = h7; }
                    if (j == 3 && wr == 1 && fr_ == 15 && !scr) { float* ha = HA + ((size_t)((pm0 >> 2) + 1) * 24 + pn_) * 512 + cc; *(f32x4*)ha = h6; *(f32x4*)(ha + 256) = h7; }
                    if (j == 0 && wr == 0 && fr_ == 0 && !scr) { float* hb = HB + ((size_t)(pm0 >> 2) * 24 + pn_) * 512 + cc; *(f32x4*)hb = acc[0][bj][0][n] * rs[0]; *(f32x4*)(hb + 256) = acc[0][bj][1][n] * rs[1]; }
                } else {
                    if (!(fr_ & 1)) { hm2 = *(const f32x4*)(stf + (size_t)(seq * 2 + 0) * DUP + oc); hm1 = *(const f32x4*)(stf + (size_t)(seq * 2 + 1) * DUP + oc); }
                    else { *(f32x4*)(ofs + (size_t)(seq * 2 + 0) * DUP + oc) = h6; *(f32x4*)(ofs + (size_t)(seq * 2 + 1) * DUP + oc) = h7; }
                }
                f32x4 p2 = hm2, p1 = hm1;
#pragma unroll
                for (int q = 0; q < 8; ++q) {
                    const f32x4 hq = (q == 6) ? h6 : (q == 7) ? h7 : acc[q >> 2][bj][q & 3][n] * rs[q];
                    const f32x4 c = bb + w0 * p2 + w1 * p1 + w2 * hq;
                    p2 = p1; p1 = hq;
                    if (bj == 0) gc[q] = c;
                    else { f32x4 a;
#pragma unroll
                        for (int e = 0; e < 4; ++e) a[e] = gelu_tanh(gc[q][e]) * c[e];
                        v2u w; w.x = pg8::cvt_pk_bf16(a[0], a[1]); w.y = pg8::cvt_pk_bf16(a[2], a[3]);
                        *(v2u*)(ap + (size_t)q * astr + 4 * n) = w; }
                }
            }
        }
        LDS_WAIT();
    }
};
template <class RowMap>
__device__ __forceinline__ void p0_transpose_item(const float* W, int ldw, int k0, int n0, bf16* WT, size_t ldt, int kcol0, RowMap drow, const float* kscale, LAS float* scr, int lane) {
#pragma unroll 8
    for (int i = 0; i < 32; ++i) { const int kk = 2 * i + (lane >> 5); float v = W[(size_t)(k0 + kk) * ldw + n0 + (lane & 31)]; if (kscale) v *= kscale[k0 + kk]; scr[kk * 33 + (lane & 31)] = v; }
    LDS_WAIT(); asm volatile("" ::: "memory");
    const int c = lane & 7;
#pragma unroll
    for (int j = 0; j < 4; ++j) { const int n = (lane >> 3) + 8 * j; const LAS float* s = scr + (8 * c) * 33 + n;
        v4u o; o.x = pk2(s[0 * 33], s[1 * 33]); o.y = pk2(s[2 * 33], s[3 * 33]); o.z = pk2(s[4 * 33], s[5 * 33]); o.w = pk2(s[6 * 33], s[7 * 33]);
        *(v4u*)(WT + (size_t)drow(n0 + n) * ldt + kcol0 + k0 + 8 * c) = o; }
    LDS_WAIT(); asm volatile("" ::: "memory");
}
struct RowId { __device__ __forceinline__ int operator()(int n) const { return n; } };
struct RowUp { __device__ __forceinline__ int operator()(int n) const { const int half = n >= DFF ? 1 : 0, c = n - half * DFF; return (c >> 7) * 256 + half * 128 + (c & 127); } };

__device__ __forceinline__ void p0_prologue(const KP& p, LAS unsigned char* lds, int vcu, int G, int wave, int lane) {
    LAS float* scr = (LAS float*)(lds + wave * 16384);
    const int gw = vcu * NWAVES + wave, NGW = G * NWAVES;
    unsigned char* ws = p.ws;
    bf16* Win_t = (bf16*)(ws + WS_WIN); bf16* Wg_t = (bf16*)(ws + WS_WG); bf16* Wbp_t = (bf16*)(ws + WS_WBP); bf16* Wpool_b = (bf16*)(ws + WS_WPOOL);
    constexpr int I_IN = (DM / 64) * (DIN / 32), I_SQ = (DM / 64) * (DM / 32), I_G = 32 * 2, I_PC = 4 * 256 * 256 / 512;
    constexpr int NITEMS = I_IN + I_SQ + I_G + I_PC;
    for (int it = gw; it < NITEMS; it += NGW) {
        int r = it;
        if (r < I_IN) { const int nblk = DIN / 32; p0_transpose_item(p.in[I_WIN], DIN, 64 * (r / nblk), 32 * (r % nblk), Win_t, DM, 0, RowId(), nullptr, scr, lane); continue; } r -= I_IN;
        if (r < I_SQ) { const int nblk = DM / 32; p0_transpose_item(p.in[I_WBRP], DM, 64 * (r / nblk), 32 * (r % nblk), Wbp_t, DM, 0, RowId(), p.in[I_PSCALE], scr, lane); continue; } r -= I_SQ;
        if (r < I_G) { const int mat = r >> 1, nb = r & 1; const float* W = (mat < 16 ? p.in[I_WRA] : p.in[I_WIX]) + (size_t)(mat & 15) * 4096;
          p0_transpose_item(W, 64, 0, 32 * nb, Wg_t + (size_t)mat * 4096, 64, 0, RowId(), nullptr, scr, lane); continue; } r -= I_G;
        { const float* s = p.in[I_WPOOL] + (size_t)r * 512 + lane * 8; const f32x4 a = *(const f32x4*)s, b = *(const f32x4*)(s + 4);
          v4u o; o.x = pk2(a[0], a[1]); o.y = pk2(a[2], a[3]); o.z = pk2(b[0], b[1]); o.w = pk2(b[2], b[3]); *(v4u*)(Wpool_b + (size_t)r * 512 + lane * 8) = o; }
    }
    {
        bf16* XN = (bf16*)(ws + WS_R0); const float* g1 = p.in[I_NMIX];
        f32x4 gv[4];
#pragma unroll
        for (int j = 0; j < 4; ++j) gv[j] = *((const f32x4*)g1 + lane + 64 * j);
        for (int m0 = gw; m0 < M; m0 += 2 * NGW) {
            f32x4 v[2][4]; float s[2];
#pragma unroll
            for (int r = 0; r < 2; ++r) { const int m = m0 + r * NGW; s[r] = 0.f;
                if (m < M) { const float* xrow = m < MP ? p.in[I_XP] + (size_t)m * DM : p.in[I_XS] + (size_t)(m - MP) * DM; const f32x4* xr = (const f32x4*)xrow + lane;
#pragma unroll
                    for (int j = 0; j < 4; ++j) v[r][j] = xr[64 * j]; } }
#pragma unroll
            for (int r = 0; r < 2; ++r) { const int m = m0 + r * NGW;
                if (m < M) {
#pragma unroll
                    for (int j = 0; j < 4; ++j) s[r] += (v[r][j][0] * v[r][j][0] + v[r][j][1] * v[r][j][1]) + (v[r][j][2] * v[r][j][2] + v[r][j][3] * v[r][j][3]);
                    const float rstd = 1.0f / sqrtf(wave_sum(s[r]) * (1.f / DM) + EPS);
                    v2u* o8 = (v2u*)(XN + (size_t)m * DM) + lane;
#pragma unroll
                    for (int j = 0; j < 4; ++j) { const f32x4 y = v[r][j] * rstd * gv[j]; v2u o; o.x = pk2(y[0], y[1]); o.y = pk2(y[2], y[3]); o8[64 * j] = o; } } }
        }
    }
}
__device__ __forceinline__ void p1_weights(const KP& p, LAS unsigned char* lds, int gw, int NGW, int wave, int lane) {
    LAS float* scr = (LAS float*)(lds + wave * 16384);
    unsigned char* ws = p.ws;
    bf16* Wcat_t = (bf16*)(ws + WS_WCAT); bf16* Wout_t = (bf16*)(ws + WS_WOUT); bf16* Wup_t = (bf16*)(ws + WS_WUP); bf16* Wdn_t = (bf16*)(ws + WS_WDN);
    constexpr int I_UP = (DM / 64) * (DUP / 32), I_SQ = (DM / 64) * (DM / 32), I_DN = (DFF / 64) * (DM / 32);
    for (int it = gw; it < I_UP + 2 * I_SQ + I_DN; it += NGW) {
        int r = it;
        if (r < I_SQ) { const int nblk = DM / 32; p0_transpose_item(p.in[I_WBRL], DM, 64 * (r / nblk), 32 * (r % nblk), Wcat_t, 2048, 0, RowId(), nullptr, scr, lane); continue; } r -= I_SQ;
        if (r < I_SQ) { const int nblk = DM / 32; p0_transpose_item(p.in[I_WOUT], DM, 64 * (r / nblk), 32 * (r % nblk), Wout_t, DM, 0, RowId(), nullptr, scr, lane); continue; } r -= I_SQ;
        if (r < I_UP) { const int nblk = DUP / 32; p0_transpose_item(p.in[I_WUP], DUP, 64 * (r / nblk), 32 * (r % nblk), Wup_t, DM, 0, RowUp(), p.in[I_NFFN]  , scr, lane); continue; } r -= I_UP;
        { const int nblk = DM / 32; p0_transpose_item(p.in[I_WDN], DM, 64 * (r / nblk), 32 * (r % nblk), Wdn_t, DFF, 0, RowId(), nullptr, scr, lane); }
    }
}

constexpr int XR_OFF = 0, XR_BYTES = 16 * 19 * 128, SEG_OFF = 40960, CIN_OFF = 45056;
template <bool FINAL>
__device__ __forceinline__ void lru_unit(const KP& p, LAS unsigned char* lds, int pm, int n, int tid, int lane, int wave) {
    constexpr bool samp = true;
    const bf16* ZR = (const bf16*)(p.ws + WS_R1); const bf16* Wg_t = (const bf16*)(p.ws + WS_WG);
    typedef float f32x2v __attribute__((ext_vector_type(2)));
    f32x2v* SUMM = (f32x2v*)(p.ws + WS_SUMM);
    bf16* HP = (bf16*)(p.ws + WS_R3);
    LAS unsigned char* XR = lds + XR_OFF; LAS f32x2v* SEG = (LAS f32x2v*)(lds + SEG_OFF); LAS float* CIN = (LAS float*)(lds + CIN_OFF);
    const int t0 = samp ? 0 : 256 * (pm & 15);
    __syncthreads();
    for (int idx = tid; idx < 304 * 8; idx += NWAVES * 64) {
        const int row = idx >> 3, ck = idx & 7, g = row / 19, k = row - g * 19, tt = 16 * g + k - 3;
        v4u v = {0u, 0u, 0u, 0u};
        if (!samp) { if (t0 + tt >= 0) v = *(const v4u*)(ZR + (size_t)(pm * 256 + tt) * 2048 + n * 64 + ck * 8); }
        else if (k < 3) { const float* s = p.in[I_STLC] + (size_t)(g * 3 + k) * DM + n * 64 + ck * 8; const f32x4 a = *(const f32x4*)s, b = *(const f32x4*)(s + 4);
            v.x = pk2(a[0], a[1]); v.y = pk2(a[2], a[3]); v.z = pk2(b[0], b[1]); v.w = pk2(b[2], b[3]); }
        else v = *(const v4u*)(ZR + (size_t)(MP + 16 * g + k - 3) * 2048 + n * 64 + ck * 8);
        *(LAS v4u*)(XR + row * 128 + ck * 16) = v;
    }
    if (FINAL && !samp && tid < 64) {
        const int npre = pm & 15; f32x2v sv[15];
#pragma unroll
        for (int k = 0; k < 15; ++k) sv[k] = (k < npre) ? SUMM[(size_t)(pm - npre + k) * DM + n * 64 + tid] : (f32x2v){1.f, 0.f};
        float c = 0.f;
#pragma unroll
        for (int k = 0; k < 15; ++k) c = sv[k].y + sv[k].x * c;
        CIN[tid] = c;
    }
    __syncthreads();
    const int i16 = lane & 15, fq = lane >> 4;
    const float* cwl = p.in[I_CLW]; const float* cbl = p.in[I_CLB];
    bf16x8 fa[2][2];
#pragma unroll
    for (int ks = 0; ks < 2; ++ks) {
        const int ch0 = 32 * ks + 8 * fq; f32x4 w[4][2], bb[2];
#pragma unroll
        for (int tp = 0; tp < 4; ++tp) { w[tp][0] = *(const f32x4*)(cwl + tp * DM + n * 64 + ch0); w[tp][1] = *(const f32x4*)(cwl + tp * DM + n * 64 + ch0 + 4); }
        bb[0] = *(const f32x4*)(cbl + n * 64 + ch0); bb[1] = *(const f32x4*)(cbl + n * 64 + ch0 + 4);
#pragma unroll
        for (int m = 0; m < 2; ++m) {
            const int tau = 8 * (i16 >> 2) + 4 * m + (i16 & 3), T = 32 * wave + tau, rb = (T >> 4) * 19 + (T & 15);
            f32x4 u0 = bb[0], u1 = bb[1];
#pragma unroll
            for (int tp = 0; tp < 4; ++tp) { const v4u x = *(const LAS v4u*)(XR + (rb + tp) * 128 + ch0 * 2);
                u0 += w[tp][0] * (f32x4){bflo(x.x), bfhi(x.x), bflo(x.y), bfhi(x.y)}; u1 += w[tp][1] * (f32x4){bflo(x.z), bfhi(x.z), bflo(x.w), bfhi(x.w)}; }
            v4u f; f.x = pk2(u0[0], u0[1]); f.y = pk2(u0[2], u0[3]); f.z = pk2(u1[0], u1[1]); f.w = pk2(u1[2], u1[3]);
            fa[m][ks] = __builtin_bit_cast(bf16x8, f);
        }
    }
    float hloc[4][8], pc[4][8], P8[4], H8[4];
    const int T0 = 32 * wave + 8 * fq, rb0 = (T0 >> 4) * 19 + (T0 & 15);
#pragma unroll
    for (int nb = 0; nb < 4; ++nb) {
        const int ch = 16 * nb + i16, gch = n * 64 + ch;
        f32x4 aR[2] = {{0.f, 0.f, 0.f, 0.f}, {0.f, 0.f, 0.f, 0.f}}, aI[2] = {{0.f, 0.f, 0.f, 0.f}, {0.f, 0.f, 0.f, 0.f}};
#pragma unroll
        for (int ks = 0; ks < 2; ++ks) {
            const bf16x8 bR = *(const bf16x8*)(Wg_t + (size_t)(n * 64 + ch) * 64 + 8 * fq + 32 * ks);
            const bf16x8 bI = *(const bf16x8*)(Wg_t + (size_t)((16 + n) * 64 + ch) * 64 + 8 * fq + 32 * ks);
#pragma unroll
            for (int m = 0; m < 2; ++m) { aR[m] = __builtin_amdgcn_mfma_f32_16x16x32_bf16(fa[m][ks], bR, aR[m], 0, 0, 0); aI[m] = __builtin_amdgcn_mfma_f32_16x16x32_bf16(fa[m][ks], bI, aI[m], 0, 0, 0); }
        }
        float x[11];
#pragma unroll
        for (int r = 0; r < 11; ++r) x[r] = __builtin_bit_cast(float, (unsigned)(*(const LAS unsigned short*)(XR + (rb0 + r) * 128 + ch * 2)) << 16);
        const float c0 = cwl[gch], c1 = cwl[DM + gch], c2 = cwl[2 * DM + gch], c3 = cwl[3 * DM + gch], cbv = cbl[gch];
        const float bra = p.in[I_BRA][gch], bix = p.in[I_BIX][gch], lam = p.in[I_LAM][gch];
        const float zz = -lam, sp = fmaxf(zz, 0.f) + log1pf(expf(-fabsf(zz))), c8 = -8.0f * sp;
        float hl = 0.f, P = 1.f;
#pragma unroll
        for (int q = 0; q < 8; ++q) {
            const float u = cbv + c0 * x[q] + c1 * x[q + 1] + c2 * x[q + 2] + c3 * x[q + 3];
            const float r = sigmoidf_fast(aR[q >> 2][q & 3] + bra), ig = sigmoidf_fast(aI[q >> 2][q & 3] + bix);
            const float la = r * c8, a = __builtin_amdgcn_exp2f(la * 1.4426950408889634f);
            const float x2 = 2.0f * la, em_small = -x2 * (1.0f + x2 * (0.5f + x2 * (0.16666667f + x2 * 0.041666668f))), em = (x2 > -0.05f) ? em_small : (1.0f - a * a);
            const float b = sqrtf(em) * ig * u;
            hl = a * hl + b; P = P * a;
            hloc[nb][q] = hl; pc[nb][q] = P;
        }
        P8[nb] = P; H8[nb] = hl;
    }
    float Pf[4][4], Hf[4][4];
#pragma unroll
    for (int nb = 0; nb < 4; ++nb)
#pragma unroll
        for (int f = 0; f < 4; ++f) { Pf[nb][f] = __shfl(P8[nb], i16 + 16 * f); Hf[nb][f] = __shfl(H8[nb], i16 + 16 * f); }
    if (!samp) {
        if (fq == 0) {
#pragma unroll
            for (int nb = 0; nb < 4; ++nb) { float hw = 0.f, pw = 1.f;
#pragma unroll
                for (int f = 0; f < 4; ++f) { hw = Hf[nb][f] + Pf[nb][f] * hw; pw *= Pf[nb][f]; }
                SEG[wave * 64 + 16 * nb + i16] = (f32x2v){pw, hw}; }
        }
        __syncthreads();
        if (!FINAL) {
            if (tid < 64) { float hu = 0.f, pu = 1.f;
#pragma unroll
                for (int w = 0; w < 8; ++w) { const f32x2v s = SEG[w * 64 + tid]; hu = s.y + s.x * hu; pu *= s.x; }
                SUMM[(size_t)pm * DM + n * 64 + tid] = (f32x2v){pu, hu}; }
            return;
        }
    }
#pragma unroll
    for (int nb = 0; nb < 4; ++nb) {
        const int ch = 16 * nb + i16, gch = n * 64 + ch;
        float c;
        if (!samp) {
            c = CIN[ch];
#pragma unroll
            for (int w = 0; w < 8; ++w) { const f32x2v s = SEG[w * 64 + ch]; if (w < wave) c = s.y + s.x * c; }
#pragma unroll
            for (int f = 0; f < 4; ++f) if (f < fq) c = Hf[nb][f] + Pf[nb][f] * c;
        } else {
            const int sq = 2 * wave + (fq >> 1);
            c = p.in[I_STH][(size_t)sq * DM + gch];
            if (fq & 1) { const float pp = (fq == 1) ? Pf[nb][0] : Pf[nb][2], hh = (fq == 1) ? Hf[nb][0] : Hf[nb][2]; c = hh + pp * c; }
        }
        bf16* hp = HP + (size_t)(pm * 256 + T0) * 2048 + gch; float hlast = 0.f;
#pragma unroll
        for (int q = 0; q < 8; ++q) { const float h = hloc[nb][q] + pc[nb][q] * c; hp[(size_t)q * 2048] = (bf16)f2bf(h); hlast = h; }
        if (!samp) { if ((pm & 15) == 15 && wave == 7 && fq == 3) p.out[OFF_HP + (size_t)(pm >> 4) * DM + gch] = hlast; }
        else if (fq & 1) p.out[OFF_HS + (size_t)(2 * wave + (fq >> 1)) * DM + gch] = hlast;
    }
}

constexpr int XL_BYTES = 33280, XL_SEG = 2 * XL_BYTES, XL_CW = XL_SEG + 4096;
__device__ __forceinline__ void lru_task(const KP& p, LAS unsigned char* lds, int s, int n, int hf, int tid, int lane, int wave) {
    const bf16* ZR = (const bf16*)(p.ws + WS_R1); const bf16* Wg_t = (const bf16*)(p.ws + WS_WG); bf16* HP = (bf16*)(p.ws + WS_R3);
    typedef float f32x2v __attribute__((ext_vector_type(2)));
    LAS f32x2v* SEG = (LAS f32x2v*)(lds + XL_SEG); LAS float* CW = (LAS float*)(lds + XL_CW);
    const int i16 = lane & 15, fq = lane >> 4;
    const float* cwl = p.in[I_CLW]; const float* cbl = p.in[I_CLB];
    const size_t rowbase = (size_t)s * SEQ;
    __syncthreads();
    if (tid < 320) { const int tp = tid >> 6, c = tid & 63; CW[tid] = tp < 4 ? cwl[tp * DM + n * 64 + c] : cbl[n * 64 + c]; }
    for (int idx = tid; idx < 259 * 8; idx += NWAVES * 64) { const int row = idx >> 3, ck = idx & 7; v4u v = {0u, 0u, 0u, 0u};
        if (row >= 3) v = *(const v4u*)(ZR + (rowbase + row - 3) * 2048 + n * 64 + ck * 8);
        *(LAS v4u*)(lds + row * 128 + ck * 16) = v; }
    bf16x8 bR[2][2], bI[2][2]; float c0[2], c1[2], c2[2], c3[2], cbv[2], bra[2], bix[2], c8[2], cin[2];
#pragma unroll
    for (int b2 = 0; b2 < 2; ++b2) { const int ch = 16 * (2 * hf + b2) + i16, gch = n * 64 + ch;
#pragma unroll
        for (int ks = 0; ks < 2; ++ks) { bR[b2][ks] = *(const bf16x8*)(Wg_t + (size_t)(n * 64 + ch) * 64 + 8 * fq + 32 * ks); bI[b2][ks] = *(const bf16x8*)(Wg_t + (size_t)((16 + n) * 64 + ch) * 64 + 8 * fq + 32 * ks); }
        c0[b2] = cwl[gch]; c1[b2] = cwl[DM + gch]; c2[b2] = cwl[2 * DM + gch]; c3[b2] = cwl[3 * DM + gch]; cbv[b2] = cbl[gch];
        bra[b2] = p.in[I_BRA][gch]; bix[b2] = p.in[I_BIX][gch];
        const float zz = -p.in[I_LAM][gch]; c8[b2] = -8.0f * (fmaxf(zz, 0.f) + log1pf(expf(-fabsf(zz)))) * 1.4426950408889634f;
        cin[b2] = 0.f; }
    __syncthreads();
    for (int tt = 0; tt < 16; ++tt) {
        LAS unsigned char* XR = lds + (tt & 1) * XL_BYTES; LAS unsigned char* XN_ = lds + ((tt + 1) & 1) * XL_BYTES;
        v4u pf[5];
        if (tt < 15) {
#pragma unroll
            for (int k = 0; k < 5; ++k) { const int idx = tid + k * (NWAVES * 64); if (idx < 259 * 8) pf[k] = *(const v4u*)(ZR + (rowbase + 256 * (tt + 1) - 3 + (idx >> 3)) * 2048 + n * 64 + (idx & 7) * 8); } }
        bf16x8 fa[2][2];
#pragma unroll
        for (int ks = 0; ks < 2; ++ks) { const int ch0 = 32 * ks + 8 * fq; f32x4 w[4][2], bb[2];
#pragma unroll
            for (int tp = 0; tp < 4; ++tp) { w[tp][0] = *(const LAS f32x4*)(CW + tp * 64 + ch0); w[tp][1] = *(const LAS f32x4*)(CW + tp * 64 + ch0 + 4); }
            bb[0] = *(const LAS f32x4*)(CW + 256 + ch0); bb[1] = *(const LAS f32x4*)(CW + 256 + ch0 + 4);
#pragma unroll
            for (int m = 0; m < 2; ++m) { const int rb = 32 * wave + 8 * (i16 >> 2) + 4 * m + (i16 & 3); f32x4 u0 = bb[0], u1 = bb[1];
#pragma unroll
                for (int tp = 0; tp < 4; ++tp) { const v4u x = *(const LAS v4u*)(XR + (rb + tp) * 128 + ch0 * 2);
                    u0 += w[tp][0] * (f32x4){bflo(x.x), bfhi(x.x), bflo(x.y), bfhi(x.y)}; u1 += w[tp][1] * (f32x4){bflo(x.z), bfhi(x.z), bflo(x.w), bfhi(x.w)}; }
                v4u f; f.x = pg8::cvt_pk_bf16(u0[0], u0[1]); f.y = pg8::cvt_pk_bf16(u0[2], u0[3]); f.z = pg8::cvt_pk_bf16(u1[0], u1[1]); f.w = pg8::cvt_pk_bf16(u1[2], u1[3]);
                fa[m][ks] = __builtin_bit_cast(bf16x8, f); } }
        float hloc[2][8], pc[2][8], P8[2], H8[2];
        const int rb0 = 32 * wave + 8 * fq;
#pragma unroll
        for (int b2 = 0; b2 < 2; ++b2) { const int ch = 16 * (2 * hf + b2) + i16;
            f32x4 aR[2] = {{0.f, 0.f, 0.f, 0.f}, {0.f, 0.f, 0.f, 0.f}}, aI[2] = {{0.f, 0.f, 0.f, 0.f}, {0.f, 0.f, 0.f, 0.f}};
#pragma unroll
            for (int ks = 0; ks < 2; ++ks)
#pragma unroll
                for (int m = 0; m < 2; ++m) { aR[m] = __builtin_amdgcn_mfma_f32_16x16x32_bf16(fa[m][ks], bR[b2][ks], aR[m], 0, 0, 0); aI[m] = __builtin_amdgcn_mfma_f32_16x16x32_bf16(fa[m][ks], bI[b2][ks], aI[m], 0, 0, 0); }
            float x[11];
#pragma unroll
            for (int r = 0; r < 11; ++r) x[r] = __builtin_bit_cast(float, (unsigned)(*(const LAS unsigned short*)(XR + (rb0 + r) * 128 + ch * 2)) << 16);
            float hl = 0.f, P = 1.f;
#pragma unroll
            for (int q = 0; q < 8; ++q) {
                const float u = cbv[b2] + c0[b2] * x[q] + c1[b2] * x[q + 1] + c2[b2] * x[q + 2] + c3[b2] * x[q + 3];
                const float r = sigmoidf_fast(aR[q >> 2][q & 3] + bra[b2]), ig = sigmoidf_fast(aI[q >> 2][q & 3] + bix[b2]);
                const float a = __builtin_amdgcn_exp2f(r * c8[b2]);
                const float b = __builtin_amdgcn_sqrtf(fmaxf(__builtin_fmaf(-a, a, 1.0f), 0.f)) * ig * u;
                hl = __builtin_fmaf(a, hl, b); P = P * a; hloc[b2][q] = hl; pc[b2][q] = P; }
            P8[b2] = P; H8[b2] = hl; }
        float Pf[2][4], Hf[2][4];
#pragma unroll
        for (int b2 = 0; b2 < 2; ++b2)
#pragma unroll
            for (int f = 0; f < 4; ++f) { Pf[b2][f] = __shfl(P8[b2], i16 + 16 * f); Hf[b2][f] = __shfl(H8[b2], i16 + 16 * f); }
        if (fq == 0) {
#pragma unroll
            for (int b2 = 0; b2 < 2; ++b2) { float hw = 0.f, pw = 1.f;
#pragma unroll
                for (int f = 0; f < 4; ++f) { hw = __builtin_fmaf(Pf[b2][f], hw, Hf[b2][f]); pw *= Pf[b2][f]; }
                SEG[(tt & 1) * 256 + wave * 32 + 16 * b2 + i16] = (f32x2v){pw, hw}; } }
        if (tt < 15) {
#pragma unroll
            for (int k = 0; k < 5; ++k) { const int idx = tid + k * (NWAVES * 64); if (idx < 259 * 8) *(LAS v4u*)(XN_ + (idx >> 3) * 128 + (idx & 7) * 16) = pf[k]; } }
        LDS_WAIT(); __syncthreads();
#pragma unroll
        for (int b2 = 0; b2 < 2; ++b2) { const int ch = 16 * (2 * hf + b2) + i16, gch = n * 64 + ch;
            float c = cin[b2], call = cin[b2];
#pragma unroll
            for (int w = 0; w < 8; ++w) { const f32x2v sg = SEG[(tt & 1) * 256 + w * 32 + 16 * b2 + i16]; call = __builtin_fmaf(sg.x, call, sg.y); if (w < wave) c = __builtin_fmaf(sg.x, c, sg.y); }
            cin[b2] = call;
#pragma unroll
            for (int f = 0; f < 4; ++f) if (f < fq) c = __builtin_fmaf(Pf[b2][f], c, Hf[b2][f]);
            bf16* hp = HP + (rowbase + 256 * tt + rb0) * 2048 + gch; float hlast = 0.f;
#pragma unroll
            for (int q = 0; q < 8; ++q) { const float h = __builtin_fmaf(pc[b2][q], c, hloc[b2][q]); hp[(size_t)q * 2048] = (bf16)f2bf(h); hlast = h; }
            if (tt == 15 && wave == 7 && fq == 3) p.out[OFF_HP + (size_t)s * DM + gch] = hlast; }
    }
}

__device__ __forceinline__ v4u pool_load8(const KP& p, const bf16* ZR, int pm, int tt, int run, int ch) {
    const bool samp = (pm == STILE); v4u w = {0u, 0u, 0u, 0u};
    if (!samp) { if (256 * (pm & 15) + tt >= 0) w = *(const v4u*)(ZR + (size_t)(pm * 256 + tt) * 2048 + 1024 + ch); }
    else { const int tl = tt - 16 * run;
        if (tl < 0) { const float* s = p.in[I_STPOOL] + (size_t)(run * 15 + 15 + tl) * DM + ch; const f32x4 a = *(const f32x4*)s, b = *(const f32x4*)(s + 4);
            w.x = pk2(a[0], a[1]); w.y = pk2(a[2], a[3]); w.z = pk2(b[0], b[1]); w.w = pk2(b[2], b[3]); }
        else w = *(const v4u*)(ZR + (size_t)(MP + tt) * 2048 + 1024 + ch); }
    return w;
}
__device__ __forceinline__ void unpack8(const v4u w, float (&v)[8]) { v[0] = bflo(w.x); v[1] = bfhi(w.x); v[2] = bflo(w.y); v[3] = bfhi(w.y); v[4] = bflo(w.z); v[5] = bfhi(w.z); v[6] = bflo(w.w); v[7] = bfhi(w.w); }
template <int W> __device__ __forceinline__ void pool_unit_w(const KP& p, int pm, int g, int tid) {
    const bf16* ZR = (const bf16*)(p.ws + WS_R1); bf16* HP = (bf16*)(p.ws + WS_R3);
    const bool samp = (pm == STILE);
    const int oct = tid & 31, run = tid >> 5, ch = 256 * g + 8 * oct;
#pragma unroll 1
    for (int hf = 0; hf < 2; ++hf) {
        const int tf = 16 * run + 8 * hf;
        const int pos0 = samp ? PAST : 256 * (pm & 15) + tf;
        v4u raw[W - 1 + 8];
#pragma unroll
        for (int r = 0; r < W - 1 + 8; ++r) raw[r] = pool_load8(p, ZR, pm, tf - (W - 1) + r, run, ch);
        float s[8];
#pragma unroll
        for (int e = 0; e < 8; ++e) s[e] = 0.f;
#pragma unroll
        for (int r = 0; r < W - 1; ++r) { float v[8]; unpack8(raw[r], v);
#pragma unroll
            for (int e = 0; e < 8; ++e) s[e] += v[e]; }
#pragma unroll
        for (int i = 0; i < 8; ++i) {
            const int cnt = min(pos0 + i + 1, W); const float inv = 1.0f / (float)cnt; float o[8], v[8], vo[8]; unpack8(raw[W - 1 + i], v); unpack8(raw[i], vo);
#pragma unroll
            for (int e = 0; e < 8; ++e) { s[e] += v[e]; o[e] = s[e] * inv - v[e]; }
            v4u ow; ow.x = pk2(o[0], o[1]); ow.y = pk2(o[2], o[3]); ow.z = pk2(o[4], o[5]); ow.w = pk2(o[6], o[7]);
            *(v4u*)(HP + (size_t)(pm * 256 + tf + i) * 2048 + 1024 + ch) = ow;
#pragma unroll
            for (int e = 0; e < 8; ++e) s[e] -= vo[e];
        }
    }
}
__device__ __forceinline__ void pool_unit(const KP& p, int pm, int g, int tid) {
    if (g == 0) pool_unit_w<2>(p, pm, g, tid); else if (g == 1) pool_unit_w<4>(p, pm, g, tid); else if (g == 2) pool_unit_w<8>(p, pm, g, tid); else pool_unit_w<16>(p, pm, g, tid);
}
__device__ __forceinline__ void state_copy(const KP& p, int gtid, int gthreads) {
    const bf16* ZR = (const bf16*)(p.ws + WS_R1);
    constexpr int N1 = NBATCH * 3 * DM, N2 = NBATCH * 15 * DM, N3 = SBATCH * 3 * DM, N4 = SBATCH * 15 * DM;
    for (int i = gtid; i < N1 + N2 + N3 + N4; i += gthreads) {
        int r = i; size_t row, col; float* dst;
        if (r < N1) { const int b = r / (3 * DM), k = (r / DM) % 3, c = r % DM; row = (size_t)b * SEQ + SEQ - 3 + k; col = c; dst = p.out + OFF_LCP + r; }
        else if ((r -= N1) < N2) { const int b = r / (15 * DM), k = (r / DM) % 15, c = r % DM; row = (size_t)b * SEQ + SEQ - 15 + k; col = 1024 + c; dst = p.out + OFF_PLP + r; }
        else if ((r -= N2) < N3) { const int b = r / (3 * DM), k = (r / DM) % 3, c = r % DM; row = (size_t)MP + b * SSEQ + SSEQ - 3 + k; col = c; dst = p.out + OFF_LCS + r; }
        else { r -= N3; const int b = r / (15 * DM), k = (r / DM) % 15, c = r % DM; row = (size_t)MP + b * SSEQ + SSEQ - 15 + k; col = 1024 + c; dst = p.out + OFF_PLS + r; }
        *dst = __builtin_bit_cast(float, (unsigned)ZR[row * 2048 + col] << 16);
    }
}

template <int MODE = 0> __device__ __forceinline__ void strip_pre(const KP& p, LAS unsigned char* lds, int pm0, int pn, int cnt, int tid, int lane, int wave) {
    const float* SSQ = (const float*)(p.ws + WS_SSQ); const bf16* XG2 = (const bf16*)(p.ws + WS_R1); const bf16* Wup_t = (const bf16*)(p.ws + WS_WUP);
    LAS float* RS = (LAS float*)(lds + RS_OFF); LAS float* ES = (LAS float*)(lds + EDGE_START_OFF); LAS float* CWL = (LAS float*)(lds + CWL_OFF);
    __syncthreads();
#pragma unroll
    for (int k = 0; k < 2; ++k) { const int idx = tid + k * (NWAVES * 64), vec = idx >> 8, col = idx & 255, oc = (col >> 7) * DFF + 128 * pn + (col & 127);
        CWL[idx] = vec < 3 ? p.in[I_CFW][(size_t)vec * DUP + oc] : p.in[I_CFB][oc]; }
    if (MODE != 2) for (int i = tid; i < cnt * 256; i += NWAVES * 64) RS[i] = row_rs(SSQ, (size_t)pm0 * 256 + i);
    ES[tid] = 0.f;
    __syncthreads();
}

__device__ __forceinline__ void strip_fix(const KP& p, int gtid, int gthreads) {
    const float* HA = (const float*)(p.ws + WS_HA); const float* HB = (const float*)(p.ws + WS_HB); bf16* ACT = (bf16*)(p.ws + WS_R2);
    const float* cw = p.in[I_CFW]; const float* cb = p.in[I_CFB];
    for (int i = gtid; i < 32 * 24 * 128; i += gthreads) {
        const int c = i & 127, sp = i >> 7, pn = sp % 24, sr = sp / 24;
        if ((sr & 3) == 0) continue;
        const float* ha = HA + (size_t)sp * 512; const float* hb = HB + (size_t)sp * 512;
        float hg[4], hv[4];
        hg[0] = ha[c]; hg[1] = ha[256 + c]; hg[2] = hb[c]; hg[3] = hb[256 + c];
        hv[0] = ha[128 + c]; hv[1] = ha[384 + c]; hv[2] = hb[128 + c]; hv[3] = hb[384 + c];
        const int og = 128 * pn + c, ov = DFF + og;
        const float g0 = cw[og], g1 = cw[DUP + og], g2 = cw[2 * DUP + og], gb = cb[og], v0 = cw[ov], v1 = cw[DUP + ov], v2 = cw[2 * DUP + ov], vb = cb[ov];
#pragma unroll
        for (int t = 0; t < 2; ++t) { const float cg = gb + g0 * hg[t] + g1 * hg[t + 1] + g2 * hg[t + 2], cv = vb + v0 * hv[t] + v1 * hv[t + 1] + v2 * hv[t + 2];
            ACT[((size_t)sr * 1024 + t) * DFF + og] = (bf16)f2bf(gelu_tanh(cg) * cv); }
    }
}

__device__ __forceinline__ void final_norm(const KP& p, int gw, int NGW, int lane) {
    const float* SSQ2 = (const float*)(p.ws + WS_SSQ2); const float* gf = p.in[I_NFIN];
    f32x4 gv[4];
#pragma unroll
    for (int j = 0; j < 4; ++j) gv[j] = *((const f32x4*)gf + lane + 64 * j);
    for (int m = gw; m < M; m += NGW) {
        const float sv = (lane < 32) ? SSQ2[(size_t)m * 32 + lane] : 0.f;
        const float rstd = 1.0f / sqrtf(wave_sum(sv) * (1.f / DM) + EPS);
        f32x4* yr = (f32x4*)(p.out + OFF_Y + (size_t)m * DM) + lane;
#pragma unroll
        for (int j = 0; j < 4; ++j) { const f32x4 v = yr[64 * j]; yr[64 * j] = v * rstd * gv[j]; }
    }
}
#ifndef MK_ONE_LAUNCH
#define MK_ONE_LAUNCH 1
#endif
#ifndef PG8_SP2
#define PG8_SP2 true
#endif
#ifndef PG8_ALIGN
#define PG8_ALIGN true
#endif
#ifndef FUSE_FINAL
#define FUSE_FINAL 1
#endif
constexpr int N_PHASES = 11;
__global__ void __launch_bounds__(NWAVES * 64, 2) mk_fwd(KP p) {
    extern __shared__ __attribute__((aligned(16))) unsigned char lds_raw[];
    LAS unsigned char* lds = (LAS unsigned char*)lds_raw;
    const int tid = threadIdx.x, lane = tid & 63, wave = __builtin_amdgcn_readfirstlane(tid >> 6);
    const int G = gridDim.x, bx = blockIdx.x, vcu = (G % 8 == 0) ? (bx % 8) * (G / 8) + bx / 8 : bx;
    volatile LAS unsigned* MISC = (volatile LAS unsigned*)(lds + MISC_OFF);
    if (tid < 32) MISC[tid] = 0u;
    __syncthreads();
    unsigned* ctl = (unsigned*)(p.ws + WS_CTL);
    const int lo = p.ph_lo, hi = p.ph_hi;
    XcdBarrier bar; bar.bar = ctl + CW_BAR; bar.x = 0; bar.st = MISC + 8;
    if (hi - lo > 1) bar = xcd_barrier_post(ctl + CW_BAR, MISC + 8);
#ifndef PH_MASK
#define PH_MASK 0xfff
#endif
#define IN(k) (((PH_MASK >> (k)) & 1) && lo <= (k) && (k) < hi)
#ifndef REP_MASK
#define REP_MASK 0
#endif
#define PH(k) if (IN(k)) for (int rep_ = 0; rep_ <= ((REP_MASK >> (k)) & 1); ++rep_)
#define REPBAR() do { if (rep_) xcd_barrier(bar); } while (0)
#define SEAM(k) do { if (IN(k) && IN((k) + 1)) xcd_barrier(bar); } while (0)
    unsigned char* ws = p.ws;
    bf16* XN = (bf16*)(ws + WS_R0); bf16* MG = (bf16*)(ws + WS_R0); bf16* ZR = (bf16*)(ws + WS_R1); bf16* XG2 = (bf16*)(ws + WS_R1);
    bf16* GT = (bf16*)(ws + WS_R2); bf16* HP = (bf16*)(ws + WS_R3); bf16* ACT = (bf16*)(ws + WS_R2);
    bf16* Win_t = (bf16*)(ws + WS_WIN); bf16* Wcat_t = (bf16*)(ws + WS_WCAT); bf16* Wout_t = (bf16*)(ws + WS_WOUT); bf16* Wup_t = (bf16*)(ws + WS_WUP); bf16* Wdn_t = (bf16*)(ws + WS_WDN);
    float* SSQ = (float*)(ws + WS_SSQ); float* SSQ2 = (float*)(ws + WS_SSQ2);
    float* Y = p.out + OFF_Y;

    PH(0) { REPBAR(); p0_prologue(p, lds, vcu, G, wave, lane); }
    SEAM(0);
    PH(1) { REPBAR();
        pg8::Gemm g{XN, Win_t, DM, DM, DM}; pg8::StaticOrder S; S.init(MP, DIN, G, bx);
        EpiZ E{ZR, GT};
        for (int su = bx; su < 64; su += G) pg8::sub_gemm<1>(lds, g, STILE, su >> 2, (su >> 1) & 1, su & 1, E);
        pg8::gemm_phase<EpiZ, pg8::StaticOrder, PG8_ALIGN, PG8_SP2>(lds, g, S, E);
        if (G > 64) { if (bx >= 64) p1_weights(p, lds, (bx - 64) * NWAVES + wave, (G - 64) * NWAVES, wave, lane); } else p1_weights(p, lds, bx * NWAVES + wave, G * NWAVES, wave, lane);
    }
    SEAM(1);
    PH(2) { REPBAR();
        state_copy(p, bx * NWAVES * 64 + tid, G * NWAVES * 64);
        for (int su = bx; su < 64; su += G) {
            const int g_ = su >> 4, q = su & 15; pg8::Gemm gw_{(const bf16*)(ws + WS_WBP) + 256 * g_, (const bf16*)(ws + WS_WPOOL) + (size_t)g_ * 65536, 256, DM, 256};
            EpiW EW{Wcat_t + 1024 + 256 * g_}; pg8::sub_gemm<1>(lds, gw_, q >> 2, 0, (q >> 1) & 1, q & 1, EW); }
        for (int t = bx; t < NBATCH * 32; t += G) lru_task(p, lds, t >> 5, (t >> 1) & 15, t & 1, tid, lane, wave);
        for (int L = bx; L < 16 + NTILE * 4; L += G) {
            if (L < 16) lru_unit<true>(p, lds, STILE, L, tid, lane, wave);
            else { const int r = L - 16; pool_unit(p, r >> 2, r & 3, tid); }
        }
    }
    if (IN(2) && IN(4)) xcd_barrier(bar);
    PH(4) { REPBAR();
        pg8::Gemm g{HP, Wcat_t, 2048, 2048, 2048}; pg8::StaticOrder S; S.init(MP, DM, G, bx);
        EpiBr E{GT, MG};
        pg8::gemm_phase<EpiBr, pg8::StaticOrder, PG8_ALIGN, PG8_SP2>(lds, g, S, E);
        for (int su = bx; su < 16; su += G) pg8::sub_gemm<1>(lds, g, STILE, su >> 2, (su >> 1) & 1, su & 1, E);
    }
    if (IN(4) && IN(6)) xcd_barrier(bar);
    PH(6) { REPBAR();
        pg8::Gemm g{MG, Wout_t, DM, DM, DM}; pg8::StaticOrder S; S.init(MP, DM, G, bx);
        EpiRes<false> E{p.in[I_XP], p.in[I_XS], Y, XG2, SSQ};
        pg8::gemm_phase<EpiRes<false>, pg8::StaticOrder, PG8_ALIGN, PG8_SP2>(lds, g, S, E);
        for (int su = bx; su < 16; su += G) pg8::sub_gemm<1>(lds, g, STILE, su >> 2, (su >> 1) & 1, su & 1, E);
    }
    SEAM(6);
    PH(7) { REPBAR();
        pg8::Gemm g{XG2, Wup_t, DM, DM, DM};
        { EpiUpS ES{ACT, p.in[I_CFW], p.in[I_CFB], p.in[I_STFFN], p.out + OFF_FCS, SSQ};
          for (int su = bx; su < 48; su += G) pg8::sub_gemm<2>(lds, g, STILE, su >> 1, su & 1, 0, ES); }
        for (int sidx = vcu; sidx < 768; sidx += G) {
            const int rg = sidx >> 8, v = sidx & 255, x = v >> 5, w = v & 31, pm0 = 4 * (4 * x + (w >> 3)), pn = 8 * rg + (w & 7);
            strip_pre(p, lds, pm0, pn, 4, tid, lane, wave);
            pg8::StripOrder S{pm0, pn, 4};
            EpiUp E{ACT, p.in[I_CFW], p.in[I_CFB], p.in[I_STFFN], p.out + OFF_FCP, p.out + OFF_FCS, lds, pm0, nullptr, (float*)(ws + WS_HA), (float*)(ws + WS_HB)};
            pg8::gemm_phase<EpiUp, pg8::StripOrder, true, PG8_SP2>(lds, g, S, E);
        }
    }
    SEAM(7);
    PH(8) { REPBAR(); strip_fix(p, bx * NWAVES * 64 + tid, G * NWAVES * 64); }
    SEAM(8);
    const bool fuse_final = (G == 256) && FUSE_FINAL;
    PH(9) { REPBAR();
        pg8::Gemm g{ACT, Wdn_t, DFF, DFF, DFF}; pg8::StaticOrder S; S.init(MP, DM, G, bx);
        if (fuse_final) {
            EpiFinal E{Y, XG2, p.in[I_NFIN], SSQ2, ctl + CW_PANEL, ctl + CW_BAR + XB_TMO, lds};
            pg8::gemm_phase<EpiFinal, pg8::StaticOrder, true  , PG8_SP2>(lds, g, S, E);
            for (int su = bx; su < 16; su += G) pg8::sub_gemm<1>(lds, g, STILE, su >> 2, (su >> 1) & 1, su & 1, E);
        } else {
            EpiRes<true> E{nullptr, nullptr, Y, XG2, SSQ2};
            pg8::gemm_phase<EpiRes<true>, pg8::StaticOrder, PG8_ALIGN, PG8_SP2>(lds, g, S, E);
            for (int su = bx; su < 16; su += G) pg8::sub_gemm<1>(lds, g, STILE, su >> 2, (su >> 1) & 1, su & 1, E);
        }
    }
#ifndef EXP
#define EXP 0
#endif
#if EXP != 0
    if (lo == 11) {
#if EXP == 1
        pg8::Gemm g{XG2, Wup_t, DM, DM, DM};
        for (int sidx = vcu; sidx < 768; sidx += G) {
            const int rg = sidx >> 8, v = sidx & 255, x = v >> 5, w = v & 31, pm0 = 4 * (4 * x + (w >> 3)), pn = 8 * rg + (w & 7);
            pg8::StripOrder S{pm0, pn, 4}; EpiNull<true> E;
            pg8::gemm_phase<EpiNull<true>, pg8::StripOrder, true, PG8_SP2>(lds, g, S, E);
        }
#elif EXP == 2
        pg8::Gemm g{XN, Win_t, DM, DM, DM}; pg8::StaticOrder S; S.init(MP, DIN, G, bx); EpiNull<false> E;
        pg8::gemm_phase<EpiNull<false>, pg8::StaticOrder, PG8_ALIGN, PG8_SP2>(lds, g, S, E);
#elif EXP == 3
        pg8::Gemm g{XG2, Wup_t, DM, DM, DM}; pg8::StaticOrder S; S.init(MP, DUP, G, bx); EpiNull<true> E;
        pg8::gemm_phase<EpiNull<true>, pg8::StaticOrder, true, PG8_SP2>(lds, g, S, E);
#elif EXP == 5
        pg8::Gemm g{XN, Win_t, DM, DM, DM}; pg8::StaticOrder S; S.init(MP, DIN, G, bx); EpiZScratch E{HP + (size_t)bx * 65536};
        pg8::gemm_phase<EpiZScratch, pg8::StaticOrder, PG8_ALIGN, PG8_SP2>(lds, g, S, E);
#elif EXP == 6
        pg8::Gemm g{XG2, Wup_t, DM, DM, DM};
        for (int sidx = vcu; sidx < 768; sidx += G) {
            const int rg = sidx >> 8, v = sidx & 255, x = v >> 5, w = v & 31, pm0 = 4 * (4 * x + (w >> 3)), pn = 8 * rg + (w & 7);
            strip_pre(p, lds, pm0, pn, 4, tid, lane, wave);
            pg8::StripOrder S{pm0, pn, 4};
            EpiUp E{ACT, p.in[I_CFW], p.in[I_CFB], p.in[I_STFFN], p.out + OFF_FCP, p.out + OFF_FCS, lds, pm0, HP + (size_t)bx * 256 * 128, nullptr, nullptr};
            pg8::gemm_phase<EpiUp, pg8::StripOrder, true, PG8_SP2>(lds, g, S, E);
        }
#elif EXP == 7
        pg8::Gemm g{XG2, Wup_t, DM, DM, DM};
        for (int sidx = vcu; sidx < 768; sidx += G) {
            const int rg = sidx >> 8, v = sidx & 255, x = v >> 5, w = v & 31, pm0 = 4 * (4 * x + (w >> 3)), pn = 8 * rg + (w & 7);
            strip_pre(p, lds, pm0, pn, 4, tid, lane, wave);
            pg8::StripOrder S{pm0, pn, 4}; EpiNull<true> E;
            pg8::gemm_phase<EpiNull<true>, pg8::StripOrder, true, PG8_SP2>(lds, g, S, E);
        }
#elif EXP == 8 || EXP == 9
        pg8::Gemm g{XG2, Wup_t, DM, DM, DM};
        for (int sidx = vcu; sidx < 768; sidx += G) {
            const int rg = sidx >> 8, v = sidx & 255, x = v >> 5, w = v & 31, pm0 = 4 * (4 * x + (w >> 3)), pn = 8 * rg + (w & 7);
            strip_pre<EXP - 7>(p, lds, pm0, pn, 4, tid, lane, wave);
            pg8::StripOrder S{pm0, pn, 4}; EpiNull<true> E;
            pg8::gemm_phase<EpiNull<true>, pg8::StripOrder, true, PG8_SP2>(lds, g, S, E);
        }
#elif EXP == 4
        pg8::Gemm g{ACT, Wdn_t, DFF, DFF, DFF}; pg8::StaticOrder S; S.init(MP, DM, G, bx); EpiNull<false> E;
        pg8::gemm_phase<EpiNull<false>, pg8::StaticOrder, true, PG8_SP2>(lds, g, S, E);
#endif
    }
#endif
    if (!fuse_final) { SEAM(9);
        PH(10) { REPBAR(); final_norm(p, vcu * NWAVES + wave, G * NWAVES, lane); } }
#undef IN
#undef SEAM
}

extern "C" void kernel_launch(void* const* d_in, const int* in_sizes, int n_in, void* d_out, int out_size, void* d_ws, size_t ws_size, hipStream_t stream) {
    static int grid = 0;
    if (grid == 0) {
        if (n_in != 26 || in_sizes[0] != MP * DM || (size_t)out_size != OUT_TOTAL || ws_size < WS_END) {
            fprintf(stderr, "kernel_launch: unexpected shapes: n_in %d in0 %d out %d ws %zu (need %zu)\n", n_in, n_in > 0 ? in_sizes[0] : -1, out_size, ws_size, (size_t)WS_END); grid = -1; return; }
        int dev = 0, cus = 0, per_cu = 0;
        if (hipGetDevice(&dev) != hipSuccess || hipDeviceGetAttribute(&cus, hipDeviceAttributeMultiprocessorCount, dev) != hipSuccess) { fprintf(stderr, "kernel_launch: device query failed\n"); grid = -1; return; }
        if (hipFuncSetAttribute((const void*)mk_fwd, hipFuncAttributeMaxDynamicSharedMemorySize, LDS_BYTES) != hipSuccess) { fprintf(stderr, "kernel_launch: hipFuncSetAttribute failed\n"); grid = -1; return; }
        if (hipOccupancyMaxActiveBlocksPerMultiprocessor(&per_cu, (const void*)mk_fwd, NWAVES * 64, LDS_BYTES) != hipSuccess || per_cu < 1) {
            fprintf(stderr, "kernel_launch: occupancy query reports %d blocks per CU\n", per_cu); (void)hipGetLastError(); per_cu = 1; }
        grid = cus;
        fprintf(stderr, "kernel_launch: grid %d (cus %d, occupancy %d/CU)\n", grid, cus, per_cu);
    }
    if (grid < 0) return;
    if (hipMemsetAsync((char*)d_ws + WS_CTL, 0, CTL_ZERO_BYTES, stream) != hipSuccess) { fprintf(stderr, "kernel_launch: memset failed\n"); return; }
    KP a{};
    for (int i = 0; i < 26; ++i) a.in[i] = (const float*)d_in[i];
    a.out = (float*)d_out; a.ws = (unsigned char*)d_ws;
#if MK_ONE_LAUNCH
    a.ph_lo = 0; a.ph_hi = N_PHASES;
    hipLaunchKernelGGL(mk_fwd, dim3(grid), dim3(NWAVES * 64), LDS_BYTES, stream, a);
#else
#ifndef PROBE_PHASE
#define PROBE_PHASE -1
#endif
    { const int phs[10] = {0, 1, 2, 4, 6, 7, 8, 9, 10, 11};
      for (int i = 0; i < 10; ++i) { if (phs[i] == 10 && FUSE_FINAL) continue; if (phs[i] == 11 && EXP == 0) continue; const int k = phs[i]; a.ph_lo = k; a.ph_hi = k + 1;
          for (int rep = 0; rep < (k == PROBE_PHASE ? 2 : 1); ++rep) hipLaunchKernelGGL(mk_fwd, dim3(grid), dim3(NWAVES * 64), LDS_BYTES, stream, a); } }
#endif
    const hipError_t le = hipPeekAtLastError();
    if (le != hipSuccess) fprintf(stderr, "kernel_launch: launch failed: %s\n", hipGetErrorName(le));
}
```

```cpp
#include <hip/hip_runtime.h>
#include <cstdio>
#include <cstdint>
#define MK_ONE_LAUNCH 1
namespace pg8 {
#define PG8_LAS __attribute__((address_space(3)))
typedef unsigned short bf16_t;
typedef short bf16x8 __attribute__((ext_vector_type(8)));
typedef float f32x4 __attribute__((ext_vector_type(4)));
typedef unsigned u32x4 __attribute__((ext_vector_type(4)));
typedef unsigned u32x2 __attribute__((ext_vector_type(2)));
constexpr int BM = 256, BK = 64, HALF = 128, HTB = HALF * BK * 2  , STAGE_BYTES = 8 * HTB, NXCD = 8, WGM = 8;

__host__ __device__ __forceinline__ int lds_byte(int r, int c) { const int st = (r >> 4) * 2 + (c >> 5), rr = r & 15, cc = c & 31, ob = rr * 64 + cc * 2; return st * 1024 + (ob ^ (((ob >> 9) & 1) << 5)); }
__host__ __device__ __forceinline__ void stage_rc(int b, int& R, int& C) { const int st = b / 1024, sb = b % 1024, swz = sb ^ (((sb >> 9) & 1) << 5); R = (st >> 1) * 16 + swz / 64; C = (st & 1) * 32 + (swz % 64) / 2; }
__host__ __device__ __forceinline__ int perm32(int rho) { const int n = rho >> 4, i = rho & 15; return 8 * (i >> 2) + 4 * n + (i & 3); }
__host__ __device__ __forceinline__ int amap_row(int R) { return 128 * (R >> 6) + 8 * (R & 15) + ((R >> 4) & 3); }

struct Unit { int pm, pn; };
struct Gemm { const bf16_t* A; const bf16_t* Bt; int K, lda, ldb; };

struct StaticOrder {
    int nM, nN, nwg, G, c;
    __host__ __device__ void init(int M, int N, int G_, int c_) { nM = M / BM; nN = N / BM; nwg = nM * nN; G = G_; c = c_; }
    __host__ __device__ bool next(int i, Unit& u) const {
        const long L = (long)i * G + c; if (L >= nwg) return false;
        int wgid = (int)L; { const int q = nwg / NXCD, r = nwg % NXCD, xcd = wgid % NXCD, off = wgid / NXCD; wgid = (xcd < r ? xcd * (q + 1) : r * (q + 1) + (xcd - r) * q) + off; }
        const int nig = WGM * nN, gid = wgid / nig, fm = gid * WGM, gsz = (nM - fm) < WGM ? (nM - fm) : WGM;
        u.pm = fm + ((wgid % nig) % gsz); u.pn = (wgid % nig) / gsz; return true;
    }
    __device__ __forceinline__ void a_ready(const Unit&) const {}
    __device__ __forceinline__ void done(const Unit&) const {}
};
struct StripOrder {
    int pm0, pn, cnt;
    __device__ __forceinline__ bool next(int i, Unit& u) const { if (i >= cnt) return false; u.pm = pm0 + i; u.pn = pn; return true; }
    __device__ __forceinline__ void a_ready(const Unit&) const {}
    __device__ __forceinline__ void done(const Unit&) const {}
};

__device__ __forceinline__ unsigned cvt_pk_bf16(float lo, float hi) { unsigned r; asm volatile("v_cvt_pk_bf16_f32 %0, %1, %2" : "=v"(r) : "v"(lo), "v"(hi)); return r; }

template <class Epi, class Sched, bool ALIGN_EPI = false, bool SP2 = false>
__device__ __forceinline__ void gemm_phase(PG8_LAS unsigned char* lds, const Gemm g, const Sched& S, const Epi& E) {
    const int tid = threadIdx.x, wid = __builtin_amdgcn_readfirstlane(tid >> 6), lane = tid & 63, wr = wid >> 2, wc = wid & 3, fr = lane & 15, fq = lane >> 4;
    const int K = g.K, nt = K / BK;
    unsigned voffA[2], voffB[2];
#pragma unroll
    for (int i = 0; i < 2; ++i) { int R, C; stage_rc(tid * 16 + i * 8192, R, C); const int Rb = Epi::PERM ? ((R & ~31) + perm32(R & 31)) : R; const int Ra = Epi::AMAP ? amap_row(R) : R;
        voffA[i] = (unsigned)(Ra * g.lda + C) * 2u; voffB[i] = (unsigned)(Rb * g.ldb + C) * 2u; }
    const size_t kstep = (size_t)(BK * 2);
    const size_t hstepA = Epi::AMAP ? (size_t)4 * g.lda * 2 : (size_t)HALF * g.lda * 2;
    const size_t hstepB = (size_t)HALF * g.ldb * 2;
    const size_t tstepA = (size_t)BM * g.lda * 2, tstepB = (size_t)BM * g.ldb * 2;
    const unsigned ldsw = (unsigned)wid * 1024u;
    const int aoff = lds_byte(wr * 64 + fr, fq * 8), boff = lds_byte(wc * 32 + fr, fq * 8);
#define PG8_SA(b, h) (((b) * 2 + (h)) * HTB)
#define PG8_SB(b, h) ((4 + (b) * 2 + (h)) * HTB)
#define PG8_STAGE(bufoff, gbase, voff) do { _Pragma("unroll") for (int _i = 0; _i < 2; ++_i) \
        __builtin_amdgcn_global_load_lds((const unsigned*)((const char*)(gbase) + (voff)[_i]), (PG8_LAS unsigned*)(lds + (bufoff) + ldsw + _i * 8192), 16, 0, 0); } while (0)
#define PG8_LDA(dst, b, h) do { _Pragma("unroll") for (int m = 0; m < 4; ++m) _Pragma("unroll") for (int k = 0; k < 2; ++k) dst[m][k] = *(const PG8_LAS bf16x8*)(lds + PG8_SA(b, h) + aoff + m * 2048 + k * 1024); } while (0)
#define PG8_LDB(dst, b, h) do { _Pragma("unroll") for (int n = 0; n < 2; ++n) _Pragma("unroll") for (int k = 0; k < 2; ++k) dst[n][k] = *(const PG8_LAS bf16x8*)(lds + PG8_SB(b, h) + boff + n * 2048 + k * 1024); } while (0)
#define PG8_MMA(ai, bj, At, Bt) do { __builtin_amdgcn_s_setprio(1); _Pragma("unroll") for (int m = 0; m < 4; ++m) _Pragma("unroll") for (int n = 0; n < 2; ++n) _Pragma("unroll") for (int k = 0; k < 2; ++k) \
        acc[ai][bj][m][n] = __builtin_amdgcn_mfma_f32_16x16x32_bf16(Bt[n][k], At[m][k], acc[ai][bj][m][n], 0, 0, 0); __builtin_amdgcn_s_setprio(0); } while (0)
#define PG8_WAIT_V(n) asm volatile("s_waitcnt vmcnt(" #n ")" ::: "memory")
#define PG8_WAIT_L(n) asm volatile("s_waitcnt lgkmcnt(" #n ")" ::: "memory")
#define PG8_BAR __builtin_amdgcn_s_barrier()
#define PG8_SCHED __builtin_amdgcn_sched_barrier(0)
    Unit cur, nxt; int ui = 0;
    if (!S.next(0, cur)) return;
    f32x4 acc[2][2][4][2];
#pragma unroll
    for (int a = 0; a < 2; ++a)
#pragma unroll
        for (int b = 0; b < 2; ++b)
#pragma unroll
            for (int m = 0; m < 4; ++m)
#pragma unroll
                for (int n = 0; n < 2; ++n) acc[a][b][m][n] = (f32x4){0.f, 0.f, 0.f, 0.f};
    bf16x8 At[4][2], B0[2][2], B1[2][2];
    const char* cA = (const char*)g.A + (size_t)cur.pm * tstepA; const char* cB = (const char*)g.Bt + (size_t)cur.pn * tstepB;
    S.a_ready(cur);
    if constexpr (SP2) {
        PG8_STAGE(PG8_SB(0, 0), cB, voffB); PG8_STAGE(PG8_SB(0, 1), cB + hstepB, voffB); PG8_STAGE(PG8_SA(0, 0), cA, voffA); PG8_STAGE(PG8_SA(0, 1), cA + hstepA, voffA);
        if (wr == 1) PG8_BAR;
        PG8_WAIT_V(2); PG8_BAR;
        PG8_STAGE(PG8_SB(1, 0), cB + kstep, voffB); PG8_STAGE(PG8_SA(1, 0), cA + kstep, voffA); PG8_STAGE(PG8_SB(1, 1), cB + hstepB + kstep, voffB);
        PG8_WAIT_V(6); PG8_BAR;
    } else {
        PG8_STAGE(PG8_SB(0, 0), cB, voffB); PG8_STAGE(PG8_SA(0, 0), cA, voffA); PG8_STAGE(PG8_SB(0, 1), cB + hstepB, voffB); PG8_STAGE(PG8_SA(0, 1), cA + hstepA, voffA);
        if (wr == 1) PG8_BAR;
        PG8_WAIT_V(4); PG8_BAR;
        PG8_STAGE(PG8_SB(1, 0), cB + kstep, voffB); PG8_STAGE(PG8_SA(1, 0), cA + kstep, voffA); PG8_STAGE(PG8_SB(1, 1), cB + hstepB + kstep, voffB);
        PG8_WAIT_V(6); PG8_BAR;
    }
    for (;;) {
        const bool has_next = S.next(ui + 1, nxt);
        const char* nA = has_next ? (const char*)g.A + (size_t)nxt.pm * tstepA : cA; const char* nB = has_next ? (const char*)g.Bt + (size_t)nxt.pn * tstepB : cB;
        for (int t = 0; t < nt; t += 2) {
            const bool last = (t == nt - 2);
            const char* a1 = cA + (size_t)(t + 1) * kstep;
            const char* a2 = last ? nA : cA + (size_t)(t + 2) * kstep; const char* b2 = last ? nB : cB + (size_t)(t + 2) * kstep;
            const char* a3 = a2 + kstep; const char* b3 = b2 + kstep;
            if (last && has_next) S.a_ready(nxt);
            if constexpr (Epi::MID) { if (t == (nt >> 1)) E.template mid<2, 2>(acc, cur, 0, 0, wr, wc, fr, fq); }
            if constexpr (SP2) {
            PG8_LDB(B0, 0, 0); PG8_LDB(B1, 0, 1); PG8_SCHED; PG8_LDA(At, 0, 0); PG8_STAGE(PG8_SA(1, 1), a1 + hstepA, voffA);
            PG8_WAIT_V(8); PG8_WAIT_L(0); PG8_BAR; PG8_MMA(0, 0, At, B0); PG8_MMA(0, 1, At, B1); PG8_BAR; PG8_SCHED;
            PG8_LDA(At, 0, 1); PG8_STAGE(PG8_SB(0, 0), b2, voffB); PG8_STAGE(PG8_SB(0, 1), b2 + hstepB, voffB); PG8_STAGE(PG8_SA(0, 0), a2, voffA);
            PG8_WAIT_V(8); PG8_WAIT_L(0); PG8_BAR; PG8_MMA(1, 0, At, B0); PG8_MMA(1, 1, At, B1); PG8_BAR; PG8_SCHED;
            PG8_LDB(B0, 1, 0); PG8_LDB(B1, 1, 1); PG8_SCHED; PG8_LDA(At, 1, 0); PG8_STAGE(PG8_SA(0, 1), a2 + hstepA, voffA);
            PG8_WAIT_V(8); PG8_WAIT_L(0); PG8_BAR; PG8_MMA(0, 0, At, B0); PG8_MMA(0, 1, At, B1); PG8_BAR; PG8_SCHED;
            PG8_LDA(At, 1, 1); PG8_STAGE(PG8_SB(1, 0), b3, voffB); PG8_STAGE(PG8_SB(1, 1), b3 + hstepB, voffB); PG8_STAGE(PG8_SA(1, 0), a3, voffA);
            PG8_WAIT_V(8); PG8_WAIT_L(0); PG8_BAR; PG8_MMA(1, 0, At, B0); PG8_MMA(1, 1, At, B1); PG8_BAR; PG8_SCHED;
            } else {
            PG8_LDB(B0, 0, 0); PG8_SCHED; PG8_LDA(At, 0, 0); PG8_STAGE(PG8_SA(1, 1), a1 + hstepA, voffA);
            PG8_WAIT_L(8); PG8_BAR; PG8_WAIT_L(0); PG8_MMA(0, 0, At, B0); PG8_BAR; PG8_SCHED;
            PG8_LDB(B1, 0, 1); PG8_STAGE(PG8_SB(0, 0), b2, voffB);
            PG8_BAR; PG8_WAIT_L(0); PG8_MMA(0, 1, At, B1); PG8_BAR;
            PG8_LDA(At, 0, 1); PG8_STAGE(PG8_SA(0, 0), a2, voffA);
            PG8_BAR; PG8_WAIT_L(0); PG8_MMA(1, 0, At, B0); PG8_BAR; PG8_SCHED;
            PG8_STAGE(PG8_SB(0, 1), b2 + hstepB, voffB);
            PG8_WAIT_V(6); PG8_BAR; PG8_MMA(1, 1, At, B1); PG8_BAR;
            PG8_LDB(B0, 1, 0); PG8_SCHED; PG8_LDA(At, 1, 0); PG8_STAGE(PG8_SA(0, 1), a2 + hstepA, voffA);
            PG8_WAIT_L(8); PG8_BAR; PG8_WAIT_L(0); PG8_MMA(0, 0, At, B0); PG8_BAR; PG8_SCHED;
            PG8_LDB(B1, 1, 1); PG8_STAGE(PG8_SB(1, 0), b3, voffB);
            PG8_BAR; PG8_WAIT_L(0); PG8_MMA(0, 1, At, B1); PG8_BAR;
            PG8_LDA(At, 1, 1); PG8_STAGE(PG8_SA(1, 0), a3, voffA);
            PG8_BAR; PG8_WAIT_L(0); PG8_MMA(1, 0, At, B0); PG8_BAR; PG8_SCHED;
            PG8_STAGE(PG8_SB(1, 1), b3 + hstepB, voffB);
            PG8_WAIT_V(6); PG8_BAR; PG8_MMA(1, 1, At, B1); PG8_BAR;
            }
        }
        if constexpr (ALIGN_EPI) { if (wr == 0) PG8_BAR; }
        E.template run<2, 2>(acc, cur, 0, 0, wr, wc, fr, fq); S.done(cur);
        if (!has_next) break;
#pragma unroll
        for (int a = 0; a < 2; ++a)
#pragma unroll
            for (int b = 0; b < 2; ++b)
#pragma unroll
                for (int m = 0; m < 4; ++m)
#pragma unroll
                    for (int n = 0; n < 2; ++n) acc[a][b][m][n] = (f32x4){0.f, 0.f, 0.f, 0.f};
        cur = nxt; cA = nA; cB = nB; ++ui;
        if constexpr (ALIGN_EPI) { if (wr == 1) PG8_BAR; }
    }
    PG8_WAIT_V(0);
    if constexpr (!ALIGN_EPI) { if (wr == 0) PG8_BAR; }
    PG8_BAR;
#undef PG8_SA
#undef PG8_SB
#undef PG8_STAGE
#undef PG8_LDA
#undef PG8_LDB
#undef PG8_MMA
#undef PG8_WAIT_V
#undef PG8_WAIT_L
#undef PG8_BAR
#undef PG8_SCHED
}

template <int NB, class Epi>
__device__ __forceinline__ void sub_gemm(PG8_LAS unsigned char* lds, const Gemm g, int pm, int pn, int ai0, int bj0, const Epi& E) {
    int tid_ = threadIdx.x; asm volatile("" : "+v"(tid_));
    const int tid = tid_, wid = __builtin_amdgcn_readfirstlane(tid >> 6), lane = tid & 63, wr = wid >> 2, wc = wid & 3, fr = lane & 15, fq = lane >> 4;
    const int nt = g.K / BK;
    unsigned voffA[2], voffB[2];
#pragma unroll
    for (int i = 0; i < 2; ++i) { int R, C; stage_rc(tid * 16 + i * 8192, R, C); const int Rb = Epi::PERM ? ((R & ~31) + perm32(R & 31)) : R;
        voffA[i] = (unsigned)(R * g.lda + C) * 2u; voffB[i] = (unsigned)(Rb * g.ldb + C) * 2u; }
    const size_t kstep = (size_t)(BK * 2), hstepB = (size_t)HALF * g.ldb * 2;
    const unsigned ldsw = (unsigned)wid * 1024u;
    const int aoff = lds_byte(wr * 64 + fr, fq * 8), boff = lds_byte(wc * 32 + fr, fq * 8);
    const char* cA = (const char*)g.A + ((size_t)pm * BM + (size_t)ai0 * HALF) * g.lda * 2; const char* cB = (const char*)g.Bt + ((size_t)pn * BM + (size_t)bj0 * HALF) * g.ldb * 2;
#define SG_BUF(b, j) ((b) * 3 * HTB + (j) * HTB)
#define SG_STAGE(bufoff, gbase, voff) do { _Pragma("unroll") for (int _i = 0; _i < 2; ++_i) \
        __builtin_amdgcn_global_load_lds((const unsigned*)((const char*)(gbase) + (voff)[_i]), (PG8_LAS unsigned*)(lds + (bufoff) + ldsw + _i * 8192), 16, 0, 0); } while (0)
    f32x4 acc[1][NB][4][2];
#pragma unroll
    for (int b = 0; b < NB; ++b)
#pragma unroll
        for (int m = 0; m < 4; ++m)
#pragma unroll
            for (int n = 0; n < 2; ++n) acc[0][b][m][n] = (f32x4){0.f, 0.f, 0.f, 0.f};
    SG_STAGE(SG_BUF(0, 0), cA, voffA);
#pragma unroll
    for (int j = 0; j < NB; ++j) SG_STAGE(SG_BUF(0, 1 + j), cB + j * hstepB, voffB);
#pragma unroll 1
    for (int t = 0; t < nt; ++t) {
        const int cur = t & 1;
        if constexpr (Epi::MID) { if (t == (nt >> 1)) E.template mid<1, NB>(acc, Unit{pm, pn}, ai0 * HALF, bj0 * HALF, wr, wc, fr, fq); }
        if (t + 1 < nt) {
            SG_STAGE(SG_BUF(cur ^ 1, 0), cA + (size_t)(t + 1) * kstep, voffA);
#pragma unroll
            for (int j = 0; j < NB; ++j) SG_STAGE(SG_BUF(cur ^ 1, 1 + j), cB + j * hstepB + (size_t)(t + 1) * kstep, voffB);
            if constexpr (NB == 1) asm volatile("s_waitcnt vmcnt(4)" ::: "memory"); else asm volatile("s_waitcnt vmcnt(6)" ::: "memory");
        } else asm volatile("s_waitcnt vmcnt(0)" ::: "memory");
        __builtin_amdgcn_s_barrier();
        bf16x8 At[4][2], Bf[NB][2][2];
#pragma unroll
        for (int m = 0; m < 4; ++m)
#pragma unroll
            for (int k = 0; k < 2; ++k) At[m][k] = *(const PG8_LAS bf16x8*)(lds + SG_BUF(cur, 0) + aoff + m * 2048 + k * 1024);
#pragma unroll
        for (int j = 0; j < NB; ++j)
#pragma unroll
            for (int n = 0; n < 2; ++n)
#pragma unroll
                for (int k = 0; k < 2; ++k) Bf[j][n][k] = *(const PG8_LAS bf16x8*)(lds + SG_BUF(cur, 1 + j) + boff + n * 2048 + k * 1024);
        asm volatile("s_waitcnt lgkmcnt(0)" ::: "memory"); __builtin_amdgcn_sched_barrier(0);
#pragma unroll
        for (int j = 0; j < NB; ++j)
#pragma unroll
            for (int m = 0; m < 4; ++m)
#pragma unroll
                for (int n = 0; n < 2; ++n)
#pragma unroll
                    for (int k = 0; k < 2; ++k) acc[0][j][m][n] = __builtin_amdgcn_mfma_f32_16x16x32_bf16(Bf[j][n][k], At[m][k], acc[0][j][m][n], 0, 0, 0);
        __builtin_amdgcn_s_barrier();
    }
    E.template run<1, NB>(acc, Unit{pm, pn}, ai0 * HALF, bj0 * HALF, wr, wc, fr, fq);
#undef SG_BUF
#undef SG_STAGE
}
}
constexpr int NWAVES = 8;
constexpr int DM = 1024, NBATCH = 8, SEQ = 4096, SBATCH = 16, SSEQ = 16, PAST = 2048;
constexpr int MP = NBATCH * SEQ, MS = SBATCH * SSEQ, M = MP + MS, NTILE = M / 256, STILE = MP / 256;
constexpr int DIN = 4096, DFF = 3072, DUP = 6144;
constexpr float EPS = 1e-6f;
constexpr size_t OFF_Y = 0, OFF_HP = (size_t)M * DM, OFF_LCP = OFF_HP + NBATCH * DM, OFF_PLP = OFF_LCP + NBATCH * 3 * DM, OFF_FCP = OFF_PLP + NBATCH * 15 * DM,
                 OFF_HS = OFF_FCP + NBATCH * 2 * DUP, OFF_LCS = OFF_HS + SBATCH * DM, OFF_PLS = OFF_LCS + SBATCH * 3 * DM, OFF_FCS = OFF_PLS + SBATCH * 15 * DM,
                 OUT_TOTAL = OFF_FCS + SBATCH * 2 * DUP;
constexpr size_t MiB = 1u << 20;
constexpr size_t WS_CTL = 0, CTL_ZERO_BYTES = 64 * 1024;
constexpr size_t WS_WIN = 1 * MiB, WS_WCAT = 9 * MiB, WS_WOUT = 13 * MiB, WS_WUP = 15 * MiB, WS_WDN = 27 * MiB, WS_WG = 33 * MiB;
constexpr size_t WS_SSQ = 33 * MiB + 512 * 1024, WS_SSQ2 = 37 * MiB + 768 * 1024, WS_SUMM = WS_SSQ;
static_assert(WS_SSQ + (size_t)M * 128 <= WS_SSQ2 && WS_SSQ2 + (size_t)M * 128 <= 42 * MiB, "ssq map");
constexpr size_t WS_R0 = 42 * MiB, WS_R1 = 107 * MiB, WS_R2 = 236 * MiB, WS_R3 = 365 * MiB, WS_WBP = 494 * MiB, WS_WPOOL = 496 * MiB, WS_HA = 497 * MiB, WS_HB = 499 * MiB, WS_END = 501 * MiB;
static_assert((size_t)M * DM * 2 <= WS_R1 - WS_R0 && (size_t)M * 2048 * 2 <= WS_R2 - WS_R1 && (size_t)M * 2048 * 2 <= WS_R3 - WS_R2 && (size_t)M * 2048 * 2 <= WS_END - WS_R3 && (size_t)M * DFF * 2 <= WS_END - WS_R2, "ws map");
constexpr int CW_BAR = 1024, CW_PANEL = 8192;
constexpr int RING_BYTES = 131072;
constexpr int MISC_OFF = RING_BYTES, RS_OFF = RING_BYTES + 512, EDGE_START_OFF = RS_OFF + 4096, EDGE_MID_OFF = EDGE_START_OFF + 2048, EDGE_PREV_OFF = EDGE_MID_OFF + 2048;
constexpr int CWL_OFF = EDGE_PREV_OFF + 4096;
constexpr int LDS_BYTES = 155648;
static_assert(CWL_OFF + 4096 <= LDS_BYTES, "LDS map");

#define GAS __attribute__((address_space(1)))
#define LAS __attribute__((address_space(3)))
typedef unsigned short bf16;
typedef unsigned v4u __attribute__((ext_vector_type(4)));
typedef unsigned v2u __attribute__((ext_vector_type(2)));
typedef float f32x4 __attribute__((ext_vector_type(4)));
typedef short bf16x8 __attribute__((ext_vector_type(8)));
#define LDS_WAIT() asm volatile("s_waitcnt lgkmcnt(0)" ::: "memory")
#define VM_WAIT() asm volatile("s_waitcnt vmcnt(0)" ::: "memory")
__device__ __forceinline__ unsigned f2bf(float f) { unsigned u = __builtin_bit_cast(unsigned, f); return (u + 0x7fffu + ((u >> 16) & 1u)) >> 16; }
__device__ __forceinline__ unsigned pk2(float lo, float hi) { return f2bf(lo) | (f2bf(hi) << 16); }
__device__ __forceinline__ float bflo(unsigned w) { return __builtin_bit_cast(float, w << 16); }
__device__ __forceinline__ float bfhi(unsigned w) { return __builtin_bit_cast(float, w & 0xffff0000u); }
__device__ __forceinline__ float sigmoidf_fast(float x) { return __builtin_amdgcn_rcpf(1.0f + __builtin_amdgcn_exp2f(-1.4426950408889634f * x)); }
__device__ __forceinline__ float gelu_tanh(float g) { const float z = g * (1.0f + 0.044715f * g * g); return g * __builtin_amdgcn_rcpf(1.0f + __builtin_amdgcn_exp2f(-2.302208198f * z)); }
__device__ __forceinline__ float dpp_shr1(float v) { return __builtin_bit_cast(float, __builtin_amdgcn_update_dpp(__builtin_bit_cast(int, v), __builtin_bit_cast(int, v), 0x111  , 0xf, 0xf, false)); }
__device__ __forceinline__ float wave_sum(float v) {
#pragma unroll
    for (int o = 1; o < 64; o <<= 1) v += __shfl_xor(v, o);
    return v;
}

#define XB_TMO      128
#define XB_XCNT(j)  (256  + 64 * (j))
#define XB_XSUB(j)  (1280 + 64 * (j))
#define XB_XGEN(j)  (2304 + 64 * (j))
#define XB_TOP      3328
#define XB_TOPGEN   3392
#define XCD_BAR_WORDS 3456
#define XB_SPIN_CAP (1u << 20)
static_assert((CW_BAR + XCD_BAR_WORDS) <= CW_PANEL && (CW_PANEL + 32 * 132) * 4 <= (int)CTL_ZERO_BYTES, "control words inside the memset region");
__device__ __forceinline__ unsigned xb_ld(unsigned* p)              { return __hip_atomic_load(p, __ATOMIC_RELAXED, __HIP_MEMORY_SCOPE_AGENT); }
__device__ __forceinline__ unsigned xb_add(unsigned* p, unsigned v) { return __hip_atomic_fetch_add(p, v, __ATOMIC_RELAXED, __HIP_MEMORY_SCOPE_AGENT); }
__device__ __forceinline__ unsigned xb_xcc_id() { return (unsigned)__builtin_amdgcn_s_getreg((3 << 11) | 20) & 0xFu; }
#define XB_SPIN(cond, bar) do { unsigned _sp = 0; while (cond) { __builtin_amdgcn_s_sleep(1); \
    if ((++_sp & 255u) == 0u) { if (xb_ld(&(bar)[XB_TMO])) break; if (_sp > XB_SPIN_CAP) { atomicAdd(&(bar)[XB_TMO], 1u); break; } } } } while (0)
struct XcdBarrier { unsigned* bar; unsigned x; volatile LAS unsigned* st; };
__device__ __forceinline__ XcdBarrier xcd_barrier_post(unsigned* bar, volatile LAS unsigned* st) {
    XcdBarrier b; b.bar = bar; b.x = xb_xcc_id(); b.st = st;
    if (threadIdx.x == 0) (void)xb_add(&bar[XB_XCNT(b.x)], 1u);
    return b;
}
__device__ __forceinline__ void xcd_barrier_complete(unsigned* bar, unsigned x, unsigned& nloc, unsigned& nx) {
    const unsigned G = gridDim.x * gridDim.y * gridDim.z;
    unsigned sum, cnt, mine, sp = 0u;
    for (;;) {
        sum = 0u; cnt = 0u; mine = 0u;
#pragma unroll
        for (unsigned j = 0; j < 16; ++j) { const unsigned c = xb_ld(&bar[XB_XCNT(j)]); sum += c; cnt += (c > 0u) ? 1u : 0u; mine = (j == x) ? c : mine; }
        if (sum == G) break;
        __builtin_amdgcn_s_sleep(1);
        if ((++sp & 255u) == 0u) { if (xb_ld(&bar[XB_TMO])) break; if (sp > XB_SPIN_CAP) { atomicAdd(&bar[XB_TMO], 1u); break; } }
    }
    nloc = mine > 0u ? mine : 1u; nx = cnt > 0u ? cnt : 1u;
}
__device__ __forceinline__ void xcd_barrier(const XcdBarrier& b) {
    asm volatile("s_waitcnt vmcnt(0)" ::: "memory");
    __syncthreads();
    if (threadIdx.x == 0) {
        unsigned* bar = b.bar;
        __builtin_amdgcn_s_waitcnt(0);
        unsigned nloc = b.st[0], nx = b.st[1];
        if (nloc == 0u) { xcd_barrier_complete(bar, b.x, nloc, nx); b.st[0] = nloc; b.st[1] = nx; }
        const unsigned old = xb_add(&bar[XB_XSUB(b.x)], 1u);
        const unsigned gen = old / nloc;
        if (old + 1u == (gen + 1u) * nloc) {
            __builtin_amdgcn_fence(__ATOMIC_RELEASE, "agent");
            asm volatile("s_waitcnt vmcnt(0)" ::: "memory");
            const unsigned og = xb_add(&bar[XB_TOP], 1u);
            const unsigned tg = og / nx;
            if (og + 1u == (tg + 1u) * nx) xb_add(&bar[XB_TOPGEN], 1u);
            else XB_SPIN(xb_ld(&bar[XB_TOPGEN]) == tg, bar);
            __builtin_amdgcn_fence(__ATOMIC_ACQUIRE, "agent");
            xb_add(&bar[XB_XGEN(b.x)], 1u);
            asm volatile("s_waitcnt vmcnt(0)" ::: "memory");
        } else {
            XB_SPIN(xb_ld(&bar[XB_XGEN(b.x)]) == gen, bar);
            __builtin_amdgcn_fence(__ATOMIC_ACQUIRE, "agent");
            asm volatile("s_waitcnt vmcnt(0)" ::: "memory");
        }
    }
    __syncthreads();
}

struct KP {
    const float* in[26];
    float* out; unsigned char* ws;
    int ph_lo, ph_hi;
};
enum { I_XP = 0, I_XS, I_STH, I_STLC, I_STPOOL, I_STFFN, I_NMIX, I_WIN, I_CLW, I_CLB, I_WRA, I_BRA, I_WIX, I_BIX, I_LAM, I_WPOOL, I_PSCALE, I_WBRL, I_WBRP, I_WOUT, I_NFFN, I_WUP, I_CFW, I_CFB, I_WDN, I_NFIN };

using pg8::Unit;
struct EpiZ {
    static constexpr bool PERM = true, AMAP = false, MID = false;
    bf16* ZR; bf16* G;
    template <int NA, int NB> __device__ __forceinline__ void run(f32x4 (&acc)[NA][NB][4][2], const Unit& u, int rowoff, int coloff, int wr, int wc, int fr, int fq) const {
        const int row0 = u.pm * 256 + rowoff + wr * 64 + fr; const bool gate = u.pn >= 8;
        bf16* base = gate ? G : ZR; const int col0 = (u.pn & 7) * 256 + coloff + wc * 32 + 8 * fq;
#pragma unroll
        for (int ai = 0; ai < NA; ++ai)
#pragma unroll
            for (int m = 0; m < 4; ++m) { bf16* rowp = base + (size_t)(row0 + ai * 128 + m * 16) * 2048 + col0;
#pragma unroll
                for (int bj = 0; bj < NB; ++bj) { f32x4 v0 = acc[ai][bj][m][0], v1 = acc[ai][bj][m][1];
                    if (gate) {
#pragma unroll
                        for (int j = 0; j < 4; ++j) { v0[j] = sigmoidf_fast(v0[j]); v1[j] = sigmoidf_fast(v1[j]); } }
                    v4u w; w.x = pg8::cvt_pk_bf16(v0[0], v0[1]); w.y = pg8::cvt_pk_bf16(v0[2], v0[3]); w.z = pg8::cvt_pk_bf16(v1[0], v1[1]); w.w = pg8::cvt_pk_bf16(v1[2], v1[3]);
                    *(v4u*)(rowp + bj * 128) = w; } }
    }
};
struct EpiBr {
    static constexpr bool PERM = true, AMAP = false, MID = true;
    const bf16* G; bf16* MG;
    template <int NA, int NB> __device__ __forceinline__ void mid(f32x4 (&acc)[NA][NB][4][2], const Unit& u, int rowoff, int coloff, int wr, int wc, int fr, int fq) const {
        int pm_ = u.pm, pn_ = u.pn; asm volatile("" : "+s"(pm_), "+s"(pn_));
        const int row0 = pm_ * 256 + rowoff + wr * 64 + fr, col0 = pn_ * 256 + coloff + wc * 32 + 8 * fq;
#pragma unroll
        for (int ai = 0; ai < NA; ++ai)
#pragma unroll
            for (int m = 0; m < 4; ++m) { const size_t row = (size_t)(row0 + ai * 128 + m * 16);
#pragma unroll
                for (int bj = 0; bj < NB; ++bj) { const int col = col0 + bj * 128;
                    const v4u ga = *(const v4u*)(G + row * 2048 + col), gb = *(const v4u*)(G + row * 2048 + 1024 + col);
                    const float a_[8] = {bflo(ga.x), bfhi(ga.x), bflo(ga.y), bfhi(ga.y), bflo(ga.z), bfhi(ga.z), bflo(ga.w), bfhi(ga.w)};
                    const float b_[8] = {bflo(gb.x), bfhi(gb.x), bflo(gb.y), bfhi(gb.y), bflo(gb.z), bfhi(gb.z), bflo(gb.w), bfhi(gb.w)};
#pragma unroll
                    for (int e = 0; e < 4; ++e) { acc[ai][bj][m][0][e] *= a_[e] * __builtin_amdgcn_rcpf(fmaxf(b_[e], 1e-30f)); acc[ai][bj][m][1][e] *= a_[4 + e] * __builtin_amdgcn_rcpf(fmaxf(b_[4 + e], 1e-30f)); } } }
    }
    template <int NA, int NB> __device__ __forceinline__ void run(f32x4 (&acc)[NA][NB][4][2], const Unit& u, int rowoff, int coloff, int wr, int wc, int fr, int fq) const {
        const int row0 = u.pm * 256 + rowoff + wr * 64 + fr, col0 = u.pn * 256 + coloff + wc * 32 + 8 * fq;
#pragma unroll
        for (int ai = 0; ai < NA; ++ai)
#pragma unroll
            for (int m = 0; m < 4; ++m) { const size_t row = (size_t)(row0 + ai * 128 + m * 16);
#pragma unroll
                for (int bj = 0; bj < NB; ++bj) { const int col = col0 + bj * 128;
                    const v4u gw = *(const v4u*)(G + row * 2048 + 1024 + col);
                    const f32x4 g0 = {bflo(gw.x), bfhi(gw.x), bflo(gw.y), bfhi(gw.y)}, g1 = {bflo(gw.z), bfhi(gw.z), bflo(gw.w), bfhi(gw.w)};
                    const f32x4 v0 = acc[ai][bj][m][0] * g0, v1 = acc[ai][bj][m][1] * g1;
                    v4u w; w.x = pg8::cvt_pk_bf16(v0[0], v0[1]); w.y = pg8::cvt_pk_bf16(v0[2], v0[3]); w.z = pg8::cvt_pk_bf16(v1[0], v1[1]); w.w = pg8::cvt_pk_bf16(v1[2], v1[3]);
                    *(v4u*)(MG + row * 1024 + col) = w; } }
    }
};
template <bool DOWN> struct EpiRes {
    static constexpr bool PERM = true, AMAP = false, MID = false;
    const float* xp; const float* xs; float* Y; bf16* X1B; float* SSQ;
    template <int NA, int NB> __device__ __forceinline__ void run(f32x4 (&acc)[NA][NB][4][2], const Unit& u, int rowoff, int coloff, int wr, int wc, int fr, int fq) const {
        const int row0 = u.pm * 256 + rowoff + wr * 64 + fr, col0 = u.pn * 256 + coloff + wc * 32 + 8 * fq;
        const float* xb = (u.pm < STILE ? xp : xs - (size_t)MP * DM);
#pragma unroll
        for (int ai = 0; ai < NA; ++ai)
#pragma unroll
            for (int m = 0; m < 4; ++m) { const size_t row = (size_t)(row0 + ai * 128 + m * 16);
#pragma unroll
                for (int bj = 0; bj < NB; ++bj) { const size_t off = row * 1024 + col0 + bj * 128; f32x4 v0, v1;
                    if (!DOWN) { v0 = acc[ai][bj][m][0] + *(const f32x4*)(xb + off); v1 = acc[ai][bj][m][1] + *(const f32x4*)(xb + off + 4); }
                    else { const v4u w = *(const v4u*)(X1B + off); v0 = acc[ai][bj][m][0] + (f32x4){bflo(w.x), bfhi(w.x), bflo(w.y), bfhi(w.y)}; v1 = acc[ai][bj][m][1] + (f32x4){bflo(w.z), bfhi(w.z), bflo(w.w), bfhi(w.w)}; }
                    float s = (v0[0] * v0[0] + v0[1] * v0[1]) + (v0[2] * v0[2] + v0[3] * v0[3]) + (v1[0] * v1[0] + v1[1] * v1[1]) + (v1[2] * v1[2] + v1[3] * v1[3]);
                    if (!DOWN) { v4u w; w.x = pg8::cvt_pk_bf16(v0[0], v0[1]); w.y = pg8::cvt_pk_bf16(v0[2], v0[3]); w.z = pg8::cvt_pk_bf16(v1[0], v1[1]); w.w = pg8::cvt_pk_bf16(v1[2], v1[3]);
                        *(v4u*)(X1B + off) = w; }
                    else { *(f32x4*)(Y + off) = v0; *(f32x4*)(Y + off + 4) = v1; }
                    s += __shfl_xor(s, 16); s += __shfl_xor(s, 32);
                    if (fq == 0) SSQ[row * 32 + u.pn * 8 + ((coloff >> 7) + bj) * 4 + wc] = s; } }
    }
};
__device__ __forceinline__ float row_rs(const float* SSQ, size_t row) {
    const f32x4* q = (const f32x4*)(SSQ + row * 32); float s = 0.f;
#pragma unroll
    for (int k = 0; k < 8; ++k) { const f32x4 a = q[k]; s += (a[0] + a[1]) + (a[2] + a[3]); }
    return 1.0f / sqrtf(s * (1.f / DM) + EPS);
}
struct EpiFinal {
    static constexpr bool PERM = true, AMAP = false, MID = false;
    float* Y; const bf16* X1B; const float* gf; float* XS; unsigned* cnt; unsigned* tmo; LAS unsigned char* lx;
    template <int NA, int NB> __device__ __forceinline__ void run(f32x4 (&acc)[NA][NB][4][2], const Unit& u, int rowoff, int coloff, int wr, int wc, int fr, int fq) const {
        LAS float* P = (LAS float*)(lx + RS_OFF); LAS float* S = P + 2048;
        int tid = threadIdx.x, pm_ = u.pm, pn_ = u.pn, fr_ = fr, fq_ = fq, wr_ = wr, wc_ = wc;
        asm volatile("" : "+v"(tid), "+s"(pm_), "+s"(pn_), "+v"(fr_), "+v"(fq_), "+s"(wr_), "+s"(wc_));
        const int wid = tid >> 6, lane = tid & 63;
        const int lrow0 = rowoff + wr_ * 64 + fr_, col0 = pn_ * 256 + coloff + wc_ * 32 + 8 * fq_, bj0 = coloff >> 7;
#pragma unroll
        for (int ai = 0; ai < NA; ++ai)
#pragma unroll
            for (int m = 0; m < 4; ++m) { const int lrow = lrow0 + ai * 128 + m * 16; const size_t row = (size_t)pm_ * 256 + lrow;
#pragma unroll
                for (int bj = 0; bj < NB; ++bj) { const size_t off = row * 1024 + col0 + bj * 128;
                    { const v4u w = *(const v4u*)(X1B + off); acc[ai][bj][m][0] += (f32x4){bflo(w.x), bfhi(w.x), bflo(w.y), bfhi(w.y)}; acc[ai][bj][m][1] += (f32x4){bflo(w.z), bfhi(w.z), bflo(w.w), bfhi(w.w)}; }
                    const f32x4 v0 = acc[ai][bj][m][0], v1 = acc[ai][bj][m][1];
                    float s = (v0[0] * v0[0] + v0[1] * v0[1]) + (v0[2] * v0[2] + v0[3] * v0[3]) + (v1[0] * v1[0] + v1[1] * v1[1]) + (v1[2] * v1[2] + v1[3] * v1[3]);
                    s += __shfl_xor(s, 16); s += __shfl_xor(s, 32);
                    if (fq_ == 0) P[lrow * 8 + (bj0 + bj) * 4 + wc_] = s; } }
        asm volatile("s_waitcnt lgkmcnt(0)" ::: "memory"); __builtin_amdgcn_s_barrier(); asm volatile("" ::: "memory");
        constexpr int RPW = (NA == 2) ? 32 : 16;
        const int nslot = (NA == 2) ? 4 : 8, slot = (NA == 2) ? pn_ : 2 * pn_ + bj0;
        const int prow = rowoff + wid * RPW + (lane & (RPW - 1));
        float* xs = XS + (size_t)pm_ * 2048;
        if (lane < RPW) { const LAS float* pp = P + prow * 8 + (NA == 2 ? 0 : bj0 * 4); float t = (pp[0] + pp[1]) + (pp[2] + pp[3]); if (NA == 2) t += (pp[4] + pp[5]) + (pp[6] + pp[7]);
            __hip_atomic_store(xs + slot * 256 + prow, t, __ATOMIC_RELAXED, __HIP_MEMORY_SCOPE_AGENT); }
        asm volatile("s_waitcnt vmcnt(0)" ::: "memory");
        unsigned* c = cnt + 32 * ((NA == 2) ? pm_ : (STILE + (rowoff >> 7)));
        if (lane == 0) __hip_atomic_fetch_add(c, 1u, __ATOMIC_RELAXED, __HIP_MEMORY_SCOPE_AGENT);
        if (wid == 0) { const unsigned want = 8u * (unsigned)nslot; unsigned sp = 0;
            while ((unsigned)__builtin_amdgcn_readfirstlane(__hip_atomic_load(c, __ATOMIC_RELAXED, __HIP_MEMORY_SCOPE_AGENT)) < want) {
                __builtin_amdgcn_s_sleep(1);
                if ((++sp & 255u) == 0u) { if (__builtin_amdgcn_readfirstlane(__hip_atomic_load(tmo, __ATOMIC_RELAXED, __HIP_MEMORY_SCOPE_AGENT)) != 0u) break; if (sp > (1u << 20)) { if (lane == 0) atomicAdd(tmo, 1u); break; } } } }
        asm volatile("s_waitcnt vmcnt(0) lgkmcnt(0)" ::: "memory"); __builtin_amdgcn_s_barrier(); asm volatile("" ::: "memory");
        if (lane < RPW) { float t = 0.f;
#pragma unroll
            for (int k = 0; k < 8; ++k) if (k < nslot) t += __hip_atomic_load(xs + k * 256 + prow, __ATOMIC_RELAXED, __HIP_MEMORY_SCOPE_AGENT);
            S[prow] = 1.0f / sqrtf(t * (1.f / DM) + EPS); }
        asm volatile("s_waitcnt lgkmcnt(0)" ::: "memory"); __builtin_amdgcn_s_barrier(); asm volatile("" ::: "memory");
        f32x4 gg[NB][2];
#pragma unroll
        for (int bj = 0; bj < NB; ++bj) { gg[bj][0] = *(const f32x4*)(gf + col0 + bj * 128); gg[bj][1] = *(const f32x4*)(gf + col0 + bj * 128 + 4); }
#pragma unroll
        for (int ai = 0; ai < NA; ++ai)
#pragma unroll
            for (int m = 0; m < 4; ++m) { const int lrow = lrow0 + ai * 128 + m * 16; const size_t row = (size_t)pm_ * 256 + lrow; const float rs = S[lrow];
#pragma unroll
                for (int bj = 0; bj < NB; ++bj) { const size_t off = row * 1024 + col0 + bj * 128;
                    *(f32x4*)(Y + off) = acc[ai][bj][m][0] * rs * gg[bj][0]; *(f32x4*)(Y + off + 4) = acc[ai][bj][m][1] * rs * gg[bj][1]; } }
    }
};
struct EpiW {
    static constexpr bool PERM = true, AMAP = false, MID = false;
    bf16* O;
    template <int NA, int NB> __device__ __forceinline__ void run(f32x4 (&acc)[NA][NB][4][2], const Unit& u, int rowoff, int coloff, int wr, int wc, int fr, int fq) const {
        const int row0 = u.pm * 256 + rowoff + wr * 64 + fr, col0 = u.pn * 256 + coloff + wc * 32 + 8 * fq;
#pragma unroll
        for (int ai = 0; ai < NA; ++ai)
#pragma unroll
            for (int m = 0; m < 4; ++m)
#pragma unroll
                for (int bj = 0; bj < NB; ++bj) { const f32x4 v0 = acc[ai][bj][m][0], v1 = acc[ai][bj][m][1];
                    v4u w; w.x = pg8::cvt_pk_bf16(v0[0], v0[1]); w.y = pg8::cvt_pk_bf16(v0[2], v0[3]); w.z = pg8::cvt_pk_bf16(v1[0], v1[1]); w.w = pg8::cvt_pk_bf16(v1[2], v1[3]);
                    *(v4u*)(O + (size_t)(row0 + ai * 128 + m * 16) * 2048 + col0 + bj * 128) = w; }
    }
};
template <bool AM> struct EpiNull {
    static constexpr bool PERM = true, AMAP = AM, MID = false;
    template <int NA, int NB> __device__ __forceinline__ void run(f32x4 (&acc)[NA][NB][4][2], const Unit&, int, int, int, int, int, int) const {
#pragma unroll
        for (int ai = 0; ai < NA; ++ai)
#pragma unroll
            for (int bj = 0; bj < NB; ++bj)
#pragma unroll
                for (int m = 0; m < 4; ++m) { asm volatile("" :: "v"(acc[ai][bj][m][0]), "v"(acc[ai][bj][m][1])); }
    }
};
struct EpiZScratch {
    static constexpr bool PERM = true, AMAP = false, MID = false;
    bf16* scr;
    template <int NA, int NB> __device__ __forceinline__ void run(f32x4 (&acc)[NA][NB][4][2], const Unit& u, int rowoff, int coloff, int wr, int wc, int fr, int fq) const {
        const int row0 = wr * 64 + fr, col0 = wc * 32 + 8 * fq;
#pragma unroll
        for (int ai = 0; ai < NA; ++ai)
#pragma unroll
            for (int m = 0; m < 4; ++m) { bf16* rowp = scr + (size_t)(row0 + ai * 128 + m * 16) * 256 + col0;
#pragma unroll
                for (int bj = 0; bj < NB; ++bj) { f32x4 v0 = acc[ai][bj][m][0], v1 = acc[ai][bj][m][1];
                    v4u w; w.x = pg8::cvt_pk_bf16(v0[0], v0[1]); w.y = pg8::cvt_pk_bf16(v0[2], v0[3]); w.z = pg8::cvt_pk_bf16(v1[0], v1[1]); w.w = pg8::cvt_pk_bf16(v1[2], v1[3]);
                    *(v4u*)(rowp + bj * 128) = w; } }
    }
};
struct EpiUpS {
    static constexpr bool PERM = true, AMAP = false, MID = false;
    bf16* ACT; const float* cw; const float* cb; const float* stf; float* ofs; const float* SSQ;
    template <int NA, int NB> __device__ __forceinline__ void run(f32x4 (&acc)[NA][NB][4][2], const Unit& u, int rowoff, int coloff, int wr, int wc, int fr, int fq) const {
        static_assert(NA == 1 && NB == 2, "sample FFN epilogue works on half sub-units");
        int pn_ = u.pn, ro_ = rowoff, fr_ = fr, fq_ = fq, wr_ = wr, wc_ = wc; asm volatile("" : "+s"(pn_), "+s"(ro_), "+v"(fr_), "+v"(fq_), "+s"(wr_), "+s"(wc_));
        const int cbase = 32 * wc_ + 8 * fq_, gcol = 128 * pn_ + cbase;
#pragma unroll
        for (int m = 0; m < 4; ++m) {
            asm volatile("" ::: "memory");
            const int lrow = ro_ + wr_ * 64 + m * 16 + fr_, seq = lrow >> 4; const size_t row = (size_t)MP + lrow;
            const float rs = row_rs(SSQ, row);
            unsigned pk[4];
#pragma unroll
            for (int n = 0; n < 2; ++n) { f32x4 gc;
#pragma unroll
                for (int bj = 0; bj < 2; ++bj) { const int oc = bj * DFF + gcol + 4 * n;
                    const f32x4 w0 = *(const f32x4*)(cw + oc), w1 = *(const f32x4*)(cw + DUP + oc), w2 = *(const f32x4*)(cw + 2 * DUP + oc), bb = *(const f32x4*)(cb + oc);
                    const f32x4 h = acc[0][bj][m][n] * rs; f32x4 hm1, hm2;
#pragma unroll
                    for (int e = 0; e < 4; ++e) { hm1[e] = __shfl_up(h[e], 1, 16); hm2[e] = __shfl_up(h[e], 2, 16); }
                    if (fr_ < 2) { const f32x4 s1 = *(const f32x4*)(stf + (size_t)(seq * 2 + 1) * DUP + oc); if (fr_ == 0) { hm1 = s1; hm2 = *(const f32x4*)(stf + (size_t)(seq * 2 + 0) * DUP + oc); } else hm2 = s1; }
                    if (fr_ >= 14) *(f32x4*)(ofs + (size_t)(seq * 2 + (fr_ - 14)) * DUP + oc) = h;
                    const f32x4 c = bb + w0 * hm2 + w1 * hm1 + w2 * h;
                    if (bj == 0) gc = c;
                    else { f32x4 a;
#pragma unroll
                        for (int e = 0; e < 4; ++e) a[e] = gelu_tanh(gc[e]) * c[e];
                        pk[2 * n] = pg8::cvt_pk_bf16(a[0], a[1]); pk[2 * n + 1] = pg8::cvt_pk_bf16(a[2], a[3]); } } }
            v4u w; w.x = pk[0]; w.y = pk[1]; w.z = pk[2]; w.w = pk[3];
            *(v4u*)(ACT + row * DFF + gcol) = w;
        }
    }
};
struct EpiUp {
    static constexpr bool PERM = true, AMAP = true, MID = false;
    bf16* ACT; const float* cw; const float* cb; const float* stf; float* ofp; float* ofs; LAS unsigned char* lx; int pm0; bf16* scr; float* HA; float* HB;
    template <int NA, int NB> __device__ __forceinline__ void run(f32x4 (&acc)[NA][NB][4][2], const Unit& u, int, int, int wr, int wc, int fr, int fq) const {
        int pm_ = u.pm, pn_ = u.pn, fr_ = fr, fq_ = fq; asm volatile("" : "+s"(pm_), "+s"(pn_), "+v"(fr_), "+v"(fq_));
        const bool samp = (pm_ == STILE); const int j = pm_ - pm0;
        const LAS float* RS = (const LAS float*)(lx + RS_OFF) + j * 256 + 128 * wr + 8 * fr_;
        const f32x4 rsa = *(const LAS f32x4*)RS, rsb = *(const LAS f32x4*)(RS + 4);
        const float rs[8] = {rsa[0], rsa[1], rsa[2], rsa[3], rsb[0], rsb[1], rsb[2], rsb[3]};
        const int cbase = 32 * wc + 8 * fq_, gcol = 128 * pn_ + cbase;
        const LAS float* Ein = (const LAS float*)(lx + (wr == 0 ? (j == 0 ? EDGE_START_OFF : EDGE_PREV_OFF + 2048 * (j & 1)) : EDGE_MID_OFF));
        LAS float* Eout = (LAS float*)(lx + (wr == 0 ? EDGE_MID_OFF : EDGE_PREV_OFF + 2048 * ((j + 1) & 1)));
        const int seq = samp ? (8 * wr + (fr_ >> 1)) : (pm_ >> 4);
        const bool lastp = (!samp) && !scr && ((pm_ & 15) == 15) && wr == 1 && fr_ == 15;
        if (!samp && fr_ == 15) {
#pragma unroll
            for (int n = 0; n < 2; ++n)
#pragma unroll
                for (int bj = 0; bj < 2; ++bj) { const int cc = bj * 128 + cbase + 4 * n;
                    *(LAS f32x4*)(Eout + cc) = acc[1][bj][2][n] * rs[6]; *(LAS f32x4*)(Eout + 256 + cc) = acc[1][bj][3][n] * rs[7]; } }
        asm volatile("s_waitcnt lgkmcnt(0)" ::: "memory"); __builtin_amdgcn_s_barrier(); asm volatile("" ::: "memory");
        const size_t astr = scr ? 128 : DFF;
        bf16* ap = scr ? scr + (size_t)(128 * wr + 8 * fr_) * 128 + cbase : ACT + (size_t)(pm_ * 256 + 128 * wr + 8 * fr_) * DFF + gcol;
#pragma unroll
        for (int n = 0; n < 2; ++n) {
            f32x4 gc[8];
#pragma unroll
            for (int bj = 0; bj < 2; ++bj) {
                const int cc = bj * 128 + cbase + 4 * n, oc = bj * DFF + gcol + 4 * n;
                const LAS float* cwl = (const LAS float*)(lx + CWL_OFF) + cc;
                const f32x4 w0 = *(const LAS f32x4*)cwl, w1 = *(const LAS f32x4*)(cwl + 256), w2 = *(const LAS f32x4*)(cwl + 512), bb = *(const LAS f32x4*)(cwl + 768);
                const f32x4 h6 = acc[1][bj][2][n] * rs[6], h7 = acc[1][bj][3][n] * rs[7];
                f32x4 hm1, hm2;
#pragma unroll
                for (int e = 0; e < 4; ++e) { hm1[e] = dpp_shr1(h7[e]); hm2[e] = dpp_shr1(h6[e]); }
                if (!samp) {
                    if (fr_ == 0) { hm2 = *(const LAS f32x4*)(Ein + cc); hm1 = *(const LAS f32x4*)(Ein + 256 + cc); }
                    if (lastp) { *(f32x4*)(ofp + (size_t)(seq * 2 + 0) * DUP + oc) = h6; *(f32x4*)(ofp + (size_t)(seq * 2 + 1) * DUP + oc) = h7; }
                    if (j == 3 && wr == 1 && fr_ == 15 && !scr) { float* ha = HA + ((size_t)((pm0 >> 2) + 1) * 24 + pn_) * 512 + cc; *(f32x4*)ha = h6; *(f32x4*)(ha + 256) = h7; }
                    if (j == 0 && wr == 0 && fr_ == 0 && !scr) { float* hb = HB + ((size_t)(pm0 >> 2) * 24 + pn_) * 512 + cc; *(f32x4*)hb = acc[0][bj][0][n] * rs[0]; *(f32x4*)(hb + 256) = acc[0][bj][1][n] * rs[1]; }
                } else {
                    if (!(fr_ & 1)) { hm2 = *(const f32x4*)(stf + (size_t)(seq * 2 + 0) * DUP + oc); hm1 = *(const f32x4*)(stf + (size_t)(seq * 2 + 1) * DUP + oc); }
                    else { *(f32x4*)(ofs + (size_t)(seq * 2 + 0) * DUP + oc) = h6; *(f32x4*)(ofs + (size_t)(seq * 2 + 1) * DUP + oc) = h7; }
                }
                f32x4 p2 = hm2, p1 = hm1;
#pragma unroll
                for (int q = 0; q < 8; ++q) {
                    const f32x4 hq = (q == 6) ? h6 : (q == 7) ? h7 : acc[q >> 2][bj][q & 3][n] * rs[q];
                    const f32x4 c = bb + w0 * p2 + w1 * p1 + w2 * hq;
                    p2 = p1; p1 = hq;
                    if (bj == 0) gc[q] = c;
                    else { f32x4 a;
#pragma unroll
                        for (int e = 0; e < 4; ++e) a[e] = gelu_tanh(gc[q][e]) * c[e];
                        v2u w; w.x = pg8::cvt_pk_bf16(a[0], a[1]); w.y = pg8::cvt_pk_bf16(a[2], a[3]);
                        *(v2u*)(ap + (size_t)q * astr + 4 * n) = w; }
                }
            }
        }
        LDS_WAIT();
    }
};
template <class RowMap>
__device__ __forceinline__ void p0_transpose_item(const float* W, int ldw, int k0, int n0, bf16* WT, size_t ldt, int kcol0, RowMap drow, const float* kscale, LAS float* scr, int lane) {
    float tv[32];
#pragma unroll
    for (int i = 0; i < 32; ++i) { const int kk = 2 * i + (lane >> 5); tv[i] = W[(size_t)(k0 + kk) * ldw + n0 + (lane & 31)]; }
    if (kscale) {
#pragma unroll
        for (int i = 0; i < 32; ++i) tv[i] *= kscale[k0 + 2 * i + (lane >> 5)]; }
#pragma unroll
    for (int i = 0; i < 32; ++i) scr[(2 * i + (lane >> 5)) * 33 + (lane & 31)] = tv[i];
    LDS_WAIT(); asm volatile("" ::: "memory");
    const int c = lane & 7;
#pragma unroll
    for (int j = 0; j < 4; ++j) { const int n = (lane >> 3) + 8 * j; const LAS float* s = scr + (8 * c) * 33 + n;
        v4u o; o.x = pk2(s[0 * 33], s[1 * 33]); o.y = pk2(s[2 * 33], s[3 * 33]); o.z = pk2(s[4 * 33], s[5 * 33]); o.w = pk2(s[6 * 33], s[7 * 33]);
        *(v4u*)(WT + (size_t)drow(n0 + n) * ldt + kcol0 + k0 + 8 * c) = o; }
    LDS_WAIT(); asm volatile("" ::: "memory");
}
struct RowId { __device__ __forceinline__ int operator()(int n) const { return n; } };
struct RowUp { __device__ __forceinline__ int operator()(int n) const { const int half = n >= DFF ? 1 : 0, c = n - half * DFF; return (c >> 7) * 256 + half * 128 + (c & 127); } };

__device__ __forceinline__ void p0_prologue(const KP& p, LAS unsigned char* lds, int vcu, int G, int wave, int lane) {
    LAS float* scr = (LAS float*)(lds + wave * 16384);
    const int gw = vcu * NWAVES + wave, NGW = G * NWAVES;
    unsigned char* ws = p.ws;
    bf16* Win_t = (bf16*)(ws + WS_WIN); bf16* Wg_t = (bf16*)(ws + WS_WG); bf16* Wbp_t = (bf16*)(ws + WS_WBP); bf16* Wpool_b = (bf16*)(ws + WS_WPOOL);
    constexpr int I_IN = (DM / 64) * (DIN / 32), I_SQ = (DM / 64) * (DM / 32), I_G = 32 * 2, I_PC = 4 * 256 * 256 / 512;
    constexpr int NITEMS = I_IN + I_SQ + I_G + I_PC;
    for (int it = gw; it < NITEMS; it += NGW) {
        int r = it;
        if (r < I_IN) { const int nblk = DIN / 32; p0_transpose_item(p.in[I_WIN], DIN, 64 * (r / nblk), 32 * (r % nblk), Win_t, DM, 0, RowId(), nullptr, scr, lane); continue; } r -= I_IN;
        if (r < I_SQ) { const int nblk = DM / 32; p0_transpose_item(p.in[I_WBRP], DM, 64 * (r / nblk), 32 * (r % nblk), Wbp_t, DM, 0, RowId(), p.in[I_PSCALE], scr, lane); continue; } r -= I_SQ;
        if (r < I_G) { const int mat = r >> 1, nb = r & 1; const float* W = (mat < 16 ? p.in[I_WRA] : p.in[I_WIX]) + (size_t)(mat & 15) * 4096;
          p0_transpose_item(W, 64, 0, 32 * nb, Wg_t + (size_t)mat * 4096, 64, 0, RowId(), nullptr, scr, lane); continue; } r -= I_G;
        { const float* s = p.in[I_WPOOL] + (size_t)r * 512 + lane * 8; const f32x4 a = *(const f32x4*)s, b = *(const f32x4*)(s + 4);
          v4u o; o.x = pk2(a[0], a[1]); o.y = pk2(a[2], a[3]); o.z = pk2(b[0], b[1]); o.w = pk2(b[2], b[3]); *(v4u*)(Wpool_b + (size_t)r * 512 + lane * 8) = o; }
    }
    {
        bf16* XN = (bf16*)(ws + WS_R0); const float* g1 = p.in[I_NMIX];
        f32x4 gv[4];
#pragma unroll
        for (int j = 0; j < 4; ++j) gv[j] = *((const f32x4*)g1 + lane + 64 * j);
        for (int m0 = gw; m0 < M; m0 += 4 * NGW) {
            f32x4 v[4][4]; float s[4];
#pragma unroll
            for (int r = 0; r < 4; ++r) { const int m = m0 + r * NGW; s[r] = 0.f;
                if (m < M) { const float* xrow = m < MP ? p.in[I_XP] + (size_t)m * DM : p.in[I_XS] + (size_t)(m - MP) * DM; const f32x4* xr = (const f32x4*)xrow + lane;
#pragma unroll
                    for (int j = 0; j < 4; ++j) v[r][j] = xr[64 * j]; } }
#pragma unroll
            for (int r = 0; r < 4; ++r) { const int m = m0 + r * NGW;
                if (m < M) {
#pragma unroll
                    for (int j = 0; j < 4; ++j) s[r] += (v[r][j][0] * v[r][j][0] + v[r][j][1] * v[r][j][1]) + (v[r][j][2] * v[r][j][2] + v[r][j][3] * v[r][j][3]);
                    const float rstd = 1.0f / sqrtf(wave_sum(s[r]) * (1.f / DM) + EPS);
                    v2u* o8 = (v2u*)(XN + (size_t)m * DM) + lane;
#pragma unroll
                    for (int j = 0; j < 4; ++j) { const f32x4 y = v[r][j] * rstd * gv[j]; v2u o; o.x = pk2(y[0], y[1]); o.y = pk2(y[2], y[3]); o8[64 * j] = o; } } }
        }
    }
}
__device__ __forceinline__ void p1_weights(const KP& p, LAS unsigned char* lds, int gw, int NGW, int wave, int lane) {
    LAS float* scr = (LAS float*)(lds + wave * 16384);
    unsigned char* ws = p.ws;
    bf16* Wcat_t = (bf16*)(ws + WS_WCAT); bf16* Wout_t = (bf16*)(ws + WS_WOUT); bf16* Wup_t = (bf16*)(ws + WS_WUP); bf16* Wdn_t = (bf16*)(ws + WS_WDN);
    constexpr int I_UP = (DM / 64) * (DUP / 32), I_SQ = (DM / 64) * (DM / 32), I_DN = (DFF / 64) * (DM / 32);
    for (int it = gw; it < I_UP + 2 * I_SQ + I_DN; it += NGW) {
        int r = it;
        if (r < I_SQ) { const int nblk = DM / 32; p0_transpose_item(p.in[I_WBRL], DM, 64 * (r / nblk), 32 * (r % nblk), Wcat_t, 2048, 0, RowId(), nullptr, scr, lane); continue; } r -= I_SQ;
        if (r < I_SQ) { const int nblk = DM / 32; p0_transpose_item(p.in[I_WOUT], DM, 64 * (r / nblk), 32 * (r % nblk), Wout_t, DM, 0, RowId(), nullptr, scr, lane); continue; } r -= I_SQ;
        if (r < I_UP) { const int nblk = DUP / 32; p0_transpose_item(p.in[I_WUP], DUP, 64 * (r / nblk), 32 * (r % nblk), Wup_t, DM, 0, RowUp(), p.in[I_NFFN]  , scr, lane); continue; } r -= I_UP;
        { const int nblk = DM / 32; p0_transpose_item(p.in[I_WDN], DM, 64 * (r / nblk), 32 * (r % nblk), Wdn_t, DFF, 0, RowId(), nullptr, scr, lane); }
    }
}

constexpr int XR_OFF = 0, XR_BYTES = 16 * 19 * 128, SEG_OFF = 40960, CIN_OFF = 45056;
template <bool FINAL>
__device__ __forceinline__ void lru_unit(const KP& p, LAS unsigned char* lds, int pm, int n, int tid, int lane, int wave) {
    constexpr bool samp = true;
    const bf16* ZR = (const bf16*)(p.ws + WS_R1); const bf16* Wg_t = (const bf16*)(p.ws + WS_WG);
    typedef float f32x2v __attribute__((ext_vector_type(2)));
    f32x2v* SUMM = (f32x2v*)(p.ws + WS_SUMM);
    bf16* HP = (bf16*)(p.ws + WS_R3);
    LAS unsigned char* XR = lds + XR_OFF; LAS f32x2v* SEG = (LAS f32x2v*)(lds + SEG_OFF); LAS float* CIN = (LAS float*)(lds + CIN_OFF);
    const int t0 = samp ? 0 : 256 * (pm & 15);
    __syncthreads();
    for (int idx = tid; idx < 304 * 8; idx += NWAVES * 64) {
        const int row = idx >> 3, ck = idx & 7, g = row / 19, k = row - g * 19, tt = 16 * g + k - 3;
        v4u v = {0u, 0u, 0u, 0u};
        if (!samp) { if (t0 + tt >= 0) v = *(const v4u*)(ZR + (size_t)(pm * 256 + tt) * 2048 + n * 64 + ck * 8); }
        else if (k < 3) { const float* s = p.in[I_STLC] + (size_t)(g * 3 + k) * DM + n * 64 + ck * 8; const f32x4 a = *(const f32x4*)s, b = *(const f32x4*)(s + 4);
            v.x = pk2(a[0], a[1]); v.y = pk2(a[2], a[3]); v.z = pk2(b[0], b[1]); v.w = pk2(b[2], b[3]); }
        else v = *(const v4u*)(ZR + (size_t)(MP + 16 * g + k - 3) * 2048 + n * 64 + ck * 8);
        *(LAS v4u*)(XR + row * 128 + ck * 16) = v;
    }
    if (FINAL && !samp && tid < 64) {
        const int npre = pm & 15; f32x2v sv[15];
#pragma unroll
        for (int k = 0; k < 15; ++k) sv[k] = (k < npre) ? SUMM[(size_t)(pm - npre + k) * DM + n * 64 + tid] : (f32x2v){1.f, 0.f};
        float c = 0.f;
#pragma unroll
        for (int k = 0; k < 15; ++k) c = sv[k].y + sv[k].x * c;
        CIN[tid] = c;
    }
    __syncthreads();
    const int i16 = lane & 15, fq = lane >> 4;
    const float* cwl = p.in[I_CLW]; const float* cbl = p.in[I_CLB];
    bf16x8 fa[2][2];
#pragma unroll
    for (int ks = 0; ks < 2; ++ks) {
        const int ch0 = 32 * ks + 8 * fq; f32x4 w[4][2], bb[2];
#pragma unroll
        for (int tp = 0; tp < 4; ++tp) { w[tp][0] = *(const f32x4*)(cwl + tp * DM + n * 64 + ch0); w[tp][1] = *(const f32x4*)(cwl + tp * DM + n * 64 + ch0 + 4); }
        bb[0] = *(const f32x4*)(cbl + n * 64 + ch0); bb[1] = *(const f32x4*)(cbl + n * 64 + ch0 + 4);
#pragma unroll
        for (int m = 0; m < 2; ++m) {
            const int tau = 8 * (i16 >> 2) + 4 * m + (i16 & 3), T = 32 * wave + tau, rb = (T >> 4) * 19 + (T & 15);
            f32x4 u0 = bb[0], u1 = bb[1];
#pragma unroll
            for (int tp = 0; tp < 4; ++tp) { const v4u x = *(const LAS v4u*)(XR + (rb + tp) * 128 + ch0 * 2);
                u0 += w[tp][0] * (f32x4){bflo(x.x), bfhi(x.x), bflo(x.y), bfhi(x.y)}; u1 += w[tp][1] * (f32x4){bflo(x.z), bfhi(x.z), bflo(x.w), bfhi(x.w)}; }
            v4u f; f.x = pk2(u0[0], u0[1]); f.y = pk2(u0[2], u0[3]); f.z = pk2(u1[0], u1[1]); f.w = pk2(u1[2], u1[3]);
            fa[m][ks] = __builtin_bit_cast(bf16x8, f);
        }
    }
    float hloc[4][8], pc[4][8], P8[4], H8[4];
    const int T0 = 32 * wave + 8 * fq, rb0 = (T0 >> 4) * 19 + (T0 & 15);
#pragma unroll
    for (int nb = 0; nb < 4; ++nb) {
        const int ch = 16 * nb + i16, gch = n * 64 + ch;
        f32x4 aR[2] = {{0.f, 0.f, 0.f, 0.f}, {0.f, 0.f, 0.f, 0.f}}, aI[2] = {{0.f, 0.f, 0.f, 0.f}, {0.f, 0.f, 0.f, 0.f}};
#pragma unroll
        for (int ks = 0; ks < 2; ++ks) {
            const bf16x8 bR = *(const bf16x8*)(Wg_t + (size_t)(n * 64 + ch) * 64 + 8 * fq + 32 * ks);
            const bf16x8 bI = *(const bf16x8*)(Wg_t + (size_t)((16 + n) * 64 + ch) * 64 + 8 * fq + 32 * ks);
#pragma unroll
            for (int m = 0; m < 2; ++m) { aR[m] = __builtin_amdgcn_mfma_f32_16x16x32_bf16(fa[m][ks], bR, aR[m], 0, 0, 0); aI[m] = __builtin_amdgcn_mfma_f32_16x16x32_bf16(fa[m][ks], bI, aI[m], 0, 0, 0); }
        }
        float x[11];
#pragma unroll
        for (int r = 0; r < 11; ++r) x[r] = __builtin_bit_cast(float, (unsigned)(*(const LAS unsigned short*)(XR + (rb0 + r) * 128 + ch * 2)) << 16);
        const float c0 = cwl[gch], c1 = cwl[DM + gch], c2 = cwl[2 * DM + gch], c3 = cwl[3 * DM + gch], cbv = cbl[gch];
        const float bra = p.in[I_BRA][gch], bix = p.in[I_BIX][gch], lam = p.in[I_LAM][gch];
        const float zz = -lam, sp = fmaxf(zz, 0.f) + log1pf(expf(-fabsf(zz))), c8 = -8.0f * sp;
        float hl = 0.f, P = 1.f;
#pragma unroll
        for (int q = 0; q < 8; ++q) {
            const float u = cbv + c0 * x[q] + c1 * x[q + 1] + c2 * x[q + 2] + c3 * x[q + 3];
            const float r = sigmoidf_fast(aR[q >> 2][q & 3] + bra), ig = sigmoidf_fast(aI[q >> 2][q & 3] + bix);
            const float la = r * c8, a = __builtin_amdgcn_exp2f(la * 1.4426950408889634f);
            const float x2 = 2.0f * la, em_small = -x2 * (1.0f + x2 * (0.5f + x2 * (0.16666667f + x2 * 0.041666668f))), em = (x2 > -0.05f) ? em_small : (1.0f - a * a);
            const float b = sqrtf(em) * ig * u;
            hl = a * hl + b; P = P * a;
            hloc[nb][q] = hl; pc[nb][q] = P;
        }
        P8[nb] = P; H8[nb] = hl;
    }
    float Pf[4][4], Hf[4][4];
#pragma unroll
    for (int nb = 0; nb < 4; ++nb)
#pragma unroll
        for (int f = 0; f < 4; ++f) { Pf[nb][f] = __shfl(P8[nb], i16 + 16 * f); Hf[nb][f] = __shfl(H8[nb], i16 + 16 * f); }
    if (!samp) {
        if (fq == 0) {
#pragma unroll
            for (int nb = 0; nb < 4; ++nb) { float hw = 0.f, pw = 1.f;
#pragma unroll
                for (int f = 0; f < 4; ++f) { hw = Hf[nb][f] + Pf[nb][f] * hw; pw *= Pf[nb][f]; }
                SEG[wave * 64 + 16 * nb + i16] = (f32x2v){pw, hw}; }
        }
        __syncthreads();
        if (!FINAL) {
            if (tid < 64) { float hu = 0.f, pu = 1.f;
#pragma unroll
                for (int w = 0; w < 8; ++w) { const f32x2v s = SEG[w * 64 + tid]; hu = s.y + s.x * hu; pu *= s.x; }
                SUMM[(size_t)pm * DM + n * 64 + tid] = (f32x2v){pu, hu}; }
            return;
        }
    }
#pragma unroll
    for (int nb = 0; nb < 4; ++nb) {
        const int ch = 16 * nb + i16, gch = n * 64 + ch;
        float c;
        if (!samp) {
            c = CIN[ch];
#pragma unroll
            for (int w = 0; w < 8; ++w) { const f32x2v s = SEG[w * 64 + ch]; if (w < wave) c = s.y + s.x * c; }
#pragma unroll
            for (int f = 0; f < 4; ++f) if (f < fq) c = Hf[nb][f] + Pf[nb][f] * c;
        } else {
            const int sq = 2 * wave + (fq >> 1);
            c = p.in[I_STH][(size_t)sq * DM + gch];
            if (fq & 1) { const float pp = (fq == 1) ? Pf[nb][0] : Pf[nb][2], hh = (fq == 1) ? Hf[nb][0] : Hf[nb][2]; c = hh + pp * c; }
        }
        bf16* hp = HP + (size_t)(pm * 256 + T0) * 2048 + gch; float hlast = 0.f;
#pragma unroll
        for (int q = 0; q < 8; ++q) { const float h = hloc[nb][q] + pc[nb][q] * c; hp[(size_t)q * 2048] = (bf16)f2bf(h); hlast = h; }
        if (!samp) { if ((pm & 15) == 15 && wave == 7 && fq == 3) p.out[OFF_HP + (size_t)(pm >> 4) * DM + gch] = hlast; }
        else if (fq & 1) p.out[OFF_HS + (size_t)(2 * wave + (fq >> 1)) * DM + gch] = hlast;
    }
}

constexpr int XL_BYTES = 33280, XL_SEG = 2 * XL_BYTES, XL_CW = XL_SEG + 4096;
__device__ __forceinline__ void lru_task(const KP& p, LAS unsigned char* lds, int s, int n, int hf, int tid, int lane, int wave) {
    const bf16* ZR = (const bf16*)(p.ws + WS_R1); const bf16* Wg_t = (const bf16*)(p.ws + WS_WG); bf16* HP = (bf16*)(p.ws + WS_R3);
    typedef float f32x2v __attribute__((ext_vector_type(2)));
    LAS f32x2v* SEG = (LAS f32x2v*)(lds + XL_SEG); LAS float* CW = (LAS float*)(lds + XL_CW);
    const int i16 = lane & 15, fq = lane >> 4;
    const float* cwl = p.in[I_CLW]; const float* cbl = p.in[I_CLB];
    const size_t rowbase = (size_t)s * SEQ;
    __syncthreads();
    if (tid < 320) { const int tp = tid >> 6, c = tid & 63; CW[tid] = tp < 4 ? cwl[tp * DM + n * 64 + c] : cbl[n * 64 + c]; }
    for (int idx = tid; idx < 259 * 8; idx += NWAVES * 64) { const int row = idx >> 3, ck = idx & 7; v4u v = {0u, 0u, 0u, 0u};
        if (row >= 3) v = *(const v4u*)(ZR + (rowbase + row - 3) * 2048 + n * 64 + ck * 8);
        *(LAS v4u*)(lds + row * 128 + ck * 16) = v; }
    bf16x8 bR[2][2], bI[2][2]; float c0[2], c1[2], c2[2], c3[2], cbv[2], bra[2], bix[2], c8[2], cin[2];
#pragma unroll
    for (int b2 = 0; b2 < 2; ++b2) { const int ch = 16 * (2 * hf + b2) + i16, gch = n * 64 + ch;
#pragma unroll
        for (int ks = 0; ks < 2; ++ks) { bR[b2][ks] = *(const bf16x8*)(Wg_t + (size_t)(n * 64 + ch) * 64 + 8 * fq + 32 * ks); bI[b2][ks] = *(const bf16x8*)(Wg_t + (size_t)((16 + n) * 64 + ch) * 64 + 8 * fq + 32 * ks); }
        c0[b2] = cwl[gch]; c1[b2] = cwl[DM + gch]; c2[b2] = cwl[2 * DM + gch]; c3[b2] = cwl[3 * DM + gch]; cbv[b2] = cbl[gch];
        bra[b2] = p.in[I_BRA][gch]; bix[b2] = p.in[I_BIX][gch];
        const float zz = -p.in[I_LAM][gch]; c8[b2] = -8.0f * (fmaxf(zz, 0.f) + log1pf(expf(-fabsf(zz)))) * 1.4426950408889634f;
        cin[b2] = 0.f; }
    __syncthreads();
    for (int tt = 0; tt < 16; ++tt) {
        LAS unsigned char* XR = lds + (tt & 1) * XL_BYTES; LAS unsigned char* XN_ = lds + ((tt + 1) & 1) * XL_BYTES;
        v4u pf[5];
        if (tt < 15) {
#pragma unroll
            for (int k = 0; k < 5; ++k) { const int idx = tid + k * (NWAVES * 64); if (idx < 259 * 8) pf[k] = *(const v4u*)(ZR + (rowbase + 256 * (tt + 1) - 3 + (idx >> 3)) * 2048 + n * 64 + (idx & 7) * 8); } }
        bf16x8 fa[2][2];
#pragma unroll
        for (int ks = 0; ks < 2; ++ks) { const int ch0 = 32 * ks + 8 * fq; f32x4 w[4][2], bb[2];
#pragma unroll
            for (int tp = 0; tp < 4; ++tp) { w[tp][0] = *(const LAS f32x4*)(CW + tp * 64 + ch0); w[tp][1] = *(const LAS f32x4*)(CW + tp * 64 + ch0 + 4); }
            bb[0] = *(const LAS f32x4*)(CW + 256 + ch0); bb[1] = *(const LAS f32x4*)(CW + 256 + ch0 + 4);
#pragma unroll
            for (int m = 0; m < 2; ++m) { const int rb = 32 * wave + 8 * (i16 >> 2) + 4 * m + (i16 & 3); f32x4 u0 = bb[0], u1 = bb[1];
#pragma unroll
                for (int tp = 0; tp < 4; ++tp) { const v4u x = *(const LAS v4u*)(XR + (rb + tp) * 128 + ch0 * 2);
                    u0 += w[tp][0] * (f32x4){bflo(x.x), bfhi(x.x), bflo(x.y), bfhi(x.y)}; u1 += w[tp][1] * (f32x4){bflo(x.z), bfhi(x.z), bflo(x.w), bfhi(x.w)}; }
                v4u f; f.x = pg8::cvt_pk_bf16(u0[0], u0[1]); f.y = pg8::cvt_pk_bf16(u0[2], u0[3]); f.z = pg8::cvt_pk_bf16(u1[0], u1[1]); f.w = pg8::cvt_pk_bf16(u1[2], u1[3]);
                fa[m][ks] = __builtin_bit_cast(bf16x8, f); } }
        float hloc[2][8], pc[2][8], P8[2], H8[2];
        const int rb0 = 32 * wave + 8 * fq;
#pragma unroll
        for (int b2 = 0; b2 < 2; ++b2) { const int ch = 16 * (2 * hf + b2) + i16;
            f32x4 aR[2] = {{0.f, 0.f, 0.f, 0.f}, {0.f, 0.f, 0.f, 0.f}}, aI[2] = {{0.f, 0.f, 0.f, 0.f}, {0.f, 0.f, 0.f, 0.f}};
#pragma unroll
            for (int ks = 0; ks < 2; ++ks)
#pragma unroll
                for (int m = 0; m < 2; ++m) { aR[m] = __builtin_amdgcn_mfma_f32_16x16x32_bf16(fa[m][ks], bR[b2][ks], aR[m], 0, 0, 0); aI[m] = __builtin_amdgcn_mfma_f32_16x16x32_bf16(fa[m][ks], bI[b2][ks], aI[m], 0, 0, 0); }
            float x[11];
#pragma unroll
            for (int r = 0; r < 11; ++r) x[r] = __builtin_bit_cast(float, (unsigned)(*(const LAS unsigned short*)(XR + (rb0 + r) * 128 + ch * 2)) << 16);
            float hl = 0.f, P = 1.f;
#pragma unroll
            for (int q = 0; q < 8; ++q) {
                const float u = cbv[b2] + c0[b2] * x[q] + c1[b2] * x[q + 1] + c2[b2] * x[q + 2] + c3[b2] * x[q + 3];
                const float r = sigmoidf_fast(aR[q >> 2][q & 3] + bra[b2]), ig = sigmoidf_fast(aI[q >> 2][q & 3] + bix[b2]);
                const float a = __builtin_amdgcn_exp2f(r * c8[b2]);
                const float b = __builtin_amdgcn_sqrtf(fmaxf(__builtin_fmaf(-a, a, 1.0f), 0.f)) * ig * u;
                hl = __builtin_fmaf(a, hl, b); P = P * a; hloc[b2][q] = hl; pc[b2][q] = P; }
            P8[b2] = P; H8[b2] = hl; }
        float Pf[2][4], Hf[2][4];
#pragma unroll
        for (int b2 = 0; b2 < 2; ++b2)
#pragma unroll
            for (int f = 0; f < 4; ++f) { Pf[b2][f] = __shfl(P8[b2], i16 + 16 * f); Hf[b2][f] = __shfl(H8[b2], i16 + 16 * f); }
        if (fq == 0) {
#pragma unroll
            for (int b2 = 0; b2 < 2; ++b2) { float hw = 0.f, pw = 1.f;
#pragma unroll
                for (int f = 0; f < 4; ++f) { hw = __builtin_fmaf(Pf[b2][f], hw, Hf[b2][f]); pw *= Pf[b2][f]; }
                SEG[(tt & 1) * 256 + wave * 32 + 16 * b2 + i16] = (f32x2v){pw, hw}; } }
        if (tt < 15) {
#pragma unroll
            for (int k = 0; k < 5; ++k) { const int idx = tid + k * (NWAVES * 64); if (idx < 259 * 8) *(LAS v4u*)(XN_ + (idx >> 3) * 128 + (idx & 7) * 16) = pf[k]; } }
        LDS_WAIT(); __syncthreads();
#pragma unroll
        for (int b2 = 0; b2 < 2; ++b2) { const int ch = 16 * (2 * hf + b2) + i16, gch = n * 64 + ch;
            float c = cin[b2], call = cin[b2];
#pragma unroll
            for (int w = 0; w < 8; ++w) { const f32x2v sg = SEG[(tt & 1) * 256 + w * 32 + 16 * b2 + i16]; call = __builtin_fmaf(sg.x, call, sg.y); if (w < wave) c = __builtin_fmaf(sg.x, c, sg.y); }
            cin[b2] = call;
#pragma unroll
            for (int f = 0; f < 4; ++f) if (f < fq) c = __builtin_fmaf(Pf[b2][f], c, Hf[b2][f]);
            bf16* hp = HP + (rowbase + 256 * tt + rb0) * 2048 + gch; float hlast = 0.f;
#pragma unroll
            for (int q = 0; q < 8; ++q) { const float h = __builtin_fmaf(pc[b2][q], c, hloc[b2][q]); hp[(size_t)q * 2048] = (bf16)f2bf(h); hlast = h; }
            if (tt == 15 && wave == 7 && fq == 3) p.out[OFF_HP + (size_t)s * DM + gch] = hlast; }
    }
}

__device__ __forceinline__ v4u pool_load8(const KP& p, const bf16* ZR, int pm, int tt, int run, int ch) {
    const bool samp = (pm == STILE); v4u w = {0u, 0u, 0u, 0u};
    if (!samp) { if (256 * (pm & 15) + tt >= 0) w = *(const v4u*)(ZR + (size_t)(pm * 256 + tt) * 2048 + 1024 + ch); }
    else { const int tl = tt - 16 * run;
        if (tl < 0) { const float* s = p.in[I_STPOOL] + (size_t)(run * 15 + 15 + tl) * DM + ch; const f32x4 a = *(const f32x4*)s, b = *(const f32x4*)(s + 4);
            w.x = pk2(a[0], a[1]); w.y = pk2(a[2], a[3]); w.z = pk2(b[0], b[1]); w.w = pk2(b[2], b[3]); }
        else w = *(const v4u*)(ZR + (size_t)(MP + tt) * 2048 + 1024 + ch); }
    return w;
}
__device__ __forceinline__ void unpack8(const v4u w, float (&v)[8]) { v[0] = bflo(w.x); v[1] = bfhi(w.x); v[2] = bflo(w.y); v[3] = bfhi(w.y); v[4] = bflo(w.z); v[5] = bfhi(w.z); v[6] = bflo(w.w); v[7] = bfhi(w.w); }
template <int W> __device__ __forceinline__ void pool_unit_w(const KP& p, int pm, int g, int tid) {
    const bf16* ZR = (const bf16*)(p.ws + WS_R1); bf16* HP = (bf16*)(p.ws + WS_R3);
    const bool samp = (pm == STILE);
    const int oct = tid & 31, run = tid >> 5, ch = 256 * g + 8 * oct;
#pragma unroll 1
    for (int hf = 0; hf < 2; ++hf) {
        const int tf = 16 * run + 8 * hf;
        const int pos0 = samp ? PAST : 256 * (pm & 15) + tf;
        v4u raw[W - 1 + 8];
#pragma unroll
        for (int r = 0; r < W - 1 + 8; ++r) raw[r] = pool_load8(p, ZR, pm, tf - (W - 1) + r, run, ch);
        float s[8];
#pragma unroll
        for (int e = 0; e < 8; ++e) s[e] = 0.f;
#pragma unroll
        for (int r = 0; r < W - 1; ++r) { float v[8]; unpack8(raw[r], v);
#pragma unroll
            for (int e = 0; e < 8; ++e) s[e] += v[e]; }
#pragma unroll
        for (int i = 0; i < 8; ++i) {
            const int cnt = min(pos0 + i + 1, W); const float inv = 1.0f / (float)cnt; float o[8], v[8], vo[8]; unpack8(raw[W - 1 + i], v); unpack8(raw[i], vo);
#pragma unroll
            for (int e = 0; e < 8; ++e) { s[e] += v[e]; o[e] = s[e] * inv - v[e]; }
            v4u ow; ow.x = pk2(o[0], o[1]); ow.y = pk2(o[2], o[3]); ow.z = pk2(o[4], o[5]); ow.w = pk2(o[6], o[7]);
            *(v4u*)(HP + (size_t)(pm * 256 + tf + i) * 2048 + 1024 + ch) = ow;
#pragma unroll
            for (int e = 0; e < 8; ++e) s[e] -= vo[e];
        }
    }
}
__device__ __forceinline__ void pool_unit(const KP& p, int pm, int g, int tid) {
    if (g == 0) pool_unit_w<2>(p, pm, g, tid); else if (g == 1) pool_unit_w<4>(p, pm, g, tid); else if (g == 2) pool_unit_w<8>(p, pm, g, tid); else pool_unit_w<16>(p, pm, g, tid);
}
__device__ __forceinline__ void state_copy(const KP& p, int gtid, int gthreads) {
    const bf16* ZR = (const bf16*)(p.ws + WS_R1);
    constexpr int N1 = NBATCH * 3 * DM, N2 = NBATCH * 15 * DM, N3 = SBATCH * 3 * DM, N4 = SBATCH * 15 * DM;
    constexpr int NT = N1 + N2 + N3 + N4;
    for (int i0 = gtid; i0 < NT; i0 += 4 * gthreads) {
        unsigned short raw[4]; float* dsts[4];
#pragma unroll
        for (int k = 0; k < 4; ++k) { const int i = i0 + k * gthreads; raw[k] = 0; dsts[k] = nullptr;
            if (i < NT) { int r = i; size_t row, col; float* dst;
                if (r < N1) { const int b = r / (3 * DM), kk = (r / DM) % 3, c = r % DM; row = (size_t)b * SEQ + SEQ - 3 + kk; col = c; dst = p.out + OFF_LCP + r; }
                else if ((r -= N1) < N2) { const int b = r / (15 * DM), kk = (r / DM) % 15, c = r % DM; row = (size_t)b * SEQ + SEQ - 15 + kk; col = 1024 + c; dst = p.out + OFF_PLP + r; }
                else if ((r -= N2) < N3) { const int b = r / (3 * DM), kk = (r / DM) % 3, c = r % DM; row = (size_t)MP + b * SSEQ + SSEQ - 3 + kk; col = c; dst = p.out + OFF_LCS + r; }
                else { r -= N3; const int b = r / (15 * DM), kk = (r / DM) % 15, c = r % DM; row = (size_t)MP + b * SSEQ + SSEQ - 15 + kk; col = 1024 + c; dst = p.out + OFF_PLS + r; }
                raw[k] = ZR[row * 2048 + col]; dsts[k] = dst; } }
#pragma unroll
        for (int k = 0; k < 4; ++k) if (dsts[k]) *dsts[k] = __builtin_bit_cast(float, (unsigned)raw[k] << 16);
    }
}

template <int MODE = 0> __device__ __forceinline__ void strip_pre(const KP& p, LAS unsigned char* lds, int pm0, int pn, int cnt, int tid, int lane, int wave) {
    const float* SSQ = (const float*)(p.ws + WS_SSQ); const bf16* XG2 = (const bf16*)(p.ws + WS_R1); const bf16* Wup_t = (const bf16*)(p.ws + WS_WUP);
    LAS float* RS = (LAS float*)(lds + RS_OFF); LAS float* ES = (LAS float*)(lds + EDGE_START_OFF); LAS float* CWL = (LAS float*)(lds + CWL_OFF);
    __syncthreads();
#pragma unroll
    for (int k = 0; k < 2; ++k) { const int idx = tid + k * (NWAVES * 64), vec = idx >> 8, col = idx & 255, oc = (col >> 7) * DFF + 128 * pn + (col & 127);
        CWL[idx] = vec < 3 ? p.in[I_CFW][(size_t)vec * DUP + oc] : p.in[I_CFB][oc]; }
    if (MODE != 2) for (int i = tid; i < cnt * 256; i += NWAVES * 64) RS[i] = row_rs(SSQ, (size_t)pm0 * 256 + i);
    ES[tid] = 0.f;
    __syncthreads();
}

__device__ __forceinline__ void strip_fix(const KP& p, int gtid, int gthreads) {
    const float* HA = (const float*)(p.ws + WS_HA); const float* HB = (const float*)(p.ws + WS_HB); bf16* ACT = (bf16*)(p.ws + WS_R2);
    const float* cw = p.in[I_CFW]; const float* cb = p.in[I_CFB];
    for (int i = gtid; i < 32 * 24 * 128; i += gthreads) {
        const int c = i & 127, sp = i >> 7, pn = sp % 24, sr = sp / 24;
        if ((sr & 3) == 0) continue;
        const float* ha = HA + (size_t)sp * 512; const float* hb = HB + (size_t)sp * 512;
        float hg[4], hv[4];
        hg[0] = ha[c]; hg[1] = ha[256 + c]; hg[2] = hb[c]; hg[3] = hb[256 + c];
        hv[0] = ha[128 + c]; hv[1] = ha[384 + c]; hv[2] = hb[128 + c]; hv[3] = hb[384 + c];
        const int og = 128 * pn + c, ov = DFF + og;
        const float g0 = cw[og], g1 = cw[DUP + og], g2 = cw[2 * DUP + og], gb = cb[og], v0 = cw[ov], v1 = cw[DUP + ov], v2 = cw[2 * DUP + ov], vb = cb[ov];
#pragma unroll
        for (int t = 0; t < 2; ++t) { const float cg = gb + g0 * hg[t] + g1 * hg[t + 1] + g2 * hg[t + 2], cv = vb + v0 * hv[t] + v1 * hv[t + 1] + v2 * hv[t + 2];
            ACT[((size_t)sr * 1024 + t) * DFF + og] = (bf16)f2bf(gelu_tanh(cg) * cv); }
    }
}

__device__ __forceinline__ void final_norm(const KP& p, int gw, int NGW, int lane) {
    const float* SSQ2 = (const float*)(p.ws + WS_SSQ2); const float* gf = p.in[I_NFIN];
    f32x4 gv[4];
#pragma unroll
    for (int j = 0; j < 4; ++j) gv[j] = *((const f32x4*)gf + lane + 64 * j);
    for (int m = gw; m < M; m += NGW) {
        const float sv = (lane < 32) ? SSQ2[(size_t)m * 32 + lane] : 0.f;
        const float rstd = 1.0f / sqrtf(wave_sum(sv) * (1.f / DM) + EPS);
        f32x4* yr = (f32x4*)(p.out + OFF_Y + (size_t)m * DM) + lane;
#pragma unroll
        for (int j = 0; j < 4; ++j) { const f32x4 v = yr[64 * j]; yr[64 * j] = v * rstd * gv[j]; }
    }
}
#ifndef MK_ONE_LAUNCH
#define MK_ONE_LAUNCH 1
#endif
#ifndef PG8_SP2
#define PG8_SP2 true
#endif
#ifndef PG8_ALIGN
#define PG8_ALIGN true
#endif
#ifndef FUSE_FINAL
#define FUSE_FINAL 1
#endif
constexpr int N_PHASES = 11;
__global__ void __launch_bounds__(NWAVES * 64, 2) mk_fwd(KP p) {
    extern __shared__ __attribute__((aligned(16))) unsigned char lds_raw[];
    LAS unsigned char* lds = (LAS unsigned char*)lds_raw;
    const int tid = threadIdx.x, lane = tid & 63, wave = __builtin_amdgcn_readfirstlane(tid >> 6);
    const int G = gridDim.x, bx = blockIdx.x, vcu = (G % 8 == 0) ? (bx % 8) * (G / 8) + bx / 8 : bx;
    volatile LAS unsigned* MISC = (volatile LAS unsigned*)(lds + MISC_OFF);
    if (tid < 32) MISC[tid] = 0u;
    __syncthreads();
    unsigned* ctl = (unsigned*)(p.ws + WS_CTL);
    const int lo = p.ph_lo, hi = p.ph_hi;
    XcdBarrier bar; bar.bar = ctl + CW_BAR; bar.x = 0; bar.st = MISC + 8;
    if (hi - lo > 1) bar = xcd_barrier_post(ctl + CW_BAR, MISC + 8);
#ifndef PH_MASK
#define PH_MASK 0xfff
#endif
#define IN(k) (((PH_MASK >> (k)) & 1) && lo <= (k) && (k) < hi)
#ifndef REP_MASK
#define REP_MASK 0
#endif
#define PH(k) if (IN(k)) for (int rep_ = 0; rep_ <= ((REP_MASK >> (k)) & 1); ++rep_)
#define REPBAR() do { if (rep_) xcd_barrier(bar); } while (0)
#define SEAM(k) do { if (IN(k) && IN((k) + 1)) xcd_barrier(bar); } while (0)
    unsigned char* ws = p.ws;
    bf16* XN = (bf16*)(ws + WS_R0); bf16* MG = (bf16*)(ws + WS_R0); bf16* ZR = (bf16*)(ws + WS_R1); bf16* XG2 = (bf16*)(ws + WS_R1);
    bf16* GT = (bf16*)(ws + WS_R2); bf16* HP = (bf16*)(ws + WS_R3); bf16* ACT = (bf16*)(ws + WS_R2);
    bf16* Win_t = (bf16*)(ws + WS_WIN); bf16* Wcat_t = (bf16*)(ws + WS_WCAT); bf16* Wout_t = (bf16*)(ws + WS_WOUT); bf16* Wup_t = (bf16*)(ws + WS_WUP); bf16* Wdn_t = (bf16*)(ws + WS_WDN);
    float* SSQ = (float*)(ws + WS_SSQ); float* SSQ2 = (float*)(ws + WS_SSQ2);
    float* Y = p.out + OFF_Y;

    PH(0) { REPBAR(); p0_prologue(p, lds, vcu, G, wave, lane); }
    SEAM(0);
    PH(1) { REPBAR();
        pg8::Gemm g{XN, Win_t, DM, DM, DM}; pg8::StaticOrder S; S.init(MP, DIN, G, bx);
        EpiZ E{ZR, GT};
        const bool wfirst = (G > 64) && bx >= 64 && (bx & 1);
        for (int su = bx; su < 64; su += G) pg8::sub_gemm<1>(lds, g, STILE, su >> 2, (su >> 1) & 1, su & 1, E);
        if (wfirst) { p1_weights(p, lds, (bx - 64) * NWAVES + wave, (G - 64) * NWAVES, wave, lane); __syncthreads(); }
        pg8::gemm_phase<EpiZ, pg8::StaticOrder, PG8_ALIGN, PG8_SP2>(lds, g, S, E);
        if (G > 64) { if (bx >= 64 && !wfirst) p1_weights(p, lds, (bx - 64) * NWAVES + wave, (G - 64) * NWAVES, wave, lane); } else p1_weights(p, lds, bx * NWAVES + wave, G * NWAVES, wave, lane);
    }
    SEAM(1);
    PH(2) { REPBAR();
        state_copy(p, bx * NWAVES * 64 + tid, G * NWAVES * 64);
        for (int su = bx; su < 64; su += G) {
            const int g_ = su >> 4, q = su & 15; pg8::Gemm gw_{(const bf16*)(ws + WS_WBP) + 256 * g_, (const bf16*)(ws + WS_WPOOL) + (size_t)g_ * 65536, 256, DM, 256};
            EpiW EW{Wcat_t + 1024 + 256 * g_}; pg8::sub_gemm<1>(lds, gw_, q >> 2, 0, (q >> 1) & 1, q & 1, EW); }
        for (int t = bx; t < NBATCH * 32; t += G) lru_task(p, lds, t >> 5, (t >> 1) & 15, t & 1, tid, lane, wave);
        for (int L = bx; L < 16 + NTILE * 4; L += G) {
            if (L < 16) lru_unit<true>(p, lds, STILE, L, tid, lane, wave);
            else { const int r = L - 16; pool_unit(p, r >> 2, r & 3, tid); }
        }
    }
    if (IN(2) && IN(4)) xcd_barrier(bar);
    PH(4) { REPBAR();
        pg8::Gemm g{HP, Wcat_t, 2048, 2048, 2048}; pg8::StaticOrder S; S.init(MP, DM, G, bx);
        EpiBr E{GT, MG};
        pg8::gemm_phase<EpiBr, pg8::StaticOrder, PG8_ALIGN, PG8_SP2>(lds, g, S, E);
        for (int su = bx; su < 16; su += G) pg8::sub_gemm<1>(lds, g, STILE, su >> 2, (su >> 1) & 1, su & 1, E);
    }
    if (IN(4) && IN(6)) xcd_barrier(bar);
    PH(6) { REPBAR();
        pg8::Gemm g{MG, Wout_t, DM, DM, DM}; pg8::StaticOrder S; S.init(MP, DM, G, bx);
        EpiRes<false> E{p.in[I_XP], p.in[I_XS], Y, XG2, SSQ};
        pg8::gemm_phase<EpiRes<false>, pg8::StaticOrder, PG8_ALIGN, PG8_SP2>(lds, g, S, E);
        for (int su = bx; su < 16; su += G) pg8::sub_gemm<1>(lds, g, STILE, su >> 2, (su >> 1) & 1, su & 1, E);
    }
    SEAM(6);
    PH(7) { REPBAR();
        pg8::Gemm g{XG2, Wup_t, DM, DM, DM};
        { EpiUpS ES{ACT, p.in[I_CFW], p.in[I_CFB], p.in[I_STFFN], p.out + OFF_FCS, SSQ};
          for (int su = bx; su < 48; su += G) pg8::sub_gemm<2>(lds, g, STILE, su >> 1, su & 1, 0, ES); }
        for (int sidx = vcu; sidx < 768; sidx += G) {
            const int rg = sidx >> 8, v = sidx & 255, x = v >> 5, w = v & 31, pm0 = 4 * (4 * x + (w >> 3)), pn = 8 * rg + (w & 7);
            strip_pre(p, lds, pm0, pn, 4, tid, lane, wave);
            pg8::StripOrder S{pm0, pn, 4};
            EpiUp E{ACT, p.in[I_CFW], p.in[I_CFB], p.in[I_STFFN], p.out + OFF_FCP, p.out + OFF_FCS, lds, pm0, nullptr, (float*)(ws + WS_HA), (float*)(ws + WS_HB)};
            pg8::gemm_phase<EpiUp, pg8::StripOrder, true, PG8_SP2>(lds, g, S, E);
        }
    }
    SEAM(7);
    PH(8) { REPBAR(); strip_fix(p, bx * NWAVES * 64 + tid, G * NWAVES * 64); }
    SEAM(8);
    const bool fuse_final = (G == 256) && FUSE_FINAL;
    PH(9) { REPBAR();
        pg8::Gemm g{ACT, Wdn_t, DFF, DFF, DFF}; pg8::StaticOrder S; S.init(MP, DM, G, bx);
        if (fuse_final) {
            EpiFinal E{Y, XG2, p.in[I_NFIN], SSQ2, ctl + CW_PANEL, ctl + CW_BAR + XB_TMO, lds};
            pg8::gemm_phase<EpiFinal, pg8::StaticOrder, true  , PG8_SP2>(lds, g, S, E);
            for (int su = bx; su < 16; su += G) pg8::sub_gemm<1>(lds, g, STILE, su >> 2, (su >> 1) & 1, su & 1, E);
        } else {
            EpiRes<true> E{nullptr, nullptr, Y, XG2, SSQ2};
            pg8::gemm_phase<EpiRes<true>, pg8::StaticOrder, PG8_ALIGN, PG8_SP2>(lds, g, S, E);
            for (int su = bx; su < 16; su += G) pg8::sub_gemm<1>(lds, g, STILE, su >> 2, (su >> 1) & 1, su & 1, E);
        }
    }
#ifndef EXP
#define EXP 0
#endif
#if EXP != 0
    if (lo == 11) {
#if EXP == 1
        pg8::Gemm g{XG2, Wup_t, DM, DM, DM};
        for (int sidx = vcu; sidx < 768; sidx += G) {
            const int rg = sidx >> 8, v = sidx & 255, x = v >> 5, w = v & 31, pm0 = 4 * (4 * x + (w >> 3)), pn = 8 * rg + (w & 7);
            pg8::StripOrder S{pm0, pn, 4}; EpiNull<true> E;
            pg8::gemm_phase<EpiNull<true>, pg8::StripOrder, true, PG8_SP2>(lds, g, S, E);
        }
#elif EXP == 2
        pg8::Gemm g{XN, Win_t, DM, DM, DM}; pg8::StaticOrder S; S.init(MP, DIN, G, bx); EpiNull<false> E;
        pg8::gemm_phase<EpiNull<false>, pg8::StaticOrder, PG8_ALIGN, PG8_SP2>(lds, g, S, E);
#elif EXP == 3
        pg8::Gemm g{XG2, Wup_t, DM, DM, DM}; pg8::StaticOrder S; S.init(MP, DUP, G, bx); EpiNull<true> E;
        pg8::gemm_phase<EpiNull<true>, pg8::StaticOrder, true, PG8_SP2>(lds, g, S, E);
#elif EXP == 5
        pg8::Gemm g{XN, Win_t, DM, DM, DM}; pg8::StaticOrder S; S.init(MP, DIN, G, bx); EpiZScratch E{HP + (size_t)bx * 65536};
        pg8::gemm_phase<EpiZScratch, pg8::StaticOrder, PG8_ALIGN, PG8_SP2>(lds, g, S, E);
#elif EXP == 6
        pg8::Gemm g{XG2, Wup_t, DM, DM, DM};
        for (int sidx = vcu; sidx < 768; sidx += G) {
            const int rg = sidx >> 8, v = sidx & 255, x = v >> 5, w = v & 31, pm0 = 4 * (4 * x + (w >> 3)), pn = 8 * rg + (w & 7);
            strip_pre(p, lds, pm0, pn, 4, tid, lane, wave);
            pg8::StripOrder S{pm0, pn, 4};
            EpiUp E{ACT, p.in[I_CFW], p.in[I_CFB], p.in[I_STFFN], p.out + OFF_FCP, p.out + OFF_FCS, lds, pm0, HP + (size_t)bx * 256 * 128, nullptr, nullptr};
            pg8::gemm_phase<EpiUp, pg8::StripOrder, true, PG8_SP2>(lds, g, S, E);
        }
#elif EXP == 7
        pg8::Gemm g{XG2, Wup_t, DM, DM, DM};
        for (int sidx = vcu; sidx < 768; sidx += G) {
            const int rg = sidx >> 8, v = sidx & 255, x = v >> 5, w = v & 31, pm0 = 4 * (4 * x + (w >> 3)), pn = 8 * rg + (w & 7);
            strip_pre(p, lds, pm0, pn, 4, tid, lane, wave);
            pg8::StripOrder S{pm0, pn, 4}; EpiNull<true> E;
            pg8::gemm_phase<EpiNull<true>, pg8::StripOrder, true, PG8_SP2>(lds, g, S, E);
        }
#elif EXP == 8 || EXP == 9
        pg8::Gemm g{XG2, Wup_t, DM, DM, DM};
        for (int sidx = vcu; sidx < 768; sidx += G) {
            const int rg = sidx >> 8, v = sidx & 255, x = v >> 5, w = v & 31, pm0 = 4 * (4 * x + (w >> 3)), pn = 8 * rg + (w & 7);
            strip_pre<EXP - 7>(p, lds, pm0, pn, 4, tid, lane, wave);
            pg8::StripOrder S{pm0, pn, 4}; EpiNull<true> E;
            pg8::gemm_phase<EpiNull<true>, pg8::StripOrder, true, PG8_SP2>(lds, g, S, E);
        }
#elif EXP == 4
        pg8::Gemm g{ACT, Wdn_t, DFF, DFF, DFF}; pg8::StaticOrder S; S.init(MP, DM, G, bx); EpiNull<false> E;
        pg8::gemm_phase<EpiNull<false>, pg8::StaticOrder, true, PG8_SP2>(lds, g, S, E);
#endif
    }
#endif
    if (!fuse_final) { SEAM(9);
        PH(10) { REPBAR(); final_norm(p, vcu * NWAVES + wave, G * NWAVES, lane); } }
#undef IN
#undef SEAM
}

extern "C" void kernel_launch(void* const* d_in, const int* in_sizes, int n_in, void* d_out, int out_size, void* d_ws, size_t ws_size, hipStream_t stream) {
    static int grid = 0;
    if (grid == 0) {
        if (n_in != 26 || in_sizes[0] != MP * DM || (size_t)out_size != OUT_TOTAL || ws_size < WS_END) {
            fprintf(stderr, "kernel_launch: unexpected shapes: n_in %d in0 %d out %d ws %zu (need %zu)\n", n_in, n_in > 0 ? in_sizes[0] : -1, out_size, ws_size, (size_t)WS_END); grid = -1; return; }
        int dev = 0, cus = 0, per_cu = 0;
        if (hipGetDevice(&dev) != hipSuccess || hipDeviceGetAttribute(&cus, hipDeviceAttributeMultiprocessorCount, dev) != hipSuccess) { fprintf(stderr, "kernel_launch: device query failed\n"); grid = -1; return; }
        if (hipFuncSetAttribute((const void*)mk_fwd, hipFuncAttributeMaxDynamicSharedMemorySize, LDS_BYTES) != hipSuccess) { fprintf(stderr, "kernel_launch: hipFuncSetAttribute failed\n"); grid = -1; return; }
        if (hipOccupancyMaxActiveBlocksPerMultiprocessor(&per_cu, (const void*)mk_fwd, NWAVES * 64, LDS_BYTES) != hipSuccess || per_cu < 1) {
            fprintf(stderr, "kernel_launch: occupancy query reports %d blocks per CU\n", per_cu); (void)hipGetLastError(); per_cu = 1; }
        grid = cus;
        fprintf(stderr, "kernel_launch: grid %d (cus %d, occupancy %d/CU)\n", grid, cus, per_cu);
    }
    if (grid < 0) return;
    if (hipMemsetAsync((char*)d_ws + WS_CTL, 0, CTL_ZERO_BYTES, stream) != hipSuccess) { fprintf(stderr, "kernel_launch: memset failed\n"); return; }
    KP a{};
    for (int i = 0; i < 26; ++i) a.in[i] = (const float*)d_in[i];
    a.out = (float*)d_out; a.ws = (unsigned char*)d_ws;
#if MK_ONE_LAUNCH
    a.ph_lo = 0; a.ph_hi = N_PHASES;
    hipLaunchKernelGGL(mk_fwd, dim3(grid), dim3(NWAVES * 64), LDS_BYTES, stream, a);
#else
#ifndef PROBE_PHASE
#define PROBE_PHASE -1
#endif
    { const int phs[10] = {0, 1, 2, 4, 6, 7, 8, 9, 10, 11};
      for (int i = 0; i < 10; ++i) { if (phs[i] == 10 && FUSE_FINAL) continue; if (phs[i] == 11 && EXP == 0) continue; const int k = phs[i]; a.ph_lo = k; a.ph_hi = k + 1;
          for (int rep = 0; rep < (k == PROBE_PHASE ? 2 : 1); ++rep) hipLaunchKernelGGL(mk_fwd, dim3(grid), dim3(NWAVES * 64), LDS_BYTES, stream, a); } }
#endif
    const hipError_t le = hipPeekAtLastError();
    if (le != hipSuccess) fprintf(stderr, "kernel_launch: launch failed: %s\n", hipGetErrorName(le));
}
```

```cpp
#include <hip/hip_runtime.h>
#include <cstdio>
#include <cstdint>
#define MK_ONE_LAUNCH 1
namespace pg8 {
#define PG8_LAS __attribute__((address_space(3)))
typedef unsigned short bf16_t;
typedef short bf16x8 __attribute__((ext_vector_type(8)));
typedef float f32x4 __attribute__((ext_vector_type(4)));
typedef unsigned u32x4 __attribute__((ext_vector_type(4)));
typedef unsigned u32x2 __attribute__((ext_vector_type(2)));
constexpr int BM = 256, BK = 64, HALF = 128, HTB = HALF * BK * 2  , STAGE_BYTES = 8 * HTB, NXCD = 8, WGM = 8;

__host__ __device__ __forceinline__ int lds_byte(int r, int c) { const int st = (r >> 4) * 2 + (c >> 5), rr = r & 15, cc = c & 31, ob = rr * 64 + cc * 2; return st * 1024 + (ob ^ (((ob >> 9) & 1) << 5)); }
__host__ __device__ __forceinline__ void stage_rc(int b, int& R, int& C) { const int st = b / 1024, sb = b % 1024, swz = sb ^ (((sb >> 9) & 1) << 5); R = (st >> 1) * 16 + swz / 64; C = (st & 1) * 32 + (swz % 64) / 2; }
__host__ __device__ __forceinline__ int perm32(int rho) { const int n = rho >> 4, i = rho & 15; return 8 * (i >> 2) + 4 * n + (i & 3); }
__host__ __device__ __forceinline__ int amap_row(int R) { return 128 * (R >> 6) + 8 * (R & 15) + ((R >> 4) & 3); }

struct Unit { int pm, pn; };
struct Gemm { const bf16_t* A; const bf16_t* Bt; int K, lda, ldb; };

struct StaticOrder {
    int nM, nN, nwg, G, c;
    __host__ __device__ void init(int M, int N, int G_, int c_) { nM = M / BM; nN = N / BM; nwg = nM * nN; G = G_; c = c_; }
    __host__ __device__ bool next(int i, Unit& u) const {
        const long L = (long)i * G + c; if (L >= nwg) return false;
        int wgid = (int)L; { const int q = nwg / NXCD, r = nwg % NXCD, xcd = wgid % NXCD, off = wgid / NXCD; wgid = (xcd < r ? xcd * (q + 1) : r * (q + 1) + (xcd - r) * q) + off; }
        const int nig = WGM * nN, gid = wgid / nig, fm = gid * WGM, gsz = (nM - fm) < WGM ? (nM - fm) : WGM;
        u.pm = fm + ((wgid % nig) % gsz); u.pn = (wgid % nig) / gsz; return true;
    }
    __device__ __forceinline__ void a_ready(const Unit&) const {}
    __device__ __forceinline__ void done(const Unit&) const {}
};
struct StripOrder {
    int pm0, pn, cnt;
    __device__ __forceinline__ bool next(int i, Unit& u) const { if (i >= cnt) return false; u.pm = pm0 + i; u.pn = pn; return true; }
    __device__ __forceinline__ void a_ready(const Unit&) const {}
    __device__ __forceinline__ void done(const Unit&) const {}
};

__device__ __forceinline__ unsigned cvt_pk_bf16(float lo, float hi) { unsigned r; asm volatile("v_cvt_pk_bf16_f32 %0, %1, %2" : "=v"(r) : "v"(lo), "v"(hi)); return r; }

template <class Epi, class Sched, bool ALIGN_EPI = false, bool SP2 = false>
__device__ __forceinline__ void gemm_phase(PG8_LAS unsigned char* lds, const Gemm g, const Sched& S, const Epi& E) {
    const int tid = threadIdx.x, wid = __builtin_amdgcn_readfirstlane(tid >> 6), lane = tid & 63, wr = wid >> 2, wc = wid & 3, fr = lane & 15, fq = lane >> 4;
    const int K = g.K, nt = K / BK;
    unsigned voffA[2], voffB[2];
#pragma unroll
    for (int i = 0; i < 2; ++i) { int R, C; stage_rc(tid * 16 + i * 8192, R, C); const int Rb = Epi::PERM ? ((R & ~31) + perm32(R & 31)) : R; const int Ra = Epi::AMAP ? amap_row(R) : R;
        voffA[i] = (unsigned)(Ra * g.lda + C) * 2u; voffB[i] = (unsigned)(Rb * g.ldb + C) * 2u; }
    const size_t kstep = (size_t)(BK * 2);
    const size_t hstepA = Epi::AMAP ? (size_t)4 * g.lda * 2 : (size_t)HALF * g.lda * 2;
    const size_t hstepB = (size_t)HALF * g.ldb * 2;
    const size_t tstepA = (size_t)BM * g.lda * 2, tstepB = (size_t)BM * g.ldb * 2;
    const unsigned ldsw = (unsigned)wid * 1024u;
    const int aoff = lds_byte(wr * 64 + fr, fq * 8), boff = lds_byte(wc * 32 + fr, fq * 8);
#define PG8_SA(b, h) (((b) * 2 + (h)) * HTB)
#define PG8_SB(b, h) ((4 + (b) * 2 + (h)) * HTB)
#define PG8_STAGE(bufoff, gbase, voff) do { _Pragma("unroll") for (int _i = 0; _i < 2; ++_i) \
        __builtin_amdgcn_global_load_lds((const unsigned*)((const char*)(gbase) + (voff)[_i]), (PG8_LAS unsigned*)(lds + (bufoff) + ldsw + _i * 8192), 16, 0, 0); } while (0)
#define PG8_LDA(dst, b, h) do { _Pragma("unroll") for (int m = 0; m < 4; ++m) _Pragma("unroll") for (int k = 0; k < 2; ++k) dst[m][k] = *(const PG8_LAS bf16x8*)(lds + PG8_SA(b, h) + aoff + m * 2048 + k * 1024); } while (0)
#define PG8_LDB(dst, b, h) do { _Pragma("unroll") for (int n = 0; n < 2; ++n) _Pragma("unroll") for (int k = 0; k < 2; ++k) dst[n][k] = *(const PG8_LAS bf16x8*)(lds + PG8_SB(b, h) + boff + n * 2048 + k * 1024); } while (0)
#define PG8_MMA(ai, bj, At, Bt) do { __builtin_amdgcn_s_setprio(1); _Pragma("unroll") for (int m = 0; m < 4; ++m) _Pragma("unroll") for (int n = 0; n < 2; ++n) _Pragma("unroll") for (int k = 0; k < 2; ++k) \
        acc[ai][bj][m][n] = __builtin_amdgcn_mfma_f32_16x16x32_bf16(Bt[n][k], At[m][k], acc[ai][bj][m][n], 0, 0, 0); __builtin_amdgcn_s_setprio(0); } while (0)
#define PG8_WAIT_V(n) asm volatile("s_waitcnt vmcnt(" #n ")" ::: "memory")
#define PG8_WAIT_L(n) asm volatile("s_waitcnt lgkmcnt(" #n ")" ::: "memory")
#define PG8_BAR __builtin_amdgcn_s_barrier()
#define PG8_SCHED __builtin_amdgcn_sched_barrier(0)
    Unit cur, nxt; int ui = 0;
    if (!S.next(0, cur)) return;
    f32x4 acc[2][2][4][2];
#pragma unroll
    for (int a = 0; a < 2; ++a)
#pragma unroll
        for (int b = 0; b < 2; ++b)
#pragma unroll
            for (int m = 0; m < 4; ++m)
#pragma unroll
                for (int n = 0; n < 2; ++n) acc[a][b][m][n] = (f32x4){0.f, 0.f, 0.f, 0.f};
    bf16x8 At[4][2], B0[2][2], B1[2][2];
    const char* cA = (const char*)g.A + (size_t)cur.pm * tstepA; const char* cB = (const char*)g.Bt + (size_t)cur.pn * tstepB;
    S.a_ready(cur);
    if constexpr (SP2) {
        PG8_STAGE(PG8_SB(0, 0), cB, voffB); PG8_STAGE(PG8_SB(0, 1), cB + hstepB, voffB); PG8_STAGE(PG8_SA(0, 0), cA, voffA); PG8_STAGE(PG8_SA(0, 1), cA + hstepA, voffA);
        if (wr == 1) PG8_BAR;
        PG8_WAIT_V(2); PG8_BAR;
        PG8_STAGE(PG8_SB(1, 0), cB + kstep, voffB); PG8_STAGE(PG8_SA(1, 0), cA + kstep, voffA); PG8_STAGE(PG8_SB(1, 1), cB + hstepB + kstep, voffB);
        PG8_WAIT_V(6); PG8_BAR;
    } else {
        PG8_STAGE(PG8_SB(0, 0), cB, voffB); PG8_STAGE(PG8_SA(0, 0), cA, voffA); PG8_STAGE(PG8_SB(0, 1), cB + hstepB, voffB); PG8_STAGE(PG8_SA(0, 1), cA + hstepA, voffA);
        if (wr == 1) PG8_BAR;
        PG8_WAIT_V(4); PG8_BAR;
        PG8_STAGE(PG8_SB(1, 0), cB + kstep, voffB); PG8_STAGE(PG8_SA(1, 0), cA + kstep, voffA); PG8_STAGE(PG8_SB(1, 1), cB + hstepB + kstep, voffB);
        PG8_WAIT_V(6); PG8_BAR;
    }
    for (;;) {
        const bool has_next = S.next(ui + 1, nxt);
        const char* nA = has_next ? (const char*)g.A + (size_t)nxt.pm * tstepA : cA; const char* nB = has_next ? (const char*)g.Bt + (size_t)nxt.pn * tstepB : cB;
        for (int t = 0; t < nt; t += 2) {
            const bool last = (t == nt - 2);
            const char* a1 = cA + (size_t)(t + 1) * kstep;
            const char* a2 = last ? nA : cA + (size_t)(t + 2) * kstep; const char* b2 = last ? nB : cB + (size_t)(t + 2) * kstep;
            const char* a3 = a2 + kstep; const char* b3 = b2 + kstep;
            if (last && has_next) S.a_ready(nxt);
            if constexpr (Epi::MID) { if (t == (nt >> 1)) {
                if (wr == 0) PG8_BAR; E.template mid<2, 2>(acc, cur, 0, 0, wr, wc, fr, fq); if (wr == 1) PG8_BAR; } }
            if constexpr (SP2) {
            PG8_LDB(B0, 0, 0); PG8_LDB(B1, 0, 1); PG8_SCHED; PG8_LDA(At, 0, 0); PG8_STAGE(PG8_SA(1, 1), a1 + hstepA, voffA);
            PG8_WAIT_V(8); PG8_WAIT_L(0); PG8_BAR; PG8_MMA(0, 0, At, B0); PG8_MMA(0, 1, At, B1); PG8_BAR; PG8_SCHED;
            PG8_LDA(At, 0, 1); PG8_STAGE(PG8_SB(0, 0), b2, voffB); PG8_STAGE(PG8_SB(0, 1), b2 + hstepB, voffB); PG8_STAGE(PG8_SA(0, 0), a2, voffA);
            PG8_WAIT_V(8); PG8_WAIT_L(0); PG8_BAR; PG8_MMA(1, 0, At, B0); PG8_MMA(1, 1, At, B1); PG8_BAR; PG8_SCHED;
            PG8_LDB(B0, 1, 0); PG8_LDB(B1, 1, 1); PG8_SCHED; PG8_LDA(At, 1, 0); PG8_STAGE(PG8_SA(0, 1), a2 + hstepA, voffA);
            PG8_WAIT_V(8); PG8_WAIT_L(0); PG8_BAR; PG8_MMA(0, 0, At, B0); PG8_MMA(0, 1, At, B1); PG8_BAR; PG8_SCHED;
            PG8_LDA(At, 1, 1); PG8_STAGE(PG8_SB(1, 0), b3, voffB); PG8_STAGE(PG8_SB(1, 1), b3 + hstepB, voffB); PG8_STAGE(PG8_SA(1, 0), a3, voffA);
            PG8_WAIT_V(8); PG8_WAIT_L(0); PG8_BAR; PG8_MMA(1, 0, At, B0); PG8_MMA(1, 1, At, B1); PG8_BAR; PG8_SCHED;
            } else {
            PG8_LDB(B0, 0, 0); PG8_SCHED; PG8_LDA(At, 0, 0); PG8_STAGE(PG8_SA(1, 1), a1 + hstepA, voffA);
            PG8_WAIT_L(8); PG8_BAR; PG8_WAIT_L(0); PG8_MMA(0, 0, At, B0); PG8_BAR; PG8_SCHED;
            PG8_LDB(B1, 0, 1); PG8_STAGE(PG8_SB(0, 0), b2, voffB);
            PG8_BAR; PG8_WAIT_L(0); PG8_MMA(0, 1, At, B1); PG8_BAR;
            PG8_LDA(At, 0, 1); PG8_STAGE(PG8_SA(0, 0), a2, voffA);
            PG8_BAR; PG8_WAIT_L(0); PG8_MMA(1, 0, At, B0); PG8_BAR; PG8_SCHED;
            PG8_STAGE(PG8_SB(0, 1), b2 + hstepB, voffB);
            PG8_WAIT_V(6); PG8_BAR; PG8_MMA(1, 1, At, B1); PG8_BAR;
            PG8_LDB(B0, 1, 0); PG8_SCHED; PG8_LDA(At, 1, 0); PG8_STAGE(PG8_SA(0, 1), a2 + hstepA, voffA);
            PG8_WAIT_L(8); PG8_BAR; PG8_WAIT_L(0); PG8_MMA(0, 0, At, B0); PG8_BAR; PG8_SCHED;
            PG8_LDB(B1, 1, 1); PG8_STAGE(PG8_SB(1, 0), b3, voffB);
            PG8_BAR; PG8_WAIT_L(0); PG8_MMA(0, 1, At, B1); PG8_BAR;
            PG8_LDA(At, 1, 1); PG8_STAGE(PG8_SA(1, 0), a3, voffA);
            PG8_BAR; PG8_WAIT_L(0); PG8_MMA(1, 0, At, B0); PG8_BAR; PG8_SCHED;
            PG8_STAGE(PG8_SB(1, 1), b3 + hstepB, voffB);
            PG8_WAIT_V(6); PG8_BAR; PG8_MMA(1, 1, At, B1); PG8_BAR;
            }
        }
        if constexpr (ALIGN_EPI) { if (wr == 0) PG8_BAR; }
        E.template run<2, 2>(acc, cur, 0, 0, wr, wc, fr, fq); S.done(cur);
        if (!has_next) break;
#pragma unroll
        for (int a = 0; a < 2; ++a)
#pragma unroll
            for (int b = 0; b < 2; ++b)
#pragma unroll
                for (int m = 0; m < 4; ++m)
#pragma unroll
                    for (int n = 0; n < 2; ++n) acc[a][b][m][n] = (f32x4){0.f, 0.f, 0.f, 0.f};
        cur = nxt; cA = nA; cB = nB; ++ui;
        if constexpr (ALIGN_EPI) { if (wr == 1) PG8_BAR; }
    }
    PG8_WAIT_V(0);
    if constexpr (!ALIGN_EPI) { if (wr == 0) PG8_BAR; }
    PG8_BAR;
#undef PG8_SA
#undef PG8_SB
#undef PG8_STAGE
#undef PG8_LDA
#undef PG8_LDB
#undef PG8_MMA
#undef PG8_WAIT_V
#undef PG8_WAIT_L
#undef PG8_BAR
#undef PG8_SCHED
}

template <int NB, class Epi>
__device__ __forceinline__ void sub_gemm(PG8_LAS unsigned char* lds, const Gemm g, int pm, int pn, int ai0, int bj0, const Epi& E) {
    int tid_ = threadIdx.x; asm volatile("" : "+v"(tid_));
    const int tid = tid_, wid = __builtin_amdgcn_readfirstlane(tid >> 6), lane = tid & 63, wr = wid >> 2, wc = wid & 3, fr = lane & 15, fq = lane >> 4;
    const int nt = g.K / BK;
    unsigned voffA[2], voffB[2];
#pragma unroll
    for (int i = 0; i < 2; ++i) { int R, C; stage_rc(tid * 16 + i * 8192, R, C); const int Rb = Epi::PERM ? ((R & ~31) + perm32(R & 31)) : R;
        voffA[i] = (unsigned)(R * g.lda + C) * 2u; voffB[i] = (unsigned)(Rb * g.ldb + C) * 2u; }
    const size_t kstep = (size_t)(BK * 2), hstepB = (size_t)HALF * g.ldb * 2;
    const unsigned ldsw = (unsigned)wid * 1024u;
    const int aoff = lds_byte(wr * 64 + fr, fq * 8), boff = lds_byte(wc * 32 + fr, fq * 8);
    const char* cA = (const char*)g.A + ((size_t)pm * BM + (size_t)ai0 * HALF) * g.lda * 2; const char* cB = (const char*)g.Bt + ((size_t)pn * BM + (size_t)bj0 * HALF) * g.ldb * 2;
    constexpr int NBUF = (NB == 1) ? 4 : 2, LPT = 2 * (1 + NB);
#define SG_BUF(b, j) ((b) * (1 + NB) * HTB + (j) * HTB)
#define SG_STAGE(bufoff, gbase, voff) do { _Pragma("unroll") for (int _i = 0; _i < 2; ++_i) \
        __builtin_amdgcn_global_load_lds((const unsigned*)((const char*)(gbase) + (voff)[_i]), (PG8_LAS unsigned*)(lds + (bufoff) + ldsw + _i * 8192), 16, 0, 0); } while (0)
#define SG_STAGE_TILE(t_) do { const int b_ = (t_) % NBUF; SG_STAGE(SG_BUF(b_, 0), cA + (size_t)(t_) * kstep, voffA); \
        _Pragma("unroll") for (int j = 0; j < NB; ++j) SG_STAGE(SG_BUF(b_, 1 + j), cB + j * hstepB + (size_t)(t_) * kstep, voffB); } while (0)
    f32x4 acc[1][NB][4][2];
#pragma unroll
    for (int b = 0; b < NB; ++b)
#pragma unroll
        for (int m = 0; m < 4; ++m)
#pragma unroll
            for (int n = 0; n < 2; ++n) acc[0][b][m][n] = (f32x4){0.f, 0.f, 0.f, 0.f};
#pragma unroll
    for (int t = 0; t < NBUF - 1; ++t) SG_STAGE_TILE(t);
#pragma unroll 1
    for (int t = 0; t < nt; ++t) {
        const int cur = t % NBUF;
        if constexpr (Epi::MID) { if (t == (nt >> 1)) E.template mid<1, NB>(acc, Unit{pm, pn}, ai0 * HALF, bj0 * HALF, wr, wc, fr, fq); }
        if (t + NBUF - 1 < nt) { SG_STAGE_TILE(t + NBUF - 1); asm volatile("s_waitcnt vmcnt(%0)" :: "n"((NBUF - 1) * LPT) : "memory"); }
        else if (NBUF >= 3 && t + 2 < nt) asm volatile("s_waitcnt vmcnt(%0)" :: "n"(NBUF >= 3 ? 2 * LPT : 0) : "memory");
        else if (NBUF >= 2 && t + 1 < nt) asm volatile("s_waitcnt vmcnt(%0)" :: "n"(LPT) : "memory");
        else asm volatile("s_waitcnt vmcnt(0)" ::: "memory");
        __builtin_amdgcn_s_barrier();
        bf16x8 At[4][2], Bf[NB][2][2];
#pragma unroll
        for (int m = 0; m < 4; ++m)
#pragma unroll
            for (int k = 0; k < 2; ++k) At[m][k] = *(const PG8_LAS bf16x8*)(lds + SG_BUF(cur, 0) + aoff + m * 2048 + k * 1024);
#pragma unroll
        for (int j = 0; j < NB; ++j)
#pragma unroll
            for (int n = 0; n < 2; ++n)
#pragma unroll
                for (int k = 0; k < 2; ++k) Bf[j][n][k] = *(const PG8_LAS bf16x8*)(lds + SG_BUF(cur, 1 + j) + boff + n * 2048 + k * 1024);
        asm volatile("s_waitcnt lgkmcnt(0)" ::: "memory"); __builtin_amdgcn_sched_barrier(0);
#pragma unroll
        for (int j = 0; j < NB; ++j)
#pragma unroll
            for (int m = 0; m < 4; ++m)
#pragma unroll
                for (int n = 0; n < 2; ++n)
#pragma unroll
                    for (int k = 0; k < 2; ++k) acc[0][j][m][n] = __builtin_amdgcn_mfma_f32_16x16x32_bf16(Bf[j][n][k], At[m][k], acc[0][j][m][n], 0, 0, 0);
        __builtin_amdgcn_s_barrier();
    }
    E.template run<1, NB>(acc, Unit{pm, pn}, ai0 * HALF, bj0 * HALF, wr, wc, fr, fq);
#undef SG_BUF
#undef SG_STAGE
#undef SG_STAGE_TILE
}
}
constexpr int NWAVES = 8;
constexpr int DM = 1024, NBATCH = 8, SEQ = 4096, SBATCH = 16, SSEQ = 16, PAST = 2048;
constexpr int MP = NBATCH * SEQ, MS = SBATCH * SSEQ, M = MP + MS, NTILE = M / 256, STILE = MP / 256;
constexpr int DIN = 4096, DFF = 3072, DUP = 6144;
constexpr float EPS = 1e-6f;
constexpr size_t OFF_Y = 0, OFF_HP = (size_t)M * DM, OFF_LCP = OFF_HP + NBATCH * DM, OFF_PLP = OFF_LCP + NBATCH * 3 * DM, OFF_FCP = OFF_PLP + NBATCH * 15 * DM,
                 OFF_HS = OFF_FCP + NBATCH * 2 * DUP, OFF_LCS = OFF_HS + SBATCH * DM, OFF_PLS = OFF_LCS + SBATCH * 3 * DM, OFF_FCS = OFF_PLS + SBATCH * 15 * DM,
                 OUT_TOTAL = OFF_FCS + SBATCH * 2 * DUP;
constexpr size_t MiB = 1u << 20;
constexpr size_t WS_CTL = 0, CTL_ZERO_BYTES = 64 * 1024;
constexpr size_t WS_WIN = 1 * MiB, WS_WCAT = 9 * MiB, WS_WOUT = 13 * MiB, WS_WUP = 15 * MiB, WS_WDN = 27 * MiB, WS_WG = 33 * MiB;
constexpr size_t WS_SSQ = 33 * MiB + 512 * 1024, WS_SSQ2 = 37 * MiB + 768 * 1024, WS_SUMM = WS_SSQ;
static_assert(WS_SSQ + (size_t)M * 128 <= WS_SSQ2 && WS_SSQ2 + (size_t)M * 128 <= 42 * MiB, "ssq map");
constexpr size_t WS_R0 = 42 * MiB, WS_R1 = 107 * MiB, WS_R2 = 236 * MiB, WS_R3 = 365 * MiB, WS_WBP = 494 * MiB, WS_WPOOL = 496 * MiB, WS_HA = 497 * MiB, WS_HB = 499 * MiB, WS_END = 501 * MiB;
static_assert((size_t)M * DM * 2 <= WS_R1 - WS_R0 && (size_t)M * 2048 * 2 <= WS_R2 - WS_R1 && (size_t)M * 2048 * 2 <= WS_R3 - WS_R2 && (size_t)M * 2048 * 2 <= WS_END - WS_R3 && (size_t)M * DFF * 2 <= WS_END - WS_R2, "ws map");
constexpr int CW_BAR = 1024, CW_PANEL = 8192;
constexpr int RING_BYTES = 131072;
constexpr int MISC_OFF = RING_BYTES, RS_OFF = RING_BYTES + 512, EDGE_START_OFF = RS_OFF + 4096, EDGE_MID_OFF = EDGE_START_OFF + 2048, EDGE_PREV_OFF = EDGE_MID_OFF + 2048;
constexpr int CWL_OFF = EDGE_PREV_OFF + 4096;
constexpr int LDS_BYTES = 155648;
static_assert(CWL_OFF + 4096 <= LDS_BYTES, "LDS map");

#define GAS __attribute__((address_space(1)))
#define LAS __attribute__((address_space(3)))
typedef unsigned short bf16;
typedef unsigned v4u __attribute__((ext_vector_type(4)));
typedef unsigned v2u __attribute__((ext_vector_type(2)));
typedef float f32x4 __attribute__((ext_vector_type(4)));
typedef short bf16x8 __attribute__((ext_vector_type(8)));
#define LDS_WAIT() asm volatile("s_waitcnt lgkmcnt(0)" ::: "memory")
#define VM_WAIT() asm volatile("s_waitcnt vmcnt(0)" ::: "memory")
__device__ __forceinline__ unsigned f2bf(float f) { unsigned u = __builtin_bit_cast(unsigned, f); return (u + 0x7fffu + ((u >> 16) & 1u)) >> 16; }
__device__ __forceinline__ unsigned pk2(float lo, float hi) { return f2bf(lo) | (f2bf(hi) << 16); }
__device__ __forceinline__ float bflo(unsigned w) { return __builtin_bit_cast(float, w << 16); }
__device__ __forceinline__ float bfhi(unsigned w) { return __builtin_bit_cast(float, w & 0xffff0000u); }
__device__ __forceinline__ float sigmoidf_fast(float x) { return __builtin_amdgcn_rcpf(1.0f + __builtin_amdgcn_exp2f(-1.4426950408889634f * x)); }
__device__ __forceinline__ float gelu_tanh(float g) { const float z = g * (1.0f + 0.044715f * g * g); return g * __builtin_amdgcn_rcpf(1.0f + __builtin_amdgcn_exp2f(-2.302208198f * z)); }
__device__ __forceinline__ float dpp_shr1(float v) { return __builtin_bit_cast(float, __builtin_amdgcn_update_dpp(__builtin_bit_cast(int, v), __builtin_bit_cast(int, v), 0x111  , 0xf, 0xf, false)); }
__device__ __forceinline__ float wave_sum(float v) {
#pragma unroll
    for (int o = 1; o < 64; o <<= 1) v += __shfl_xor(v, o);
    return v;
}

#define XB_TMO      128
#define XB_XCNT(j)  (256  + 64 * (j))
#define XB_XSUB(j)  (1280 + 64 * (j))
#define XB_XGEN(j)  (2304 + 64 * (j))
#define XB_TOP      3328
#define XB_TOPGEN   3392
#define XCD_BAR_WORDS 3456
#define XB_SPIN_CAP (1u << 20)
static_assert((CW_BAR + XCD_BAR_WORDS) <= CW_PANEL && (CW_PANEL + 32 * 132) * 4 <= (int)CTL_ZERO_BYTES, "control words inside the memset region");
__device__ __forceinline__ unsigned xb_ld(unsigned* p)              { return __hip_atomic_load(p, __ATOMIC_RELAXED, __HIP_MEMORY_SCOPE_AGENT); }
__device__ __forceinline__ unsigned xb_add(unsigned* p, unsigned v) { return __hip_atomic_fetch_add(p, v, __ATOMIC_RELAXED, __HIP_MEMORY_SCOPE_AGENT); }
__device__ __forceinline__ unsigned xb_xcc_id() { return (unsigned)__builtin_amdgcn_s_getreg((3 << 11) | 20) & 0xFu; }
#define XB_SPIN(cond, bar) do { unsigned _sp = 0; while (cond) { __builtin_amdgcn_s_sleep(1); \
    if ((++_sp & 255u) == 0u) { if (xb_ld(&(bar)[XB_TMO])) break; if (_sp > XB_SPIN_CAP) { atomicAdd(&(bar)[XB_TMO], 1u); break; } } } } while (0)
struct XcdBarrier { unsigned* bar; unsigned x; volatile LAS unsigned* st; };
__device__ __forceinline__ XcdBarrier xcd_barrier_post(unsigned* bar, volatile LAS unsigned* st) {
    XcdBarrier b; b.bar = bar; b.x = xb_xcc_id(); b.st = st;
    if (threadIdx.x == 0) (void)xb_add(&bar[XB_XCNT(b.x)], 1u);
    return b;
}
__device__ __forceinline__ void xcd_barrier_complete(unsigned* bar, unsigned x, unsigned& nloc, unsigned& nx) {
    const unsigned G = gridDim.x * gridDim.y * gridDim.z;
    unsigned sum, cnt, mine, sp = 0u;
    for (;;) {
        sum = 0u; cnt = 0u; mine = 0u;
#pragma unroll
        for (unsigned j = 0; j < 16; ++j) { const unsigned c = xb_ld(&bar[XB_XCNT(j)]); sum += c; cnt += (c > 0u) ? 1u : 0u; mine = (j == x) ? c : mine; }
        if (sum == G) break;
        __builtin_amdgcn_s_sleep(1);
        if ((++sp & 255u) == 0u) { if (xb_ld(&bar[XB_TMO])) break; if (sp > XB_SPIN_CAP) { atomicAdd(&bar[XB_TMO], 1u); break; } }
    }
    nloc = mine > 0u ? mine : 1u; nx = cnt > 0u ? cnt : 1u;
}
__device__ __forceinline__ void xcd_barrier(const XcdBarrier& b) {
    asm volatile("s_waitcnt vmcnt(0)" ::: "memory");
    __syncthreads();
    if (threadIdx.x == 0) {
        unsigned* bar = b.bar;
        __builtin_amdgcn_s_waitcnt(0);
        unsigned nloc = b.st[0], nx = b.st[1];
        if (nloc == 0u) { xcd_barrier_complete(bar, b.x, nloc, nx); b.st[0] = nloc; b.st[1] = nx; }
        const unsigned old = xb_add(&bar[XB_XSUB(b.x)], 1u);
        const unsigned gen = old / nloc;
        if (old + 1u == (gen + 1u) * nloc) {
            __builtin_amdgcn_fence(__ATOMIC_RELEASE, "agent");
            asm volatile("s_waitcnt vmcnt(0)" ::: "memory");
            const unsigned og = xb_add(&bar[XB_TOP], 1u);
            const unsigned tg = og / nx;
            if (og + 1u == (tg + 1u) * nx) xb_add(&bar[XB_TOPGEN], 1u);
            else XB_SPIN(xb_ld(&bar[XB_TOPGEN]) == tg, bar);
            __builtin_amdgcn_fence(__ATOMIC_ACQUIRE, "agent");
            xb_add(&bar[XB_XGEN(b.x)], 1u);
            asm volatile("s_waitcnt vmcnt(0)" ::: "memory");
        } else {
            XB_SPIN(xb_ld(&bar[XB_XGEN(b.x)]) == gen, bar);
            __builtin_amdgcn_fence(__ATOMIC_ACQUIRE, "agent");
            asm volatile("s_waitcnt vmcnt(0)" ::: "memory");
        }
    }
    __syncthreads();
}

struct KP {
    const float* in[26];
    float* out; unsigned char* ws;
    int ph_lo, ph_hi;
};
enum { I_XP = 0, I_XS, I_STH, I_STLC, I_STPOOL, I_STFFN, I_NMIX, I_WIN, I_CLW, I_CLB, I_WRA, I_BRA, I_WIX, I_BIX, I_LAM, I_WPOOL, I_PSCALE, I_WBRL, I_WBRP, I_WOUT, I_NFFN, I_WUP, I_CFW, I_CFB, I_WDN, I_NFIN };

using pg8::Unit;
struct EpiZ {
    static constexpr bool PERM = true, AMAP = false, MID = false;
    bf16* ZR; bf16* G;
    template <int NA, int NB> __device__ __forceinline__ void run(f32x4 (&acc)[NA][NB][4][2], const Unit& u, int rowoff, int coloff, int wr, int wc, int fr, int fq) const {
        const int row0 = u.pm * 256 + rowoff + wr * 64 + fr; const bool gate = u.pn >= 8;
        bf16* base = gate ? G : ZR; const int col0 = (u.pn & 7) * 256 + coloff + wc * 32 + 8 * fq;
#pragma unroll
        for (int ai = 0; ai < NA; ++ai)
#pragma unroll
            for (int m = 0; m < 4; ++m) { bf16* rowp = base + (size_t)(row0 + ai * 128 + m * 16) * 2048 + col0;
#pragma unroll
                for (int bj = 0; bj < NB; ++bj) { f32x4 v0 = acc[ai][bj][m][0], v1 = acc[ai][bj][m][1];
                    if (gate) {
#pragma unroll
                        for (int j = 0; j < 4; ++j) { v0[j] = sigmoidf_fast(v0[j]); v1[j] = sigmoidf_fast(v1[j]); } }
                    v4u w; w.x = pg8::cvt_pk_bf16(v0[0], v0[1]); w.y = pg8::cvt_pk_bf16(v0[2], v0[3]); w.z = pg8::cvt_pk_bf16(v1[0], v1[1]); w.w = pg8::cvt_pk_bf16(v1[2], v1[3]);
                    *(v4u*)(rowp + bj * 128) = w; } }
    }
};
struct EpiBr {
    static constexpr bool PERM = true, AMAP = false, MID = true;
    const bf16* G; bf16* MG;
    template <int NA, int NB> __device__ __forceinline__ void mid(f32x4 (&acc)[NA][NB][4][2], const Unit& u, int rowoff, int coloff, int wr, int wc, int fr, int fq) const {
        int pm_ = u.pm, pn_ = u.pn; asm volatile("" : "+s"(pm_), "+s"(pn_));
        const int row0 = pm_ * 256 + rowoff + wr * 64 + fr, col0 = pn_ * 256 + coloff + wc * 32 + 8 * fq;
#pragma unroll
        for (int ai = 0; ai < NA; ++ai)
#pragma unroll
            for (int m = 0; m < 4; ++m) { const size_t row = (size_t)(row0 + ai * 128 + m * 16);
#pragma unroll
                for (int bj = 0; bj < NB; ++bj) { const int col = col0 + bj * 128;
                    const v4u ga = *(const v4u*)(G + row * 2048 + col), gb = *(const v4u*)(G + row * 2048 + 1024 + col);
                    const float a_[8] = {bflo(ga.x), bfhi(ga.x), bflo(ga.y), bfhi(ga.y), bflo(ga.z), bfhi(ga.z), bflo(ga.w), bfhi(ga.w)};
                    const float b_[8] = {bflo(gb.x), bfhi(gb.x), bflo(gb.y), bfhi(gb.y), bflo(gb.z), bfhi(gb.z), bflo(gb.w), bfhi(gb.w)};
#pragma unroll
                    for (int e = 0; e < 4; ++e) { acc[ai][bj][m][0][e] *= a_[e] * __builtin_amdgcn_rcpf(fmaxf(b_[e], 1e-30f)); acc[ai][bj][m][1][e] *= a_[4 + e] * __builtin_amdgcn_rcpf(fmaxf(b_[4 + e], 1e-30f)); } } }
    }
    template <int NA, int NB> __device__ __forceinline__ void run(f32x4 (&acc)[NA][NB][4][2], const Unit& u, int rowoff, int coloff, int wr, int wc, int fr, int fq) const {
        const int row0 = u.pm * 256 + rowoff + wr * 64 + fr, col0 = u.pn * 256 + coloff + wc * 32 + 8 * fq;
#pragma unroll
        for (int ai = 0; ai < NA; ++ai)
#pragma unroll
            for (int m = 0; m < 4; ++m) { const size_t row = (size_t)(row0 + ai * 128 + m * 16);
#pragma unroll
                for (int bj = 0; bj < NB; ++bj) { const int col = col0 + bj * 128;
                    const v4u gw = *(const v4u*)(G + row * 2048 + 1024 + col);
                    const f32x4 g0 = {bflo(gw.x), bfhi(gw.x), bflo(gw.y), bfhi(gw.y)}, g1 = {bflo(gw.z), bfhi(gw.z), bflo(gw.w), bfhi(gw.w)};
                    const f32x4 v0 = acc[ai][bj][m][0] * g0, v1 = acc[ai][bj][m][1] * g1;
                    v4u w; w.x = pg8::cvt_pk_bf16(v0[0], v0[1]); w.y = pg8::cvt_pk_bf16(v0[2], v0[3]); w.z = pg8::cvt_pk_bf16(v1[0], v1[1]); w.w = pg8::cvt_pk_bf16(v1[2], v1[3]);
                    *(v4u*)(MG + row * 1024 + col) = w; } }
    }
};
template <bool DOWN> struct EpiRes {
    static constexpr bool PERM = true, AMAP = false, MID = false;
    const float* xp; const float* xs; float* Y; bf16* X1B; float* SSQ;
    template <int NA, int NB> __device__ __forceinline__ void run(f32x4 (&acc)[NA][NB][4][2], const Unit& u, int rowoff, int coloff, int wr, int wc, int fr, int fq) const {
        const int row0 = u.pm * 256 + rowoff + wr * 64 + fr, col0 = u.pn * 256 + coloff + wc * 32 + 8 * fq;
        const float* xb = (u.pm < STILE ? xp : xs - (size_t)MP * DM);
#pragma unroll
        for (int ai = 0; ai < NA; ++ai)
#pragma unroll
            for (int m = 0; m < 4; ++m) { const size_t row = (size_t)(row0 + ai * 128 + m * 16);
#pragma unroll
                for (int bj = 0; bj < NB; ++bj) { const size_t off = row * 1024 + col0 + bj * 128; f32x4 v0, v1;
                    if (!DOWN) { v0 = acc[ai][bj][m][0] + *(const f32x4*)(xb + off); v1 = acc[ai][bj][m][1] + *(const f32x4*)(xb + off + 4); }
                    else { const v4u w = *(const v4u*)(X1B + off); v0 = acc[ai][bj][m][0] + (f32x4){bflo(w.x), bfhi(w.x), bflo(w.y), bfhi(w.y)}; v1 = acc[ai][bj][m][1] + (f32x4){bflo(w.z), bfhi(w.z), bflo(w.w), bfhi(w.w)}; }
                    float s = (v0[0] * v0[0] + v0[1] * v0[1]) + (v0[2] * v0[2] + v0[3] * v0[3]) + (v1[0] * v1[0] + v1[1] * v1[1]) + (v1[2] * v1[2] + v1[3] * v1[3]);
                    if (!DOWN) { v4u w; w.x = pg8::cvt_pk_bf16(v0[0], v0[1]); w.y = pg8::cvt_pk_bf16(v0[2], v0[3]); w.z = pg8::cvt_pk_bf16(v1[0], v1[1]); w.w = pg8::cvt_pk_bf16(v1[2], v1[3]);
                        *(v4u*)(X1B + off) = w; }
                    else { *(f32x4*)(Y + off) = v0; *(f32x4*)(Y + off + 4) = v1; }
                    s += __shfl_xor(s, 16); s += __shfl_xor(s, 32);
                    if (fq == 0) SSQ[row * 32 + u.pn * 8 + ((coloff >> 7) + bj) * 4 + wc] = s; } }
    }
};
__device__ __forceinline__ float row_rs(const float* SSQ, size_t row) {
    const f32x4* q = (const f32x4*)(SSQ + row * 32); float s = 0.f;
#pragma unroll
    for (int k = 0; k < 8; ++k) { const f32x4 a = q[k]; s += (a[0] + a[1]) + (a[2] + a[3]); }
    return 1.0f / sqrtf(s * (1.f / DM) + EPS);
}
struct EpiFinal {
    static constexpr bool PERM = true, AMAP = false, MID = false;
    float* Y; const bf16* X1B; const float* gf; float* XS; unsigned* cnt; unsigned* tmo; LAS unsigned char* lx;
    template <int NA, int NB> __device__ __forceinline__ void run(f32x4 (&acc)[NA][NB][4][2], const Unit& u, int rowoff, int coloff, int wr, int wc, int fr, int fq) const {
        LAS float* P = (LAS float*)(lx + RS_OFF); LAS float* S = P + 2048;
        int tid = threadIdx.x, pm_ = u.pm, pn_ = u.pn, fr_ = fr, fq_ = fq, wr_ = wr, wc_ = wc;
        asm volatile("" : "+v"(tid), "+s"(pm_), "+s"(pn_), "+v"(fr_), "+v"(fq_), "+s"(wr_), "+s"(wc_));
        const int wid = tid >> 6, lane = tid & 63;
        const int lrow0 = rowoff + wr_ * 64 + fr_, col0 = pn_ * 256 + coloff + wc_ * 32 + 8 * fq_, bj0 = coloff >> 7;
#pragma unroll
        for (int ai = 0; ai < NA; ++ai)
#pragma unroll
            for (int m = 0; m < 4; ++m) { const int lrow = lrow0 + ai * 128 + m * 16; const size_t row = (size_t)pm_ * 256 + lrow;
#pragma unroll
                for (int bj = 0; bj < NB; ++bj) { const size_t off = row * 1024 + col0 + bj * 128;
                    { const v4u w = *(const v4u*)(X1B + off); acc[ai][bj][m][0] += (f32x4){bflo(w.x), bfhi(w.x), bflo(w.y), bfhi(w.y)}; acc[ai][bj][m][1] += (f32x4){bflo(w.z), bfhi(w.z), bflo(w.w), bfhi(w.w)}; }
                    const f32x4 v0 = acc[ai][bj][m][0], v1 = acc[ai][bj][m][1];
                    float s = (v0[0] * v0[0] + v0[1] * v0[1]) + (v0[2] * v0[2] + v0[3] * v0[3]) + (v1[0] * v1[0] + v1[1] * v1[1]) + (v1[2] * v1[2] + v1[3] * v1[3]);
                    s += __shfl_xor(s, 16); s += __shfl_xor(s, 32);
                    if (fq_ == 0) P[lrow * 8 + (bj0 + bj) * 4 + wc_] = s; } }
        asm volatile("s_waitcnt lgkmcnt(0)" ::: "memory"); __builtin_amdgcn_s_barrier(); asm volatile("" ::: "memory");
        constexpr int RPW = (NA == 2) ? 32 : 16;
        const int nslot = (NA == 2) ? 4 : 8, slot = (NA == 2) ? pn_ : 2 * pn_ + bj0;
        const int prow = rowoff + wid * RPW + (lane & (RPW - 1));
        float* xs = XS + (size_t)pm_ * 2048;
        if (lane < RPW) { const LAS float* pp = P + prow * 8 + (NA == 2 ? 0 : bj0 * 4); float t = (pp[0] + pp[1]) + (pp[2] + pp[3]); if (NA == 2) t += (pp[4] + pp[5]) + (pp[6] + pp[7]);
            __hip_atomic_store(xs + slot * 256 + prow, t, __ATOMIC_RELAXED, __HIP_MEMORY_SCOPE_AGENT); }
        asm volatile("s_waitcnt vmcnt(0)" ::: "memory");
        unsigned* c = cnt + 32 * ((NA == 2) ? pm_ : (STILE + (rowoff >> 7)));
        if (lane == 0) __hip_atomic_fetch_add(c, 1u, __ATOMIC_RELAXED, __HIP_MEMORY_SCOPE_AGENT);
        if (wid == 0) { const unsigned want = 8u * (unsigned)nslot; unsigned sp = 0;
            while ((unsigned)__builtin_amdgcn_readfirstlane(__hip_atomic_load(c, __ATOMIC_RELAXED, __HIP_MEMORY_SCOPE_AGENT)) < want) {
                __builtin_amdgcn_s_sleep(1);
                if ((++sp & 255u) == 0u) { if (__builtin_amdgcn_readfirstlane(__hip_atomic_load(tmo, __ATOMIC_RELAXED, __HIP_MEMORY_SCOPE_AGENT)) != 0u) break; if (sp > (1u << 20)) { if (lane == 0) atomicAdd(tmo, 1u); break; } } } }
        asm volatile("s_waitcnt vmcnt(0) lgkmcnt(0)" ::: "memory"); __builtin_amdgcn_s_barrier(); asm volatile("" ::: "memory");
        if (lane < RPW) { float t = 0.f;
#pragma unroll
            for (int k = 0; k < 8; ++k) if (k < nslot) t += __hip_atomic_load(xs + k * 256 + prow, __ATOMIC_RELAXED, __HIP_MEMORY_SCOPE_AGENT);
            S[prow] = 1.0f / sqrtf(t * (1.f / DM) + EPS); }
        asm volatile("s_waitcnt lgkmcnt(0)" ::: "memory"); __builtin_amdgcn_s_barrier(); asm volatile("" ::: "memory");
        f32x4 gg[NB][2];
#pragma unroll
        for (int bj = 0; bj < NB; ++bj) { gg[bj][0] = *(const f32x4*)(gf + col0 + bj * 128); gg[bj][1] = *(const f32x4*)(gf + col0 + bj * 128 + 4); }
#pragma unroll
        for (int ai = 0; ai < NA; ++ai)
#pragma unroll
            for (int m = 0; m < 4; ++m) { const int lrow = lrow0 + ai * 128 + m * 16; const size_t row = (size_t)pm_ * 256 + lrow; const float rs = S[lrow];
#pragma unroll
                for (int bj = 0; bj < NB; ++bj) { const size_t off = row * 1024 + col0 + bj * 128;
                    *(f32x4*)(Y + off) = acc[ai][bj][m][0] * rs * gg[bj][0]; *(f32x4*)(Y + off + 4) = acc[ai][bj][m][1] * rs * gg[bj][1]; } }
    }
};
struct EpiW {
    static constexpr bool PERM = true, AMAP = false, MID = false;
    bf16* O;
    template <int NA, int NB> __device__ __forceinline__ void run(f32x4 (&acc)[NA][NB][4][2], const Unit& u, int rowoff, int coloff, int wr, int wc, int fr, int fq) const {
        const int row0 = u.pm * 256 + rowoff + wr * 64 + fr, col0 = u.pn * 256 + coloff + wc * 32 + 8 * fq;
#pragma unroll
        for (int ai = 0; ai < NA; ++ai)
#pragma unroll
            for (int m = 0; m < 4; ++m)
#pragma unroll
                for (int bj = 0; bj < NB; ++bj) { const f32x4 v0 = acc[ai][bj][m][0], v1 = acc[ai][bj][m][1];
                    v4u w; w.x = pg8::cvt_pk_bf16(v0[0], v0[1]); w.y = pg8::cvt_pk_bf16(v0[2], v0[3]); w.z = pg8::cvt_pk_bf16(v1[0], v1[1]); w.w = pg8::cvt_pk_bf16(v1[2], v1[3]);
                    *(v4u*)(O + (size_t)(row0 + ai * 128 + m * 16) * 2048 + col0 + bj * 128) = w; }
    }
};
template <bool AM> struct EpiNull {
    static constexpr bool PERM = true, AMAP = AM, MID = false;
    template <int NA, int NB> __device__ __forceinline__ void run(f32x4 (&acc)[NA][NB][4][2], const Unit&, int, int, int, int, int, int) const {
#pragma unroll
        for (int ai = 0; ai < NA; ++ai)
#pragma unroll
            for (int bj = 0; bj < NB; ++bj)
#pragma unroll
                for (int m = 0; m < 4; ++m) { asm volatile("" :: "v"(acc[ai][bj][m][0]), "v"(acc[ai][bj][m][1])); }
    }
};
struct EpiZScratch {
    static constexpr bool PERM = true, AMAP = false, MID = false;
    bf16* scr;
    template <int NA, int NB> __device__ __forceinline__ void run(f32x4 (&acc)[NA][NB][4][2], const Unit& u, int rowoff, int coloff, int wr, int wc, int fr, int fq) const {
        const int row0 = wr * 64 + fr, col0 = wc * 32 + 8 * fq;
#pragma unroll
        for (int ai = 0; ai < NA; ++ai)
#pragma unroll
            for (int m = 0; m < 4; ++m) { bf16* rowp = scr + (size_t)(row0 + ai * 128 + m * 16) * 256 + col0;
#pragma unroll
                for (int bj = 0; bj < NB; ++bj) { f32x4 v0 = acc[ai][bj][m][0], v1 = acc[ai][bj][m][1];
                    v4u w; w.x = pg8::cvt_pk_bf16(v0[0], v0[1]); w.y = pg8::cvt_pk_bf16(v0[2], v0[3]); w.z = pg8::cvt_pk_bf16(v1[0], v1[1]); w.w = pg8::cvt_pk_bf16(v1[2], v1[3]);
                    *(v4u*)(rowp + bj * 128) = w; } }
    }
};
struct EpiUpS {
    static constexpr bool PERM = true, AMAP = false, MID = false;
    bf16* ACT; const float* cw; const float* cb; const float* stf; float* ofs; const float* SSQ;
    template <int NA, int NB> __device__ __forceinline__ void run(f32x4 (&acc)[NA][NB][4][2], const Unit& u, int rowoff, int coloff, int wr, int wc, int fr, int fq) const {
        static_assert(NA == 1 && NB == 2, "sample FFN epilogue works on half sub-units");
        int pn_ = u.pn, ro_ = rowoff, fr_ = fr, fq_ = fq, wr_ = wr, wc_ = wc; asm volatile("" : "+s"(pn_), "+s"(ro_), "+v"(fr_), "+v"(fq_), "+s"(wr_), "+s"(wc_));
        const int cbase = 32 * wc_ + 8 * fq_, gcol = 128 * pn_ + cbase;
#pragma unroll
        for (int m = 0; m < 4; ++m) {
            asm volatile("" ::: "memory");
            const int lrow = ro_ + wr_ * 64 + m * 16 + fr_, seq = lrow >> 4; const size_t row = (size_t)MP + lrow;
            const float rs = row_rs(SSQ, row);
            unsigned pk[4];
#pragma unroll
            for (int n = 0; n < 2; ++n) { f32x4 gc;
#pragma unroll
                for (int bj = 0; bj < 2; ++bj) { const int oc = bj * DFF + gcol + 4 * n;
                    const f32x4 w0 = *(const f32x4*)(cw + oc), w1 = *(const f32x4*)(cw + DUP + oc), w2 = *(const f32x4*)(cw + 2 * DUP + oc), bb = *(const f32x4*)(cb + oc);
                    const f32x4 h = acc[0][bj][m][n] * rs; f32x4 hm1, hm2;
#pragma unroll
                    for (int e = 0; e < 4; ++e) { hm1[e] = __shfl_up(h[e], 1, 16); hm2[e] = __shfl_up(h[e], 2, 16); }
                    if (fr_ < 2) { const f32x4 s1 = *(const f32x4*)(stf + (size_t)(seq * 2 + 1) * DUP + oc); if (fr_ == 0) { hm1 = s1; hm2 = *(const f32x4*)(stf + (size_t)(seq * 2 + 0) * DUP + oc); } else hm2 = s1; }
                    if (fr_ >= 14) *(f32x4*)(ofs + (size_t)(seq * 2 + (fr_ - 14)) * DUP + oc) = h;
                    const f32x4 c = bb + w0 * hm2 + w1 * hm1 + w2 * h;
                    if (bj == 0) gc = c;
                    else { f32x4 a;
#pragma unroll
                        for (int e = 0; e < 4; ++e) a[e] = gelu_tanh(gc[e]) * c[e];
                        pk[2 * n] = pg8::cvt_pk_bf16(a[0], a[1]); pk[2 * n + 1] = pg8::cvt_pk_bf16(a[2], a[3]); } } }
            v4u w; w.x = pk[0]; w.y = pk[1]; w.z = pk[2]; w.w = pk[3];
            *(v4u*)(ACT + row * DFF + gcol) = w;
        }
    }
};
struct EpiUp {
    static constexpr bool PERM = true, AMAP = true, MID = false;
    bf16* ACT; const float* cw; const float* cb; const float* stf; float* ofp; float* ofs; LAS unsigned char* lx; int pm0; bf16* scr; float* HA; float* HB;
    template <int NA, int NB> __device__ __forceinline__ void run(f32x4 (&acc)[NA][NB][4][2], const Unit& u, int, int, int wr, int wc, int fr, int fq) const {
        int pm_ = u.pm, pn_ = u.pn, fr_ = fr, fq_ = fq; asm volatile("" : "+s"(pm_), "+s"(pn_), "+v"(fr_), "+v"(fq_));
        const bool samp = (pm_ == STILE); const int j = pm_ - pm0;
        const LAS float* RS = (const LAS float*)(lx + RS_OFF) + j * 256 + 128 * wr + 8 * fr_;
        const f32x4 rsa = *(const LAS f32x4*)RS, rsb = *(const LAS f32x4*)(RS + 4);
        const float rs[8] = {rsa[0], rsa[1], rsa[2], rsa[3], rsb[0], rsb[1], rsb[2], rsb[3]};
        const int cbase = 32 * wc + 8 * fq_, gcol = 128 * pn_ + cbase;
        const LAS float* Ein = (const LAS float*)(lx + (wr == 0 ? (j == 0 ? EDGE_START_OFF : EDGE_PREV_OFF + 2048 * (j & 1)) : EDGE_MID_OFF));
        LAS float* Eout = (LAS float*)(lx + (wr == 0 ? EDGE_MID_OFF : EDGE_PREV_OFF + 2048 * ((j + 1) & 1)));
        const int seq = samp ? (8 * wr + (fr_ >> 1)) : (pm_ >> 4);
        const bool lastp = (!samp) && !scr && ((pm_ & 15) == 15) && wr == 1 && fr_ == 15;
        if (!samp && fr_ == 15) {
#pragma unroll
            for (int n = 0; n < 2; ++n)
#pragma unroll
                for (int bj = 0; bj < 2; ++bj) { const int cc = bj * 128 + cbase + 4 * n;
                    *(LAS f32x4*)(Eout + cc) = acc[1][bj][2][n] * rs[6]; *(LAS f32x4*)(Eout + 256 + cc) = acc[1][bj][3][n] * rs[7]; } }
        asm volatile("s_waitcnt lgkmcnt(0)" ::: "memory"); __builtin_amdgcn_s_barrier(); asm volatile("" ::: "memory");
        const size_t astr = scr ? 128 : DFF;
        bf16* ap = scr ? scr + (size_t)(128 * wr + 8 * fr_) * 128 + cbase : ACT + (size_t)(pm_ * 256 + 128 * wr + 8 * fr_) * DFF + gcol;
#pragma unroll
        for (int n = 0; n < 2; ++n) {
            f32x4 gc[8];
#pragma unroll
            for (int bj = 0; bj < 2; ++bj) {
                const int cc = bj * 128 + cbase + 4 * n, oc = bj * DFF + gcol + 4 * n;
                const LAS float* cwl = (const LAS float*)(lx + CWL_OFF) + cc;
                const f32x4 w0 = *(const LAS f32x4*)cwl, w1 = *(const LAS f32x4*)(cwl + 256), w2 = *(const LAS f32x4*)(cwl + 512), bb = *(const LAS f32x4*)(cwl + 768);
                const f32x4 h6 = acc[1][bj][2][n] * rs[6], h7 = acc[1][bj][3][n] * rs[7];
                f32x4 hm1, hm2;
#pragma unroll
                for (int e = 0; e < 4; ++e) { hm1[e] = dpp_shr1(h7[e]); hm2[e] = dpp_shr1(h6[e]); }
                if (!samp) {
                    if (fr_ == 0) { hm2 = *(const LAS f32x4*)(Ein + cc); hm1 = *(const LAS f32x4*)(Ein + 256 + cc); }
                    if (lastp) { *(f32x4*)(ofp + (size_t)(seq * 2 + 0) * DUP + oc) = h6; *(f32x4*)(ofp + (size_t)(seq * 2 + 1) * DUP + oc) = h7; }
                    if (j == 3 && wr == 1 && fr_ == 15 && !scr) { float* ha = HA + ((size_t)((pm0 >> 2) + 1) * 24 + pn_) * 512 + cc; *(f32x4*)ha = h6; *(f32x4*)(ha + 256) = h7; }
                    if (j == 0 && wr == 0 && fr_ == 0 && !scr) { float* hb = HB + ((size_t)(pm0 >> 2) * 24 + pn_) * 512 + cc; *(f32x4*)hb = acc[0][bj][0][n] * rs[0]; *(f32x4*)(hb + 256) = acc[0][bj][1][n] * rs[1]; }
                } else {
                    if (!(fr_ & 1)) { hm2 = *(const f32x4*)(stf + (size_t)(seq * 2 + 0) * DUP + oc); hm1 = *(const f32x4*)(stf + (size_t)(seq * 2 + 1) * DUP + oc); }
                    else { *(f32x4*)(ofs + (size_t)(seq * 2 + 0) * DUP + oc) = h6; *(f32x4*)(ofs + (size_t)(seq * 2 + 1) * DUP + oc) = h7; }
                }
                f32x4 p2 = hm2, p1 = hm1;
#pragma unroll
                for (int q = 0; q < 8; ++q) {
                    const f32x4 hq = (q == 6) ? h6 : (q == 7) ? h7 : acc[q >> 2][bj][q & 3][n] * rs[q];
                    const f32x4 c = bb + w0 * p2 + w1 * p1 + w2 * hq;
                    p2 = p1; p1 = hq;
                    if (bj == 0) gc[q] = c;
                    else { f32x4 a;
#pragma unroll
                        for (int e = 0; e < 4; ++e) a[e] = gelu_tanh(gc[q][e]) * c[e];
                        v2u w; w.x = pg8::cvt_pk_bf16(a[0], a[1]); w.y = pg8::cvt_pk_bf16(a[2], a[3]);
                        *(v2u*)(ap + (size_t)q * astr + 4 * n) = w; }
                }
            }
        }
        LDS_WAIT();
    }
};
template <class RowMap>
__device__ __forceinline__ void p0_transpose_item(const float* W, int ldw, int k0, int n0, bf16* WT, size_t ldt, int kcol0, RowMap drow, const float* kscale, LAS float* scr, int lane) {
    float tv[32];
#pragma unroll
    for (int i = 0; i < 32; ++i) { const int kk = 2 * i + (lane >> 5); tv[i] = W[(size_t)(k0 + kk) * ldw + n0 + (lane & 31)]; }
    if (kscale) {
#pragma unroll
        for (int i = 0; i < 32; ++i) tv[i] *= kscale[k0 + 2 * i + (lane >> 5)]; }
#pragma unroll
    for (int i = 0; i < 32; ++i) scr[(2 * i + (lane >> 5)) * 33 + (lane & 31)] = tv[i];
    LDS_WAIT(); asm volatile("" ::: "memory");
    const int c = lane & 7;
#pragma unroll
    for (int j = 0; j < 4; ++j) { const int n = (lane >> 3) + 8 * j; const LAS float* s = scr + (8 * c) * 33 + n;
        v4u o; o.x = pk2(s[0 * 33], s[1 * 33]); o.y = pk2(s[2 * 33], s[3 * 33]); o.z = pk2(s[4 * 33], s[5 * 33]); o.w = pk2(s[6 * 33], s[7 * 33]);
        *(v4u*)(WT + (size_t)drow(n0 + n) * ldt + kcol0 + k0 + 8 * c) = o; }
    LDS_WAIT(); asm volatile("" ::: "memory");
}
struct RowId { __device__ __forceinline__ int operator()(int n) const { return n; } };
struct RowUp { __device__ __forceinline__ int operator()(int n) const { const int half = n >= DFF ? 1 : 0, c = n - half * DFF; return (c >> 7) * 256 + half * 128 + (c & 127); } };

__device__ __forceinline__ void p0_prologue(const KP& p, LAS unsigned char* lds, int vcu, int G, int wave, int lane) {
    LAS float* scr = (LAS float*)(lds + wave * 16384);
    const int gw = vcu * NWAVES + wave, NGW = G * NWAVES;
    unsigned char* ws = p.ws;
    bf16* Win_t = (bf16*)(ws + WS_WIN); bf16* Wg_t = (bf16*)(ws + WS_WG); bf16* Wbp_t = (bf16*)(ws + WS_WBP); bf16* Wpool_b = (bf16*)(ws + WS_WPOOL);
    constexpr int I_IN = (DM / 64) * (DIN / 32), I_SQ = (DM / 64) * (DM / 32), I_G = 32 * 2, I_PC = 4 * 256 * 256 / 512;
    constexpr int NITEMS = I_IN + I_SQ + I_G + I_PC;
    for (int it = gw; it < NITEMS; it += NGW) {
        int r = it;
        if (r < I_IN) { const int nblk = DIN / 32; p0_transpose_item(p.in[I_WIN], DIN, 64 * (r / nblk), 32 * (r % nblk), Win_t, DM, 0, RowId(), nullptr, scr, lane); continue; } r -= I_IN;
        if (r < I_SQ) { const int nblk = DM / 32; p0_transpose_item(p.in[I_WBRP], DM, 64 * (r / nblk), 32 * (r % nblk), Wbp_t, DM, 0, RowId(), p.in[I_PSCALE], scr, lane); continue; } r -= I_SQ;
        if (r < I_G) { const int mat = r >> 1, nb = r & 1; const float* W = (mat < 16 ? p.in[I_WRA] : p.in[I_WIX]) + (size_t)(mat & 15) * 4096;
          p0_transpose_item(W, 64, 0, 32 * nb, Wg_t + (size_t)mat * 4096, 64, 0, RowId(), nullptr, scr, lane); continue; } r -= I_G;
        { const float* s = p.in[I_WPOOL] + (size_t)r * 512 + lane * 8; const f32x4 a = *(const f32x4*)s, b = *(const f32x4*)(s + 4);
          v4u o; o.x = pk2(a[0], a[1]); o.y = pk2(a[2], a[3]); o.z = pk2(b[0], b[1]); o.w = pk2(b[2], b[3]); *(v4u*)(Wpool_b + (size_t)r * 512 + lane * 8) = o; }
    }
    {
        bf16* XN = (bf16*)(ws + WS_R0); const float* g1 = p.in[I_NMIX];
        f32x4 gv[4];
#pragma unroll
        for (int j = 0; j < 4; ++j) gv[j] = *((const f32x4*)g1 + lane + 64 * j);
        for (int m0 = gw; m0 < M; m0 += 4 * NGW) {
            f32x4 v[4][4]; float s[4];
#pragma unroll
            for (int r = 0; r < 4; ++r) { const int m = m0 + r * NGW; s[r] = 0.f;
                if (m < M) { const float* xrow = m < MP ? p.in[I_XP] + (size_t)m * DM : p.in[I_XS] + (size_t)(m - MP) * DM; const f32x4* xr = (const f32x4*)xrow + lane;
#pragma unroll
                    for (int j = 0; j < 4; ++j) v[r][j] = xr[64 * j]; } }
#pragma unroll
            for (int r = 0; r < 4; ++r) { const int m = m0 + r * NGW;
                if (m < M) {
#pragma unroll
                    for (int j = 0; j < 4; ++j) s[r] += (v[r][j][0] * v[r][j][0] + v[r][j][1] * v[r][j][1]) + (v[r][j][2] * v[r][j][2] + v[r][j][3] * v[r][j][3]);
                    const float rstd = 1.0f / sqrtf(wave_sum(s[r]) * (1.f / DM) + EPS);
                    v2u* o8 = (v2u*)(XN + (size_t)m * DM) + lane;
#pragma unroll
                    for (int j = 0; j < 4; ++j) { const f32x4 y = v[r][j] * rstd * gv[j]; v2u o; o.x = pk2(y[0], y[1]); o.y = pk2(y[2], y[3]); o8[64 * j] = o; } } }
        }
    }
}
__device__ __forceinline__ void p1_weights(const KP& p, LAS unsigned char* lds, int gw, int NGW, int wave, int lane) {
    LAS float* scr = (LAS float*)(lds + wave * 16384);
    unsigned char* ws = p.ws;
    bf16* Wcat_t = (bf16*)(ws + WS_WCAT); bf16* Wout_t = (bf16*)(ws + WS_WOUT); bf16* Wup_t = (bf16*)(ws + WS_WUP); bf16* Wdn_t = (bf16*)(ws + WS_WDN);
    constexpr int I_UP = (DM / 64) * (DUP / 32), I_SQ = (DM / 64) * (DM / 32), I_DN = (DFF / 64) * (DM / 32);
    for (int it = gw; it < I_UP + 2 * I_SQ + I_DN; it += NGW) {
        int r = it;
        if (r < I_SQ) { const int nblk = DM / 32; p0_transpose_item(p.in[I_WBRL], DM, 64 * (r / nblk), 32 * (r % nblk), Wcat_t, 2048, 0, RowId(), nullptr, scr, lane); continue; } r -= I_SQ;
        if (r < I_SQ) { const int nblk = DM / 32; p0_transpose_item(p.in[I_WOUT], DM, 64 * (r / nblk), 32 * (r % nblk), Wout_t, DM, 0, RowId(), nullptr, scr, lane); continue; } r -= I_SQ;
        if (r < I_UP) { const int nblk = DUP / 32; p0_transpose_item(p.in[I_WUP], DUP, 64 * (r / nblk), 32 * (r % nblk), Wup_t, DM, 0, RowUp(), p.in[I_NFFN]  , scr, lane); continue; } r -= I_UP;
        { const int nblk = DM / 32; p0_transpose_item(p.in[I_WDN], DM, 64 * (r / nblk), 32 * (r % nblk), Wdn_t, DFF, 0, RowId(), nullptr, scr, lane); }
    }
}

constexpr int XR_OFF = 0, XR_BYTES = 16 * 19 * 128, SEG_OFF = 40960, CIN_OFF = 45056;
template <bool FINAL>
__device__ __forceinline__ void lru_unit(const KP& p, LAS unsigned char* lds, int pm, int n, int tid, int lane, int wave) {
    constexpr bool samp = true;
    const bf16* ZR = (const bf16*)(p.ws + WS_R1); const bf16* Wg_t = (const bf16*)(p.ws + WS_WG);
    typedef float f32x2v __attribute__((ext_vector_type(2)));
    f32x2v* SUMM = (f32x2v*)(p.ws + WS_SUMM);
    bf16* HP = (bf16*)(p.ws + WS_R3);
    LAS unsigned char* XR = lds + XR_OFF; LAS f32x2v* SEG = (LAS f32x2v*)(lds + SEG_OFF); LAS float* CIN = (LAS float*)(lds + CIN_OFF);
    const int t0 = samp ? 0 : 256 * (pm & 15);
    __syncthreads();
    for (int idx = tid; idx < 304 * 8; idx += NWAVES * 64) {
        const int row = idx >> 3, ck = idx & 7, g = row / 19, k = row - g * 19, tt = 16 * g + k - 3;
        v4u v = {0u, 0u, 0u, 0u};
        if (!samp) { if (t0 + tt >= 0) v = *(const v4u*)(ZR + (size_t)(pm * 256 + tt) * 2048 + n * 64 + ck * 8); }
        else if (k < 3) { const float* s = p.in[I_STLC] + (size_t)(g * 3 + k) * DM + n * 64 + ck * 8; const f32x4 a = *(const f32x4*)s, b = *(const f32x4*)(s + 4);
            v.x = pk2(a[0], a[1]); v.y = pk2(a[2], a[3]); v.z = pk2(b[0], b[1]); v.w = pk2(b[2], b[3]); }
        else v = *(const v4u*)(ZR + (size_t)(MP + 16 * g + k - 3) * 2048 + n * 64 + ck * 8);
        *(LAS v4u*)(XR + row * 128 + ck * 16) = v;
    }
    if (FINAL && !samp && tid < 64) {
        const int npre = pm & 15; f32x2v sv[15];
#pragma unroll
        for (int k = 0; k < 15; ++k) sv[k] = (k < npre) ? SUMM[(size_t)(pm - npre + k) * DM + n * 64 + tid] : (f32x2v){1.f, 0.f};
        float c = 0.f;
#pragma unroll
        for (int k = 0; k < 15; ++k) c = sv[k].y + sv[k].x * c;
        CIN[tid] = c;
    }
    __syncthreads();
    const int i16 = lane & 15, fq = lane >> 4;
    const float* cwl = p.in[I_CLW]; const float* cbl = p.in[I_CLB];
    bf16x8 fa[2][2];
#pragma unroll
    for (int ks = 0; ks < 2; ++ks) {
        const int ch0 = 32 * ks + 8 * fq; f32x4 w[4][2], bb[2];
#pragma unroll
        for (int tp = 0; tp < 4; ++tp) { w[tp][0] = *(const f32x4*)(cwl + tp * DM + n * 64 + ch0); w[tp][1] = *(const f32x4*)(cwl + tp * DM + n * 64 + ch0 + 4); }
        bb[0] = *(const f32x4*)(cbl + n * 64 + ch0); bb[1] = *(const f32x4*)(cbl + n * 64 + ch0 + 4);
#pragma unroll
        for (int m = 0; m < 2; ++m) {
            const int tau = 8 * (i16 >> 2) + 4 * m + (i16 & 3), T = 32 * wave + tau, rb = (T >> 4) * 19 + (T & 15);
            f32x4 u0 = bb[0], u1 = bb[1];
#pragma unroll
            for (int tp = 0; tp < 4; ++tp) { const v4u x = *(const LAS v4u*)(XR + (rb + tp) * 128 + ch0 * 2);
                u0 += w[tp][0] * (f32x4){bflo(x.x), bfhi(x.x), bflo(x.y), bfhi(x.y)}; u1 += w[tp][1] * (f32x4){bflo(x.z), bfhi(x.z), bflo(x.w), bfhi(x.w)}; }
            v4u f; f.x = pk2(u0[0], u0[1]); f.y = pk2(u0[2], u0[3]); f.z = pk2(u1[0], u1[1]); f.w = pk2(u1[2], u1[3]);
            fa[m][ks] = __builtin_bit_cast(bf16x8, f);
        }
    }
    float hloc[4][8], pc[4][8], P8[4], H8[4];
    const int T0 = 32 * wave + 8 * fq, rb0 = (T0 >> 4) * 19 + (T0 & 15);
#pragma unroll
    for (int nb = 0; nb < 4; ++nb) {
        const int ch = 16 * nb + i16, gch = n * 64 + ch;
        f32x4 aR[2] = {{0.f, 0.f, 0.f, 0.f}, {0.f, 0.f, 0.f, 0.f}}, aI[2] = {{0.f, 0.f, 0.f, 0.f}, {0.f, 0.f, 0.f, 0.f}};
#pragma unroll
        for (int ks = 0; ks < 2; ++ks) {
            const bf16x8 bR = *(const bf16x8*)(Wg_t + (size_t)(n * 64 + ch) * 64 + 8 * fq + 32 * ks);
            const bf16x8 bI = *(const bf16x8*)(Wg_t + (size_t)((16 + n) * 64 + ch) * 64 + 8 * fq + 32 * ks);
#pragma unroll
            for (int m = 0; m < 2; ++m) { aR[m] = __builtin_amdgcn_mfma_f32_16x16x32_bf16(fa[m][ks], bR, aR[m], 0, 0, 0); aI[m] = __builtin_amdgcn_mfma_f32_16x16x32_bf16(fa[m][ks], bI, aI[m], 0, 0, 0); }
        }
        float x[11];
#pragma unroll
        for (int r = 0; r < 11; ++r) x[r] = __builtin_bit_cast(float, (unsigned)(*(const LAS unsigned short*)(XR + (rb0 + r) * 128 + ch * 2)) << 16);
        const float c0 = cwl[gch], c1 = cwl[DM + gch], c2 = cwl[2 * DM + gch], c3 = cwl[3 * DM + gch], cbv = cbl[gch];
        const float bra = p.in[I_BRA][gch], bix = p.in[I_BIX][gch], lam = p.in[I_LAM][gch];
        const float zz = -lam, sp = fmaxf(zz, 0.f) + log1pf(expf(-fabsf(zz))), c8 = -8.0f * sp;
        float hl = 0.f, P = 1.f;
#pragma unroll
        for (int q = 0; q < 8; ++q) {
            const float u = cbv + c0 * x[q] + c1 * x[q + 1] + c2 * x[q + 2] + c3 * x[q + 3];
            const float r = sigmoidf_fast(aR[q >> 2][q & 3] + bra), ig = sigmoidf_fast(aI[q >> 2][q & 3] + bix);
            const float la = r * c8, a = __builtin_amdgcn_exp2f(la * 1.4426950408889634f);
            const float x2 = 2.0f * la, em_small = -x2 * (1.0f + x2 * (0.5f + x2 * (0.16666667f + x2 * 0.041666668f))), em = (x2 > -0.05f) ? em_small : (1.0f - a * a);
            const float b = sqrtf(em) * ig * u;
            hl = a * hl + b; P = P * a;
            hloc[nb][q] = hl; pc[nb][q] = P;
        }
        P8[nb] = P; H8[nb] = hl;
    }
    float Pf[4][4], Hf[4][4];
#pragma unroll
    for (int nb = 0; nb < 4; ++nb)
#pragma unroll
        for (int f = 0; f < 4; ++f) { Pf[nb][f] = __shfl(P8[nb], i16 + 16 * f); Hf[nb][f] = __shfl(H8[nb], i16 + 16 * f); }
    if (!samp) {
        if (fq == 0) {
#pragma unroll
            for (int nb = 0; nb < 4; ++nb) { float hw = 0.f, pw = 1.f;
#pragma unroll
                for (int f = 0; f < 4; ++f) { hw = Hf[nb][f] + Pf[nb][f] * hw; pw *= Pf[nb][f]; }
                SEG[wave * 64 + 16 * nb + i16] = (f32x2v){pw, hw}; }
        }
        __syncthreads();
        if (!FINAL) {
            if (tid < 64) { float hu = 0.f, pu = 1.f;
#pragma unroll
                for (int w = 0; w < 8; ++w) { const f32x2v s = SEG[w * 64 + tid]; hu = s.y + s.x * hu; pu *= s.x; }
                SUMM[(size_t)pm * DM + n * 64 + tid] = (f32x2v){pu, hu}; }
            return;
        }
    }
#pragma unroll
    for (int nb = 0; nb < 4; ++nb) {
        const int ch = 16 * nb + i16, gch = n * 64 + ch;
        float c;
        if (!samp) {
            c = CIN[ch];
#pragma unroll
            for (int w = 0; w < 8; ++w) { const f32x2v s = SEG[w * 64 + ch]; if (w < wave) c = s.y + s.x * c; }
#pragma unroll
            for (int f = 0; f < 4; ++f) if (f < fq) c = Hf[nb][f] + Pf[nb][f] * c;
        } else {
            const int sq = 2 * wave + (fq >> 1);
            c = p.in[I_STH][(size_t)sq * DM + gch];
            if (fq & 1) { const float pp = (fq == 1) ? Pf[nb][0] : Pf[nb][2], hh = (fq == 1) ? Hf[nb][0] : Hf[nb][2]; c = hh + pp * c; }
        }
        bf16* hp = HP + (size_t)(pm * 256 + T0) * 2048 + gch; float hlast = 0.f;
#pragma unroll
        for (int q = 0; q < 8; ++q) { const float h = hloc[nb][q] + pc[nb][q] * c; hp[(size_t)q * 2048] = (bf16)f2bf(h); hlast = h; }
        if (!samp) { if ((pm & 15) == 15 && wave == 7 && fq == 3) p.out[OFF_HP + (size_t)(pm >> 4) * DM + gch] = hlast; }
        else if (fq & 1) p.out[OFF_HS + (size_t)(2 * wave + (fq >> 1)) * DM + gch] = hlast;
    }
}

constexpr int XL_RS = 144  , XL_BYTES = 259 * XL_RS + 16, XL_SEG = 2 * XL_BYTES, XL_CW = XL_SEG + 4096;
__device__ __forceinline__ void lru_task(const KP& p, LAS unsigned char* lds, int s, int n, int hf, int tid, int lane, int wave) {
    const bf16* ZR = (const bf16*)(p.ws + WS_R1); const bf16* Wg_t = (const bf16*)(p.ws + WS_WG); bf16* HP = (bf16*)(p.ws + WS_R3);
    typedef float f32x2v __attribute__((ext_vector_type(2)));
    LAS f32x2v* SEG = (LAS f32x2v*)(lds + XL_SEG); LAS float* CW = (LAS float*)(lds + XL_CW);
    const int i16 = lane & 15, fq = lane >> 4;
    const float* cwl = p.in[I_CLW]; const float* cbl = p.in[I_CLB];
    const size_t rowbase = (size_t)s * SEQ;
    __syncthreads();
    if (tid < 320) { const int tp = tid >> 6, c = tid & 63; CW[tid] = tp < 4 ? cwl[tp * DM + n * 64 + c] : cbl[n * 64 + c]; }
    for (int idx = tid; idx < 259 * 8; idx += NWAVES * 64) { const int row = idx >> 3, ck = idx & 7; v4u v = {0u, 0u, 0u, 0u};
        if (row >= 3) v = *(const v4u*)(ZR + (rowbase + row - 3) * 2048 + n * 64 + ck * 8);
        *(LAS v4u*)(lds + row * XL_RS + ck * 16) = v; }
    bf16x8 bR[2][2], bI[2][2]; float c0[2], c1[2], c2[2], c3[2], cbv[2], bra[2], bix[2], c8[2], cin[2];
#pragma unroll
    for (int b2 = 0; b2 < 2; ++b2) { const int ch = 16 * (2 * hf + b2) + i16, gch = n * 64 + ch;
#pragma unroll
        for (int ks = 0; ks < 2; ++ks) { bR[b2][ks] = *(const bf16x8*)(Wg_t + (size_t)(n * 64 + ch) * 64 + 8 * fq + 32 * ks); bI[b2][ks] = *(const bf16x8*)(Wg_t + (size_t)((16 + n) * 64 + ch) * 64 + 8 * fq + 32 * ks); }
        c0[b2] = cwl[gch]; c1[b2] = cwl[DM + gch]; c2[b2] = cwl[2 * DM + gch]; c3[b2] = cwl[3 * DM + gch]; cbv[b2] = cbl[gch];
        bra[b2] = p.in[I_BRA][gch]; bix[b2] = p.in[I_BIX][gch];
        const float zz = -p.in[I_LAM][gch]; c8[b2] = -8.0f * (fmaxf(zz, 0.f) + log1pf(expf(-fabsf(zz)))) * 1.4426950408889634f;
        cin[b2] = 0.f; }
    __syncthreads();
    for (int tt = 0; tt < 16; ++tt) {
        LAS unsigned char* XR = lds + (tt & 1) * XL_BYTES; LAS unsigned char* XN_ = lds + ((tt + 1) & 1) * XL_BYTES;
        v4u pf[5];
        if (tt < 15) {
#pragma unroll
            for (int k = 0; k < 5; ++k) { const int idx = tid + k * (NWAVES * 64); if (idx < 259 * 8) pf[k] = *(const v4u*)(ZR + (rowbase + 256 * (tt + 1) - 3 + (idx >> 3)) * 2048 + n * 64 + (idx & 7) * 8); } }
        bf16x8 fa[2][2];
#pragma unroll
        for (int ks = 0; ks < 2; ++ks) { const int ch0 = 32 * ks + 8 * fq; f32x4 w[4][2], bb[2];
#pragma unroll
            for (int tp = 0; tp < 4; ++tp) { w[tp][0] = *(const LAS f32x4*)(CW + tp * 64 + ch0); w[tp][1] = *(const LAS f32x4*)(CW + tp * 64 + ch0 + 4); }
            bb[0] = *(const LAS f32x4*)(CW + 256 + ch0); bb[1] = *(const LAS f32x4*)(CW + 256 + ch0 + 4);
#pragma unroll
            for (int m = 0; m < 2; ++m) { const int rb = 32 * wave + 8 * (i16 >> 2) + 4 * m + (i16 & 3); f32x4 u0 = bb[0], u1 = bb[1];
#pragma unroll
                for (int tp = 0; tp < 4; ++tp) { const v4u x = *(const LAS v4u*)(XR + (rb + tp) * XL_RS + ch0 * 2);
                    u0 += w[tp][0] * (f32x4){bflo(x.x), bfhi(x.x), bflo(x.y), bfhi(x.y)}; u1 += w[tp][1] * (f32x4){bflo(x.z), bfhi(x.z), bflo(x.w), bfhi(x.w)}; }
                v4u f; f.x = pg8::cvt_pk_bf16(u0[0], u0[1]); f.y = pg8::cvt_pk_bf16(u0[2], u0[3]); f.z = pg8::cvt_pk_bf16(u1[0], u1[1]); f.w = pg8::cvt_pk_bf16(u1[2], u1[3]);
                fa[m][ks] = __builtin_bit_cast(bf16x8, f); } }
        float hloc[2][8], pc[2][8], P8[2], H8[2];
        const int rb0 = 32 * wave + 8 * fq;
#pragma unroll
        for (int b2 = 0; b2 < 2; ++b2) { const int ch = 16 * (2 * hf + b2) + i16;
            f32x4 aR[2] = {{0.f, 0.f, 0.f, 0.f}, {0.f, 0.f, 0.f, 0.f}}, aI[2] = {{0.f, 0.f, 0.f, 0.f}, {0.f, 0.f, 0.f, 0.f}};
#pragma unroll
            for (int ks = 0; ks < 2; ++ks)
#pragma unroll
                for (int m = 0; m < 2; ++m) { aR[m] = __builtin_amdgcn_mfma_f32_16x16x32_bf16(fa[m][ks], bR[b2][ks], aR[m], 0, 0, 0); aI[m] = __builtin_amdgcn_mfma_f32_16x16x32_bf16(fa[m][ks], bI[b2][ks], aI[m], 0, 0, 0); }
            float x[11];
#pragma unroll
            for (int r = 0; r < 11; ++r) x[r] = __builtin_bit_cast(float, (unsigned)(*(const LAS unsigned short*)(XR + (rb0 + r) * XL_RS + ch * 2)) << 16);
            float hl = 0.f, P = 1.f;
#pragma unroll
            for (int q = 0; q < 8; ++q) {
                const float u = cbv[b2] + c0[b2] * x[q] + c1[b2] * x[q + 1] + c2[b2] * x[q + 2] + c3[b2] * x[q + 3];
                const float r = sigmoidf_fast(aR[q >> 2][q & 3] + bra[b2]), ig = sigmoidf_fast(aI[q >> 2][q & 3] + bix[b2]);
                const float a = __builtin_amdgcn_exp2f(r * c8[b2]);
                const float b = __builtin_amdgcn_sqrtf(fmaxf(__builtin_fmaf(-a, a, 1.0f), 0.f)) * ig * u;
                hl = __builtin_fmaf(a, hl, b); P = P * a; hloc[b2][q] = hl; pc[b2][q] = P; }
            P8[b2] = P; H8[b2] = hl; }
        float Pf[2][4], Hf[2][4];
#pragma unroll
        for (int b2 = 0; b2 < 2; ++b2)
#pragma unroll
            for (int f = 0; f < 4; ++f) { Pf[b2][f] = __shfl(P8[b2], i16 + 16 * f); Hf[b2][f] = __shfl(H8[b2], i16 + 16 * f); }
        if (fq == 0) {
#pragma unroll
            for (int b2 = 0; b2 < 2; ++b2) { float hw = 0.f, pw = 1.f;
#pragma unroll
                for (int f = 0; f < 4; ++f) { hw = __builtin_fmaf(Pf[b2][f], hw, Hf[b2][f]); pw *= Pf[b2][f]; }
                SEG[(tt & 1) * 256 + wave * 32 + 16 * b2 + i16] = (f32x2v){pw, hw}; } }
        if (tt < 15) {
#pragma unroll
            for (int k = 0; k < 5; ++k) { const int idx = tid + k * (NWAVES * 64); if (idx < 259 * 8) *(LAS v4u*)(XN_ + (idx >> 3) * XL_RS + (idx & 7) * 16) = pf[k]; } }
        LDS_WAIT(); __syncthreads();
#pragma unroll
        for (int b2 = 0; b2 < 2; ++b2) { const int ch = 16 * (2 * hf + b2) + i16, gch = n * 64 + ch;
            float c = cin[b2], call = cin[b2];
#pragma unroll
            for (int w = 0; w < 8; ++w) { const f32x2v sg = SEG[(tt & 1) * 256 + w * 32 + 16 * b2 + i16]; call = __builtin_fmaf(sg.x, call, sg.y); if (w < wave) c = __builtin_fmaf(sg.x, c, sg.y); }
            cin[b2] = call;
#pragma unroll
            for (int f = 0; f < 4; ++f) if (f < fq) c = __builtin_fmaf(Pf[b2][f], c, Hf[b2][f]);
            bf16* hp = HP + (rowbase + 256 * tt + rb0) * 2048 + gch; float hlast = 0.f;
#pragma unroll
            for (int q = 0; q < 8; ++q) { const float h = __builtin_fmaf(pc[b2][q], c, hloc[b2][q]); hp[(size_t)q * 2048] = (bf16)f2bf(h); hlast = h; }
            if (tt == 15 && wave == 7 && fq == 3) p.out[OFF_HP + (size_t)s * DM + gch] = hlast; }
    }
}

__device__ __forceinline__ v4u pool_load8(const KP& p, const bf16* ZR, int pm, int tt, int run, int ch) {
    const bool samp = (pm == STILE); v4u w = {0u, 0u, 0u, 0u};
    if (!samp) { if (256 * (pm & 15) + tt >= 0) w = *(const v4u*)(ZR + (size_t)(pm * 256 + tt) * 2048 + 1024 + ch); }
    else { const int tl = tt - 16 * run;
        if (tl < 0) { const float* s = p.in[I_STPOOL] + (size_t)(run * 15 + 15 + tl) * DM + ch; const f32x4 a = *(const f32x4*)s, b = *(const f32x4*)(s + 4);
            w.x = pk2(a[0], a[1]); w.y = pk2(a[2], a[3]); w.z = pk2(b[0], b[1]); w.w = pk2(b[2], b[3]); }
        else w = *(const v4u*)(ZR + (size_t)(MP + tt) * 2048 + 1024 + ch); }
    return w;
}
__device__ __forceinline__ void unpack8(const v4u w, float (&v)[8]) { v[0] = bflo(w.x); v[1] = bfhi(w.x); v[2] = bflo(w.y); v[3] = bfhi(w.y); v[4] = bflo(w.z); v[5] = bfhi(w.z); v[6] = bflo(w.w); v[7] = bfhi(w.w); }
template <int W> __device__ __forceinline__ void pool_unit_w(const KP& p, int pm, int g, int tid) {
    const bf16* ZR = (const bf16*)(p.ws + WS_R1); bf16* HP = (bf16*)(p.ws + WS_R3);
    const bool samp = (pm == STILE);
    const int oct = tid & 31, run = tid >> 5, ch = 256 * g + 8 * oct;
#pragma unroll 1
    for (int hf = 0; hf < 2; ++hf) {
        const int tf = 16 * run + 8 * hf;
        const int pos0 = samp ? PAST : 256 * (pm & 15) + tf;
        v4u raw[W - 1 + 8];
#pragma unroll
        for (int r = 0; r < W - 1 + 8; ++r) raw[r] = pool_load8(p, ZR, pm, tf - (W - 1) + r, run, ch);
        float s[8];
#pragma unroll
        for (int e = 0; e < 8; ++e) s[e] = 0.f;
#pragma unroll
        for (int r = 0; r < W - 1; ++r) { float v[8]; unpack8(raw[r], v);
#pragma unroll
            for (int e = 0; e < 8; ++e) s[e] += v[e]; }
#pragma unroll
        for (int i = 0; i < 8; ++i) {
            const int cnt = min(pos0 + i + 1, W); const float inv = 1.0f / (float)cnt; float o[8], v[8], vo[8]; unpack8(raw[W - 1 + i], v); unpack8(raw[i], vo);
#pragma unroll
            for (int e = 0; e < 8; ++e) { s[e] += v[e]; o[e] = s[e] * inv - v[e]; }
            v4u ow; ow.x = pk2(o[0], o[1]); ow.y = pk2(o[2], o[3]); ow.z = pk2(o[4], o[5]); ow.w = pk2(o[6], o[7]);
            *(v4u*)(HP + (size_t)(pm * 256 + tf + i) * 2048 + 1024 + ch) = ow;
#pragma unroll
            for (int e = 0; e < 8; ++e) s[e] -= vo[e];
        }
    }
}
__device__ __forceinline__ void pool_unit(const KP& p, int pm, int g, int tid) {
    if (g == 0) pool_unit_w<2>(p, pm, g, tid); else if (g == 1) pool_unit_w<4>(p, pm, g, tid); else if (g == 2) pool_unit_w<8>(p, pm, g, tid); else pool_unit_w<16>(p, pm, g, tid);
}
constexpr int PL_RS = 272;
template <int W> __device__ __forceinline__ void pool_half_w(const KP& p, LAS unsigned char* lds, int pm, int g, int half, int tid) {
    const bf16* ZR = (const bf16*)(p.ws + WS_R1); bf16* HP = (bf16*)(p.ws + WS_R3);
    const int ch0 = 256 * g + 128 * half, t0seq = 256 * (pm & 15);
    __syncthreads();
    v4u st[9];
#pragma unroll
    for (int k = 0; k < 9; ++k) { const int idx = tid + k * (NWAVES * 64), row = idx >> 4, ck = idx & 15; st[k] = (v4u){0u, 0u, 0u, 0u};
        if (idx < 271 * 16 && t0seq + row - 15 >= 0) st[k] = *(const v4u*)(ZR + (size_t)(pm * 256 + row - 15) * 2048 + 1024 + ch0 + ck * 8); }
#pragma unroll
    for (int k = 0; k < 9; ++k) { const int idx = tid + k * (NWAVES * 64); if (idx < 271 * 16) *(LAS v4u*)(lds + (idx >> 4) * PL_RS + (idx & 15) * 16) = st[k]; }
    __syncthreads();
    const int oct = tid & 15, tf = 8 * (tid >> 4), pos0 = t0seq + tf;
    v4u raw[W - 1 + 8];
#pragma unroll
    for (int r = 0; r < W - 1 + 8; ++r) raw[r] = *(const LAS v4u*)(lds + (tf - (W - 1) + r + 15) * PL_RS + oct * 16);
    float s[8];
#pragma unroll
    for (int e = 0; e < 8; ++e) s[e] = 0.f;
#pragma unroll
    for (int r = 0; r < W - 1; ++r) { float v[8]; unpack8(raw[r], v);
#pragma unroll
        for (int e = 0; e < 8; ++e) s[e] += v[e]; }
#pragma unroll
    for (int i = 0; i < 8; ++i) {
        const int cnt = min(pos0 + i + 1, W); const float inv = __builtin_amdgcn_rcpf((float)cnt); float o[8], v[8], vo[8]; unpack8(raw[W - 1 + i], v); unpack8(raw[i], vo);
#pragma unroll
        for (int e = 0; e < 8; ++e) { s[e] += v[e]; o[e] = s[e] * inv - v[e]; }
        v4u ow; ow.x = pg8::cvt_pk_bf16(o[0], o[1]); ow.y = pg8::cvt_pk_bf16(o[2], o[3]); ow.z = pg8::cvt_pk_bf16(o[4], o[5]); ow.w = pg8::cvt_pk_bf16(o[6], o[7]);
        *(v4u*)(HP + (size_t)(pm * 256 + tf + i) * 2048 + 1024 + ch0 + oct * 8) = ow;
#pragma unroll
        for (int e = 0; e < 8; ++e) s[e] -= vo[e];
    }
}
__device__ __forceinline__ void pool_half(const KP& p, LAS unsigned char* lds, int pm, int g, int half, int tid) {
    if (g == 0) pool_half_w<2>(p, lds, pm, g, half, tid); else if (g == 1) pool_half_w<4>(p, lds, pm, g, half, tid); else if (g == 2) pool_half_w<8>(p, lds, pm, g, half, tid); else pool_half_w<16>(p, lds, pm, g, half, tid);
}
__device__ __forceinline__ void state_copy(const KP& p, int gtid, int gthreads) {
    const bf16* ZR = (const bf16*)(p.ws + WS_R1);
    constexpr int N1 = NBATCH * 3 * DM, N2 = NBATCH * 15 * DM, N3 = SBATCH * 3 * DM, N4 = SBATCH * 15 * DM;
    constexpr int NT = N1 + N2 + N3 + N4;
    for (int i0 = gtid; i0 < NT; i0 += 4 * gthreads) {
        unsigned short raw[4]; float* dsts[4];
#pragma unroll
        for (int k = 0; k < 4; ++k) { const int i = i0 + k * gthreads; raw[k] = 0; dsts[k] = nullptr;
            if (i < NT) { int r = i; size_t row, col; float* dst;
                if (r < N1) { const int b = r / (3 * DM), kk = (r / DM) % 3, c = r % DM; row = (size_t)b * SEQ + SEQ - 3 + kk; col = c; dst = p.out + OFF_LCP + r; }
                else if ((r -= N1) < N2) { const int b = r / (15 * DM), kk = (r / DM) % 15, c = r % DM; row = (size_t)b * SEQ + SEQ - 15 + kk; col = 1024 + c; dst = p.out + OFF_PLP + r; }
                else if ((r -= N2) < N3) { const int b = r / (3 * DM), kk = (r / DM) % 3, c = r % DM; row = (size_t)MP + b * SSEQ + SSEQ - 3 + kk; col = c; dst = p.out + OFF_LCS + r; }
                else { r -= N3; const int b = r / (15 * DM), kk = (r / DM) % 15, c = r % DM; row = (size_t)MP + b * SSEQ + SSEQ - 15 + kk; col = 1024 + c; dst = p.out + OFF_PLS + r; }
                raw[k] = ZR[row * 2048 + col]; dsts[k] = dst; } }
#pragma unroll
        for (int k = 0; k < 4; ++k) if (dsts[k]) *dsts[k] = __builtin_bit_cast(float, (unsigned)raw[k] << 16);
    }
}

template <int MODE = 0> __device__ __forceinline__ void strip_pre(const KP& p, LAS unsigned char* lds, int pm0, int pn, int cnt, int tid, int lane, int wave) {
    const float* SSQ = (const float*)(p.ws + WS_SSQ); const bf16* XG2 = (const bf16*)(p.ws + WS_R1); const bf16* Wup_t = (const bf16*)(p.ws + WS_WUP);
    LAS float* RS = (LAS float*)(lds + RS_OFF); LAS float* ES = (LAS float*)(lds + EDGE_START_OFF); LAS float* CWL = (LAS float*)(lds + CWL_OFF);
    __syncthreads();
#pragma unroll
    for (int k = 0; k < 2; ++k) { const int idx = tid + k * (NWAVES * 64), vec = idx >> 8, col = idx & 255, oc = (col >> 7) * DFF + 128 * pn + (col & 127);
        CWL[idx] = vec < 3 ? p.in[I_CFW][(size_t)vec * DUP + oc] : p.in[I_CFB][oc]; }
    if (MODE != 2) for (int i = tid; i < cnt * 256; i += NWAVES * 64) RS[i] = row_rs(SSQ, (size_t)pm0 * 256 + i);
    ES[tid] = 0.f;
    __syncthreads();
}

__device__ __forceinline__ void strip_fix(const KP& p, int gtid, int gthreads) {
    const float* HA = (const float*)(p.ws + WS_HA); const float* HB = (const float*)(p.ws + WS_HB); bf16* ACT = (bf16*)(p.ws + WS_R2);
    const float* cw = p.in[I_CFW]; const float* cb = p.in[I_CFB];
    for (int i = gtid; i < 32 * 24 * 128; i += gthreads) {
        const int c = i & 127, sp = i >> 7, pn = sp % 24, sr = sp / 24;
        if ((sr & 3) == 0) continue;
        const float* ha = HA + (size_t)sp * 512; const float* hb = HB + (size_t)sp * 512;
        float hg[4], hv[4];
        hg[0] = ha[c]; hg[1] = ha[256 + c]; hg[2] = hb[c]; hg[3] = hb[256 + c];
        hv[0] = ha[128 + c]; hv[1] = ha[384 + c]; hv[2] = hb[128 + c]; hv[3] = hb[384 + c];
        const int og = 128 * pn + c, ov = DFF + og;
        const float g0 = cw[og], g1 = cw[DUP + og], g2 = cw[2 * DUP + og], gb = cb[og], v0 = cw[ov], v1 = cw[DUP + ov], v2 = cw[2 * DUP + ov], vb = cb[ov];
#pragma unroll
        for (int t = 0; t < 2; ++t) { const float cg = gb + g0 * hg[t] + g1 * hg[t + 1] + g2 * hg[t + 2], cv = vb + v0 * hv[t] + v1 * hv[t + 1] + v2 * hv[t + 2];
            ACT[((size_t)sr * 1024 + t) * DFF + og] = (bf16)f2bf(gelu_tanh(cg) * cv); }
    }
}

__device__ __forceinline__ void final_norm(const KP& p, int gw, int NGW, int lane) {
    const float* SSQ2 = (const float*)(p.ws + WS_SSQ2); const float* gf = p.in[I_NFIN];
    f32x4 gv[4];
#pragma unroll
    for (int j = 0; j < 4; ++j) gv[j] = *((const f32x4*)gf + lane + 64 * j);
    for (int m = gw; m < M; m += NGW) {
        const float sv = (lane < 32) ? SSQ2[(size_t)m * 32 + lane] : 0.f;
        const float rstd = 1.0f / sqrtf(wave_sum(sv) * (1.f / DM) + EPS);
        f32x4* yr = (f32x4*)(p.out + OFF_Y + (size_t)m * DM) + lane;
#pragma unroll
        for (int j = 0; j < 4; ++j) { const f32x4 v = yr[64 * j]; yr[64 * j] = v * rstd * gv[j]; }
    }
}
#ifndef MK_ONE_LAUNCH
#define MK_ONE_LAUNCH 1
#endif
#ifndef PG8_SP2
#define PG8_SP2 true
#endif
#ifndef PG8_ALIGN
#define PG8_ALIGN true
#endif
#ifndef FUSE_FINAL
#define FUSE_FINAL 1
#endif
constexpr int N_PHASES = 11;
__global__ void __launch_bounds__(NWAVES * 64, 2) mk_fwd(KP p) {
    extern __shared__ __attribute__((aligned(16))) unsigned char lds_raw[];
    LAS unsigned char* lds = (LAS unsigned char*)lds_raw;
    const int tid = threadIdx.x, lane = tid & 63, wave = __builtin_amdgcn_readfirstlane(tid >> 6);
    const int G = gridDim.x, bx = blockIdx.x, vcu = (G % 8 == 0) ? (bx % 8) * (G / 8) + bx / 8 : bx;
    volatile LAS unsigned* MISC = (volatile LAS unsigned*)(lds + MISC_OFF);
    if (tid < 32) MISC[tid] = 0u;
    __syncthreads();
    unsigned* ctl = (unsigned*)(p.ws + WS_CTL);
    const int lo = p.ph_lo, hi = p.ph_hi;
    XcdBarrier bar; bar.bar = ctl + CW_BAR; bar.x = 0; bar.st = MISC + 8;
    if (hi - lo > 1) bar = xcd_barrier_post(ctl + CW_BAR, MISC + 8);
#ifndef PH_MASK
#define PH_MASK 0xfff
#endif
#define IN(k) (((PH_MASK >> (k)) & 1) && lo <= (k) && (k) < hi)
#ifndef REP_MASK
#define REP_MASK 0
#endif
#define PH(k) if (IN(k)) for (int rep_ = 0; rep_ <= ((REP_MASK >> (k)) & 1); ++rep_)
#define REPBAR() do { if (rep_) xcd_barrier(bar); } while (0)
#define SEAM(k) do { if (IN(k) && IN((k) + 1)) xcd_barrier(bar); } while (0)
    unsigned char* ws = p.ws;
    bf16* XN = (bf16*)(ws + WS_R0); bf16* MG = (bf16*)(ws + WS_R0); bf16* ZR = (bf16*)(ws + WS_R1); bf16* XG2 = (bf16*)(ws + WS_R1);
    bf16* GT = (bf16*)(ws + WS_R2); bf16* HP = (bf16*)(ws + WS_R3); bf16* ACT = (bf16*)(ws + WS_R2);
    bf16* Win_t = (bf16*)(ws + WS_WIN); bf16* Wcat_t = (bf16*)(ws + WS_WCAT); bf16* Wout_t = (bf16*)(ws + WS_WOUT); bf16* Wup_t = (bf16*)(ws + WS_WUP); bf16* Wdn_t = (bf16*)(ws + WS_WDN);
    float* SSQ = (float*)(ws + WS_SSQ); float* SSQ2 = (float*)(ws + WS_SSQ2);
    float* Y = p.out + OFF_Y;

    PH(0) { REPBAR(); p0_prologue(p, lds, vcu, G, wave, lane); }
    SEAM(0);
    PH(1) { REPBAR();
        pg8::Gemm g{XN, Win_t, DM, DM, DM}; pg8::StaticOrder S; S.init(MP, DIN, G, bx);
        EpiZ E{ZR, GT};
        const bool wfirst = (G > 64) && bx >= 64 && (bx & 1);
        for (int su = bx; su < 64; su += G) pg8::sub_gemm<1>(lds, g, STILE, su >> 2, (su >> 1) & 1, su & 1, E);
        if (wfirst) { p1_weights(p, lds, (bx - 64) * NWAVES + wave, (G - 64) * NWAVES, wave, lane); __syncthreads(); }
        pg8::gemm_phase<EpiZ, pg8::StaticOrder, PG8_ALIGN, PG8_SP2>(lds, g, S, E);
        if (G > 64) { if (bx >= 64 && !wfirst) p1_weights(p, lds, (bx - 64) * NWAVES + wave, (G - 64) * NWAVES, wave, lane); } else p1_weights(p, lds, bx * NWAVES + wave, G * NWAVES, wave, lane);
    }
    SEAM(1);
    PH(2) { REPBAR();
        state_copy(p, bx * NWAVES * 64 + tid, G * NWAVES * 64);
        for (int su = bx; su < 64; su += G) {
            const int g_ = su >> 4, q = su & 15; pg8::Gemm gw_{(const bf16*)(ws + WS_WBP) + 256 * g_, (const bf16*)(ws + WS_WPOOL) + (size_t)g_ * 65536, 256, DM, 256};
            EpiW EW{Wcat_t + 1024 + 256 * g_}; pg8::sub_gemm<1>(lds, gw_, q >> 2, 0, (q >> 1) & 1, q & 1, EW); }
        const bool pool_first = ((bx >> 3) & 1) != 0;
        if (pool_first) { for (int L = bx; L < 4 * 2 * STILE; L += G) { const int g_ = L / (2 * STILE), r = L % (2 * STILE); pool_half(p, lds, r >> 1, g_, r & 1, tid); } }
        for (int t = bx; t < NBATCH * 32; t += G) lru_task(p, lds, t >> 5, (t >> 1) & 15, t & 1, tid, lane, wave);
        for (int L = bx; L < 16 + 4; L += G) {
            if (L < 16) lru_unit<true>(p, lds, STILE, L, tid, lane, wave);
            else pool_unit(p, STILE, L - 16, tid);
        }
        if (!pool_first) { for (int L = bx; L < 4 * 2 * STILE; L += G) { const int g_ = L / (2 * STILE), r = L % (2 * STILE); pool_half(p, lds, r >> 1, g_, r & 1, tid); } }
    }
    if (IN(2) && IN(4)) xcd_barrier(bar);
    PH(4) { REPBAR();
        pg8::Gemm g{HP, Wcat_t, 2048, 2048, 2048}; pg8::StaticOrder S; S.init(MP, DM, G, bx);
        EpiBr E{GT, MG};
        pg8::gemm_phase<EpiBr, pg8::StaticOrder, PG8_ALIGN, PG8_SP2>(lds, g, S, E);
        for (int su = bx; su < 16; su += G) pg8::sub_gemm<1>(lds, g, STILE, su >> 2, (su >> 1) & 1, su & 1, E);
    }
    if (IN(4) && IN(6)) xcd_barrier(bar);
    PH(6) { REPBAR();
        pg8::Gemm g{MG, Wout_t, DM, DM, DM}; pg8::StaticOrder S; S.init(MP, DM, G, bx);
        EpiRes<false> E{p.in[I_XP], p.in[I_XS], Y, XG2, SSQ};
        pg8::gemm_phase<EpiRes<false>, pg8::StaticOrder, PG8_ALIGN, PG8_SP2>(lds, g, S, E);
        for (int su = bx; su < 16; su += G) pg8::sub_gemm<1>(lds, g, STILE, su >> 2, (su >> 1) & 1, su & 1, E);
    }
    SEAM(6);
    PH(7) { REPBAR();
        pg8::Gemm g{XG2, Wup_t, DM, DM, DM};
        { EpiUpS ES{ACT, p.in[I_CFW], p.in[I_CFB], p.in[I_STFFN], p.out + OFF_FCS, SSQ};
          for (int su = bx; su < 48; su += G) pg8::sub_gemm<2>(lds, g, STILE, su >> 1, su & 1, 0, ES); }
        for (int sidx = vcu; sidx < 768; sidx += G) {
            const int rg = sidx >> 8, v = sidx & 255, x = v >> 5, w = v & 31, pm0 = 4 * (4 * x + (w >> 3)), pn = 8 * rg + (w & 7);
            strip_pre(p, lds, pm0, pn, 4, tid, lane, wave);
            pg8::StripOrder S{pm0, pn, 4};
            EpiUp E{ACT, p.in[I_CFW], p.in[I_CFB], p.in[I_STFFN], p.out + OFF_FCP, p.out + OFF_FCS, lds, pm0, nullptr, (float*)(ws + WS_HA), (float*)(ws + WS_HB)};
            pg8::gemm_phase<EpiUp, pg8::StripOrder, true, PG8_SP2>(lds, g, S, E);
        }
    }
    SEAM(7);
    PH(8) { REPBAR(); strip_fix(p, bx * NWAVES * 64 + tid, G * NWAVES * 64); }
    SEAM(8);
    const bool fuse_final = (G == 256) && FUSE_FINAL;
    PH(9) { REPBAR();
        pg8::Gemm g{ACT, Wdn_t, DFF, DFF, DFF}; pg8::StaticOrder S; S.init(MP, DM, G, bx);
        if (fuse_final) {
            EpiFinal E{Y, XG2, p.in[I_NFIN], SSQ2, ctl + CW_PANEL, ctl + CW_BAR + XB_TMO, lds};
            pg8::gemm_phase<EpiFinal, pg8::StaticOrder, true  , PG8_SP2>(lds, g, S, E);
            for (int su = bx; su < 16; su += G) pg8::sub_gemm<1>(lds, g, STILE, su >> 2, (su >> 1) & 1, su & 1, E);
        } else {
            EpiRes<true> E{nullptr, nullptr, Y, XG2, SSQ2};
            pg8::gemm_phase<EpiRes<true>, pg8::StaticOrder, PG8_ALIGN, PG8_SP2>(lds, g, S, E);
            for (int su = bx; su < 16; su += G) pg8::sub_gemm<1>(lds, g, STILE, su >> 2, (su >> 1) & 1, su & 1, E);
        }
    }
#ifndef EXP
#define EXP 0
#endif
#if EXP != 0
    if (lo == 11) {
#if EXP == 1
        pg8::Gemm g{XG2, Wup_t, DM, DM, DM};
        for (int sidx = vcu; sidx < 768; sidx += G) {
            const int rg = sidx >> 8, v = sidx & 255, x = v >> 5, w = v & 31, pm0 = 4 * (4 * x + (w >> 3)), pn = 8 * rg + (w & 7);
            pg8::StripOrder S{pm0, pn, 4}; EpiNull<true> E;
            pg8::gemm_phase<EpiNull<true>, pg8::StripOrder, true, PG8_SP2>(lds, g, S, E);
        }
#elif EXP == 2
        pg8::Gemm g{XN, Win_t, DM, DM, DM}; pg8::StaticOrder S; S.init(MP, DIN, G, bx); EpiNull<false> E;
        pg8::gemm_phase<EpiNull<false>, pg8::StaticOrder, PG8_ALIGN, PG8_SP2>(lds, g, S, E);
#elif EXP == 3
        pg8::Gemm g{XG2, Wup_t, DM, DM, DM}; pg8::StaticOrder S; S.init(MP, DUP, G, bx); EpiNull<true> E;
        pg8::gemm_phase<EpiNull<true>, pg8::StaticOrder, true, PG8_SP2>(lds, g, S, E);
#elif EXP == 5
        pg8::Gemm g{XN, Win_t, DM, DM, DM}; pg8::StaticOrder S; S.init(MP, DIN, G, bx); EpiZScratch E{HP + (size_t)bx * 65536};
        pg8::gemm_phase<EpiZScratch, pg8::StaticOrder, PG8_ALIGN, PG8_SP2>(lds, g, S, E);
#elif EXP == 6
        pg8::Gemm g{XG2, Wup_t, DM, DM, DM};
        for (int sidx = vcu; sidx < 768; sidx += G) {
            const int rg = sidx >> 8, v = sidx & 255, x = v >> 5, w = v & 31, pm0 = 4 * (4 * x + (w >> 3)), pn = 8 * rg + (w & 7);
            strip_pre(p, lds, pm0, pn, 4, tid, lane, wave);
            pg8::StripOrder S{pm0, pn, 4};
            EpiUp E{ACT, p.in[I_CFW], p.in[I_CFB], p.in[I_STFFN], p.out + OFF_FCP, p.out + OFF_FCS, lds, pm0, HP + (size_t)bx * 256 * 128, nullptr, nullptr};
            pg8::gemm_phase<EpiUp, pg8::StripOrder, true, PG8_SP2>(lds, g, S, E);
        }
#elif EXP == 7
        pg8::Gemm g{XG2, Wup_t, DM, DM, DM};
        for (int sidx = vcu; sidx < 768; sidx += G) {
            const int rg = sidx >> 8, v = sidx & 255, x = v >> 5, w = v & 31, pm0 = 4 * (4 * x + (w >> 3)), pn = 8 * rg + (w & 7);
            strip_pre(p, lds, pm0, pn, 4, tid, lane, wave);
            pg8::StripOrder S{pm0, pn, 4}; EpiNull<true> E;
            pg8::gemm_phase<EpiNull<true>, pg8::StripOrder, true, PG8_SP2>(lds, g, S, E);
        }
#elif EXP == 8 || EXP == 9
        pg8::Gemm g{XG2, Wup_t, DM, DM, DM};
        for (int sidx = vcu; sidx < 768; sidx += G) {
            const int rg = sidx >> 8, v = sidx & 255, x = v >> 5, w = v & 31, pm0 = 4 * (4 * x + (w >> 3)), pn = 8 * rg + (w & 7);
            strip_pre<EXP - 7>(p, lds, pm0, pn, 4, tid, lane, wave);
            pg8::StripOrder S{pm0, pn, 4}; EpiNull<true> E;
            pg8::gemm_phase<EpiNull<true>, pg8::StripOrder, true, PG8_SP2>(lds, g, S, E);
        }
#elif EXP == 10
        pg8::Gemm g{ACT, Wdn_t, DFF, DFF, DFF}; EpiNull<false> E;
        for (int su = bx; su < 16; su += G) pg8::sub_gemm<1>(lds, g, STILE, su >> 2, (su >> 1) & 1, su & 1, E);
#elif EXP == 11
        pg8::Gemm g{XN, Win_t, DM, DM, DM}; EpiNull<false> E;
        for (int su = bx; su < 64; su += G) pg8::sub_gemm<1>(lds, g, STILE, su >> 2, (su >> 1) & 1, su & 1, E);
#elif EXP == 12
        for (int t = bx; t < NBATCH * 32; t += G) lru_task(p, lds, t >> 5, (t >> 1) & 15, t & 1, tid, lane, wave);
#elif EXP == 13
        for (int L = bx + 16; L < 16 + NTILE * 4; L += G) { const int r = L - 16; pool_unit(p, r >> 2, r & 3, tid); }
#elif EXP == 4
        pg8::Gemm g{ACT, Wdn_t, DFF, DFF, DFF}; pg8::StaticOrder S; S.init(MP, DM, G, bx); EpiNull<false> E;
        pg8::gemm_phase<EpiNull<false>, pg8::StaticOrder, true, PG8_SP2>(lds, g, S, E);
#endif
    }
#endif
    if (!fuse_final) { SEAM(9);
        PH(10) { REPBAR(); final_norm(p, vcu * NWAVES + wave, G * NWAVES, lane); } }
#undef IN
#undef SEAM
}

extern "C" void kernel_launch(void* const* d_in, const int* in_sizes, int n_in, void* d_out, int out_size, void* d_ws, size_t ws_size, hipStream_t stream) {
    static int grid = 0;
    if (grid == 0) {
        if (n_in != 26 || in_sizes[0] != MP * DM || (size_t)out_size != OUT_TOTAL || ws_size < WS_END) {
            fprintf(stderr, "kernel_launch: unexpected shapes: n_in %d in0 %d out %d ws %zu (need %zu)\n", n_in, n_in > 0 ? in_sizes[0] : -1, out_size, ws_size, (size_t)WS_END); grid = -1; return; }
        int dev = 0, cus = 0, per_cu = 0;
        if (hipGetDevice(&dev) != hipSuccess || hipDeviceGetAttribute(&cus, hipDeviceAttributeMultiprocessorCount, dev) != hipSuccess) { fprintf(stderr, "kernel_launch: device query failed\n"); grid = -1; return; }
        if (hipFuncSetAttribute((const void*)mk_fwd, hipFuncAttributeMaxDynamicSharedMemorySize, LDS_BYTES) != hipSuccess) { fprintf(stderr, "kernel_launch: hipFuncSetAttribute failed\n"); grid = -1; return; }
        if (hipOccupancyMaxActiveBlocksPerMultiprocessor(&per_cu, (const void*)mk_fwd, NWAVES * 64, LDS_BYTES) != hipSuccess || per_cu < 1) {
            fprintf(stderr, "kernel_launch: occupancy query reports %d blocks per CU\n", per_cu); (void)hipGetLastError(); per_cu = 1; }
        grid = cus;
        fprintf(stderr, "kernel_launch: grid %d (cus %d, occupancy %d/CU)\n", grid, cus, per_cu);
    }
    if (grid < 0) return;
    if (hipMemsetAsync((char*)d_ws + WS_CTL, 0, CTL_ZERO_BYTES, stream) != hipSuccess) { fprintf(stderr, "kernel_launch: memset failed\n"); return; }
    KP a{};
    for (int i = 0; i < 26; ++i) a.in[i] = (const float*)d_in[i];
    a.out = (float*)d_out; a.ws = (unsigned char*)d_ws;
#if MK_ONE_LAUNCH
    a.ph_lo = 0; a.ph_hi = N_PHASES;
    hipLaunchKernelGGL(mk_fwd, dim3(grid), dim3(NWAVES * 64), LDS_BYTES, stream, a);
#else
#ifndef PROBE_PHASE
#define PROBE_PHASE -1
#endif
    { const int phs[10] = {0, 1, 2, 4, 6, 7, 8, 9, 10, 11};
      for (int i = 0; i < 10; ++i) { if (phs[i] == 10 && FUSE_FINAL) continue; if (phs[i] == 11 && EXP == 0) continue; const int k = phs[i]; a.ph_lo = k; a.ph_hi = k + 1;
          for (int rep = 0; rep < (k == PROBE_PHASE ? 2 : 1); ++rep) hipLaunchKernelGGL(mk_fwd, dim3(grid), dim3(NWAVES * 64), LDS_BYTES, stream, a); } }
#endif
    const hipError_t le = hipPeekAtLastError();
    if (le != hipSuccess) fprintf(stderr, "kernel_launch: launch failed: %s\n", hipGetErrorName(le));
}
```

```cpp
#include <hip/hip_runtime.h>
#include <cstdio>
#include <cstdint>
#define MK_ONE_LAUNCH 1
namespace pg8 {
#define PG8_LAS __attribute__((address_space(3)))
typedef unsigned short bf16_t;
typedef short bf16x8 __attribute__((ext_vector_type(8)));
typedef float f32x4 __attribute__((ext_vector_type(4)));
typedef unsigned u32x4 __attribute__((ext_vector_type(4)));
typedef unsigned u32x2 __attribute__((ext_vector_type(2)));
constexpr int BM = 256, BK = 64, HALF = 128, HTB = HALF * BK * 2  , STAGE_BYTES = 8 * HTB, NXCD = 8, WGM = 8;

__host__ __device__ __forceinline__ int lds_byte(int r, int c) { const int st = (r >> 4) * 2 + (c >> 5), rr = r & 15, cc = c & 31, ob = rr * 64 + cc * 2; return st * 1024 + (ob ^ (((ob >> 9) & 1) << 5)); }
__host__ __device__ __forceinline__ void stage_rc(int b, int& R, int& C) { const int st = b / 1024, sb = b % 1024, swz = sb ^ (((sb >> 9) & 1) << 5); R = (st >> 1) * 16 + swz / 64; C = (st & 1) * 32 + (swz % 64) / 2; }
__host__ __device__ __forceinline__ int perm32(int rho) { const int n = rho >> 4, i = rho & 15; return 8 * (i >> 2) + 4 * n + (i & 3); }
__host__ __device__ __forceinline__ int amap_row(int R) { return 128 * (R >> 6) + 8 * (R & 15) + ((R >> 4) & 3); }

struct Unit { int pm, pn; };
struct Gemm { const bf16_t* A; const bf16_t* Bt; int K, lda, ldb; };

struct StaticOrder {
    int nM, nN, nwg, G, c;
    __host__ __device__ void init(int M, int N, int G_, int c_) { nM = M / BM; nN = N / BM; nwg = nM * nN; G = G_; c = c_; }
    __host__ __device__ bool next(int i, Unit& u) const {
        const long L = (long)i * G + c; if (L >= nwg) return false;
        int wgid = (int)L; { const int q = nwg / NXCD, r = nwg % NXCD, xcd = wgid % NXCD, off = wgid / NXCD; wgid = (xcd < r ? xcd * (q + 1) : r * (q + 1) + (xcd - r) * q) + off; }
        const int nig = WGM * nN, gid = wgid / nig, fm = gid * WGM, gsz = (nM - fm) < WGM ? (nM - fm) : WGM;
        u.pm = fm + ((wgid % nig) % gsz); u.pn = (wgid % nig) / gsz; return true;
    }
    __device__ __forceinline__ void a_ready(const Unit&) const {}
    __device__ __forceinline__ void done(const Unit&) const {}
};
struct StripOrder {
    int pm0, pn, cnt;
    __device__ __forceinline__ bool next(int i, Unit& u) const { if (i >= cnt) return false; u.pm = pm0 + i; u.pn = pn; return true; }
    __device__ __forceinline__ void a_ready(const Unit&) const {}
    __device__ __forceinline__ void done(const Unit&) const {}
};

__device__ __forceinline__ unsigned cvt_pk_bf16(float lo, float hi) { unsigned r; asm volatile("v_cvt_pk_bf16_f32 %0, %1, %2" : "=v"(r) : "v"(lo), "v"(hi)); return r; }

template <class Epi, class Sched, bool ALIGN_EPI = false, bool SP2 = false>
__device__ __forceinline__ void gemm_phase(PG8_LAS unsigned char* lds, const Gemm g, const Sched& S, const Epi& E) {
    const int tid = threadIdx.x, wid = __builtin_amdgcn_readfirstlane(tid >> 6), lane = tid & 63, wr = wid >> 2, wc = wid & 3, fr = lane & 15, fq = lane >> 4;
    const int K = g.K, nt = K / BK;
    unsigned voffA[2], voffB[2];
#pragma unroll
    for (int i = 0; i < 2; ++i) { int R, C; stage_rc(tid * 16 + i * 8192, R, C); const int Rb = Epi::PERM ? ((R & ~31) + perm32(R & 31)) : R; const int Ra = Epi::AMAP ? amap_row(R) : R;
        voffA[i] = (unsigned)(Ra * g.lda + C) * 2u; voffB[i] = (unsigned)(Rb * g.ldb + C) * 2u; }
    const size_t kstep = (size_t)(BK * 2);
    const size_t hstepA = Epi::AMAP ? (size_t)4 * g.lda * 2 : (size_t)HALF * g.lda * 2;
    const size_t hstepB = (size_t)HALF * g.ldb * 2;
    const size_t tstepA = (size_t)BM * g.lda * 2, tstepB = (size_t)BM * g.ldb * 2;
    const unsigned ldsw = (unsigned)wid * 1024u;
    const int aoff = lds_byte(wr * 64 + fr, fq * 8), boff = lds_byte(wc * 32 + fr, fq * 8);
#define PG8_SA(b, h) (((b) * 2 + (h)) * HTB)
#define PG8_SB(b, h) ((4 + (b) * 2 + (h)) * HTB)
#define PG8_STAGE(bufoff, gbase, voff) do { _Pragma("unroll") for (int _i = 0; _i < 2; ++_i) \
        __builtin_amdgcn_global_load_lds((const unsigned*)((const char*)(gbase) + (voff)[_i]), (PG8_LAS unsigned*)(lds + (bufoff) + ldsw + _i * 8192), 16, 0, 0); } while (0)
#define PG8_LDA(dst, b, h) do { _Pragma("unroll") for (int m = 0; m < 4; ++m) _Pragma("unroll") for (int k = 0; k < 2; ++k) dst[m][k] = *(const PG8_LAS bf16x8*)(lds + PG8_SA(b, h) + aoff + m * 2048 + k * 1024); } while (0)
#define PG8_LDB(dst, b, h) do { _Pragma("unroll") for (int n = 0; n < 2; ++n) _Pragma("unroll") for (int k = 0; k < 2; ++k) dst[n][k] = *(const PG8_LAS bf16x8*)(lds + PG8_SB(b, h) + boff + n * 2048 + k * 1024); } while (0)
#define PG8_MMA(ai, bj, At, Bt) do { __builtin_amdgcn_s_setprio(1); _Pragma("unroll") for (int m = 0; m < 4; ++m) _Pragma("unroll") for (int n = 0; n < 2; ++n) _Pragma("unroll") for (int k = 0; k < 2; ++k) \
        acc[ai][bj][m][n] = __builtin_amdgcn_mfma_f32_16x16x32_bf16(Bt[n][k], At[m][k], acc[ai][bj][m][n], 0, 0, 0); __builtin_amdgcn_s_setprio(0); } while (0)
#define PG8_WAIT_V(n) asm volatile("s_waitcnt vmcnt(" #n ")" ::: "memory")
#define PG8_WAIT_L(n) asm volatile("s_waitcnt lgkmcnt(" #n ")" ::: "memory")
#define PG8_BAR __builtin_amdgcn_s_barrier()
#define PG8_SCHED __builtin_amdgcn_sched_barrier(0)
    Unit cur, nxt; int ui = 0;
    if (!S.next(0, cur)) return;
    f32x4 acc[2][2][4][2];
#pragma unroll
    for (int a = 0; a < 2; ++a)
#pragma unroll
        for (int b = 0; b < 2; ++b)
#pragma unroll
            for (int m = 0; m < 4; ++m)
#pragma unroll
                for (int n = 0; n < 2; ++n) acc[a][b][m][n] = (f32x4){0.f, 0.f, 0.f, 0.f};
    bf16x8 At[4][2], B0[2][2], B1[2][2];
    const char* cA = (const char*)g.A + (size_t)cur.pm * tstepA; const char* cB = (const char*)g.Bt + (size_t)cur.pn * tstepB;
    S.a_ready(cur);
    if constexpr (SP2) {
        PG8_STAGE(PG8_SB(0, 0), cB, voffB); PG8_STAGE(PG8_SB(0, 1), cB + hstepB, voffB); PG8_STAGE(PG8_SA(0, 0), cA, voffA); PG8_STAGE(PG8_SA(0, 1), cA + hstepA, voffA);
        if (wr == 1) PG8_BAR;
        PG8_WAIT_V(2); PG8_BAR;
        PG8_STAGE(PG8_SB(1, 0), cB + kstep, voffB); PG8_STAGE(PG8_SA(1, 0), cA + kstep, voffA); PG8_STAGE(PG8_SB(1, 1), cB + hstepB + kstep, voffB);
        PG8_WAIT_V(6); PG8_BAR;
    } else {
        PG8_STAGE(PG8_SB(0, 0), cB, voffB); PG8_STAGE(PG8_SA(0, 0), cA, voffA); PG8_STAGE(PG8_SB(0, 1), cB + hstepB, voffB); PG8_STAGE(PG8_SA(0, 1), cA + hstepA, voffA);
        if (wr == 1) PG8_BAR;
        PG8_WAIT_V(4); PG8_BAR;
        PG8_STAGE(PG8_SB(1, 0), cB + kstep, voffB); PG8_STAGE(PG8_SA(1, 0), cA + kstep, voffA); PG8_STAGE(PG8_SB(1, 1), cB + hstepB + kstep, voffB);
        PG8_WAIT_V(6); PG8_BAR;
    }
    for (;;) {
        const bool has_next = S.next(ui + 1, nxt);
        const char* nA = has_next ? (const char*)g.A + (size_t)nxt.pm * tstepA : cA; const char* nB = has_next ? (const char*)g.Bt + (size_t)nxt.pn * tstepB : cB;
        for (int t = 0; t < nt; t += 2) {
            const bool last = (t == nt - 2);
            const char* a1 = cA + (size_t)(t + 1) * kstep;
            const char* a2 = last ? nA : cA + (size_t)(t + 2) * kstep; const char* b2 = last ? nB : cB + (size_t)(t + 2) * kstep;
            const char* a3 = a2 + kstep; const char* b3 = b2 + kstep;
            if (last && has_next) S.a_ready(nxt);
            if constexpr (Epi::MID) { if (t == (nt >> 1)) {
                if (wr == 0) PG8_BAR; E.template mid<2, 2>(acc, cur, 0, 0, wr, wc, fr, fq); if (wr == 1) PG8_BAR; } }
            if constexpr (SP2) {
            PG8_LDB(B0, 0, 0); PG8_LDB(B1, 0, 1); PG8_SCHED; PG8_LDA(At, 0, 0); PG8_STAGE(PG8_SA(1, 1), a1 + hstepA, voffA);
            PG8_WAIT_V(8); PG8_WAIT_L(0); PG8_BAR; PG8_MMA(0, 0, At, B0); PG8_MMA(0, 1, At, B1); PG8_BAR; PG8_SCHED;
            PG8_LDA(At, 0, 1); PG8_STAGE(PG8_SB(0, 0), b2, voffB); PG8_STAGE(PG8_SB(0, 1), b2 + hstepB, voffB); PG8_STAGE(PG8_SA(0, 0), a2, voffA);
            PG8_WAIT_V(8); PG8_WAIT_L(0); PG8_BAR; PG8_MMA(1, 0, At, B0); PG8_MMA(1, 1, At, B1); PG8_BAR; PG8_SCHED;
            PG8_LDB(B0, 1, 0); PG8_LDB(B1, 1, 1); PG8_SCHED; PG8_LDA(At, 1, 0); PG8_STAGE(PG8_SA(0, 1), a2 + hstepA, voffA);
            PG8_WAIT_V(8); PG8_WAIT_L(0); PG8_BAR; PG8_MMA(0, 0, At, B0); PG8_MMA(0, 1, At, B1); PG8_BAR; PG8_SCHED;
            PG8_LDA(At, 1, 1); PG8_STAGE(PG8_SB(1, 0), b3, voffB); PG8_STAGE(PG8_SB(1, 1), b3 + hstepB, voffB); PG8_STAGE(PG8_SA(1, 0), a3, voffA);
            PG8_WAIT_V(8); PG8_WAIT_L(0); PG8_BAR; PG8_MMA(1, 0, At, B0); PG8_MMA(1, 1, At, B1); PG8_BAR; PG8_SCHED;
            } else {
            PG8_LDB(B0, 0, 0); PG8_SCHED; PG8_LDA(At, 0, 0); PG8_STAGE(PG8_SA(1, 1), a1 + hstepA, voffA);
            PG8_WAIT_L(8); PG8_BAR; PG8_WAIT_L(0); PG8_MMA(0, 0, At, B0); PG8_BAR; PG8_SCHED;
            PG8_LDB(B1, 0, 1); PG8_STAGE(PG8_SB(0, 0), b2, voffB);
            PG8_BAR; PG8_WAIT_L(0); PG8_MMA(0, 1, At, B1); PG8_BAR;
            PG8_LDA(At, 0, 1); PG8_STAGE(PG8_SA(0, 0), a2, voffA);
            PG8_BAR; PG8_WAIT_L(0); PG8_MMA(1, 0, At, B0); PG8_BAR; PG8_SCHED;
            PG8_STAGE(PG8_SB(0, 1), b2 + hstepB, voffB);
            PG8_WAIT_V(6); PG8_BAR; PG8_MMA(1, 1, At, B1); PG8_BAR;
            PG8_LDB(B0, 1, 0); PG8_SCHED; PG8_LDA(At, 1, 0); PG8_STAGE(PG8_SA(0, 1), a2 + hstepA, voffA);
            PG8_WAIT_L(8); PG8_BAR; PG8_WAIT_L(0); PG8_MMA(0, 0, At, B0); PG8_BAR; PG8_SCHED;
            PG8_LDB(B1, 1, 1); PG8_STAGE(PG8_SB(1, 0), b3, voffB);
            PG8_BAR; PG8_WAIT_L(0); PG8_MMA(0, 1, At, B1); PG8_BAR;
            PG8_LDA(At, 1, 1); PG8_STAGE(PG8_SA(1, 0), a3, voffA);
            PG8_BAR; PG8_WAIT_L(0); PG8_MMA(1, 0, At, B0); PG8_BAR; PG8_SCHED;
            PG8_STAGE(PG8_SB(1, 1), b3 + hstepB, voffB);
            PG8_WAIT_V(6); PG8_BAR; PG8_MMA(1, 1, At, B1); PG8_BAR;
            }
        }
        if constexpr (ALIGN_EPI) { if (wr == 0) PG8_BAR; }
        E.template run<2, 2>(acc, cur, 0, 0, wr, wc, fr, fq); S.done(cur);
        if (!has_next) break;
#pragma unroll
        for (int a = 0; a < 2; ++a)
#pragma unroll
            for (int b = 0; b < 2; ++b)
#pragma unroll
                for (int m = 0; m < 4; ++m)
#pragma unroll
                    for (int n = 0; n < 2; ++n) acc[a][b][m][n] = (f32x4){0.f, 0.f, 0.f, 0.f};
        cur = nxt; cA = nA; cB = nB; ++ui;
        if constexpr (ALIGN_EPI) { if (wr == 1) PG8_BAR; }
    }
    PG8_WAIT_V(0);
    if constexpr (!ALIGN_EPI) { if (wr == 0) PG8_BAR; }
    PG8_BAR;
#undef PG8_SA
#undef PG8_SB
#undef PG8_STAGE
#undef PG8_LDA
#undef PG8_LDB
#undef PG8_MMA
#undef PG8_WAIT_V
#undef PG8_WAIT_L
#undef PG8_BAR
#undef PG8_SCHED
}

template <int NB, class Epi>
__device__ __forceinline__ void sub_gemm(PG8_LAS unsigned char* lds, const Gemm g, int pm, int pn, int ai0, int bj0, const Epi& E) {
    int tid_ = threadIdx.x; asm volatile("" : "+v"(tid_));
    const int tid = tid_, wid = __builtin_amdgcn_readfirstlane(tid >> 6), lane = tid & 63, wr = wid >> 2, wc = wid & 3, fr = lane & 15, fq = lane >> 4;
    const int nt = g.K / BK;
    unsigned voffA[2], voffB[2];
#pragma unroll
    for (int i = 0; i < 2; ++i) { int R, C; stage_rc(tid * 16 + i * 8192, R, C); const int Rb = Epi::PERM ? ((R & ~31) + perm32(R & 31)) : R;
        voffA[i] = (unsigned)(R * g.lda + C) * 2u; voffB[i] = (unsigned)(Rb * g.ldb + C) * 2u; }
    const size_t kstep = (size_t)(BK * 2), hstepB = (size_t)HALF * g.ldb * 2;
    const unsigned ldsw = (unsigned)wid * 1024u;
    const int aoff = lds_byte(wr * 64 + fr, fq * 8), boff = lds_byte(wc * 32 + fr, fq * 8);
    const char* cA = (const char*)g.A + ((size_t)pm * BM + (size_t)ai0 * HALF) * g.lda * 2; const char* cB = (const char*)g.Bt + ((size_t)pn * BM + (size_t)bj0 * HALF) * g.ldb * 2;
    constexpr int NBUF = (NB == 1) ? 4 : 2, LPT = 2 * (1 + NB);
#define SG_BUF(b, j) ((b) * (1 + NB) * HTB + (j) * HTB)
#define SG_STAGE(bufoff, gbase, voff) do { _Pragma("unroll") for (int _i = 0; _i < 2; ++_i) \
        __builtin_amdgcn_global_load_lds((const unsigned*)((const char*)(gbase) + (voff)[_i]), (PG8_LAS unsigned*)(lds + (bufoff) + ldsw + _i * 8192), 16, 0, 0); } while (0)
#define SG_STAGE_TILE(t_) do { const int b_ = (t_) % NBUF; SG_STAGE(SG_BUF(b_, 0), cA + (size_t)(t_) * kstep, voffA); \
        _Pragma("unroll") for (int j = 0; j < NB; ++j) SG_STAGE(SG_BUF(b_, 1 + j), cB + j * hstepB + (size_t)(t_) * kstep, voffB); } while (0)
    f32x4 acc[1][NB][4][2];
#pragma unroll
    for (int b = 0; b < NB; ++b)
#pragma unroll
        for (int m = 0; m < 4; ++m)
#pragma unroll
            for (int n = 0; n < 2; ++n) acc[0][b][m][n] = (f32x4){0.f, 0.f, 0.f, 0.f};
#pragma unroll
    for (int t = 0; t < NBUF - 1; ++t) SG_STAGE_TILE(t);
#pragma unroll 1
    for (int t = 0; t < nt; ++t) {
        const int cur = t % NBUF;
        if constexpr (Epi::MID) { if (t == (nt >> 1)) E.template mid<1, NB>(acc, Unit{pm, pn}, ai0 * HALF, bj0 * HALF, wr, wc, fr, fq); }
        if (t + NBUF - 1 < nt) { SG_STAGE_TILE(t + NBUF - 1); asm volatile("s_waitcnt vmcnt(%0)" :: "n"((NBUF - 1) * LPT) : "memory"); }
        else if (NBUF >= 3 && t + 2 < nt) asm volatile("s_waitcnt vmcnt(%0)" :: "n"(NBUF >= 3 ? 2 * LPT : 0) : "memory");
        else if (NBUF >= 2 && t + 1 < nt) asm volatile("s_waitcnt vmcnt(%0)" :: "n"(LPT) : "memory");
        else asm volatile("s_waitcnt vmcnt(0)" ::: "memory");
        __builtin_amdgcn_s_barrier();
        bf16x8 At[4][2], Bf[NB][2][2];
#pragma unroll
        for (int m = 0; m < 4; ++m)
#pragma unroll
            for (int k = 0; k < 2; ++k) At[m][k] = *(const PG8_LAS bf16x8*)(lds + SG_BUF(cur, 0) + aoff + m * 2048 + k * 1024);
#pragma unroll
        for (int j = 0; j < NB; ++j)
#pragma unroll
            for (int n = 0; n < 2; ++n)
#pragma unroll
                for (int k = 0; k < 2; ++k) Bf[j][n][k] = *(const PG8_LAS bf16x8*)(lds + SG_BUF(cur, 1 + j) + boff + n * 2048 + k * 1024);
        asm volatile("s_waitcnt lgkmcnt(0)" ::: "memory"); __builtin_amdgcn_sched_barrier(0);
#pragma unroll
        for (int j = 0; j < NB; ++j)
#pragma unroll
            for (int m = 0; m < 4; ++m)
#pragma unroll
                for (int n = 0; n < 2; ++n)
#pragma unroll
                    for (int k = 0; k < 2; ++k) acc[0][j][m][n] = __builtin_amdgcn_mfma_f32_16x16x32_bf16(Bf[j][n][k], At[m][k], acc[0][j][m][n], 0, 0, 0);
        __builtin_amdgcn_s_barrier();
    }
    E.template run<1, NB>(acc, Unit{pm, pn}, ai0 * HALF, bj0 * HALF, wr, wc, fr, fq);
#undef SG_BUF
#undef SG_STAGE
#undef SG_STAGE_TILE
}
}
constexpr int NWAVES = 8;
constexpr int DM = 1024, NBATCH = 8, SEQ = 4096, SBATCH = 16, SSEQ = 16, PAST = 2048;
constexpr int MP = NBATCH * SEQ, MS = SBATCH * SSEQ, M = MP + MS, NTILE = M / 256, STILE = MP / 256;
constexpr int DIN = 4096, DFF = 3072, DUP = 6144;
constexpr float EPS = 1e-6f;
constexpr size_t OFF_Y = 0, OFF_HP = (size_t)M * DM, OFF_LCP = OFF_HP + NBATCH * DM, OFF_PLP = OFF_LCP + NBATCH * 3 * DM, OFF_FCP = OFF_PLP + NBATCH * 15 * DM,
                 OFF_HS = OFF_FCP + NBATCH * 2 * DUP, OFF_LCS = OFF_HS + SBATCH * DM, OFF_PLS = OFF_LCS + SBATCH * 3 * DM, OFF_FCS = OFF_PLS + SBATCH * 15 * DM,
                 OUT_TOTAL = OFF_FCS + SBATCH * 2 * DUP;
constexpr size_t MiB = 1u << 20;
constexpr size_t WS_CTL = 0, CTL_ZERO_BYTES = 64 * 1024;
constexpr size_t WS_WIN = 1 * MiB, WS_WCAT = 9 * MiB, WS_WOUT = 13 * MiB, WS_WUP = 15 * MiB, WS_WDN = 27 * MiB, WS_WG = 33 * MiB;
constexpr size_t WS_SSQ = 33 * MiB + 512 * 1024, WS_SSQ2 = 37 * MiB + 768 * 1024, WS_SUMM = WS_SSQ;
static_assert(WS_SSQ + (size_t)M * 128 <= WS_SSQ2 && WS_SSQ2 + (size_t)M * 128 <= 42 * MiB, "ssq map");
constexpr size_t WS_R0 = 42 * MiB, WS_R1 = 107 * MiB, WS_R2 = 236 * MiB, WS_R3 = 365 * MiB, WS_WBP = 494 * MiB, WS_WPOOL = 496 * MiB, WS_HA = 497 * MiB, WS_HB = 499 * MiB, WS_END = 501 * MiB;
static_assert((size_t)M * DM * 2 <= WS_R1 - WS_R0 && (size_t)M * 2048 * 2 <= WS_R2 - WS_R1 && (size_t)M * 2048 * 2 <= WS_R3 - WS_R2 && (size_t)M * 2048 * 2 <= WS_END - WS_R3 && (size_t)M * DFF * 2 <= WS_END - WS_R2, "ws map");
constexpr int CW_BAR = 1024, CW_PANEL = 8192;
constexpr int RING_BYTES = 131072;
constexpr int MISC_OFF = RING_BYTES, RS_OFF = RING_BYTES + 512, EDGE_START_OFF = RS_OFF + 4096, EDGE_MID_OFF = EDGE_START_OFF + 2048, EDGE_PREV_OFF = EDGE_MID_OFF + 2048;
constexpr int CWL_OFF = EDGE_PREV_OFF + 4096;
constexpr int LDS_BYTES = 155648;
static_assert(CWL_OFF + 4096 <= LDS_BYTES, "LDS map");

#define GAS __attribute__((address_space(1)))
#define LAS __attribute__((address_space(3)))
typedef unsigned short bf16;
typedef unsigned v4u __attribute__((ext_vector_type(4)));
typedef unsigned v2u __attribute__((ext_vector_type(2)));
typedef float f32x4 __attribute__((ext_vector_type(4)));
typedef short bf16x8 __attribute__((ext_vector_type(8)));
#define LDS_WAIT() asm volatile("s_waitcnt lgkmcnt(0)" ::: "memory")
#define VM_WAIT() asm volatile("s_waitcnt vmcnt(0)" ::: "memory")
__device__ __forceinline__ unsigned f2bf(float f) { unsigned u = __builtin_bit_cast(unsigned, f); return (u + 0x7fffu + ((u >> 16) & 1u)) >> 16; }
__device__ __forceinline__ unsigned pk2(float lo, float hi) { return f2bf(lo) | (f2bf(hi) << 16); }
__device__ __forceinline__ float bflo(unsigned w) { return __builtin_bit_cast(float, w << 16); }
__device__ __forceinline__ float bfhi(unsigned w) { return __builtin_bit_cast(float, w & 0xffff0000u); }
__device__ __forceinline__ float sigmoidf_fast(float x) { return __builtin_amdgcn_rcpf(1.0f + __builtin_amdgcn_exp2f(-1.4426950408889634f * x)); }
__device__ __forceinline__ float gelu_tanh(float g) { const float z = g * (1.0f + 0.044715f * g * g); return g * __builtin_amdgcn_rcpf(1.0f + __builtin_amdgcn_exp2f(-2.302208198f * z)); }
__device__ __forceinline__ float dpp_shr1(float v) { return __builtin_bit_cast(float, __builtin_amdgcn_update_dpp(__builtin_bit_cast(int, v), __builtin_bit_cast(int, v), 0x111  , 0xf, 0xf, false)); }
__device__ __forceinline__ float wave_sum(float v) {
#pragma unroll
    for (int o = 1; o < 64; o <<= 1) v += __shfl_xor(v, o);
    return v;
}

#define XB_TMO      128
#define XB_XCNT(j)  (256  + 64 * (j))
#define XB_XSUB(j)  (1280 + 64 * (j))
#define XB_XGEN(j)  (2304 + 64 * (j))
#define XB_TOP      3328
#define XB_TOPGEN   3392
#define XCD_BAR_WORDS 3456
#define XB_SPIN_CAP (1u << 20)
static_assert((CW_BAR + XCD_BAR_WORDS) <= CW_PANEL && (CW_PANEL + 32 * 132) * 4 <= (int)CTL_ZERO_BYTES, "control words inside the memset region");
__device__ __forceinline__ unsigned xb_ld(unsigned* p)              { return __hip_atomic_load(p, __ATOMIC_RELAXED, __HIP_MEMORY_SCOPE_AGENT); }
__device__ __forceinline__ unsigned xb_add(unsigned* p, unsigned v) { return __hip_atomic_fetch_add(p, v, __ATOMIC_RELAXED, __HIP_MEMORY_SCOPE_AGENT); }
__device__ __forceinline__ unsigned xb_xcc_id() { return (unsigned)__builtin_amdgcn_s_getreg((3 << 11) | 20) & 0xFu; }
#define XB_SPIN(cond, bar) do { unsigned _sp = 0; while (cond) { __builtin_amdgcn_s_sleep(1); \
    if ((++_sp & 255u) == 0u) { if (xb_ld(&(bar)[XB_TMO])) break; if (_sp > XB_SPIN_CAP) { atomicAdd(&(bar)[XB_TMO], 1u); break; } } } } while (0)
struct XcdBarrier { unsigned* bar; unsigned x; volatile LAS unsigned* st; };
__device__ __forceinline__ XcdBarrier xcd_barrier_post(unsigned* bar, volatile LAS unsigned* st) {
    XcdBarrier b; b.bar = bar; b.x = xb_xcc_id(); b.st = st;
    if (threadIdx.x == 0) (void)xb_add(&bar[XB_XCNT(b.x)], 1u);
    return b;
}
__device__ __forceinline__ void xcd_barrier_complete(unsigned* bar, unsigned x, unsigned& nloc, unsigned& nx) {
    const unsigned G = gridDim.x * gridDim.y * gridDim.z;
    unsigned sum, cnt, mine, sp = 0u;
    for (;;) {
        sum = 0u; cnt = 0u; mine = 0u;
#pragma unroll
        for (unsigned j = 0; j < 16; ++j) { const unsigned c = xb_ld(&bar[XB_XCNT(j)]); sum += c; cnt += (c > 0u) ? 1u : 0u; mine = (j == x) ? c : mine; }
        if (sum == G) break;
        __builtin_amdgcn_s_sleep(1);
        if ((++sp & 255u) == 0u) { if (xb_ld(&bar[XB_TMO])) break; if (sp > XB_SPIN_CAP) { atomicAdd(&bar[XB_TMO], 1u); break; } }
    }
    nloc = mine > 0u ? mine : 1u; nx = cnt > 0u ? cnt : 1u;
}
__device__ __forceinline__ void xcd_barrier(const XcdBarrier& b) {
    asm volatile("s_waitcnt vmcnt(0)" ::: "memory");
    __syncthreads();
    if (threadIdx.x == 0) {
        unsigned* bar = b.bar;
        __builtin_amdgcn_s_waitcnt(0);
        unsigned nloc = b.st[0], nx = b.st[1];
        if (nloc == 0u) { xcd_barrier_complete(bar, b.x, nloc, nx); b.st[0] = nloc; b.st[1] = nx; }
        const unsigned old = xb_add(&bar[XB_XSUB(b.x)], 1u);
        const unsigned gen = old / nloc;
        if (old + 1u == (gen + 1u) * nloc) {
            __builtin_amdgcn_fence(__ATOMIC_RELEASE, "agent");
            asm volatile("s_waitcnt vmcnt(0)" ::: "memory");
            const unsigned og = xb_add(&bar[XB_TOP], 1u);
            const unsigned tg = og / nx;
            if (og + 1u == (tg + 1u) * nx) xb_add(&bar[XB_TOPGEN], 1u);
            else XB_SPIN(xb_ld(&bar[XB_TOPGEN]) == tg, bar);
            __builtin_amdgcn_fence(__ATOMIC_ACQUIRE, "agent");
            xb_add(&bar[XB_XGEN(b.x)], 1u);
            asm volatile("s_waitcnt vmcnt(0)" ::: "memory");
        } else {
            XB_SPIN(xb_ld(&bar[XB_XGEN(b.x)]) == gen, bar);
            __builtin_amdgcn_fence(__ATOMIC_ACQUIRE, "agent");
            asm volatile("s_waitcnt vmcnt(0)" ::: "memory");
        }
    }
    __syncthreads();
}

struct KP {
    const float* in[26];
    float* out; unsigned char* ws;
    int ph_lo, ph_hi;
};
enum { I_XP = 0, I_XS, I_STH, I_STLC, I_STPOOL, I_STFFN, I_NMIX, I_WIN, I_CLW, I_CLB, I_WRA, I_BRA, I_WIX, I_BIX, I_LAM, I_WPOOL, I_PSCALE, I_WBRL, I_WBRP, I_WOUT, I_NFFN, I_WUP, I_CFW, I_CFB, I_WDN, I_NFIN };

using pg8::Unit;
struct EpiZ {
    static constexpr bool PERM = true, AMAP = false, MID = false;
    bf16* ZR; bf16* G;
    template <int NA, int NB> __device__ __forceinline__ void run(f32x4 (&acc)[NA][NB][4][2], const Unit& u, int rowoff, int coloff, int wr, int wc, int fr, int fq) const {
        const int row0 = u.pm * 256 + rowoff + wr * 64 + fr;
        if (u.pn < 8) {
            const int col0 = u.pn * 256 + coloff + wc * 32 + 8 * fq;
#pragma unroll
            for (int ai = 0; ai < NA; ++ai)
#pragma unroll
                for (int m = 0; m < 4; ++m) { bf16* rowp = ZR + (size_t)(row0 + ai * 128 + m * 16) * 2048 + col0;
#pragma unroll
                    for (int bj = 0; bj < NB; ++bj) { const f32x4 v0 = acc[ai][bj][m][0], v1 = acc[ai][bj][m][1];
                        v4u w; w.x = pg8::cvt_pk_bf16(v0[0], v0[1]); w.y = pg8::cvt_pk_bf16(v0[2], v0[3]); w.z = pg8::cvt_pk_bf16(v1[0], v1[1]); w.w = pg8::cvt_pk_bf16(v1[2], v1[3]);
                        *(v4u*)(rowp + bj * 128) = w; } }
        } else if constexpr (NB == 2) {
            const int col0 = (u.pn - 8) * 128 + wc * 32 + 8 * fq;
#pragma unroll
            for (int ai = 0; ai < NA; ++ai)
#pragma unroll
                for (int m = 0; m < 4; ++m) { bf16* rowp = G + (size_t)(row0 + ai * 128 + m * 16) * 2048 + col0; f32x4 r[2], b[2];
#pragma unroll
                    for (int n = 0; n < 2; ++n)
#pragma unroll
                        for (int e = 0; e < 4; ++e) { const float ea = __builtin_amdgcn_exp2f(-1.4426950408889634f * acc[ai][0][m][n][e]), eb = __builtin_amdgcn_exp2f(-1.4426950408889634f * acc[ai][1][m][n][e]);
                            b[n][e] = __builtin_amdgcn_rcpf(1.0f + eb); r[n][e] = fminf((1.0f + eb) * __builtin_amdgcn_rcpf(1.0f + ea), 3.0e38f); }
                    v4u w; w.x = pg8::cvt_pk_bf16(r[0][0], r[0][1]); w.y = pg8::cvt_pk_bf16(r[0][2], r[0][3]); w.z = pg8::cvt_pk_bf16(r[1][0], r[1][1]); w.w = pg8::cvt_pk_bf16(r[1][2], r[1][3]);
                    *(v4u*)rowp = w;
                    w.x = pg8::cvt_pk_bf16(b[0][0], b[0][1]); w.y = pg8::cvt_pk_bf16(b[0][2], b[0][3]); w.z = pg8::cvt_pk_bf16(b[1][0], b[1][1]); w.w = pg8::cvt_pk_bf16(b[1][2], b[1][3]);
                    *(v4u*)(rowp + 1024) = w; }
        }
    }
};
struct EpiBr {
    static constexpr bool PERM = true, AMAP = false, MID = true;
    const bf16* G; bf16* MG;
    template <int NA, int NB> __device__ __forceinline__ void mid(f32x4 (&acc)[NA][NB][4][2], const Unit& u, int rowoff, int coloff, int wr, int wc, int fr, int fq) const {
        int pm_ = u.pm, pn_ = u.pn; asm volatile("" : "+s"(pm_), "+s"(pn_));
        const int row0 = pm_ * 256 + rowoff + wr * 64 + fr, col0 = pn_ * 256 + coloff + wc * 32 + 8 * fq;
#pragma unroll
        for (int ai = 0; ai < NA; ++ai)
#pragma unroll
            for (int m = 0; m < 4; ++m) { const size_t row = (size_t)(row0 + ai * 128 + m * 16);
#pragma unroll
                for (int bj = 0; bj < NB; ++bj) { const int col = col0 + bj * 128;
                    const v4u ga = *(const v4u*)(G + row * 2048 + col);
                    acc[ai][bj][m][0] *= (f32x4){bflo(ga.x), bfhi(ga.x), bflo(ga.y), bfhi(ga.y)}; acc[ai][bj][m][1] *= (f32x4){bflo(ga.z), bfhi(ga.z), bflo(ga.w), bfhi(ga.w)}; } }
    }
    template <int NA, int NB> __device__ __forceinline__ void run(f32x4 (&acc)[NA][NB][4][2], const Unit& u, int rowoff, int coloff, int wr, int wc, int fr, int fq) const {
        const int row0 = u.pm * 256 + rowoff + wr * 64 + fr, col0 = u.pn * 256 + coloff + wc * 32 + 8 * fq;
#pragma unroll
        for (int ai = 0; ai < NA; ++ai)
#pragma unroll
            for (int m = 0; m < 4; ++m) { const size_t row = (size_t)(row0 + ai * 128 + m * 16);
#pragma unroll
                for (int bj = 0; bj < NB; ++bj) { const int col = col0 + bj * 128;
                    const v4u gw = *(const v4u*)(G + row * 2048 + 1024 + col);
                    const f32x4 g0 = {bflo(gw.x), bfhi(gw.x), bflo(gw.y), bfhi(gw.y)}, g1 = {bflo(gw.z), bfhi(gw.z), bflo(gw.w), bfhi(gw.w)};
                    const f32x4 v0 = acc[ai][bj][m][0] * g0, v1 = acc[ai][bj][m][1] * g1;
                    v4u w; w.x = pg8::cvt_pk_bf16(v0[0], v0[1]); w.y = pg8::cvt_pk_bf16(v0[2], v0[3]); w.z = pg8::cvt_pk_bf16(v1[0], v1[1]); w.w = pg8::cvt_pk_bf16(v1[2], v1[3]);
                    *(v4u*)(MG + row * 1024 + col) = w; } }
    }
};
template <bool DOWN> struct EpiRes {
    static constexpr bool PERM = true, AMAP = false, MID = false;
    const float* xp; const float* xs; float* Y; bf16* X1B; float* SSQ; LAS unsigned char* lx;
    template <int NA, int NB> __device__ __forceinline__ void run(f32x4 (&acc)[NA][NB][4][2], const Unit& u, int rowoff, int coloff, int wr, int wc, int fr, int fq) const {
        int pm_ = u.pm, pn_ = u.pn, fr_ = fr, fq_ = fq, wr_ = wr, wc_ = wc, tid = threadIdx.x;
        asm volatile("" : "+s"(pm_), "+s"(pn_), "+v"(fr_), "+v"(fq_), "+s"(wr_), "+s"(wc_), "+v"(tid));
        LAS float* P = (LAS float*)(lx + RS_OFF);
        const int lrow0 = rowoff + wr_ * 64 + fr_, col0 = pn_ * 256 + coloff + wc_ * 32 + 8 * fq_, bj0 = coloff >> 7;
        const float* xb = (pm_ < STILE ? xp : xs - (size_t)MP * DM);
#pragma unroll
        for (int ai = 0; ai < NA; ++ai)
#pragma unroll
            for (int m = 0; m < 4; ++m) { const int lrow = lrow0 + ai * 128 + m * 16; const size_t row = (size_t)pm_ * 256 + lrow;
#pragma unroll
                for (int bj = 0; bj < NB; ++bj) { const size_t off = row * 1024 + col0 + bj * 128; f32x4 v0, v1;
                    if (!DOWN) { v0 = acc[ai][bj][m][0] + *(const f32x4*)(xb + off); v1 = acc[ai][bj][m][1] + *(const f32x4*)(xb + off + 4); }
                    else { const v4u w = *(const v4u*)(X1B + off); v0 = acc[ai][bj][m][0] + (f32x4){bflo(w.x), bfhi(w.x), bflo(w.y), bfhi(w.y)}; v1 = acc[ai][bj][m][1] + (f32x4){bflo(w.z), bfhi(w.z), bflo(w.w), bfhi(w.w)}; }
                    float s = (v0[0] * v0[0] + v0[1] * v0[1]) + (v0[2] * v0[2] + v0[3] * v0[3]) + (v1[0] * v1[0] + v1[1] * v1[1]) + (v1[2] * v1[2] + v1[3] * v1[3]);
                    if (!DOWN) { v4u w; w.x = pg8::cvt_pk_bf16(v0[0], v0[1]); w.y = pg8::cvt_pk_bf16(v0[2], v0[3]); w.z = pg8::cvt_pk_bf16(v1[0], v1[1]); w.w = pg8::cvt_pk_bf16(v1[2], v1[3]);
                        *(v4u*)(X1B + off) = w; }
                    else { *(f32x4*)(Y + off) = v0; *(f32x4*)(Y + off + 4) = v1; }
                    s += __shfl_xor(s, 16); s += __shfl_xor(s, 32);
                    if (fq_ == 0) P[lrow * 8 + (bj0 + bj) * 4 + wc_] = s; } }
        asm volatile("s_waitcnt lgkmcnt(0)" ::: "memory"); __builtin_amdgcn_s_barrier(); asm volatile("" ::: "memory");
        if (tid < NA * 128) { const int lrow = rowoff + tid; const LAS f32x4* pp = (const LAS f32x4*)(P + lrow * 8); float* d = SSQ + ((size_t)pm_ * 256 + lrow) * 8 + pn_ * 2;
            if (NA == 2) { const f32x4 a = pp[0], b = pp[1]; d[0] = (a[0] + a[1]) + (a[2] + a[3]); d[1] = (b[0] + b[1]) + (b[2] + b[3]); }
            else { const f32x4 a = pp[bj0]; d[bj0] = (a[0] + a[1]) + (a[2] + a[3]); } }
    }
};
__device__ __forceinline__ float row_rs(const float* SSQ, size_t row) {
    const f32x4* q = (const f32x4*)(SSQ + row * 8); const f32x4 a = q[0], b = q[1];
    return 1.0f / sqrtf((((a[0] + a[1]) + (a[2] + a[3])) + ((b[0] + b[1]) + (b[2] + b[3]))) * (1.f / DM) + EPS);
}
struct EpiFinal {
    static constexpr bool PERM = true, AMAP = false, MID = false;
    float* Y; const bf16* X1B; const float* gf; float* XS; unsigned* cnt; unsigned* tmo; LAS unsigned char* lx;
    template <int NA, int NB> __device__ __forceinline__ void run(f32x4 (&acc)[NA][NB][4][2], const Unit& u, int rowoff, int coloff, int wr, int wc, int fr, int fq) const {
        LAS float* P = (LAS float*)(lx + RS_OFF); LAS float* S = P + 2048;
        int tid = threadIdx.x, pm_ = u.pm, pn_ = u.pn, fr_ = fr, fq_ = fq, wr_ = wr, wc_ = wc;
        asm volatile("" : "+v"(tid), "+s"(pm_), "+s"(pn_), "+v"(fr_), "+v"(fq_), "+s"(wr_), "+s"(wc_));
        const int wid = tid >> 6, lane = tid & 63;
        const int lrow0 = rowoff + wr_ * 64 + fr_, col0 = pn_ * 256 + coloff + wc_ * 32 + 8 * fq_, bj0 = coloff >> 7;
#pragma unroll
        for (int ai = 0; ai < NA; ++ai)
#pragma unroll
            for (int m = 0; m < 4; ++m) { const int lrow = lrow0 + ai * 128 + m * 16; const size_t row = (size_t)pm_ * 256 + lrow;
#pragma unroll
                for (int bj = 0; bj < NB; ++bj) { const size_t off = row * 1024 + col0 + bj * 128;
                    { const v4u w = *(const v4u*)(X1B + off); acc[ai][bj][m][0] += (f32x4){bflo(w.x), bfhi(w.x), bflo(w.y), bfhi(w.y)}; acc[ai][bj][m][1] += (f32x4){bflo(w.z), bfhi(w.z), bflo(w.w), bfhi(w.w)}; }
                    const f32x4 v0 = acc[ai][bj][m][0], v1 = acc[ai][bj][m][1];
                    float s = (v0[0] * v0[0] + v0[1] * v0[1]) + (v0[2] * v0[2] + v0[3] * v0[3]) + (v1[0] * v1[0] + v1[1] * v1[1]) + (v1[2] * v1[2] + v1[3] * v1[3]);
                    s += __shfl_xor(s, 16); s += __shfl_xor(s, 32);
                    if (fq_ == 0) P[lrow * 8 + (bj0 + bj) * 4 + wc_] = s; } }
        asm volatile("s_waitcnt lgkmcnt(0)" ::: "memory"); __builtin_amdgcn_s_barrier(); asm volatile("" ::: "memory");
        constexpr int RPW = (NA == 2) ? 32 : 16;
        const int nslot = (NA == 2) ? 4 : 8, slot = (NA == 2) ? pn_ : 2 * pn_ + bj0;
        const int prow = rowoff + wid * RPW + (lane & (RPW - 1));
        float* xs = XS + (size_t)pm_ * 2048;
        if (lane < RPW) { const LAS float* pp = P + prow * 8 + (NA == 2 ? 0 : bj0 * 4); float t = (pp[0] + pp[1]) + (pp[2] + pp[3]); if (NA == 2) t += (pp[4] + pp[5]) + (pp[6] + pp[7]);
            __hip_atomic_store(xs + slot * 256 + prow, t, __ATOMIC_RELAXED, __HIP_MEMORY_SCOPE_AGENT); }
        asm volatile("s_waitcnt vmcnt(0)" ::: "memory");
        unsigned* c = cnt + 32 * ((NA == 2) ? pm_ : (STILE + (rowoff >> 7)));
        if (lane == 0) __hip_atomic_fetch_add(c, 1u, __ATOMIC_RELAXED, __HIP_MEMORY_SCOPE_AGENT);
        if (wid == 0) { const unsigned want = 8u * (unsigned)nslot; unsigned sp = 0;
            while ((unsigned)__builtin_amdgcn_readfirstlane(__hip_atomic_load(c, __ATOMIC_RELAXED, __HIP_MEMORY_SCOPE_AGENT)) < want) {
                __builtin_amdgcn_s_sleep(1);
                if ((++sp & 255u) == 0u) { if (__builtin_amdgcn_readfirstlane(__hip_atomic_load(tmo, __ATOMIC_RELAXED, __HIP_MEMORY_SCOPE_AGENT)) != 0u) break; if (sp > (1u << 20)) { if (lane == 0) atomicAdd(tmo, 1u); break; } } } }
        asm volatile("s_waitcnt vmcnt(0) lgkmcnt(0)" ::: "memory"); __builtin_amdgcn_s_barrier(); asm volatile("" ::: "memory");
        if (lane < RPW) { float t = 0.f;
#pragma unroll
            for (int k = 0; k < 8; ++k) if (k < nslot) t += __hip_atomic_load(xs + k * 256 + prow, __ATOMIC_RELAXED, __HIP_MEMORY_SCOPE_AGENT);
            S[prow] = 1.0f / sqrtf(t * (1.f / DM) + EPS); }
        asm volatile("s_waitcnt lgkmcnt(0)" ::: "memory"); __builtin_amdgcn_s_barrier(); asm volatile("" ::: "memory");
        f32x4 gg[NB][2];
#pragma unroll
        for (int bj = 0; bj < NB; ++bj) { gg[bj][0] = *(const f32x4*)(gf + col0 + bj * 128); gg[bj][1] = *(const f32x4*)(gf + col0 + bj * 128 + 4); }
#pragma unroll
        for (int ai = 0; ai < NA; ++ai)
#pragma unroll
            for (int m = 0; m < 4; ++m) { const int lrow = lrow0 + ai * 128 + m * 16; const size_t row = (size_t)pm_ * 256 + lrow; const float rs = S[lrow];
#pragma unroll
                for (int bj = 0; bj < NB; ++bj) { const size_t off = row * 1024 + col0 + bj * 128;
                    *(f32x4*)(Y + off) = acc[ai][bj][m][0] * rs * gg[bj][0]; *(f32x4*)(Y + off + 4) = acc[ai][bj][m][1] * rs * gg[bj][1]; } }
    }
};
struct EpiW {
    static constexpr bool PERM = true, AMAP = false, MID = false;
    bf16* O;
    template <int NA, int NB> __device__ __forceinline__ void run(f32x4 (&acc)[NA][NB][4][2], const Unit& u, int rowoff, int coloff, int wr, int wc, int fr, int fq) const {
        const int row0 = u.pm * 256 + rowoff + wr * 64 + fr, col0 = u.pn * 256 + coloff + wc * 32 + 8 * fq;
#pragma unroll
        for (int ai = 0; ai < NA; ++ai)
#pragma unroll
            for (int m = 0; m < 4; ++m)
#pragma unroll
                for (int bj = 0; bj < NB; ++bj) { const f32x4 v0 = acc[ai][bj][m][0], v1 = acc[ai][bj][m][1];
                    v4u w; w.x = pg8::cvt_pk_bf16(v0[0], v0[1]); w.y = pg8::cvt_pk_bf16(v0[2], v0[3]); w.z = pg8::cvt_pk_bf16(v1[0], v1[1]); w.w = pg8::cvt_pk_bf16(v1[2], v1[3]);
                    *(v4u*)(O + (size_t)(row0 + ai * 128 + m * 16) * 2048 + col0 + bj * 128) = w; }
    }
};
template <bool AM> struct EpiNull {
    static constexpr bool PERM = true, AMAP = AM, MID = false;
    template <int NA, int NB> __device__ __forceinline__ void run(f32x4 (&acc)[NA][NB][4][2], const Unit&, int, int, int, int, int, int) const {
#pragma unroll
        for (int ai = 0; ai < NA; ++ai)
#pragma unroll
            for (int bj = 0; bj < NB; ++bj)
#pragma unroll
                for (int m = 0; m < 4; ++m) { asm volatile("" :: "v"(acc[ai][bj][m][0]), "v"(acc[ai][bj][m][1])); }
    }
};
struct EpiZScratch {
    static constexpr bool PERM = true, AMAP = false, MID = false;
    bf16* scr;
    template <int NA, int NB> __device__ __forceinline__ void run(f32x4 (&acc)[NA][NB][4][2], const Unit& u, int rowoff, int coloff, int wr, int wc, int fr, int fq) const {
        const int row0 = wr * 64 + fr, col0 = wc * 32 + 8 * fq;
#pragma unroll
        for (int ai = 0; ai < NA; ++ai)
#pragma unroll
            for (int m = 0; m < 4; ++m) { bf16* rowp = scr + (size_t)(row0 + ai * 128 + m * 16) * 256 + col0;
#pragma unroll
                for (int bj = 0; bj < NB; ++bj) { f32x4 v0 = acc[ai][bj][m][0], v1 = acc[ai][bj][m][1];
                    v4u w; w.x = pg8::cvt_pk_bf16(v0[0], v0[1]); w.y = pg8::cvt_pk_bf16(v0[2], v0[3]); w.z = pg8::cvt_pk_bf16(v1[0], v1[1]); w.w = pg8::cvt_pk_bf16(v1[2], v1[3]);
                    *(v4u*)(rowp + bj * 128) = w; } }
    }
};
struct EpiUpS {
    static constexpr bool PERM = true, AMAP = false, MID = false;
    bf16* ACT; const float* cw; const float* cb; const float* stf; float* ofs; const float* SSQ;
    template <int NA, int NB> __device__ __forceinline__ void run(f32x4 (&acc)[NA][NB][4][2], const Unit& u, int rowoff, int coloff, int wr, int wc, int fr, int fq) const {
        static_assert(NA == 1 && NB == 2, "sample FFN epilogue works on half sub-units");
        int pn_ = u.pn, ro_ = rowoff, fr_ = fr, fq_ = fq, wr_ = wr, wc_ = wc; asm volatile("" : "+s"(pn_), "+s"(ro_), "+v"(fr_), "+v"(fq_), "+s"(wr_), "+s"(wc_));
        const int cbase = 32 * wc_ + 8 * fq_, gcol = 128 * pn_ + cbase;
#pragma unroll
        for (int m = 0; m < 4; ++m) {
            asm volatile("" ::: "memory");
            const int lrow = ro_ + wr_ * 64 + m * 16 + fr_, seq = lrow >> 4; const size_t row = (size_t)MP + lrow;
            const float rs = row_rs(SSQ, row);
            unsigned pk[4];
#pragma unroll
            for (int n = 0; n < 2; ++n) { f32x4 gc;
#pragma unroll
                for (int bj = 0; bj < 2; ++bj) { const int oc = bj * DFF + gcol + 4 * n;
                    const f32x4 w0 = *(const f32x4*)(cw + oc), w1 = *(const f32x4*)(cw + DUP + oc), w2 = *(const f32x4*)(cw + 2 * DUP + oc), bb = *(const f32x4*)(cb + oc);
                    const f32x4 h = acc[0][bj][m][n] * rs; f32x4 hm1, hm2;
#pragma unroll
                    for (int e = 0; e < 4; ++e) { hm1[e] = __shfl_up(h[e], 1, 16); hm2[e] = __shfl_up(h[e], 2, 16); }
                    if (fr_ < 2) { const f32x4 s1 = *(const f32x4*)(stf + (size_t)(seq * 2 + 1) * DUP + oc); if (fr_ == 0) { hm1 = s1; hm2 = *(const f32x4*)(stf + (size_t)(seq * 2 + 0) * DUP + oc); } else hm2 = s1; }
                    if (fr_ >= 14) *(f32x4*)(ofs + (size_t)(seq * 2 + (fr_ - 14)) * DUP + oc) = h;
                    const f32x4 c = bb + w0 * hm2 + w1 * hm1 + w2 * h;
                    if (bj == 0) gc = c;
                    else { f32x4 a;
#pragma unroll
                        for (int e = 0; e < 4; ++e) a[e] = gelu_tanh(gc[e]) * c[e];
                        pk[2 * n] = pg8::cvt_pk_bf16(a[0], a[1]); pk[2 * n + 1] = pg8::cvt_pk_bf16(a[2], a[3]); } } }
            v4u w; w.x = pk[0]; w.y = pk[1]; w.z = pk[2]; w.w = pk[3];
            *(v4u*)(ACT + row * DFF + gcol) = w;
        }
    }
};
struct EpiUp {
    static constexpr bool PERM = true, AMAP = true, MID = false;
    bf16* ACT; const float* cw; const float* cb; const float* stf; float* ofp; float* ofs; LAS unsigned char* lx; int pm0; bf16* scr; float* HA; float* HB;
    template <int NA, int NB> __device__ __forceinline__ void run(f32x4 (&acc)[NA][NB][4][2], const Unit& u, int, int, int wr, int wc, int fr, int fq) const {
        int pm_ = u.pm, pn_ = u.pn, fr_ = fr, fq_ = fq; asm volatile("" : "+s"(pm_), "+s"(pn_), "+v"(fr_), "+v"(fq_));
        const bool samp = (pm_ == STILE); const int j = pm_ - pm0;
        const LAS float* RS = (const LAS float*)(lx + RS_OFF) + j * 256 + 128 * wr + 8 * fr_;
        const f32x4 rsa = *(const LAS f32x4*)RS, rsb = *(const LAS f32x4*)(RS + 4);
        const float rs[8] = {rsa[0], rsa[1], rsa[2], rsa[3], rsb[0], rsb[1], rsb[2], rsb[3]};
        const int cbase = 32 * wc + 8 * fq_, gcol = 128 * pn_ + cbase;
        const LAS float* Ein = (const LAS float*)(lx + (wr == 0 ? (j == 0 ? EDGE_START_OFF : EDGE_PREV_OFF + 2048 * (j & 1)) : EDGE_MID_OFF));
        LAS float* Eout = (LAS float*)(lx + (wr == 0 ? EDGE_MID_OFF : EDGE_PREV_OFF + 2048 * ((j + 1) & 1)));
        const int seq = samp ? (8 * wr + (fr_ >> 1)) : (pm_ >> 4);
        const bool lastp = (!samp) && !scr && ((pm_ & 15) == 15) && wr == 1 && fr_ == 15;
        if (!samp && fr_ == 15) {
#pragma unroll
            for (int n = 0; n < 2; ++n)
#pragma unroll
                for (int bj = 0; bj < 2; ++bj) { const int cc = bj * 128 + cbase + 4 * n;
                    *(LAS f32x4*)(Eout + cc) = acc[1][bj][2][n] * rs[6]; *(LAS f32x4*)(Eout + 256 + cc) = acc[1][bj][3][n] * rs[7]; } }
        asm volatile("s_waitcnt lgkmcnt(0)" ::: "memory"); __builtin_amdgcn_s_barrier(); asm volatile("" ::: "memory");
        const size_t astr = scr ? 128 : DFF;
        bf16* ap = scr ? scr + (size_t)(128 * wr + 8 * fr_) * 128 + cbase : ACT + (size_t)(pm_ * 256 + 128 * wr + 8 * fr_) * DFF + gcol;
#pragma unroll
        for (int n = 0; n < 2; ++n) {
            f32x4 gc[8];
#pragma unroll
            for (int bj = 0; bj < 2; ++bj) {
                const int cc = bj * 128 + cbase + 4 * n, oc = bj * DFF + gcol + 4 * n;
                const LAS float* cwl = (const LAS float*)(lx + CWL_OFF) + cc;
                const f32x4 w0 = *(const LAS f32x4*)cwl, w1 = *(const LAS f32x4*)(cwl + 256), w2 = *(const LAS f32x4*)(cwl + 512), bb = *(const LAS f32x4*)(cwl + 768);
                const f32x4 h6 = acc[1][bj][2][n] * rs[6], h7 = acc[1][bj][3][n] * rs[7];
                f32x4 hm1, hm2;
#pragma unroll
                for (int e = 0; e < 4; ++e) { hm1[e] = dpp_shr1(h7[e]); hm2[e] = dpp_shr1(h6[e]); }
                if (!samp) {
                    if (fr_ == 0) { hm2 = *(const LAS f32x4*)(Ein + cc); hm1 = *(const LAS f32x4*)(Ein + 256 + cc); }
                    if (lastp) { *(f32x4*)(ofp + (size_t)(seq * 2 + 0) * DUP + oc) = h6; *(f32x4*)(ofp + (size_t)(seq * 2 + 1) * DUP + oc) = h7; }
                    if (j == 3 && wr == 1 && fr_ == 15 && !scr) { float* ha = HA + ((size_t)((pm0 >> 2) + 1) * 24 + pn_) * 512 + cc; *(f32x4*)ha = h6; *(f32x4*)(ha + 256) = h7; }
                    if (j == 0 && wr == 0 && fr_ == 0 && !scr) { float* hb = HB + ((size_t)(pm0 >> 2) * 24 + pn_) * 512 + cc; *(f32x4*)hb = acc[0][bj][0][n] * rs[0]; *(f32x4*)(hb + 256) = acc[0][bj][1][n] * rs[1]; }
                } else {
                    if (!(fr_ & 1)) { hm2 = *(const f32x4*)(stf + (size_t)(seq * 2 + 0) * DUP + oc); hm1 = *(const f32x4*)(stf + (size_t)(seq * 2 + 1) * DUP + oc); }
                    else { *(f32x4*)(ofs + (size_t)(seq * 2 + 0) * DUP + oc) = h6; *(f32x4*)(ofs + (size_t)(seq * 2 + 1) * DUP + oc) = h7; }
                }
                f32x4 p2 = hm2, p1 = hm1;
#pragma unroll
                for (int q = 0; q < 8; ++q) {
                    const f32x4 hq = (q == 6) ? h6 : (q == 7) ? h7 : acc[q >> 2][bj][q & 3][n] * rs[q];
                    const f32x4 c = bb + w0 * p2 + w1 * p1 + w2 * hq;
                    p2 = p1; p1 = hq;
                    if (bj == 0) gc[q] = c;
                    else { f32x4 a;
#pragma unroll
                        for (int e = 0; e < 4; ++e) a[e] = gelu_tanh(gc[q][e]) * c[e];
                        v2u w; w.x = pg8::cvt_pk_bf16(a[0], a[1]); w.y = pg8::cvt_pk_bf16(a[2], a[3]);
                        *(v2u*)(ap + (size_t)q * astr + 4 * n) = w; }
                }
            }
        }
        LDS_WAIT();
    }
};
template <class RowMap>
__device__ __forceinline__ void p0_transpose_item(const float* W, int ldw, int k0, int n0, bf16* WT, size_t ldt, int kcol0, RowMap drow, const float* kscale, LAS float* scr, int lane) {
    float tv[32];
#pragma unroll
    for (int i = 0; i < 32; ++i) { const int kk = 2 * i + (lane >> 5); tv[i] = W[(size_t)(k0 + kk) * ldw + n0 + (lane & 31)]; }
    if (kscale) {
#pragma unroll
        for (int i = 0; i < 32; ++i) tv[i] *= kscale[k0 + 2 * i + (lane >> 5)]; }
#pragma unroll
    for (int i = 0; i < 32; ++i) scr[(2 * i + (lane >> 5)) * 33 + (lane & 31)] = tv[i];
    LDS_WAIT(); asm volatile("" ::: "memory");
    const int c = lane & 7;
#pragma unroll
    for (int j = 0; j < 4; ++j) { const int n = (lane >> 3) + 8 * j; const LAS float* s = scr + (8 * c) * 33 + n;
        v4u o; o.x = pk2(s[0 * 33], s[1 * 33]); o.y = pk2(s[2 * 33], s[3 * 33]); o.z = pk2(s[4 * 33], s[5 * 33]); o.w = pk2(s[6 * 33], s[7 * 33]);
        *(v4u*)(WT + (size_t)drow(n0 + n) * ldt + kcol0 + k0 + 8 * c) = o; }
    LDS_WAIT(); asm volatile("" ::: "memory");
}
struct RowId { __device__ __forceinline__ int operator()(int n) const { return n; } };
struct RowGate { __device__ __forceinline__ int operator()(int n) const { if (n < 2048) return n; const int c = n - 2048, br = c >> 10, cc = c & 1023; return 2048 + (cc >> 7) * 256 + br * 128 + (cc & 127); } };
struct RowUp { __device__ __forceinline__ int operator()(int n) const { const int half = n >= DFF ? 1 : 0, c = n - half * DFF; return (c >> 7) * 256 + half * 128 + (c & 127); } };

__device__ __forceinline__ void p0_prologue(const KP& p, LAS unsigned char* lds, int vcu, int G, int wave, int lane) {
    LAS float* scr = (LAS float*)(lds + wave * 16384);
    const int gw = vcu * NWAVES + wave, NGW = G * NWAVES;
    unsigned char* ws = p.ws;
    bf16* Win_t = (bf16*)(ws + WS_WIN); bf16* Wg_t = (bf16*)(ws + WS_WG); bf16* Wbp_t = (bf16*)(ws + WS_WBP); bf16* Wpool_b = (bf16*)(ws + WS_WPOOL);
    constexpr int I_IN = (DM / 64) * (DIN / 32), I_SQ = (DM / 64) * (DM / 32), I_G = 32 * 2, I_PC = 4 * 256 * 256 / 512;
    constexpr int NITEMS = I_IN + I_SQ + I_G + I_PC;
    for (int it = gw; it < NITEMS; it += NGW) {
        int r = it;
        if (r < I_IN) { const int nblk = DIN / 32; p0_transpose_item(p.in[I_WIN], DIN, 64 * (r / nblk), 32 * (r % nblk), Win_t, DM, 0, RowGate(), nullptr, scr, lane); continue; } r -= I_IN;
        if (r < I_SQ) { const int nblk = DM / 32; p0_transpose_item(p.in[I_WBRP], DM, 64 * (r / nblk), 32 * (r % nblk), Wbp_t, DM, 0, RowId(), p.in[I_PSCALE], scr, lane); continue; } r -= I_SQ;
        if (r < I_G) { const int mat = r >> 1, nb = r & 1; const float* W = (mat < 16 ? p.in[I_WRA] : p.in[I_WIX]) + (size_t)(mat & 15) * 4096;
          p0_transpose_item(W, 64, 0, 32 * nb, Wg_t + (size_t)mat * 4096, 64, 0, RowId(), nullptr, scr, lane); continue; } r -= I_G;
        { const float* s = p.in[I_WPOOL] + (size_t)r * 512 + lane * 8; const f32x4 a = *(const f32x4*)s, b = *(const f32x4*)(s + 4);
          v4u o; o.x = pk2(a[0], a[1]); o.y = pk2(a[2], a[3]); o.z = pk2(b[0], b[1]); o.w = pk2(b[2], b[3]); *(v4u*)(Wpool_b + (size_t)r * 512 + lane * 8) = o; }
    }
    {
        bf16* XN = (bf16*)(ws + WS_R0); const float* g1 = p.in[I_NMIX];
        f32x4 gv[4];
#pragma unroll
        for (int j = 0; j < 4; ++j) gv[j] = *((const f32x4*)g1 + lane + 64 * j);
        for (int m0 = gw; m0 < M; m0 += 4 * NGW) {
            f32x4 v[4][4]; float s[4];
#pragma unroll
            for (int r = 0; r < 4; ++r) { const int m = m0 + r * NGW; s[r] = 0.f;
                if (m < M) { const float* xrow = m < MP ? p.in[I_XP] + (size_t)m * DM : p.in[I_XS] + (size_t)(m - MP) * DM; const f32x4* xr = (const f32x4*)xrow + lane;
#pragma unroll
                    for (int j = 0; j < 4; ++j) v[r][j] = xr[64 * j]; } }
#pragma unroll
            for (int r = 0; r < 4; ++r) { const int m = m0 + r * NGW;
                if (m < M) {
#pragma unroll
                    for (int j = 0; j < 4; ++j) s[r] += (v[r][j][0] * v[r][j][0] + v[r][j][1] * v[r][j][1]) + (v[r][j][2] * v[r][j][2] + v[r][j][3] * v[r][j][3]);
                    const float rstd = 1.0f / sqrtf(wave_sum(s[r]) * (1.f / DM) + EPS);
                    v2u* o8 = (v2u*)(XN + (size_t)m * DM) + lane;
#pragma unroll
                    for (int j = 0; j < 4; ++j) { const f32x4 y = v[r][j] * rstd * gv[j]; v2u o; o.x = pk2(y[0], y[1]); o.y = pk2(y[2], y[3]); o8[64 * j] = o; } } }
        }
    }
}
__device__ __forceinline__ void p1_weights(const KP& p, LAS unsigned char* lds, int gw, int NGW, int wave, int lane) {
    LAS float* scr = (LAS float*)(lds + wave * 16384);
    unsigned char* ws = p.ws;
    bf16* Wcat_t = (bf16*)(ws + WS_WCAT); bf16* Wout_t = (bf16*)(ws + WS_WOUT); bf16* Wup_t = (bf16*)(ws + WS_WUP); bf16* Wdn_t = (bf16*)(ws + WS_WDN);
    constexpr int I_UP = (DM / 64) * (DUP / 32), I_SQ = (DM / 64) * (DM / 32), I_DN = (DFF / 64) * (DM / 32);
    for (int it = gw; it < I_UP + 2 * I_SQ + I_DN; it += NGW) {
        int r = it;
        if (r < I_SQ) { const int nblk = DM / 32; p0_transpose_item(p.in[I_WBRL], DM, 64 * (r / nblk), 32 * (r % nblk), Wcat_t, 2048, 0, RowId(), nullptr, scr, lane); continue; } r -= I_SQ;
        if (r < I_SQ) { const int nblk = DM / 32; p0_transpose_item(p.in[I_WOUT], DM, 64 * (r / nblk), 32 * (r % nblk), Wout_t, DM, 0, RowId(), nullptr, scr, lane); continue; } r -= I_SQ;
        if (r < I_UP) { const int nblk = DUP / 32; p0_transpose_item(p.in[I_WUP], DUP, 64 * (r / nblk), 32 * (r % nblk), Wup_t, DM, 0, RowUp(), p.in[I_NFFN]  , scr, lane); continue; } r -= I_UP;
        { const int nblk = DM / 32; p0_transpose_item(p.in[I_WDN], DM, 64 * (r / nblk), 32 * (r % nblk), Wdn_t, DFF, 0, RowId(), nullptr, scr, lane); }
    }
}

constexpr int XR_OFF = 0, XR_BYTES = 16 * 19 * 128, SEG_OFF = 40960, CIN_OFF = 45056;
template <bool FINAL>
__device__ __forceinline__ void lru_unit(const KP& p, LAS unsigned char* lds, int pm, int n, int tid, int lane, int wave) {
    constexpr bool samp = true;
    const bf16* ZR = (const bf16*)(p.ws + WS_R1); const bf16* Wg_t = (const bf16*)(p.ws + WS_WG);
    typedef float f32x2v __attribute__((ext_vector_type(2)));
    f32x2v* SUMM = (f32x2v*)(p.ws + WS_SUMM);
    bf16* HP = (bf16*)(p.ws + WS_R3);
    LAS unsigned char* XR = lds + XR_OFF; LAS f32x2v* SEG = (LAS f32x2v*)(lds + SEG_OFF); LAS float* CIN = (LAS float*)(lds + CIN_OFF);
    const int t0 = samp ? 0 : 256 * (pm & 15);
    __syncthreads();
    for (int idx = tid; idx < 304 * 8; idx += NWAVES * 64) {
        const int row = idx >> 3, ck = idx & 7, g = row / 19, k = row - g * 19, tt = 16 * g + k - 3;
        v4u v = {0u, 0u, 0u, 0u};
        if (!samp) { if (t0 + tt >= 0) v = *(const v4u*)(ZR + (size_t)(pm * 256 + tt) * 2048 + n * 64 + ck * 8); }
        else if (k < 3) { const float* s = p.in[I_STLC] + (size_t)(g * 3 + k) * DM + n * 64 + ck * 8; const f32x4 a = *(const f32x4*)s, b = *(const f32x4*)(s + 4);
            v.x = pk2(a[0], a[1]); v.y = pk2(a[2], a[3]); v.z = pk2(b[0], b[1]); v.w = pk2(b[2], b[3]); }
        else v = *(const v4u*)(ZR + (size_t)(MP + 16 * g + k - 3) * 2048 + n * 64 + ck * 8);
        *(LAS v4u*)(XR + row * 128 + ck * 16) = v;
    }
    if (FINAL && !samp && tid < 64) {
        const int npre = pm & 15; f32x2v sv[15];
#pragma unroll
        for (int k = 0; k < 15; ++k) sv[k] = (k < npre) ? SUMM[(size_t)(pm - npre + k) * DM + n * 64 + tid] : (f32x2v){1.f, 0.f};
        float c = 0.f;
#pragma unroll
        for (int k = 0; k < 15; ++k) c = sv[k].y + sv[k].x * c;
        CIN[tid] = c;
    }
    __syncthreads();
    const int i16 = lane & 15, fq = lane >> 4;
    const float* cwl = p.in[I_CLW]; const float* cbl = p.in[I_CLB];
    bf16x8 fa[2][2];
#pragma unroll
    for (int ks = 0; ks < 2; ++ks) {
        const int ch0 = 32 * ks + 8 * fq; f32x4 w[4][2], bb[2];
#pragma unroll
        for (int tp = 0; tp < 4; ++tp) { w[tp][0] = *(const f32x4*)(cwl + tp * DM + n * 64 + ch0); w[tp][1] = *(const f32x4*)(cwl + tp * DM + n * 64 + ch0 + 4); }
        bb[0] = *(const f32x4*)(cbl + n * 64 + ch0); bb[1] = *(const f32x4*)(cbl + n * 64 + ch0 + 4);
#pragma unroll
        for (int m = 0; m < 2; ++m) {
            const int tau = 8 * (i16 >> 2) + 4 * m + (i16 & 3), T = 32 * wave + tau, rb = (T >> 4) * 19 + (T & 15);
            f32x4 u0 = bb[0], u1 = bb[1];
#pragma unroll
            for (int tp = 0; tp < 4; ++tp) { const v4u x = *(const LAS v4u*)(XR + (rb + tp) * 128 + ch0 * 2);
                u0 += w[tp][0] * (f32x4){bflo(x.x), bfhi(x.x), bflo(x.y), bfhi(x.y)}; u1 += w[tp][1] * (f32x4){bflo(x.z), bfhi(x.z), bflo(x.w), bfhi(x.w)}; }
            v4u f; f.x = pk2(u0[0], u0[1]); f.y = pk2(u0[2], u0[3]); f.z = pk2(u1[0], u1[1]); f.w = pk2(u1[2], u1[3]);
            fa[m][ks] = __builtin_bit_cast(bf16x8, f);
        }
    }
    float hloc[4][8], pc[4][8], P8[4], H8[4];
    const int T0 = 32 * wave + 8 * fq, rb0 = (T0 >> 4) * 19 + (T0 & 15);
#pragma unroll
    for (int nb = 0; nb < 4; ++nb) {
        const int ch = 16 * nb + i16, gch = n * 64 + ch;
        f32x4 aR[2] = {{0.f, 0.f, 0.f, 0.f}, {0.f, 0.f, 0.f, 0.f}}, aI[2] = {{0.f, 0.f, 0.f, 0.f}, {0.f, 0.f, 0.f, 0.f}};
#pragma unroll
        for (int ks = 0; ks < 2; ++ks) {
            const bf16x8 bR = *(const bf16x8*)(Wg_t + (size_t)(n * 64 + ch) * 64 + 8 * fq + 32 * ks);
            const bf16x8 bI = *(const bf16x8*)(Wg_t + (size_t)((16 + n) * 64 + ch) * 64 + 8 * fq + 32 * ks);
#pragma unroll
            for (int m = 0; m < 2; ++m) { aR[m] = __builtin_amdgcn_mfma_f32_16x16x32_bf16(fa[m][ks], bR, aR[m], 0, 0, 0); aI[m] = __builtin_amdgcn_mfma_f32_16x16x32_bf16(fa[m][ks], bI, aI[m], 0, 0, 0); }
        }
        float x[11];
#pragma unroll
        for (int r = 0; r < 11; ++r) x[r] = __builtin_bit_cast(float, (unsigned)(*(const LAS unsigned short*)(XR + (rb0 + r) * 128 + ch * 2)) << 16);
        const float c0 = cwl[gch], c1 = cwl[DM + gch], c2 = cwl[2 * DM + gch], c3 = cwl[3 * DM + gch], cbv = cbl[gch];
        const float bra = p.in[I_BRA][gch], bix = p.in[I_BIX][gch], lam = p.in[I_LAM][gch];
        const float zz = -lam, sp = fmaxf(zz, 0.f) + log1pf(expf(-fabsf(zz))), c8 = -8.0f * sp;
        float hl = 0.f, P = 1.f;
#pragma unroll
        for (int q = 0; q < 8; ++q) {
            const float u = cbv + c0 * x[q] + c1 * x[q + 1] + c2 * x[q + 2] + c3 * x[q + 3];
            const float r = sigmoidf_fast(aR[q >> 2][q & 3] + bra), ig = sigmoidf_fast(aI[q >> 2][q & 3] + bix);
            const float la = r * c8, a = __builtin_amdgcn_exp2f(la * 1.4426950408889634f);
            const float x2 = 2.0f * la, em_small = -x2 * (1.0f + x2 * (0.5f + x2 * (0.16666667f + x2 * 0.041666668f))), em = (x2 > -0.05f) ? em_small : (1.0f - a * a);
            const float b = sqrtf(em) * ig * u;
            hl = a * hl + b; P = P * a;
            hloc[nb][q] = hl; pc[nb][q] = P;
        }
        P8[nb] = P; H8[nb] = hl;
    }
    float Pf[4][4], Hf[4][4];
#pragma unroll
    for (int nb = 0; nb < 4; ++nb)
#pragma unroll
        for (int f = 0; f < 4; ++f) { Pf[nb][f] = __shfl(P8[nb], i16 + 16 * f); Hf[nb][f] = __shfl(H8[nb], i16 + 16 * f); }
    if (!samp) {
        if (fq == 0) {
#pragma unroll
            for (int nb = 0; nb < 4; ++nb) { float hw = 0.f, pw = 1.f;
#pragma unroll
                for (int f = 0; f < 4; ++f) { hw = Hf[nb][f] + Pf[nb][f] * hw; pw *= Pf[nb][f]; }
                SEG[wave * 64 + 16 * nb + i16] = (f32x2v){pw, hw}; }
        }
        __syncthreads();
        if (!FINAL) {
            if (tid < 64) { float hu = 0.f, pu = 1.f;
#pragma unroll
                for (int w = 0; w < 8; ++w) { const f32x2v s = SEG[w * 64 + tid]; hu = s.y + s.x * hu; pu *= s.x; }
                SUMM[(size_t)pm * DM + n * 64 + tid] = (f32x2v){pu, hu}; }
            return;
        }
    }
#pragma unroll
    for (int nb = 0; nb < 4; ++nb) {
        const int ch = 16 * nb + i16, gch = n * 64 + ch;
        float c;
        if (!samp) {
            c = CIN[ch];
#pragma unroll
            for (int w = 0; w < 8; ++w) { const f32x2v s = SEG[w * 64 + ch]; if (w < wave) c = s.y + s.x * c; }
#pragma unroll
            for (int f = 0; f < 4; ++f) if (f < fq) c = Hf[nb][f] + Pf[nb][f] * c;
        } else {
            const int sq = 2 * wave + (fq >> 1);
            c = p.in[I_STH][(size_t)sq * DM + gch];
            if (fq & 1) { const float pp = (fq == 1) ? Pf[nb][0] : Pf[nb][2], hh = (fq == 1) ? Hf[nb][0] : Hf[nb][2]; c = hh + pp * c; }
        }
        bf16* hp = HP + (size_t)(pm * 256 + T0) * 2048 + gch; float hlast = 0.f;
#pragma unroll
        for (int q = 0; q < 8; ++q) { const float h = hloc[nb][q] + pc[nb][q] * c; hp[(size_t)q * 2048] = (bf16)f2bf(h); hlast = h; }
        if (!samp) { if ((pm & 15) == 15 && wave == 7 && fq == 3) p.out[OFF_HP + (size_t)(pm >> 4) * DM + gch] = hlast; }
        else if (fq & 1) p.out[OFF_HS + (size_t)(2 * wave + (fq >> 1)) * DM + gch] = hlast;
    }
}

constexpr int XL_RS = 144  , XL_BYTES = 259 * XL_RS + 16, XL_SEG = 2 * XL_BYTES, XL_CW = XL_SEG + 4096;
__device__ __forceinline__ void lru_task(const KP& p, LAS unsigned char* lds, int s, int n, int hf, int tid, int lane, int wave) {
    const bf16* ZR = (const bf16*)(p.ws + WS_R1); const bf16* Wg_t = (const bf16*)(p.ws + WS_WG); bf16* HP = (bf16*)(p.ws + WS_R3);
    typedef float f32x2v __attribute__((ext_vector_type(2)));
    LAS f32x2v* SEG = (LAS f32x2v*)(lds + XL_SEG); LAS float* CW = (LAS float*)(lds + XL_CW);
    const int i16 = lane & 15, fq = lane >> 4;
    const float* cwl = p.in[I_CLW]; const float* cbl = p.in[I_CLB];
    const size_t rowbase = (size_t)s * SEQ;
    __syncthreads();
    if (tid < 320) { const int tp = tid >> 6, c = tid & 63; CW[tid] = tp < 4 ? cwl[tp * DM + n * 64 + c] : cbl[n * 64 + c]; }
    for (int idx = tid; idx < 259 * 8; idx += NWAVES * 64) { const int row = idx >> 3, ck = idx & 7; v4u v = {0u, 0u, 0u, 0u};
        if (row >= 3) v = *(const v4u*)(ZR + (rowbase + row - 3) * 2048 + n * 64 + ck * 8);
        *(LAS v4u*)(lds + row * XL_RS + ck * 16) = v; }
    bf16x8 bR[2][2], bI[2][2]; float c0[2], c1[2], c2[2], c3[2], cbv[2], bra[2], bix[2], c8[2], cin[2];
#pragma unroll
    for (int b2 = 0; b2 < 2; ++b2) { const int ch = 16 * (2 * hf + b2) + i16, gch = n * 64 + ch;
#pragma unroll
        for (int ks = 0; ks < 2; ++ks) { bR[b2][ks] = *(const bf16x8*)(Wg_t + (size_t)(n * 64 + ch) * 64 + 8 * fq + 32 * ks); bI[b2][ks] = *(const bf16x8*)(Wg_t + (size_t)((16 + n) * 64 + ch) * 64 + 8 * fq + 32 * ks); }
        c0[b2] = cwl[gch]; c1[b2] = cwl[DM + gch]; c2[b2] = cwl[2 * DM + gch]; c3[b2] = cwl[3 * DM + gch]; cbv[b2] = cbl[gch];
        bra[b2] = p.in[I_BRA][gch]; bix[b2] = p.in[I_BIX][gch];
        const float zz = -p.in[I_LAM][gch]; c8[b2] = -8.0f * (fmaxf(zz, 0.f) + log1pf(expf(-fabsf(zz)))) * 1.4426950408889634f;
        cin[b2] = 0.f; }
    __syncthreads();
    for (int tt = 0; tt < 16; ++tt) {
        LAS unsigned char* XR = lds + (tt & 1) * XL_BYTES; LAS unsigned char* XN_ = lds + ((tt + 1) & 1) * XL_BYTES;
        v4u pf[5];
        if (tt < 15) {
#pragma unroll
            for (int k = 0; k < 5; ++k) { const int idx = tid + k * (NWAVES * 64); if (idx < 259 * 8) pf[k] = *(const v4u*)(ZR + (rowbase + 256 * (tt + 1) - 3 + (idx >> 3)) * 2048 + n * 64 + (idx & 7) * 8); } }
        bf16x8 fa[2][2];
#pragma unroll
        for (int ks = 0; ks < 2; ++ks) { const int ch0 = 32 * ks + 8 * fq; f32x4 w[4][2], bb[2];
#pragma unroll
            for (int tp = 0; tp < 4; ++tp) { w[tp][0] = *(const LAS f32x4*)(CW + tp * 64 + ch0); w[tp][1] = *(const LAS f32x4*)(CW + tp * 64 + ch0 + 4); }
            bb[0] = *(const LAS f32x4*)(CW + 256 + ch0); bb[1] = *(const LAS f32x4*)(CW + 256 + ch0 + 4);
#pragma unroll
            for (int m = 0; m < 2; ++m) { const int rb = 32 * wave + 8 * (i16 >> 2) + 4 * m + (i16 & 3); f32x4 u0 = bb[0], u1 = bb[1];
#pragma unroll
                for (int tp = 0; tp < 4; ++tp) { const v4u x = *(const LAS v4u*)(XR + (rb + tp) * XL_RS + ch0 * 2);
                    u0 += w[tp][0] * (f32x4){bflo(x.x), bfhi(x.x), bflo(x.y), bfhi(x.y)}; u1 += w[tp][1] * (f32x4){bflo(x.z), bfhi(x.z), bflo(x.w), bfhi(x.w)}; }
                v4u f; f.x = pg8::cvt_pk_bf16(u0[0], u0[1]); f.y = pg8::cvt_pk_bf16(u0[2], u0[3]); f.z = pg8::cvt_pk_bf16(u1[0], u1[1]); f.w = pg8::cvt_pk_bf16(u1[2], u1[3]);
                fa[m][ks] = __builtin_bit_cast(bf16x8, f); } }
        float hloc[2][8], pc[2][8], P8[2], H8[2];
        const int rb0 = 32 * wave + 8 * fq;
#pragma unroll
        for (int b2 = 0; b2 < 2; ++b2) { const int ch = 16 * (2 * hf + b2) + i16;
            f32x4 aR[2] = {{0.f, 0.f, 0.f, 0.f}, {0.f, 0.f, 0.f, 0.f}}, aI[2] = {{0.f, 0.f, 0.f, 0.f}, {0.f, 0.f, 0.f, 0.f}};
#pragma unroll
            for (int ks = 0; ks < 2; ++ks)
#pragma unroll
                for (int m = 0; m < 2; ++m) { aR[m] = __builtin_amdgcn_mfma_f32_16x16x32_bf16(fa[m][ks], bR[b2][ks], aR[m], 0, 0, 0); aI[m] = __builtin_amdgcn_mfma_f32_16x16x32_bf16(fa[m][ks], bI[b2][ks], aI[m], 0, 0, 0); }
            float x[11];
#pragma unroll
            for (int r = 0; r < 11; ++r) x[r] = __builtin_bit_cast(float, (unsigned)(*(const LAS unsigned short*)(XR + (rb0 + r) * XL_RS + ch * 2)) << 16);
            float hl = 0.f, P = 1.f;
#pragma unroll
            for (int q = 0; q < 8; ++q) {
                const float u = cbv[b2] + c0[b2] * x[q] + c1[b2] * x[q + 1] + c2[b2] * x[q + 2] + c3[b2] * x[q + 3];
                const float r = sigmoidf_fast(aR[q >> 2][q & 3] + bra[b2]), ig = sigmoidf_fast(aI[q >> 2][q & 3] + bix[b2]);
                const float a = __builtin_amdgcn_exp2f(r * c8[b2]);
                const float b = __builtin_amdgcn_sqrtf(fmaxf(__builtin_fmaf(-a, a, 1.0f), 0.f)) * ig * u;
                hl = __builtin_fmaf(a, hl, b); P = P * a; hloc[b2][q] = hl; pc[b2][q] = P; }
            P8[b2] = P; H8[b2] = hl; }
        float Pf[2][4], Hf[2][4];
#pragma unroll
        for (int b2 = 0; b2 < 2; ++b2)
#pragma unroll
            for (int f = 0; f < 4; ++f) { Pf[b2][f] = __shfl(P8[b2], i16 + 16 * f); Hf[b2][f] = __shfl(H8[b2], i16 + 16 * f); }
        if (fq == 0) {
#pragma unroll
            for (int b2 = 0; b2 < 2; ++b2) { float hw = 0.f, pw = 1.f;
#pragma unroll
                for (int f = 0; f < 4; ++f) { hw = __builtin_fmaf(Pf[b2][f], hw, Hf[b2][f]); pw *= Pf[b2][f]; }
                SEG[(tt & 1) * 256 + wave * 32 + 16 * b2 + i16] = (f32x2v){pw, hw}; } }
        if (tt < 15) {
#pragma unroll
            for (int k = 0; k < 5; ++k) { const int idx = tid + k * (NWAVES * 64); if (idx < 259 * 8) *(LAS v4u*)(XN_ + (idx >> 3) * XL_RS + (idx & 7) * 16) = pf[k]; } }
        LDS_WAIT(); __syncthreads();
#pragma unroll
        for (int b2 = 0; b2 < 2; ++b2) { const int ch = 16 * (2 * hf + b2) + i16, gch = n * 64 + ch;
            float c = cin[b2], call = cin[b2];
#pragma unroll
            for (int w = 0; w < 8; ++w) { const f32x2v sg = SEG[(tt & 1) * 256 + w * 32 + 16 * b2 + i16]; call = __builtin_fmaf(sg.x, call, sg.y); if (w < wave) c = __builtin_fmaf(sg.x, c, sg.y); }
            cin[b2] = call;
#pragma unroll
            for (int f = 0; f < 4; ++f) if (f < fq) c = __builtin_fmaf(Pf[b2][f], c, Hf[b2][f]);
            bf16* hp = HP + (rowbase + 256 * tt + rb0) * 2048 + gch; float hlast = 0.f;
#pragma unroll
            for (int q = 0; q < 8; ++q) { const float h = __builtin_fmaf(pc[b2][q], c, hloc[b2][q]); hp[(size_t)q * 2048] = (bf16)f2bf(h); hlast = h; }
            if (tt == 15 && wave == 7 && fq == 3) p.out[OFF_HP + (size_t)s * DM + gch] = hlast; }
    }
}

__device__ __forceinline__ v4u pool_load8(const KP& p, const bf16* ZR, int pm, int tt, int run, int ch) {
    const bool samp = (pm == STILE); v4u w = {0u, 0u, 0u, 0u};
    if (!samp) { if (256 * (pm & 15) + tt >= 0) w = *(const v4u*)(ZR + (size_t)(pm * 256 + tt) * 2048 + 1024 + ch); }
    else { const int tl = tt - 16 * run;
        if (tl < 0) { const float* s = p.in[I_STPOOL] + (size_t)(run * 15 + 15 + tl) * DM + ch; const f32x4 a = *(const f32x4*)s, b = *(const f32x4*)(s + 4);
            w.x = pk2(a[0], a[1]); w.y = pk2(a[2], a[3]); w.z = pk2(b[0], b[1]); w.w = pk2(b[2], b[3]); }
        else w = *(const v4u*)(ZR + (size_t)(MP + tt) * 2048 + 1024 + ch); }
    return w;
}
__device__ __forceinline__ void unpack8(const v4u w, float (&v)[8]) { v[0] = bflo(w.x); v[1] = bfhi(w.x); v[2] = bflo(w.y); v[3] = bfhi(w.y); v[4] = bflo(w.z); v[5] = bfhi(w.z); v[6] = bflo(w.w); v[7] = bfhi(w.w); }
template <int W> __device__ __forceinline__ void pool_unit_w(const KP& p, int pm, int g, int tid) {
    const bf16* ZR = (const bf16*)(p.ws + WS_R1); bf16* HP = (bf16*)(p.ws + WS_R3);
    const bool samp = (pm == STILE);
    const int oct = tid & 31, run = tid >> 5, ch = 256 * g + 8 * oct;
#pragma unroll 1
    for (int hf = 0; hf < 2; ++hf) {
        const int tf = 16 * run + 8 * hf;
        const int pos0 = samp ? PAST : 256 * (pm & 15) + tf;
        v4u raw[W - 1 + 8];
#pragma unroll
        for (int r = 0; r < W - 1 + 8; ++r) raw[r] = pool_load8(p, ZR, pm, tf - (W - 1) + r, run, ch);
        float s[8];
#pragma unroll
        for (int e = 0; e < 8; ++e) s[e] = 0.f;
#pragma unroll
        for (int r = 0; r < W - 1; ++r) { float v[8]; unpack8(raw[r], v);
#pragma unroll
            for (int e = 0; e < 8; ++e) s[e] += v[e]; }
#pragma unroll
        for (int i = 0; i < 8; ++i) {
            const int cnt = min(pos0 + i + 1, W); const float inv = 1.0f / (float)cnt; float o[8], v[8], vo[8]; unpack8(raw[W - 1 + i], v); unpack8(raw[i], vo);
#pragma unroll
            for (int e = 0; e < 8; ++e) { s[e] += v[e]; o[e] = s[e] * inv - v[e]; }
            v4u ow; ow.x = pk2(o[0], o[1]); ow.y = pk2(o[2], o[3]); ow.z = pk2(o[4], o[5]); ow.w = pk2(o[6], o[7]);
            *(v4u*)(HP + (size_t)(pm * 256 + tf + i) * 2048 + 1024 + ch) = ow;
#pragma unroll
            for (int e = 0; e < 8; ++e) s[e] -= vo[e];
        }
    }
}
__device__ __forceinline__ void pool_unit(const KP& p, int pm, int g, int tid) {
    if (g == 0) pool_unit_w<2>(p, pm, g, tid); else if (g == 1) pool_unit_w<4>(p, pm, g, tid); else if (g == 2) pool_unit_w<8>(p, pm, g, tid); else pool_unit_w<16>(p, pm, g, tid);
}
constexpr int PL_RS = 272;
template <int W> __device__ __forceinline__ void pool_half_w(const KP& p, LAS unsigned char* lds, int pm, int g, int half, int tid) {
    const bf16* ZR = (const bf16*)(p.ws + WS_R1); bf16* HP = (bf16*)(p.ws + WS_R3);
    const int ch0 = 256 * g + 128 * half, t0seq = 256 * (pm & 15);
    __syncthreads();
    v4u st[9];
#pragma unroll
    for (int k = 0; k < 9; ++k) { const int idx = tid + k * (NWAVES * 64), row = idx >> 4, ck = idx & 15; st[k] = (v4u){0u, 0u, 0u, 0u};
        if (idx < 271 * 16 && t0seq + row - 15 >= 0) st[k] = *(const v4u*)(ZR + (size_t)(pm * 256 + row - 15) * 2048 + 1024 + ch0 + ck * 8); }
#pragma unroll
    for (int k = 0; k < 9; ++k) { const int idx = tid + k * (NWAVES * 64); if (idx < 271 * 16) *(LAS v4u*)(lds + (idx >> 4) * PL_RS + (idx & 15) * 16) = st[k]; }
    __syncthreads();
    const int oct = tid & 15, tf = 8 * (tid >> 4), pos0 = t0seq + tf;
    v4u raw[W - 1 + 8];
#pragma unroll
    for (int r = 0; r < W - 1 + 8; ++r) raw[r] = *(const LAS v4u*)(lds + (tf - (W - 1) + r + 15) * PL_RS + oct * 16);
    float s[8];
#pragma unroll
    for (int e = 0; e < 8; ++e) s[e] = 0.f;
#pragma unroll
    for (int r = 0; r < W - 1; ++r) { float v[8]; unpack8(raw[r], v);
#pragma unroll
        for (int e = 0; e < 8; ++e) s[e] += v[e]; }
#pragma unroll
    for (int i = 0; i < 8; ++i) {
        const int cnt = min(pos0 + i + 1, W); const float inv = __builtin_amdgcn_rcpf((float)cnt); float o[8], v[8], vo[8]; unpack8(raw[W - 1 + i], v); unpack8(raw[i], vo);
#pragma unroll
        for (int e = 0; e < 8; ++e) { s[e] += v[e]; o[e] = s[e] * inv - v[e]; }
        v4u ow; ow.x = pg8::cvt_pk_bf16(o[0], o[1]); ow.y = pg8::cvt_pk_bf16(o[2], o[3]); ow.z = pg8::cvt_pk_bf16(o[4], o[5]); ow.w = pg8::cvt_pk_bf16(o[6], o[7]);
        *(v4u*)(HP + (size_t)(pm * 256 + tf + i) * 2048 + 1024 + ch0 + oct * 8) = ow;
#pragma unroll
        for (int e = 0; e < 8; ++e) s[e] -= vo[e];
    }
}
__device__ __forceinline__ void pool_half(const KP& p, LAS unsigned char* lds, int pm, int g, int half, int tid) {
    if (g == 0) pool_half_w<2>(p, lds, pm, g, half, tid); else if (g == 1) pool_half_w<4>(p, lds, pm, g, half, tid); else if (g == 2) pool_half_w<8>(p, lds, pm, g, half, tid); else pool_half_w<16>(p, lds, pm, g, half, tid);
}
__device__ __forceinline__ void state_copy(const KP& p, int gtid, int gthreads) {
    const bf16* ZR = (const bf16*)(p.ws + WS_R1);
    constexpr int N1 = NBATCH * 3 * DM, N2 = NBATCH * 15 * DM, N3 = SBATCH * 3 * DM, N4 = SBATCH * 15 * DM;
    constexpr int NT = N1 + N2 + N3 + N4;
    for (int i0 = gtid; i0 < NT; i0 += 4 * gthreads) {
        unsigned short raw[4]; float* dsts[4];
#pragma unroll
        for (int k = 0; k < 4; ++k) { const int i = i0 + k * gthreads; raw[k] = 0; dsts[k] = nullptr;
            if (i < NT) { int r = i; size_t row, col; float* dst;
                if (r < N1) { const int b = r / (3 * DM), kk = (r / DM) % 3, c = r % DM; row = (size_t)b * SEQ + SEQ - 3 + kk; col = c; dst = p.out + OFF_LCP + r; }
                else if ((r -= N1) < N2) { const int b = r / (15 * DM), kk = (r / DM) % 15, c = r % DM; row = (size_t)b * SEQ + SEQ - 15 + kk; col = 1024 + c; dst = p.out + OFF_PLP + r; }
                else if ((r -= N2) < N3) { const int b = r / (3 * DM), kk = (r / DM) % 3, c = r % DM; row = (size_t)MP + b * SSEQ + SSEQ - 3 + kk; col = c; dst = p.out + OFF_LCS + r; }
                else { r -= N3; const int b = r / (15 * DM), kk = (r / DM) % 15, c = r % DM; row = (size_t)MP + b * SSEQ + SSEQ - 15 + kk; col = 1024 + c; dst = p.out + OFF_PLS + r; }
                raw[k] = ZR[row * 2048 + col]; dsts[k] = dst; } }
#pragma unroll
        for (int k = 0; k < 4; ++k) if (dsts[k]) *dsts[k] = __builtin_bit_cast(float, (unsigned)raw[k] << 16);
    }
}

template <int MODE = 0> __device__ __forceinline__ void strip_pre(const KP& p, LAS unsigned char* lds, int pm0, int pn, int cnt, int tid, int lane, int wave) {
    const float* SSQ = (const float*)(p.ws + WS_SSQ); const bf16* XG2 = (const bf16*)(p.ws + WS_R1); const bf16* Wup_t = (const bf16*)(p.ws + WS_WUP);
    LAS float* RS = (LAS float*)(lds + RS_OFF); LAS float* ES = (LAS float*)(lds + EDGE_START_OFF); LAS float* CWL = (LAS float*)(lds + CWL_OFF);
    __syncthreads();
#pragma unroll
    for (int k = 0; k < 2; ++k) { const int idx = tid + k * (NWAVES * 64), vec = idx >> 8, col = idx & 255, oc = (col >> 7) * DFF + 128 * pn + (col & 127);
        CWL[idx] = vec < 3 ? p.in[I_CFW][(size_t)vec * DUP + oc] : p.in[I_CFB][oc]; }
    if (MODE != 2) for (int i = tid; i < cnt * 256; i += NWAVES * 64) RS[i] = row_rs(SSQ, (size_t)pm0 * 256 + i);
    ES[tid] = 0.f;
    __syncthreads();
}

__device__ __forceinline__ void strip_fix(const KP& p, int gtid, int gthreads) {
    const float* HA = (const float*)(p.ws + WS_HA); const float* HB = (const float*)(p.ws + WS_HB); bf16* ACT = (bf16*)(p.ws + WS_R2);
    const float* cw = p.in[I_CFW]; const float* cb = p.in[I_CFB];
    for (int i = gtid; i < 32 * 24 * 128; i += gthreads) {
        const int c = i & 127, sp = i >> 7, pn = sp % 24, sr = sp / 24;
        if ((sr & 3) == 0) continue;
        const float* ha = HA + (size_t)sp * 512; const float* hb = HB + (size_t)sp * 512;
        float hg[4], hv[4];
        hg[0] = ha[c]; hg[1] = ha[256 + c]; hg[2] = hb[c]; hg[3] = hb[256 + c];
        hv[0] = ha[128 + c]; hv[1] = ha[384 + c]; hv[2] = hb[128 + c]; hv[3] = hb[384 + c];
        const int og = 128 * pn + c, ov = DFF + og;
        const float g0 = cw[og], g1 = cw[DUP + og], g2 = cw[2 * DUP + og], gb = cb[og], v0 = cw[ov], v1 = cw[DUP + ov], v2 = cw[2 * DUP + ov], vb = cb[ov];
#pragma unroll
        for (int t = 0; t < 2; ++t) { const float cg = gb + g0 * hg[t] + g1 * hg[t + 1] + g2 * hg[t + 2], cv = vb + v0 * hv[t] + v1 * hv[t + 1] + v2 * hv[t + 2];
            ACT[((size_t)sr * 1024 + t) * DFF + og] = (bf16)f2bf(gelu_tanh(cg) * cv); }
    }
}

__device__ __forceinline__ void final_norm(const KP& p, int gw, int NGW, int lane) {
    const float* SSQ2 = (const float*)(p.ws + WS_SSQ2); const float* gf = p.in[I_NFIN];
    f32x4 gv[4];
#pragma unroll
    for (int j = 0; j < 4; ++j) gv[j] = *((const f32x4*)gf + lane + 64 * j);
    for (int m = gw; m < M; m += NGW) {
        const float sv = (lane < 8) ? SSQ2[(size_t)m * 8 + lane] : 0.f;
        const float rstd = 1.0f / sqrtf(wave_sum(sv) * (1.f / DM) + EPS);
        f32x4* yr = (f32x4*)(p.out + OFF_Y + (size_t)m * DM) + lane;
#pragma unroll
        for (int j = 0; j < 4; ++j) { const f32x4 v = yr[64 * j]; yr[64 * j] = v * rstd * gv[j]; }
    }
}
#ifndef MK_ONE_LAUNCH
#define MK_ONE_LAUNCH 1
#endif
#ifndef PG8_SP2
#define PG8_SP2 true
#endif
#ifndef PG8_ALIGN
#define PG8_ALIGN true
#endif
#ifndef FUSE_FINAL
#define FUSE_FINAL 1
#endif
constexpr int N_PHASES = 11;
__global__ void __launch_bounds__(NWAVES * 64, 2) mk_fwd(KP p) {
    extern __shared__ __attribute__((aligned(16))) unsigned char lds_raw[];
    LAS unsigned char* lds = (LAS unsigned char*)lds_raw;
    const int tid = threadIdx.x, lane = tid & 63, wave = __builtin_amdgcn_readfirstlane(tid >> 6);
    const int G = gridDim.x, bx = blockIdx.x, vcu = (G % 8 == 0) ? (bx % 8) * (G / 8) + bx / 8 : bx;
    volatile LAS unsigned* MISC = (volatile LAS unsigned*)(lds + MISC_OFF);
    if (tid < 32) MISC[tid] = 0u;
    __syncthreads();
    unsigned* ctl = (unsigned*)(p.ws + WS_CTL);
    const int lo = p.ph_lo, hi = p.ph_hi;
    XcdBarrier bar; bar.bar = ctl + CW_BAR; bar.x = 0; bar.st = MISC + 8;
    if (hi - lo > 1) bar = xcd_barrier_post(ctl + CW_BAR, MISC + 8);
#ifndef PH_MASK
#define PH_MASK 0xfff
#endif
#define IN(k) (((PH_MASK >> (k)) & 1) && lo <= (k) && (k) < hi)
#ifndef REP_MASK
#define REP_MASK 0
#endif
#define PH(k) if (IN(k)) for (int rep_ = 0; rep_ <= ((REP_MASK >> (k)) & 1); ++rep_)
#define REPBAR() do { if (rep_) xcd_barrier(bar); } while (0)
#define SEAM(k) do { if (IN(k) && IN((k) + 1)) xcd_barrier(bar); } while (0)
    unsigned char* ws = p.ws;
    bf16* XN = (bf16*)(ws + WS_R0); bf16* MG = (bf16*)(ws + WS_R0); bf16* ZR = (bf16*)(ws + WS_R1); bf16* XG2 = (bf16*)(ws + WS_R1);
    bf16* GT = (bf16*)(ws + WS_R2); bf16* HP = (bf16*)(ws + WS_R3); bf16* ACT = (bf16*)(ws + WS_R2);
    bf16* Win_t = (bf16*)(ws + WS_WIN); bf16* Wcat_t = (bf16*)(ws + WS_WCAT); bf16* Wout_t = (bf16*)(ws + WS_WOUT); bf16* Wup_t = (bf16*)(ws + WS_WUP); bf16* Wdn_t = (bf16*)(ws + WS_WDN);
    float* SSQ = (float*)(ws + WS_SSQ); float* SSQ2 = (float*)(ws + WS_SSQ2);
    float* Y = p.out + OFF_Y;

    PH(0) { REPBAR(); p0_prologue(p, lds, vcu, G, wave, lane); }
    SEAM(0);
    PH(1) { REPBAR();
        pg8::Gemm g{XN, Win_t, DM, DM, DM}; pg8::StaticOrder S; S.init(MP, DIN, G, bx);
        EpiZ E{ZR, GT};
        const bool wfirst = (G > 64) && bx >= 64 && (bx & 1);
        for (int su = bx; su < 48; su += G) { if (su < 32) pg8::sub_gemm<1>(lds, g, STILE, su >> 2, (su >> 1) & 1, su & 1, E); else pg8::sub_gemm<2>(lds, g, STILE, 8 + ((su - 32) >> 1), su & 1, 0, E); }
        if (wfirst) { p1_weights(p, lds, (bx - 64) * NWAVES + wave, (G - 64) * NWAVES, wave, lane); __syncthreads(); }
        pg8::gemm_phase<EpiZ, pg8::StaticOrder, PG8_ALIGN, PG8_SP2>(lds, g, S, E);
        if (G > 64) { if (bx >= 64 && !wfirst) p1_weights(p, lds, (bx - 64) * NWAVES + wave, (G - 64) * NWAVES, wave, lane); } else p1_weights(p, lds, bx * NWAVES + wave, G * NWAVES, wave, lane);
    }
    SEAM(1);
    PH(2) { REPBAR();
        state_copy(p, bx * NWAVES * 64 + tid, G * NWAVES * 64);
        for (int su = bx; su < 64; su += G) {
            const int g_ = su >> 4, q = su & 15; pg8::Gemm gw_{(const bf16*)(ws + WS_WBP) + 256 * g_, (const bf16*)(ws + WS_WPOOL) + (size_t)g_ * 65536, 256, DM, 256};
            EpiW EW{Wcat_t + 1024 + 256 * g_}; pg8::sub_gemm<1>(lds, gw_, q >> 2, 0, (q >> 1) & 1, q & 1, EW); }
        const bool pool_first = ((bx >> 3) & 1) != 0;
        if (pool_first) { for (int L = bx; L < 4 * 2 * STILE; L += G) { const int g_ = L / (2 * STILE), r = L % (2 * STILE); pool_half(p, lds, r >> 1, g_, r & 1, tid); } }
        for (int t = bx; t < NBATCH * 32; t += G) lru_task(p, lds, t >> 5, (t >> 1) & 15, t & 1, tid, lane, wave);
        for (int L = bx; L < 16 + 4; L += G) {
            if (L < 16) lru_unit<true>(p, lds, STILE, L, tid, lane, wave);
            else pool_unit(p, STILE, L - 16, tid);
        }
        if (!pool_first) { for (int L = bx; L < 4 * 2 * STILE; L += G) { const int g_ = L / (2 * STILE), r = L % (2 * STILE); pool_half(p, lds, r >> 1, g_, r & 1, tid); } }
    }
    if (IN(2) && IN(4)) xcd_barrier(bar);
    PH(4) { REPBAR();
        pg8::Gemm g{HP, Wcat_t, 2048, 2048, 2048}; pg8::StaticOrder S; S.init(MP, DM, G, bx);
        EpiBr E{GT, MG};
        pg8::gemm_phase<EpiBr, pg8::StaticOrder, PG8_ALIGN, PG8_SP2>(lds, g, S, E);
        for (int su = bx; su < 16; su += G) pg8::sub_gemm<1>(lds, g, STILE, su >> 2, (su >> 1) & 1, su & 1, E);
    }
    if (IN(4) && IN(6)) xcd_barrier(bar);
    PH(6) { REPBAR();
        pg8::Gemm g{MG, Wout_t, DM, DM, DM}; pg8::StaticOrder S; S.init(MP, DM, G, bx);
        EpiRes<false> E{p.in[I_XP], p.in[I_XS], Y, XG2, SSQ, lds};
        pg8::gemm_phase<EpiRes<false>, pg8::StaticOrder, true  , PG8_SP2>(lds, g, S, E);
        for (int su = bx; su < 16; su += G) pg8::sub_gemm<1>(lds, g, STILE, su >> 2, (su >> 1) & 1, su & 1, E);
    }
    SEAM(6);
    PH(7) { REPBAR();
        pg8::Gemm g{XG2, Wup_t, DM, DM, DM};
        { EpiUpS ES{ACT, p.in[I_CFW], p.in[I_CFB], p.in[I_STFFN], p.out + OFF_FCS, SSQ};
          for (int su = bx; su < 48; su += G) pg8::sub_gemm<2>(lds, g, STILE, su >> 1, su & 1, 0, ES); }
        for (int sidx = vcu; sidx < 768; sidx += G) {
            const int rg = sidx >> 8, v = sidx & 255, x = v >> 5, w = v & 31, pm0 = 4 * (4 * x + (w >> 3)), pn = 8 * rg + (w & 7);
            strip_pre(p, lds, pm0, pn, 4, tid, lane, wave);
            pg8::StripOrder S{pm0, pn, 4};
            EpiUp E{ACT, p.in[I_CFW], p.in[I_CFB], p.in[I_STFFN], p.out + OFF_FCP, p.out + OFF_FCS, lds, pm0, nullptr, (float*)(ws + WS_HA), (float*)(ws + WS_HB)};
            pg8::gemm_phase<EpiUp, pg8::StripOrder, true, PG8_SP2>(lds, g, S, E);
        }
    }
    SEAM(7);
    PH(8) { REPBAR(); strip_fix(p, bx * NWAVES * 64 + tid, G * NWAVES * 64); }
    SEAM(8);
    const bool fuse_final = (G == 256) && FUSE_FINAL;
    PH(9) { REPBAR();
        pg8::Gemm g{ACT, Wdn_t, DFF, DFF, DFF}; pg8::StaticOrder S; S.init(MP, DM, G, bx);
        if (fuse_final) {
            EpiFinal E{Y, XG2, p.in[I_NFIN], SSQ2, ctl + CW_PANEL, ctl + CW_BAR + XB_TMO, lds};
            pg8::gemm_phase<EpiFinal, pg8::StaticOrder, true  , PG8_SP2>(lds, g, S, E);
            for (int su = bx; su < 16; su += G) pg8::sub_gemm<1>(lds, g, STILE, su >> 2, (su >> 1) & 1, su & 1, E);
        } else {
            EpiRes<true> E{nullptr, nullptr, Y, XG2, SSQ2, lds};
            pg8::gemm_phase<EpiRes<true>, pg8::StaticOrder, true, PG8_SP2>(lds, g, S, E);
            for (int su = bx; su < 16; su += G) pg8::sub_gemm<1>(lds, g, STILE, su >> 2, (su >> 1) & 1, su & 1, E);
        }
    }
#ifndef EXP
#define EXP 0
#endif
#if EXP != 0
    if (lo == 11) {
#if EXP == 1
        pg8::Gemm g{XG2, Wup_t, DM, DM, DM};
        for (int sidx = vcu; sidx < 768; sidx += G) {
            const int rg = sidx >> 8, v = sidx & 255, x = v >> 5, w = v & 31, pm0 = 4 * (4 * x + (w >> 3)), pn = 8 * rg + (w & 7);
            pg8::StripOrder S{pm0, pn, 4}; EpiNull<true> E;
            pg8::gemm_phase<EpiNull<true>, pg8::StripOrder, true, PG8_SP2>(lds, g, S, E);
        }
#elif EXP == 2
        pg8::Gemm g{XN, Win_t, DM, DM, DM}; pg8::StaticOrder S; S.init(MP, DIN, G, bx); EpiNull<false> E;
        pg8::gemm_phase<EpiNull<false>, pg8::StaticOrder, PG8_ALIGN, PG8_SP2>(lds, g, S, E);
#elif EXP == 3
        pg8::Gemm g{XG2, Wup_t, DM, DM, DM}; pg8::StaticOrder S; S.init(MP, DUP, G, bx); EpiNull<true> E;
        pg8::gemm_phase<EpiNull<true>, pg8::StaticOrder, true, PG8_SP2>(lds, g, S, E);
#elif EXP == 5
        pg8::Gemm g{XN, Win_t, DM, DM, DM}; pg8::StaticOrder S; S.init(MP, DIN, G, bx); EpiZScratch E{HP + (size_t)bx * 65536};
        pg8::gemm_phase<EpiZScratch, pg8::StaticOrder, PG8_ALIGN, PG8_SP2>(lds, g, S, E);
#elif EXP == 6
        pg8::Gemm g{XG2, Wup_t, DM, DM, DM};
        for (int sidx = vcu; sidx < 768; sidx += G) {
            const int rg = sidx >> 8, v = sidx & 255, x = v >> 5, w = v & 31, pm0 = 4 * (4 * x + (w >> 3)), pn = 8 * rg + (w & 7);
            strip_pre(p, lds, pm0, pn, 4, tid, lane, wave);
            pg8::StripOrder S{pm0, pn, 4};
            EpiUp E{ACT, p.in[I_CFW], p.in[I_CFB], p.in[I_STFFN], p.out + OFF_FCP, p.out + OFF_FCS, lds, pm0, HP + (size_t)bx * 256 * 128, nullptr, nullptr};
            pg8::gemm_phase<EpiUp, pg8::StripOrder, true, PG8_SP2>(lds, g, S, E);
        }
#elif EXP == 7
        pg8::Gemm g{XG2, Wup_t, DM, DM, DM};
        for (int sidx = vcu; sidx < 768; sidx += G) {
            const int rg = sidx >> 8, v = sidx & 255, x = v >> 5, w = v & 31, pm0 = 4 * (4 * x + (w >> 3)), pn = 8 * rg + (w & 7);
            strip_pre(p, lds, pm0, pn, 4, tid, lane, wave);
            pg8::StripOrder S{pm0, pn, 4}; EpiNull<true> E;
            pg8::gemm_phase<EpiNull<true>, pg8::StripOrder, true, PG8_SP2>(lds, g, S, E);
        }
#elif EXP == 8 || EXP == 9
        pg8::Gemm g{XG2, Wup_t, DM, DM, DM};
        for (int sidx = vcu; sidx < 768; sidx += G) {
            const int rg = sidx >> 8, v = sidx & 255, x = v >> 5, w = v & 31, pm0 = 4 * (4 * x + (w >> 3)), pn = 8 * rg + (w & 7);
            strip_pre<EXP - 7>(p, lds, pm0, pn, 4, tid, lane, wave);
            pg8::StripOrder S{pm0, pn, 4}; EpiNull<true> E;
            pg8::gemm_phase<EpiNull<true>, pg8::StripOrder, true, PG8_SP2>(lds, g, S, E);
        }
#elif EXP == 10
        pg8::Gemm g{ACT, Wdn_t, DFF, DFF, DFF}; EpiNull<false> E;
        for (int su = bx; su < 16; su += G) pg8::sub_gemm<1>(lds, g, STILE, su >> 2, (su >> 1) & 1, su & 1, E);
#elif EXP == 11
        pg8::Gemm g{XN, Win_t, DM, DM, DM}; EpiNull<false> E;
        for (int su = bx; su < 64; su += G) pg8::sub_gemm<1>(lds, g, STILE, su >> 2, (su >> 1) & 1, su & 1, E);
#elif EXP == 12
        for (int t = bx; t < NBATCH * 32; t += G) lru_task(p, lds, t >> 5, (t >> 1) & 15, t & 1, tid, lane, wave);
#elif EXP == 13
        for (int L = bx + 16; L < 16 + NTILE * 4; L += G) { const int r = L - 16; pool_unit(p, r >> 2, r & 3, tid); }
#elif EXP == 4
        pg8::Gemm g{ACT, Wdn_t, DFF, DFF, DFF}; pg8::StaticOrder S; S.init(MP, DM, G, bx); EpiNull<false> E;
        pg8::gemm_phase<EpiNull<false>, pg8::StaticOrder, true, PG8_SP2>(lds, g, S, E);
#endif
    }
#endif
    if (!fuse_final) { SEAM(9);
        PH(10) { REPBAR(); final_norm(p, vcu * NWAVES + wave, G * NWAVES, lane); } }
#undef IN
#undef SEAM
}

extern "C" void kernel_launch(void* const* d_in, const int* in_sizes, int n_in, void* d_out, int out_size, void* d_ws, size_t ws_size, hipStream_t stream) {
    static int grid = 0;
    if (grid == 0) {
        if (n_in != 26 || in_sizes[0] != MP * DM || (size_t)out_size != OUT_TOTAL || ws_size < WS_END) {
            fprintf(stderr, "kernel_launch: unexpected shapes: n_in %d in0 %d out %d ws %zu (need %zu)\n", n_in, n_in > 0 ? in_sizes[0] : -1, out_size, ws_size, (size_t)WS_END); grid = -1; return; }
        int dev = 0, cus = 0, per_cu = 0;
        if (hipGetDevice(&dev) != hipSuccess || hipDeviceGetAttribute(&cus, hipDeviceAttributeMultiprocessorCount, dev) != hipSuccess) { fprintf(stderr, "kernel_launch: device query failed\n"); grid = -1; return; }
        if (hipFuncSetAttribute((const void*)mk_fwd, hipFuncAttributeMaxDynamicSharedMemorySize, LDS_BYTES) != hipSuccess) { fprintf(stderr, "kernel_launch: hipFuncSetAttribute failed\n"); grid = -1; return; }
        if (hipOccupancyMaxActiveBlocksPerMultiprocessor(&per_cu, (const void*)mk_fwd, NWAVES * 64, LDS_BYTES) != hipSuccess || per_cu < 1) {
            fprintf(stderr, "kernel_launch: occupancy query reports %d blocks per CU\n", per_cu); (void)hipGetLastError(); per_cu = 1; }
        grid = cus;
        fprintf(stderr, "kernel_launch: grid %d (cus %d, occupancy %d/CU)\n", grid, cus, per_cu);
    }
    if (grid < 0) return;
    if (hipMemsetAsync((char*)d_ws + WS_CTL, 0, CTL_ZERO_BYTES, stream) != hipSuccess) { fprintf(stderr, "kernel_launch: memset failed\n"); return; }
    KP a{};
    for (int i = 0; i < 26; ++i) a.in[i] = (const float*)d_in[i];
    a.out = (float*)d_out; a.ws = (unsigned char*)d_ws;
#if MK_ONE_LAUNCH
    a.ph_lo = 0; a.ph_hi = N_PHASES;
    hipLaunchKernelGGL(mk_fwd, dim3(grid), dim3(NWAVES * 64), LDS_BYTES, stream, a);
#else
#ifndef PROBE_PHASE
#define PROBE_PHASE -1
#endif
    { const int phs[10] = {0, 1, 2, 4, 6, 7, 8, 9, 10, 11};
      for (int i = 0; i < 10; ++i) { if (phs[i] == 10 && FUSE_FINAL) continue; if (phs[i] == 11 && EXP == 0) continue; const int k = phs[i]; a.ph_lo = k; a.ph_hi = k + 1;
          for (int rep = 0; rep < (k == PROBE_PHASE ? 2 : 1); ++rep) hipLaunchKernelGGL(mk_fwd, dim3(grid), dim3(NWAVES * 64), LDS_BYTES, stream, a); } }
#endif
    const hipError_t le = hipPeekAtLastError();
    if (le != hipSuccess) fprintf(stderr, "kernel_launch: launch failed: %s\n", hipGetErrorName(le));
}
```

```cpp
#include <hip/hip_runtime.h>
#include <cstdio>
#include <cstdint>
#define MK_ONE_LAUNCH 1
namespace pg8 {
#define PG8_LAS __attribute__((address_space(3)))
typedef unsigned short bf16_t;
typedef short bf16x8 __attribute__((ext_vector_type(8)));
typedef float f32x4 __attribute__((ext_vector_type(4)));
typedef unsigned u32x4 __attribute__((ext_vector_type(4)));
typedef unsigned u32x2 __attribute__((ext_vector_type(2)));
constexpr int BM = 256, BK = 64, HALF = 128, HTB = HALF * BK * 2  , STAGE_BYTES = 8 * HTB, NXCD = 8, WGM = 8;

__host__ __device__ __forceinline__ int lds_byte(int r, int c) { const int st = (r >> 4) * 2 + (c >> 5), rr = r & 15, cc = c & 31, ob = rr * 64 + cc * 2; return st * 1024 + (ob ^ (((ob >> 9) & 1) << 5)); }
__host__ __device__ __forceinline__ void stage_rc(int b, int& R, int& C) { const int st = b / 1024, sb = b % 1024, swz = sb ^ (((sb >> 9) & 1) << 5); R = (st >> 1) * 16 + swz / 64; C = (st & 1) * 32 + (swz % 64) / 2; }
__host__ __device__ __forceinline__ int perm32(int rho) { const int n = rho >> 4, i = rho & 15; return 8 * (i >> 2) + 4 * n + (i & 3); }
__host__ __device__ __forceinline__ int amap_row(int R) { return 128 * (R >> 6) + 8 * (R & 15) + ((R >> 4) & 3); }

struct Unit { int pm, pn; };
struct Gemm { const bf16_t* A; const bf16_t* Bt; int K, lda, ldb; };

struct StaticOrder {
    int nM, nN, nwg, G, c;
    __host__ __device__ void init(int M, int N, int G_, int c_) { nM = M / BM; nN = N / BM; nwg = nM * nN; G = G_; c = c_; }
    __host__ __device__ bool next(int i, Unit& u) const {
        const long L = (long)i * G + c; if (L >= nwg) return false;
        int wgid = (int)L; { const int q = nwg / NXCD, r = nwg % NXCD, xcd = wgid % NXCD, off = wgid / NXCD; wgid = (xcd < r ? xcd * (q + 1) : r * (q + 1) + (xcd - r) * q) + off; }
        const int nig = WGM * nN, gid = wgid / nig, fm = gid * WGM, gsz = (nM - fm) < WGM ? (nM - fm) : WGM;
        u.pm = fm + ((wgid % nig) % gsz); u.pn = (wgid % nig) / gsz; return true;
    }
    __device__ __forceinline__ void a_ready(const Unit&) const {}
    __device__ __forceinline__ void done(const Unit&) const {}
};
struct StripOrder {
    int pm0, pn, cnt;
    __device__ __forceinline__ bool next(int i, Unit& u) const { if (i >= cnt) return false; u.pm = pm0 + i; u.pn = pn; return true; }
    __device__ __forceinline__ void a_ready(const Unit&) const {}
    __device__ __forceinline__ void done(const Unit&) const {}
};

__device__ __forceinline__ unsigned cvt_pk_bf16(float lo, float hi) { unsigned r; asm volatile("v_cvt_pk_bf16_f32 %0, %1, %2" : "=v"(r) : "v"(lo), "v"(hi)); return r; }

template <class Epi, class Sched, bool ALIGN_EPI = false, bool SP2 = false>
__device__ __forceinline__ void gemm_phase(PG8_LAS unsigned char* lds, const Gemm g, const Sched& S, const Epi& E) {
    const int tid = threadIdx.x, wid = __builtin_amdgcn_readfirstlane(tid >> 6), lane = tid & 63, wr = wid >> 2, wc = wid & 3, fr = lane & 15, fq = lane >> 4;
    const int K = g.K, nt = K / BK;
    unsigned voffA[2], voffB[2];
#pragma unroll
    for (int i = 0; i < 2; ++i) { int R, C; stage_rc(tid * 16 + i * 8192, R, C); const int Rb = Epi::PERM ? ((R & ~31) + perm32(R & 31)) : R; const int Ra = Epi::AMAP ? amap_row(R) : R;
        voffA[i] = (unsigned)(Ra * g.lda + C) * 2u; voffB[i] = (unsigned)(Rb * g.ldb + C) * 2u; }
    const size_t kstep = (size_t)(BK * 2);
    const size_t hstepA = Epi::AMAP ? (size_t)4 * g.lda * 2 : (size_t)HALF * g.lda * 2;
    const size_t hstepB = (size_t)HALF * g.ldb * 2;
    const size_t tstepA = (size_t)BM * g.lda * 2, tstepB = (size_t)BM * g.ldb * 2;
    const unsigned ldsw = (unsigned)wid * 1024u;
    const int aoff = lds_byte(wr * 64 + fr, fq * 8), boff = lds_byte(wc * 32 + fr, fq * 8);
#define PG8_SA(b, h) (((b) * 2 + (h)) * HTB)
#define PG8_SB(b, h) ((4 + (b) * 2 + (h)) * HTB)
#define PG8_STAGE(bufoff, gbase, voff) do { _Pragma("unroll") for (int _i = 0; _i < 2; ++_i) \
        __builtin_amdgcn_global_load_lds((const unsigned*)((const char*)(gbase) + (voff)[_i]), (PG8_LAS unsigned*)(lds + (bufoff) + ldsw + _i * 8192), 16, 0, 0); } while (0)
#define PG8_LDA(dst, b, h) do { _Pragma("unroll") for (int m = 0; m < 4; ++m) _Pragma("unroll") for (int k = 0; k < 2; ++k) dst[m][k] = *(const PG8_LAS bf16x8*)(lds + PG8_SA(b, h) + aoff + m * 2048 + k * 1024); } while (0)
#define PG8_LDB(dst, b, h) do { _Pragma("unroll") for (int n = 0; n < 2; ++n) _Pragma("unroll") for (int k = 0; k < 2; ++k) dst[n][k] = *(const PG8_LAS bf16x8*)(lds + PG8_SB(b, h) + boff + n * 2048 + k * 1024); } while (0)
#define PG8_MMA(ai, bj, At, Bt) do { __builtin_amdgcn_s_setprio(1); _Pragma("unroll") for (int m = 0; m < 4; ++m) _Pragma("unroll") for (int n = 0; n < 2; ++n) _Pragma("unroll") for (int k = 0; k < 2; ++k) \
        acc[ai][bj][m][n] = __builtin_amdgcn_mfma_f32_16x16x32_bf16(Bt[n][k], At[m][k], acc[ai][bj][m][n], 0, 0, 0); __builtin_amdgcn_s_setprio(0); } while (0)
#define PG8_WAIT_V(n) asm volatile("s_waitcnt vmcnt(" #n ")" ::: "memory")
#define PG8_WAIT_L(n) asm volatile("s_waitcnt lgkmcnt(" #n ")" ::: "memory")
#define PG8_BAR __builtin_amdgcn_s_barrier()
#define PG8_SCHED __builtin_amdgcn_sched_barrier(0)
    Unit cur, nxt; int ui = 0;
    if (!S.next(0, cur)) return;
    f32x4 acc[2][2][4][2];
#pragma unroll
    for (int a = 0; a < 2; ++a)
#pragma unroll
        for (int b = 0; b < 2; ++b)
#pragma unroll
            for (int m = 0; m < 4; ++m)
#pragma unroll
                for (int n = 0; n < 2; ++n) acc[a][b][m][n] = (f32x4){0.f, 0.f, 0.f, 0.f};
    bf16x8 At[4][2], B0[2][2], B1[2][2];
    const char* cA = (const char*)g.A + (size_t)cur.pm * tstepA; const char* cB = (const char*)g.Bt + (size_t)cur.pn * tstepB;
    S.a_ready(cur);
    if constexpr (SP2) {
        PG8_STAGE(PG8_SB(0, 0), cB, voffB); PG8_STAGE(PG8_SB(0, 1), cB + hstepB, voffB); PG8_STAGE(PG8_SA(0, 0), cA, voffA); PG8_STAGE(PG8_SA(0, 1), cA + hstepA, voffA);
        if (wr == 1) PG8_BAR;
        PG8_WAIT_V(2); PG8_BAR;
        PG8_STAGE(PG8_SB(1, 0), cB + kstep, voffB); PG8_STAGE(PG8_SA(1, 0), cA + kstep, voffA); PG8_STAGE(PG8_SB(1, 1), cB + hstepB + kstep, voffB);
        PG8_WAIT_V(6); PG8_BAR;
    } else {
        PG8_STAGE(PG8_SB(0, 0), cB, voffB); PG8_STAGE(PG8_SA(0, 0), cA, voffA); PG8_STAGE(PG8_SB(0, 1), cB + hstepB, voffB); PG8_STAGE(PG8_SA(0, 1), cA + hstepA, voffA);
        if (wr == 1) PG8_BAR;
        PG8_WAIT_V(4); PG8_BAR;
        PG8_STAGE(PG8_SB(1, 0), cB + kstep, voffB); PG8_STAGE(PG8_SA(1, 0), cA + kstep, voffA); PG8_STAGE(PG8_SB(1, 1), cB + hstepB + kstep, voffB);
        PG8_WAIT_V(6); PG8_BAR;
    }
    for (;;) {
        const bool has_next = S.next(ui + 1, nxt);
        const char* nA = has_next ? (const char*)g.A + (size_t)nxt.pm * tstepA : cA; const char* nB = has_next ? (const char*)g.Bt + (size_t)nxt.pn * tstepB : cB;
        for (int t = 0; t < nt; t += 2) {
            const bool last = (t == nt - 2);
            const char* a1 = cA + (size_t)(t + 1) * kstep;
            const char* a2 = last ? nA : cA + (size_t)(t + 2) * kstep; const char* b2 = last ? nB : cB + (size_t)(t + 2) * kstep;
            const char* a3 = a2 + kstep; const char* b3 = b2 + kstep;
            if (last && has_next) S.a_ready(nxt);
            if constexpr (Epi::MID) { if (t == (nt >> 1)) {
                if (wr == 0) PG8_BAR; E.template mid<2, 2>(acc, cur, 0, 0, wr, wc, fr, fq); if (wr == 1) PG8_BAR; } }
            if constexpr (SP2) {
            PG8_LDB(B0, 0, 0); PG8_LDB(B1, 0, 1); PG8_SCHED; PG8_LDA(At, 0, 0); PG8_STAGE(PG8_SA(1, 1), a1 + hstepA, voffA);
            PG8_WAIT_V(8); PG8_WAIT_L(0); PG8_BAR; PG8_MMA(0, 0, At, B0); PG8_MMA(0, 1, At, B1); PG8_BAR; PG8_SCHED;
            PG8_LDA(At, 0, 1); PG8_STAGE(PG8_SB(0, 0), b2, voffB); PG8_STAGE(PG8_SB(0, 1), b2 + hstepB, voffB); PG8_STAGE(PG8_SA(0, 0), a2, voffA);
            PG8_WAIT_V(8); PG8_WAIT_L(0); PG8_BAR; PG8_MMA(1, 0, At, B0); PG8_MMA(1, 1, At, B1); PG8_BAR; PG8_SCHED;
            PG8_LDB(B0, 1, 0); PG8_LDB(B1, 1, 1); PG8_SCHED; PG8_LDA(At, 1, 0); PG8_STAGE(PG8_SA(0, 1), a2 + hstepA, voffA);
            PG8_WAIT_V(8); PG8_WAIT_L(0); PG8_BAR; PG8_MMA(0, 0, At, B0); PG8_MMA(0, 1, At, B1); PG8_BAR; PG8_SCHED;
            PG8_LDA(At, 1, 1); PG8_STAGE(PG8_SB(1, 0), b3, voffB); PG8_STAGE(PG8_SB(1, 1), b3 + hstepB, voffB); PG8_STAGE(PG8_SA(1, 0), a3, voffA);
            PG8_WAIT_V(8); PG8_WAIT_L(0); PG8_BAR; PG8_MMA(1, 0, At, B0); PG8_MMA(1, 1, At, B1); PG8_BAR; PG8_SCHED;
            } else {
            PG8_LDB(B0, 0, 0); PG8_SCHED; PG8_LDA(At, 0, 0); PG8_STAGE(PG8_SA(1, 1), a1 + hstepA, voffA);
            PG8_WAIT_L(8); PG8_BAR; PG8_WAIT_L(0); PG8_MMA(0, 0, At, B0); PG8_BAR; PG8_SCHED;
            PG8_LDB(B1, 0, 1); PG8_STAGE(PG8_SB(0, 0), b2, voffB);
            PG8_BAR; PG8_WAIT_L(0); PG8_MMA(0, 1, At, B1); PG8_BAR;
            PG8_LDA(At, 0, 1); PG8_STAGE(PG8_SA(0, 0), a2, voffA);
            PG8_BAR; PG8_WAIT_L(0); PG8_MMA(1, 0, At, B0); PG8_BAR; PG8_SCHED;
            PG8_STAGE(PG8_SB(0, 1), b2 + hstepB, voffB);
            PG8_WAIT_V(6); PG8_BAR; PG8_MMA(1, 1, At, B1); PG8_BAR;
            PG8_LDB(B0, 1, 0); PG8_SCHED; PG8_LDA(At, 1, 0); PG8_STAGE(PG8_SA(0, 1), a2 + hstepA, voffA);
            PG8_WAIT_L(8); PG8_BAR; PG8_WAIT_L(0); PG8_MMA(0, 0, At, B0); PG8_BAR; PG8_SCHED;
            PG8_LDB(B1, 1, 1); PG8_STAGE(PG8_SB(1, 0), b3, voffB);
            PG8_BAR; PG8_WAIT_L(0); PG8_MMA(0, 1, At, B1); PG8_BAR;
            PG8_LDA(At, 1, 1); PG8_STAGE(PG8_SA(1, 0), a3, voffA);
            PG8_BAR; PG8_WAIT_L(0); PG8_MMA(1, 0, At, B0); PG8_BAR; PG8_SCHED;
            PG8_STAGE(PG8_SB(1, 1), b3 + hstepB, voffB);
            PG8_WAIT_V(6); PG8_BAR; PG8_MMA(1, 1, At, B1); PG8_BAR;
            }
        }
        if constexpr (ALIGN_EPI) { if (wr == 0) PG8_BAR; }
        E.template run<2, 2>(acc, cur, 0, 0, wr, wc, fr, fq); S.done(cur);
        if (!has_next) break;
#pragma unroll
        for (int a = 0; a < 2; ++a)
#pragma unroll
            for (int b = 0; b < 2; ++b)
#pragma unroll
                for (int m = 0; m < 4; ++m)
#pragma unroll
                    for (int n = 0; n < 2; ++n) acc[a][b][m][n] = (f32x4){0.f, 0.f, 0.f, 0.f};
        cur = nxt; cA = nA; cB = nB; ++ui;
        if constexpr (ALIGN_EPI) { if (wr == 1) PG8_BAR; }
    }
    PG8_WAIT_V(0);
    if constexpr (!ALIGN_EPI) { if (wr == 0) PG8_BAR; }
    PG8_BAR;
#undef PG8_SA
#undef PG8_SB
#undef PG8_STAGE
#undef PG8_LDA
#undef PG8_LDB
#undef PG8_MMA
#undef PG8_WAIT_V
#undef PG8_WAIT_L
#undef PG8_BAR
#undef PG8_SCHED
}

template <int NB, class Epi>
__device__ __forceinline__ void sub_gemm(PG8_LAS unsigned char* lds, const Gemm g, int pm, int pn, int ai0, int bj0, const Epi& E) {
    int tid_ = threadIdx.x; asm volatile("" : "+v"(tid_));
    const int tid = tid_, wid = __builtin_amdgcn_readfirstlane(tid >> 6), lane = tid & 63, wr = wid >> 2, wc = wid & 3, fr = lane & 15, fq = lane >> 4;
    const int nt = g.K / BK;
    unsigned voffA[2], voffB[2];
#pragma unroll
    for (int i = 0; i < 2; ++i) { int R, C; stage_rc(tid * 16 + i * 8192, R, C); const int Rb = Epi::PERM ? ((R & ~31) + perm32(R & 31)) : R;
        voffA[i] = (unsigned)(R * g.lda + C) * 2u; voffB[i] = (unsigned)(Rb * g.ldb + C) * 2u; }
    const size_t kstep = (size_t)(BK * 2), hstepB = (size_t)HALF * g.ldb * 2;
    const unsigned ldsw = (unsigned)wid * 1024u;
    const int aoff = lds_byte(wr * 64 + fr, fq * 8), boff = lds_byte(wc * 32 + fr, fq * 8);
    const char* cA = (const char*)g.A + ((size_t)pm * BM + (size_t)ai0 * HALF) * g.lda * 2; const char* cB = (const char*)g.Bt + ((size_t)pn * BM + (size_t)bj0 * HALF) * g.ldb * 2;
    constexpr int NBUF = (NB == 1) ? 4 : 2, LPT = 2 * (1 + NB);
#define SG_BUF(b, j) ((b) * (1 + NB) * HTB + (j) * HTB)
#define SG_STAGE(bufoff, gbase, voff) do { _Pragma("unroll") for (int _i = 0; _i < 2; ++_i) \
        __builtin_amdgcn_global_load_lds((const unsigned*)((const char*)(gbase) + (voff)[_i]), (PG8_LAS unsigned*)(lds + (bufoff) + ldsw + _i * 8192), 16, 0, 0); } while (0)
#define SG_STAGE_TILE(t_) do { const int b_ = (t_) % NBUF; SG_STAGE(SG_BUF(b_, 0), cA + (size_t)(t_) * kstep, voffA); \
        _Pragma("unroll") for (int j = 0; j < NB; ++j) SG_STAGE(SG_BUF(b_, 1 + j), cB + j * hstepB + (size_t)(t_) * kstep, voffB); } while (0)
    f32x4 acc[1][NB][4][2];
#pragma unroll
    for (int b = 0; b < NB; ++b)
#pragma unroll
        for (int m = 0; m < 4; ++m)
#pragma unroll
            for (int n = 0; n < 2; ++n) acc[0][b][m][n] = (f32x4){0.f, 0.f, 0.f, 0.f};
#pragma unroll
    for (int t = 0; t < NBUF - 1; ++t) SG_STAGE_TILE(t);
#pragma unroll 1
    for (int t = 0; t < nt; ++t) {
        const int cur = t % NBUF;
        if constexpr (Epi::MID) { if (t == (nt >> 1)) E.template mid<1, NB>(acc, Unit{pm, pn}, ai0 * HALF, bj0 * HALF, wr, wc, fr, fq); }
        if (t + NBUF - 1 < nt) { SG_STAGE_TILE(t + NBUF - 1); asm volatile("s_waitcnt vmcnt(%0)" :: "n"((NBUF - 1) * LPT) : "memory"); }
        else if (NBUF >= 3 && t + 2 < nt) asm volatile("s_waitcnt vmcnt(%0)" :: "n"(NBUF >= 3 ? 2 * LPT : 0) : "memory");
        else if (NBUF >= 2 && t + 1 < nt) asm volatile("s_waitcnt vmcnt(%0)" :: "n"(LPT) : "memory");
        else asm volatile("s_waitcnt vmcnt(0)" ::: "memory");
        __builtin_amdgcn_s_barrier();
        bf16x8 At[4][2], Bf[NB][2][2];
#pragma unroll
        for (int m = 0; m < 4; ++m)
#pragma unroll
            for (int k = 0; k < 2; ++k) At[m][k] = *(const PG8_LAS bf16x8*)(lds + SG_BUF(cur, 0) + aoff + m * 2048 + k * 1024);
#pragma unroll
        for (int j = 0; j < NB; ++j)
#pragma unroll
            for (int n = 0; n < 2; ++n)
#pragma unroll
                for (int k = 0; k < 2; ++k) Bf[j][n][k] = *(const PG8_LAS bf16x8*)(lds + SG_BUF(cur, 1 + j) + boff + n * 2048 + k * 1024);
        asm volatile("s_waitcnt lgkmcnt(0)" ::: "memory"); __builtin_amdgcn_sched_barrier(0);
#pragma unroll
        for (int j = 0; j < NB; ++j)
#pragma unroll
            for (int m = 0; m < 4; ++m)
#pragma unroll
                for (int n = 0; n < 2; ++n)
#pragma unroll
                    for (int k = 0; k < 2; ++k) acc[0][j][m][n] = __builtin_amdgcn_mfma_f32_16x16x32_bf16(Bf[j][n][k], At[m][k], acc[0][j][m][n], 0, 0, 0);
        __builtin_amdgcn_s_barrier();
    }
    E.template run<1, NB>(acc, Unit{pm, pn}, ai0 * HALF, bj0 * HALF, wr, wc, fr, fq);
#undef SG_BUF
#undef SG_STAGE
#undef SG_STAGE_TILE
}
}
constexpr int NWAVES = 8;
constexpr int DM = 1024, NBATCH = 8, SEQ = 4096, SBATCH = 16, SSEQ = 16, PAST = 2048;
constexpr int MP = NBATCH * SEQ, MS = SBATCH * SSEQ, M = MP + MS, NTILE = M / 256, STILE = MP / 256;
constexpr int DIN = 4096, DFF = 3072, DUP = 6144;
constexpr float EPS = 1e-6f;
constexpr size_t OFF_Y = 0, OFF_HP = (size_t)M * DM, OFF_LCP = OFF_HP + NBATCH * DM, OFF_PLP = OFF_LCP + NBATCH * 3 * DM, OFF_FCP = OFF_PLP + NBATCH * 15 * DM,
                 OFF_HS = OFF_FCP + NBATCH * 2 * DUP, OFF_LCS = OFF_HS + SBATCH * DM, OFF_PLS = OFF_LCS + SBATCH * 3 * DM, OFF_FCS = OFF_PLS + SBATCH * 15 * DM,
                 OUT_TOTAL = OFF_FCS + SBATCH * 2 * DUP;
constexpr size_t MiB = 1u << 20;
constexpr size_t WS_CTL = 0, CTL_ZERO_BYTES = 64 * 1024;
constexpr size_t WS_WIN = 1 * MiB, WS_WCAT = 9 * MiB, WS_WOUT = 13 * MiB, WS_WUP = 15 * MiB, WS_WDN = 27 * MiB, WS_WG = 33 * MiB;
constexpr size_t WS_SSQ = 33 * MiB + 512 * 1024, WS_SSQ2 = 37 * MiB + 768 * 1024, WS_SUMM = WS_SSQ;
static_assert(WS_SSQ + (size_t)M * 128 <= WS_SSQ2 && WS_SSQ2 + (size_t)M * 128 <= 42 * MiB, "ssq map");
constexpr size_t WS_R0 = 42 * MiB, WS_R1 = 107 * MiB, WS_R2 = 236 * MiB, WS_R3 = 365 * MiB, WS_WBP = 494 * MiB, WS_WPOOL = 496 * MiB, WS_HA = 497 * MiB, WS_HB = 499 * MiB, WS_END = 501 * MiB;
static_assert((size_t)M * DM * 2 <= WS_R1 - WS_R0 && (size_t)M * 2048 * 2 <= WS_R2 - WS_R1 && (size_t)M * 2048 * 2 <= WS_R3 - WS_R2 && (size_t)M * 2048 * 2 <= WS_END - WS_R3 && (size_t)M * DFF * 2 <= WS_END - WS_R2, "ws map");
constexpr int CW_BAR = 1024, CW_PANEL = 8192;
constexpr int RING_BYTES = 131072;
constexpr int MISC_OFF = RING_BYTES, RS_OFF = RING_BYTES + 512, EDGE_START_OFF = RS_OFF + 4096, EDGE_MID_OFF = EDGE_START_OFF + 2048, EDGE_PREV_OFF = EDGE_MID_OFF + 2048;
constexpr int CWL_OFF = EDGE_PREV_OFF + 4096;
constexpr int LDS_BYTES = 155648;
static_assert(CWL_OFF + 4096 <= LDS_BYTES, "LDS map");

#define GAS __attribute__((address_space(1)))
#define LAS __attribute__((address_space(3)))
typedef unsigned short bf16;
typedef unsigned v4u __attribute__((ext_vector_type(4)));
typedef unsigned v2u __attribute__((ext_vector_type(2)));
typedef float f32x4 __attribute__((ext_vector_type(4)));
typedef short bf16x8 __attribute__((ext_vector_type(8)));
#define LDS_WAIT() asm volatile("s_waitcnt lgkmcnt(0)" ::: "memory")
#define VM_WAIT() asm volatile("s_waitcnt vmcnt(0)" ::: "memory")
__device__ __forceinline__ unsigned f2bf(float f) { unsigned u = __builtin_bit_cast(unsigned, f); return (u + 0x7fffu + ((u >> 16) & 1u)) >> 16; }
__device__ __forceinline__ unsigned pk2(float lo, float hi) { return f2bf(lo) | (f2bf(hi) << 16); }
__device__ __forceinline__ float bflo(unsigned w) { return __builtin_bit_cast(float, w << 16); }
__device__ __forceinline__ float bfhi(unsigned w) { return __builtin_bit_cast(float, w & 0xffff0000u); }
__device__ __forceinline__ float sigmoidf_fast(float x) { return __builtin_amdgcn_rcpf(1.0f + __builtin_amdgcn_exp2f(-1.4426950408889634f * x)); }
__device__ __forceinline__ float gelu_tanh(float g) { const float z = g * (1.0f + 0.044715f * g * g); return g * __builtin_amdgcn_rcpf(1.0f + __builtin_amdgcn_exp2f(-2.302208198f * z)); }
__device__ __forceinline__ float dpp_shr1(float v) { return __builtin_bit_cast(float, __builtin_amdgcn_update_dpp(__builtin_bit_cast(int, v), __builtin_bit_cast(int, v), 0x111  , 0xf, 0xf, false)); }
__device__ __forceinline__ float wave_sum(float v) {
#pragma unroll
    for (int o = 1; o < 64; o <<= 1) v += __shfl_xor(v, o);
    return v;
}

#define XB_TMO      128
#define XB_XCNT(j)  (256  + 64 * (j))
#define XB_XSUB(j)  (1280 + 64 * (j))
#define XB_XGEN(j)  (2304 + 64 * (j))
#define XB_TOP      3328
#define XB_TOPGEN   3392
#define XCD_BAR_WORDS 3456
#define XB_SPIN_CAP (1u << 20)
static_assert((CW_BAR + XCD_BAR_WORDS) <= CW_PANEL && (CW_PANEL + 32 * 132) * 4 <= (int)CTL_ZERO_BYTES, "control words inside the memset region");
__device__ __forceinline__ unsigned xb_ld(unsigned* p)              { return __hip_atomic_load(p, __ATOMIC_RELAXED, __HIP_MEMORY_SCOPE_AGENT); }
__device__ __forceinline__ unsigned xb_add(unsigned* p, unsigned v) { return __hip_atomic_fetch_add(p, v, __ATOMIC_RELAXED, __HIP_MEMORY_SCOPE_AGENT); }
__device__ __forceinline__ unsigned xb_xcc_id() { return (unsigned)__builtin_amdgcn_s_getreg((3 << 11) | 20) & 0xFu; }
#define XB_SPIN(cond, bar) do { unsigned _sp = 0; while (cond) { __builtin_amdgcn_s_sleep(1); \
    if ((++_sp & 255u) == 0u) { if (xb_ld(&(bar)[XB_TMO])) break; if (_sp > XB_SPIN_CAP) { atomicAdd(&(bar)[XB_TMO], 1u); break; } } } } while (0)
struct XcdBarrier { unsigned* bar; unsigned x; volatile LAS unsigned* st; };
__device__ __forceinline__ XcdBarrier xcd_barrier_post(unsigned* bar, volatile LAS unsigned* st) {
    XcdBarrier b; b.bar = bar; b.x = xb_xcc_id(); b.st = st;
    if (threadIdx.x == 0) (void)xb_add(&bar[XB_XCNT(b.x)], 1u);
    return b;
}
__device__ __forceinline__ void xcd_barrier_complete(unsigned* bar, unsigned x, unsigned& nloc, unsigned& nx) {
    const unsigned G = gridDim.x * gridDim.y * gridDim.z;
    unsigned sum, cnt, mine, sp = 0u;
    for (;;) {
        sum = 0u; cnt = 0u; mine = 0u;
#pragma unroll
        for (unsigned j = 0; j < 16; ++j) { const unsigned c = xb_ld(&bar[XB_XCNT(j)]); sum += c; cnt += (c > 0u) ? 1u : 0u; mine = (j == x) ? c : mine; }
        if (sum == G) break;
        __builtin_amdgcn_s_sleep(1);
        if ((++sp & 255u) == 0u) { if (xb_ld(&bar[XB_TMO])) break; if (sp > XB_SPIN_CAP) { atomicAdd(&bar[XB_TMO], 1u); break; } }
    }
    nloc = mine > 0u ? mine : 1u; nx = cnt > 0u ? cnt : 1u;
}
__device__ __forceinline__ void xcd_barrier(const XcdBarrier& b) {
    asm volatile("s_waitcnt vmcnt(0)" ::: "memory");
    __syncthreads();
    if (threadIdx.x == 0) {
        unsigned* bar = b.bar;
        __builtin_amdgcn_s_waitcnt(0);
        unsigned nloc = b.st[0], nx = b.st[1];
        if (nloc == 0u) { xcd_barrier_complete(bar, b.x, nloc, nx); b.st[0] = nloc; b.st[1] = nx; }
        const unsigned old = xb_add(&bar[XB_XSUB(b.x)], 1u);
        const unsigned gen = old / nloc;
        if (old + 1u == (gen + 1u) * nloc) {
            __builtin_amdgcn_fence(__ATOMIC_RELEASE, "agent");
            asm volatile("s_waitcnt vmcnt(0)" ::: "memory");
            const unsigned og = xb_add(&bar[XB_TOP], 1u);
            const unsigned tg = og / nx;
            if (og + 1u == (tg + 1u) * nx) xb_add(&bar[XB_TOPGEN], 1u);
            else XB_SPIN(xb_ld(&bar[XB_TOPGEN]) == tg, bar);
            __builtin_amdgcn_fence(__ATOMIC_ACQUIRE, "agent");
            xb_add(&bar[XB_XGEN(b.x)], 1u);
            asm volatile("s_waitcnt vmcnt(0)" ::: "memory");
        } else {
            XB_SPIN(xb_ld(&bar[XB_XGEN(b.x)]) == gen, bar);
            __builtin_amdgcn_fence(__ATOMIC_ACQUIRE, "agent");
            asm volatile("s_waitcnt vmcnt(0)" ::: "memory");
        }
    }
    __syncthreads();
}

struct KP {
    const float* in[26];
    float* out; unsigned char* ws;
    int ph_lo, ph_hi;
};
enum { I_XP = 0, I_XS, I_STH, I_STLC, I_STPOOL, I_STFFN, I_NMIX, I_WIN, I_CLW, I_CLB, I_WRA, I_BRA, I_WIX, I_BIX, I_LAM, I_WPOOL, I_PSCALE, I_WBRL, I_WBRP, I_WOUT, I_NFFN, I_WUP, I_CFW, I_CFB, I_WDN, I_NFIN };

using pg8::Unit;
struct EpiZ {
    static constexpr bool PERM = true, AMAP = false, MID = false;
    bf16* ZR; bf16* G;
    template <int NA, int NB> __device__ __forceinline__ void run(f32x4 (&acc)[NA][NB][4][2], const Unit& u, int rowoff, int coloff, int wr, int wc, int fr, int fq) const {
        const int row0 = u.pm * 256 + rowoff + wr * 64 + fr;
        if (u.pn < 8) {
            const int col0 = u.pn * 256 + coloff + wc * 32 + 8 * fq;
#pragma unroll
            for (int ai = 0; ai < NA; ++ai)
#pragma unroll
                for (int m = 0; m < 4; ++m) { bf16* rowp = ZR + (size_t)(row0 + ai * 128 + m * 16) * 2048 + col0;
#pragma unroll
                    for (int bj = 0; bj < NB; ++bj) { const f32x4 v0 = acc[ai][bj][m][0], v1 = acc[ai][bj][m][1];
                        v4u w; w.x = pg8::cvt_pk_bf16(v0[0], v0[1]); w.y = pg8::cvt_pk_bf16(v0[2], v0[3]); w.z = pg8::cvt_pk_bf16(v1[0], v1[1]); w.w = pg8::cvt_pk_bf16(v1[2], v1[3]);
                        *(v4u*)(rowp + bj * 128) = w; } }
        } else if constexpr (NB == 2) {
            const int col0 = (u.pn - 8) * 128 + wc * 32 + 8 * fq;
#pragma unroll
            for (int ai = 0; ai < NA; ++ai)
#pragma unroll
                for (int m = 0; m < 4; ++m) { bf16* rowp = G + (size_t)(row0 + ai * 128 + m * 16) * 2048 + col0; f32x4 r[2], b[2];
#pragma unroll
                    for (int n = 0; n < 2; ++n)
#pragma unroll
                        for (int e = 0; e < 4; ++e) { const float ea = __builtin_amdgcn_exp2f(-1.4426950408889634f * acc[ai][0][m][n][e]), eb = __builtin_amdgcn_exp2f(-1.4426950408889634f * acc[ai][1][m][n][e]);
                            b[n][e] = __builtin_amdgcn_rcpf(1.0f + eb); r[n][e] = fminf((1.0f + eb) * __builtin_amdgcn_rcpf(1.0f + ea), 3.0e38f); }
                    v4u w; w.x = pg8::cvt_pk_bf16(r[0][0], r[0][1]); w.y = pg8::cvt_pk_bf16(r[0][2], r[0][3]); w.z = pg8::cvt_pk_bf16(r[1][0], r[1][1]); w.w = pg8::cvt_pk_bf16(r[1][2], r[1][3]);
                    *(v4u*)rowp = w;
                    w.x = pg8::cvt_pk_bf16(b[0][0], b[0][1]); w.y = pg8::cvt_pk_bf16(b[0][2], b[0][3]); w.z = pg8::cvt_pk_bf16(b[1][0], b[1][1]); w.w = pg8::cvt_pk_bf16(b[1][2], b[1][3]);
                    *(v4u*)(rowp + 1024) = w; }
        }
    }
};
struct EpiBr {
    static constexpr bool PERM = true, AMAP = false, MID = true;
    const bf16* G; bf16* MG;
    template <int NA, int NB> __device__ __forceinline__ void mid(f32x4 (&acc)[NA][NB][4][2], const Unit& u, int rowoff, int coloff, int wr, int wc, int fr, int fq) const {
        int pm_ = u.pm, pn_ = u.pn; asm volatile("" : "+s"(pm_), "+s"(pn_));
        const int row0 = pm_ * 256 + rowoff + wr * 64 + fr, col0 = pn_ * 256 + coloff + wc * 32 + 8 * fq;
#pragma unroll
        for (int ai = 0; ai < NA; ++ai)
#pragma unroll
            for (int m = 0; m < 4; ++m) { const size_t row = (size_t)(row0 + ai * 128 + m * 16);
#pragma unroll
                for (int bj = 0; bj < NB; ++bj) { const int col = col0 + bj * 128;
                    const v4u ga = *(const v4u*)(G + row * 2048 + col);
                    acc[ai][bj][m][0] *= (f32x4){bflo(ga.x), bfhi(ga.x), bflo(ga.y), bfhi(ga.y)}; acc[ai][bj][m][1] *= (f32x4){bflo(ga.z), bfhi(ga.z), bflo(ga.w), bfhi(ga.w)}; } }
    }
    template <int NA, int NB> __device__ __forceinline__ void run(f32x4 (&acc)[NA][NB][4][2], const Unit& u, int rowoff, int coloff, int wr, int wc, int fr, int fq) const {
        const int row0 = u.pm * 256 + rowoff + wr * 64 + fr, col0 = u.pn * 256 + coloff + wc * 32 + 8 * fq;
#pragma unroll
        for (int ai = 0; ai < NA; ++ai)
#pragma unroll
            for (int m = 0; m < 4; ++m) { const size_t row = (size_t)(row0 + ai * 128 + m * 16);
#pragma unroll
                for (int bj = 0; bj < NB; ++bj) { const int col = col0 + bj * 128;
                    const v4u gw = *(const v4u*)(G + row * 2048 + 1024 + col);
                    const f32x4 g0 = {bflo(gw.x), bfhi(gw.x), bflo(gw.y), bfhi(gw.y)}, g1 = {bflo(gw.z), bfhi(gw.z), bflo(gw.w), bfhi(gw.w)};
                    const f32x4 v0 = acc[ai][bj][m][0] * g0, v1 = acc[ai][bj][m][1] * g1;
                    v4u w; w.x = pg8::cvt_pk_bf16(v0[0], v0[1]); w.y = pg8::cvt_pk_bf16(v0[2], v0[3]); w.z = pg8::cvt_pk_bf16(v1[0], v1[1]); w.w = pg8::cvt_pk_bf16(v1[2], v1[3]);
                    *(v4u*)(MG + row * 1024 + col) = w; } }
    }
};
template <bool DOWN> struct EpiRes {
    static constexpr bool PERM = true, AMAP = false, MID = false;
    const float* xp; const float* xs; float* Y; bf16* X1B; float* SSQ; LAS unsigned char* lx;
    template <int NA, int NB> __device__ __forceinline__ void run(f32x4 (&acc)[NA][NB][4][2], const Unit& u, int rowoff, int coloff, int wr, int wc, int fr, int fq) const {
        int pm_ = u.pm, pn_ = u.pn, fr_ = fr, fq_ = fq, wr_ = wr, wc_ = wc, tid = threadIdx.x;
        asm volatile("" : "+s"(pm_), "+s"(pn_), "+v"(fr_), "+v"(fq_), "+s"(wr_), "+s"(wc_), "+v"(tid));
        LAS float* P = (LAS float*)(lx + RS_OFF);
        const int lrow0 = rowoff + wr_ * 64 + fr_, col0 = pn_ * 256 + coloff + wc_ * 32 + 8 * fq_, bj0 = coloff >> 7;
        const float* xb = (pm_ < STILE ? xp : xs - (size_t)MP * DM);
#pragma unroll
        for (int ai = 0; ai < NA; ++ai)
#pragma unroll
            for (int m = 0; m < 4; ++m) { const int lrow = lrow0 + ai * 128 + m * 16; const size_t row = (size_t)pm_ * 256 + lrow;
#pragma unroll
                for (int bj = 0; bj < NB; ++bj) { const size_t off = row * 1024 + col0 + bj * 128; f32x4 v0, v1;
                    if (!DOWN) { v0 = acc[ai][bj][m][0] + *(const f32x4*)(xb + off); v1 = acc[ai][bj][m][1] + *(const f32x4*)(xb + off + 4); }
                    else { const v4u w = *(const v4u*)(X1B + off); v0 = acc[ai][bj][m][0] + (f32x4){bflo(w.x), bfhi(w.x), bflo(w.y), bfhi(w.y)}; v1 = acc[ai][bj][m][1] + (f32x4){bflo(w.z), bfhi(w.z), bflo(w.w), bfhi(w.w)}; }
                    float s = (v0[0] * v0[0] + v0[1] * v0[1]) + (v0[2] * v0[2] + v0[3] * v0[3]) + (v1[0] * v1[0] + v1[1] * v1[1]) + (v1[2] * v1[2] + v1[3] * v1[3]);
                    if (!DOWN) { v4u w; w.x = pg8::cvt_pk_bf16(v0[0], v0[1]); w.y = pg8::cvt_pk_bf16(v0[2], v0[3]); w.z = pg8::cvt_pk_bf16(v1[0], v1[1]); w.w = pg8::cvt_pk_bf16(v1[2], v1[3]);
                        *(v4u*)(X1B + off) = w; }
                    else { *(f32x4*)(Y + off) = v0; *(f32x4*)(Y + off + 4) = v1; }
                    s += __shfl_xor(s, 16); s += __shfl_xor(s, 32);
                    if (fq_ == 0) P[lrow * 8 + (bj0 + bj) * 4 + wc_] = s; } }
        asm volatile("s_waitcnt lgkmcnt(0)" ::: "memory"); __builtin_amdgcn_s_barrier(); asm volatile("" ::: "memory");
        if (tid < NA * 128) { const int lrow = rowoff + tid; const LAS f32x4* pp = (const LAS f32x4*)(P + lrow * 8); float* d = SSQ + ((size_t)pm_ * 256 + lrow) * 8 + pn_ * 2;
            if (NA == 2) { const f32x4 a = pp[0], b = pp[1]; d[0] = (a[0] + a[1]) + (a[2] + a[3]); d[1] = (b[0] + b[1]) + (b[2] + b[3]); }
            else { const f32x4 a = pp[bj0]; d[bj0] = (a[0] + a[1]) + (a[2] + a[3]); } }
    }
};
__device__ __forceinline__ float row_rs(const float* SSQ, size_t row) {
    const f32x4* q = (const f32x4*)(SSQ + row * 8); const f32x4 a = q[0], b = q[1];
    return 1.0f / sqrtf((((a[0] + a[1]) + (a[2] + a[3])) + ((b[0] + b[1]) + (b[2] + b[3]))) * (1.f / DM) + EPS);
}
template <int XMODE = 0  > struct EpiFinalT {
    static constexpr bool PERM = false  , AMAP = false, MID = false;
    float* Y; const bf16* X1B; const float* gf; float* XS; unsigned* cnt; unsigned* tmo; LAS unsigned char* lx;
    template <int NA, int NB> __device__ __forceinline__ void run(f32x4 (&acc)[NA][NB][4][2], const Unit& u, int rowoff, int coloff, int wr, int wc, int fr, int fq) const {
        LAS float* P = (LAS float*)(lx + RS_OFF); LAS float* S = P + 2048;
        int tid = threadIdx.x, pm_ = u.pm, pn_ = u.pn, fr_ = fr, fq_ = fq, wr_ = wr, wc_ = wc;
        asm volatile("" : "+v"(tid), "+s"(pm_), "+s"(pn_), "+v"(fr_), "+v"(fq_), "+s"(wr_), "+s"(wc_));
        const int wid = tid >> 6, lane = tid & 63;
        const int lrow0 = rowoff + wr_ * 64 + fr_, col0 = pn_ * 256 + coloff + wc_ * 32 + 4 * fq_, bj0 = coloff >> 7;
#pragma unroll
        for (int ai = 0; ai < NA; ++ai)
#pragma unroll
            for (int m = 0; m < 4; ++m) { const int lrow = lrow0 + ai * 128 + m * 16; const size_t row = (size_t)pm_ * 256 + lrow;
#pragma unroll
                for (int bj = 0; bj < NB; ++bj) { const size_t off = row * 1024 + col0 + bj * 128;
                    { const v2u w0 = *(const v2u*)(X1B + off), w1 = *(const v2u*)(X1B + off + 16); acc[ai][bj][m][0] += (f32x4){bflo(w0.x), bfhi(w0.x), bflo(w0.y), bfhi(w0.y)}; acc[ai][bj][m][1] += (f32x4){bflo(w1.x), bfhi(w1.x), bflo(w1.y), bfhi(w1.y)}; }
                    const f32x4 v0 = acc[ai][bj][m][0], v1 = acc[ai][bj][m][1];
                    float s = (v0[0] * v0[0] + v0[1] * v0[1]) + (v0[2] * v0[2] + v0[3] * v0[3]) + (v1[0] * v1[0] + v1[1] * v1[1]) + (v1[2] * v1[2] + v1[3] * v1[3]);
                    s += __shfl_xor(s, 16); s += __shfl_xor(s, 32);
                    if (fq_ == 0) P[lrow * 8 + (bj0 + bj) * 4 + wc_] = s; } }
        f32x4 gg[NB][2];
#pragma unroll
        for (int bj = 0; bj < NB; ++bj) { gg[bj][0] = *(const f32x4*)(gf + col0 + bj * 128); gg[bj][1] = *(const f32x4*)(gf + col0 + bj * 128 + 16); }
        asm volatile("s_waitcnt lgkmcnt(0)" ::: "memory"); __builtin_amdgcn_s_barrier(); asm volatile("" ::: "memory");
        constexpr int RPW = (NA == 2) ? 32 : 16;
        const int nslot = (NA == 2) ? 4 : 8, slot = (NA == 2) ? pn_ : 2 * pn_ + bj0;
        const int prow = rowoff + wid * RPW + (lane & (RPW - 1));
        float* xs = XS + (size_t)pm_ * 2048;
        if (lane < RPW) { const LAS float* pp = P + prow * 8 + (NA == 2 ? 0 : bj0 * 4); float t = (pp[0] + pp[1]) + (pp[2] + pp[3]); if (NA == 2) t += (pp[4] + pp[5]) + (pp[6] + pp[7]);
            if (XMODE == 0) __hip_atomic_store(xs + slot * 256 + prow, t, __ATOMIC_RELAXED, __HIP_MEMORY_SCOPE_AGENT); else S[prow] = 1.0f / sqrtf(t * (1.f / 256) + EPS); }
        if (XMODE == 0) {
        asm volatile("s_waitcnt vmcnt(0)" ::: "memory");
        unsigned* c = cnt + 32 * ((NA == 2) ? pm_ : (STILE + (rowoff >> 7)));
        if (lane == 0) __hip_atomic_fetch_add(c, 1u, __ATOMIC_RELAXED, __HIP_MEMORY_SCOPE_AGENT);
        if (wid == 0) { const unsigned want = 8u * (unsigned)nslot; unsigned sp = 0;
            while ((unsigned)__builtin_amdgcn_readfirstlane(__hip_atomic_load(c, __ATOMIC_RELAXED, __HIP_MEMORY_SCOPE_AGENT)) < want) {
                __builtin_amdgcn_s_sleep(1);
                if ((++sp & 255u) == 0u) { if (__builtin_amdgcn_readfirstlane(__hip_atomic_load(tmo, __ATOMIC_RELAXED, __HIP_MEMORY_SCOPE_AGENT)) != 0u) break; if (sp > (1u << 20)) { if (lane == 0) atomicAdd(tmo, 1u); break; } } } }
        }
        asm volatile("s_waitcnt vmcnt(0) lgkmcnt(0)" ::: "memory"); __builtin_amdgcn_s_barrier(); asm volatile("" ::: "memory");
        if (XMODE == 0 && lane < RPW) { float t = 0.f;
#pragma unroll
            for (int k = 0; k < 8; ++k) if (k < nslot) t += __hip_atomic_load(xs + k * 256 + prow, __ATOMIC_RELAXED, __HIP_MEMORY_SCOPE_AGENT);
            S[prow] = 1.0f / sqrtf(t * (1.f / DM) + EPS); }
        asm volatile("s_waitcnt lgkmcnt(0)" ::: "memory"); __builtin_amdgcn_s_barrier(); asm volatile("" ::: "memory");
#pragma unroll
        for (int ai = 0; ai < NA; ++ai)
#pragma unroll
            for (int m = 0; m < 4; ++m) { const int lrow = lrow0 + ai * 128 + m * 16; const size_t row = (size_t)pm_ * 256 + lrow; const float rs = S[lrow];
#pragma unroll
                for (int bj = 0; bj < NB; ++bj) { const size_t off = row * 1024 + col0 + bj * 128;
                    if (XMODE < 2) { *(f32x4*)(Y + off) = acc[ai][bj][m][0] * rs * gg[bj][0]; *(f32x4*)(Y + off + 16) = acc[ai][bj][m][1] * rs * gg[bj][1]; }
                    else asm volatile("" :: "v"(acc[ai][bj][m][0] * rs * gg[bj][0]), "v"(acc[ai][bj][m][1] * rs * gg[bj][1])); } }
    }
};
typedef EpiFinalT<0> EpiFinal;
struct EpiW {
    static constexpr bool PERM = true, AMAP = false, MID = false;
    bf16* O;
    template <int NA, int NB> __device__ __forceinline__ void run(f32x4 (&acc)[NA][NB][4][2], const Unit& u, int rowoff, int coloff, int wr, int wc, int fr, int fq) const {
        const int row0 = u.pm * 256 + rowoff + wr * 64 + fr, col0 = u.pn * 256 + coloff + wc * 32 + 8 * fq;
#pragma unroll
        for (int ai = 0; ai < NA; ++ai)
#pragma unroll
            for (int m = 0; m < 4; ++m)
#pragma unroll
                for (int bj = 0; bj < NB; ++bj) { const f32x4 v0 = acc[ai][bj][m][0], v1 = acc[ai][bj][m][1];
                    v4u w; w.x = pg8::cvt_pk_bf16(v0[0], v0[1]); w.y = pg8::cvt_pk_bf16(v0[2], v0[3]); w.z = pg8::cvt_pk_bf16(v1[0], v1[1]); w.w = pg8::cvt_pk_bf16(v1[2], v1[3]);
                    *(v4u*)(O + (size_t)(row0 + ai * 128 + m * 16) * 2048 + col0 + bj * 128) = w; }
    }
};
template <bool AM> struct EpiNull {
    static constexpr bool PERM = true, AMAP = AM, MID = false;
    template <int NA, int NB> __device__ __forceinline__ void run(f32x4 (&acc)[NA][NB][4][2], const Unit&, int, int, int, int, int, int) const {
#pragma unroll
        for (int ai = 0; ai < NA; ++ai)
#pragma unroll
            for (int bj = 0; bj < NB; ++bj)
#pragma unroll
                for (int m = 0; m < 4; ++m) { asm volatile("" :: "v"(acc[ai][bj][m][0]), "v"(acc[ai][bj][m][1])); }
    }
};
struct EpiZScratch {
    static constexpr bool PERM = true, AMAP = false, MID = false;
    bf16* scr;
    template <int NA, int NB> __device__ __forceinline__ void run(f32x4 (&acc)[NA][NB][4][2], const Unit& u, int rowoff, int coloff, int wr, int wc, int fr, int fq) const {
        const int row0 = wr * 64 + fr, col0 = wc * 32 + 8 * fq;
#pragma unroll
        for (int ai = 0; ai < NA; ++ai)
#pragma unroll
            for (int m = 0; m < 4; ++m) { bf16* rowp = scr + (size_t)(row0 + ai * 128 + m * 16) * 256 + col0;
#pragma unroll
                for (int bj = 0; bj < NB; ++bj) { f32x4 v0 = acc[ai][bj][m][0], v1 = acc[ai][bj][m][1];
                    v4u w; w.x = pg8::cvt_pk_bf16(v0[0], v0[1]); w.y = pg8::cvt_pk_bf16(v0[2], v0[3]); w.z = pg8::cvt_pk_bf16(v1[0], v1[1]); w.w = pg8::cvt_pk_bf16(v1[2], v1[3]);
                    *(v4u*)(rowp + bj * 128) = w; } }
    }
};
struct EpiMidOnly {
    static constexpr bool PERM = true, AMAP = false, MID = true;
    const bf16* G;
    template <int NA, int NB> __device__ __forceinline__ void mid(f32x4 (&acc)[NA][NB][4][2], const Unit& u, int rowoff, int coloff, int wr, int wc, int fr, int fq) const { EpiBr e{G, nullptr}; e.template mid<NA, NB>(acc, u, rowoff, coloff, wr, wc, fr, fq); }
    template <int NA, int NB> __device__ __forceinline__ void run(f32x4 (&acc)[NA][NB][4][2], const Unit& u, int a, int b, int c, int d, int e, int f) const { EpiNull<false> n; n.template run<NA, NB>(acc, u, a, b, c, d, e, f); }
};
struct EpiUpS {
    static constexpr bool PERM = true, AMAP = false, MID = false;
    bf16* ACT; const float* cw; const float* cb; const float* stf; float* ofs; const float* SSQ;
    template <int NA, int NB> __device__ __forceinline__ void run(f32x4 (&acc)[NA][NB][4][2], const Unit& u, int rowoff, int coloff, int wr, int wc, int fr, int fq) const {
        static_assert(NA == 1 && NB == 2, "sample FFN epilogue works on half sub-units");
        int pn_ = u.pn, ro_ = rowoff, fr_ = fr, fq_ = fq, wr_ = wr, wc_ = wc; asm volatile("" : "+s"(pn_), "+s"(ro_), "+v"(fr_), "+v"(fq_), "+s"(wr_), "+s"(wc_));
        const int cbase = 32 * wc_ + 8 * fq_, gcol = 128 * pn_ + cbase;
#pragma unroll
        for (int m = 0; m < 4; ++m) {
            asm volatile("" ::: "memory");
            const int lrow = ro_ + wr_ * 64 + m * 16 + fr_, seq = lrow >> 4; const size_t row = (size_t)MP + lrow;
            const float rs = row_rs(SSQ, row);
            unsigned pk[4];
#pragma unroll
            for (int n = 0; n < 2; ++n) { f32x4 gc;
#pragma unroll
                for (int bj = 0; bj < 2; ++bj) { const int oc = bj * DFF + gcol + 4 * n;
                    const f32x4 w0 = *(const f32x4*)(cw + oc), w1 = *(const f32x4*)(cw + DUP + oc), w2 = *(const f32x4*)(cw + 2 * DUP + oc), bb = *(const f32x4*)(cb + oc);
                    const f32x4 h = acc[0][bj][m][n] * rs; f32x4 hm1, hm2;
#pragma unroll
                    for (int e = 0; e < 4; ++e) { hm1[e] = __shfl_up(h[e], 1, 16); hm2[e] = __shfl_up(h[e], 2, 16); }
                    if (fr_ < 2) { const f32x4 s1 = *(const f32x4*)(stf + (size_t)(seq * 2 + 1) * DUP + oc); if (fr_ == 0) { hm1 = s1; hm2 = *(const f32x4*)(stf + (size_t)(seq * 2 + 0) * DUP + oc); } else hm2 = s1; }
                    if (fr_ >= 14) *(f32x4*)(ofs + (size_t)(seq * 2 + (fr_ - 14)) * DUP + oc) = h;
                    const f32x4 c = bb + w0 * hm2 + w1 * hm1 + w2 * h;
                    if (bj == 0) gc = c;
                    else { f32x4 a;
#pragma unroll
                        for (int e = 0; e < 4; ++e) a[e] = gelu_tanh(gc[e]) * c[e];
                        pk[2 * n] = pg8::cvt_pk_bf16(a[0], a[1]); pk[2 * n + 1] = pg8::cvt_pk_bf16(a[2], a[3]); } } }
            v4u w; w.x = pk[0]; w.y = pk[1]; w.z = pk[2]; w.w = pk[3];
            *(v4u*)(ACT + row * DFF + gcol) = w;
        }
    }
};
struct EpiUp {
    static constexpr bool PERM = true, AMAP = true, MID = false;
    bf16* ACT; const float* cw; const float* cb; const float* stf; float* ofp; float* ofs; LAS unsigned char* lx; int pm0; bf16* scr; float* HA; float* HB;
    template <int NA, int NB> __device__ __forceinline__ void run(f32x4 (&acc)[NA][NB][4][2], const Unit& u, int, int, int wr, int wc, int fr, int fq) const {
        int pm_ = u.pm, pn_ = u.pn, fr_ = fr, fq_ = fq; asm volatile("" : "+s"(pm_), "+s"(pn_), "+v"(fr_), "+v"(fq_));
        const bool samp = (pm_ == STILE); const int j = pm_ - pm0;
        const LAS float* RS = (const LAS float*)(lx + RS_OFF) + j * 256 + 128 * wr + 8 * fr_;
        const f32x4 rsa = *(const LAS f32x4*)RS, rsb = *(const LAS f32x4*)(RS + 4);
        const float rs[8] = {rsa[0], rsa[1], rsa[2], rsa[3], rsb[0], rsb[1], rsb[2], rsb[3]};
        const int cbase = 32 * wc + 8 * fq_, gcol = 128 * pn_ + cbase;
        const LAS float* Ein = (const LAS float*)(lx + (wr == 0 ? (j == 0 ? EDGE_START_OFF : EDGE_PREV_OFF + 2048 * (j & 1)) : EDGE_MID_OFF));
        LAS float* Eout = (LAS float*)(lx + (wr == 0 ? EDGE_MID_OFF : EDGE_PREV_OFF + 2048 * ((j + 1) & 1)));
        const int seq = samp ? (8 * wr + (fr_ >> 1)) : (pm_ >> 4);
        const bool lastp = (!samp) && !scr && ((pm_ & 15) == 15) && wr == 1 && fr_ == 15;
        if (!samp && fr_ == 15) {
#pragma unroll
            for (int n = 0; n < 2; ++n)
#pragma unroll
                for (int bj = 0; bj < 2; ++bj) { const int cc = bj * 128 + cbase + 4 * n;
                    *(LAS f32x4*)(Eout + cc) = acc[1][bj][2][n] * rs[6]; *(LAS f32x4*)(Eout + 256 + cc) = acc[1][bj][3][n] * rs[7]; } }
        asm volatile("s_waitcnt lgkmcnt(0)" ::: "memory"); __builtin_amdgcn_s_barrier(); asm volatile("" ::: "memory");
        const size_t astr = scr ? 128 : DFF;
        bf16* ap = scr ? scr + (size_t)(128 * wr + 8 * fr_) * 128 + cbase : ACT + (size_t)(pm_ * 256 + 128 * wr + 8 * fr_) * DFF + gcol;
#pragma unroll
        for (int n = 0; n < 2; ++n) {
            f32x4 gc[8];
#pragma unroll
            for (int bj = 0; bj < 2; ++bj) {
                const int cc = bj * 128 + cbase + 4 * n, oc = bj * DFF + gcol + 4 * n;
                const LAS float* cwl = (const LAS float*)(lx + CWL_OFF) + cc;
                const f32x4 w0 = *(const LAS f32x4*)cwl, w1 = *(const LAS f32x4*)(cwl + 256), w2 = *(const LAS f32x4*)(cwl + 512), bb = *(const LAS f32x4*)(cwl + 768);
                const f32x4 h6 = acc[1][bj][2][n] * rs[6], h7 = acc[1][bj][3][n] * rs[7];
                f32x4 hm1, hm2;
#pragma unroll
                for (int e = 0; e < 4; ++e) { hm1[e] = dpp_shr1(h7[e]); hm2[e] = dpp_shr1(h6[e]); }
                if (!samp) {
                    if (fr_ == 0) { hm2 = *(const LAS f32x4*)(Ein + cc); hm1 = *(const LAS f32x4*)(Ein + 256 + cc); }
                    if (lastp) { *(f32x4*)(ofp + (size_t)(seq * 2 + 0) * DUP + oc) = h6; *(f32x4*)(ofp + (size_t)(seq * 2 + 1) * DUP + oc) = h7; }
                    if (j == 3 && wr == 1 && fr_ == 15 && !scr) { float* ha = HA + ((size_t)((pm0 >> 2) + 1) * 24 + pn_) * 512 + cc; *(f32x4*)ha = h6; *(f32x4*)(ha + 256) = h7; }
                    if (j == 0 && wr == 0 && fr_ == 0 && !scr) { float* hb = HB + ((size_t)(pm0 >> 2) * 24 + pn_) * 512 + cc; *(f32x4*)hb = acc[0][bj][0][n] * rs[0]; *(f32x4*)(hb + 256) = acc[0][bj][1][n] * rs[1]; }
                } else {
                    if (!(fr_ & 1)) { hm2 = *(const f32x4*)(stf + (size_t)(seq * 2 + 0) * DUP + oc); hm1 = *(const f32x4*)(stf + (size_t)(seq * 2 + 1) * DUP + oc); }
                    else { *(f32x4*)(ofs + (size_t)(seq * 2 + 0) * DUP + oc) = h6; *(f32x4*)(ofs + (size_t)(seq * 2 + 1) * DUP + oc) = h7; }
                }
                f32x4 p2 = hm2, p1 = hm1;
#pragma unroll
                for (int q = 0; q < 8; ++q) {
                    const f32x4 hq = (q == 6) ? h6 : (q == 7) ? h7 : acc[q >> 2][bj][q & 3][n] * rs[q];
                    const f32x4 c = bb + w0 * p2 + w1 * p1 + w2 * hq;
                    p2 = p1; p1 = hq;
                    if (bj == 0) gc[q] = c;
                    else { f32x4 a;
#pragma unroll
                        for (int e = 0; e < 4; ++e) a[e] = gelu_tanh(gc[q][e]) * c[e];
                        v2u w; w.x = pg8::cvt_pk_bf16(a[0], a[1]); w.y = pg8::cvt_pk_bf16(a[2], a[3]);
                        *(v2u*)(ap + (size_t)q * astr + 4 * n) = w; }
                }
            }
        }
        LDS_WAIT();
    }
};
template <class RowMap>
__device__ __forceinline__ void p0_transpose_item(const float* W, int ldw, int k0, int n0, bf16* WT, size_t ldt, int kcol0, RowMap drow, const float* kscale, LAS float* scr, int lane) {
    float tv[32];
#pragma unroll
    for (int i = 0; i < 32; ++i) { const int kk = 2 * i + (lane >> 5); tv[i] = W[(size_t)(k0 + kk) * ldw + n0 + (lane & 31)]; }
    if (kscale) {
#pragma unroll
        for (int i = 0; i < 32; ++i) tv[i] *= kscale[k0 + 2 * i + (lane >> 5)]; }
#pragma unroll
    for (int i = 0; i < 32; ++i) scr[(2 * i + (lane >> 5)) * 33 + (lane & 31)] = tv[i];
    LDS_WAIT(); asm volatile("" ::: "memory");
    const int c = lane & 7;
#pragma unroll
    for (int j = 0; j < 4; ++j) { const int n = (lane >> 3) + 8 * j; const LAS float* s = scr + (8 * c) * 33 + n;
        v4u o; o.x = pk2(s[0 * 33], s[1 * 33]); o.y = pk2(s[2 * 33], s[3 * 33]); o.z = pk2(s[4 * 33], s[5 * 33]); o.w = pk2(s[6 * 33], s[7 * 33]);
        *(v4u*)(WT + (size_t)drow(n0 + n) * ldt + kcol0 + k0 + 8 * c) = o; }
    LDS_WAIT(); asm volatile("" ::: "memory");
}
struct RowId { __device__ __forceinline__ int operator()(int n) const { return n; } };
struct RowGate { __device__ __forceinline__ int operator()(int n) const { if (n < 2048) return n; const int c = n - 2048, br = c >> 10, cc = c & 1023; return 2048 + (cc >> 7) * 256 + br * 128 + (cc & 127); } };
struct RowUp { __device__ __forceinline__ int operator()(int n) const { const int half = n >= DFF ? 1 : 0, c = n - half * DFF; return (c >> 7) * 256 + half * 128 + (c & 127); } };

__device__ __forceinline__ void p0_prologue(const KP& p, LAS unsigned char* lds, int vcu, int G, int wave, int lane) {
    LAS float* scr = (LAS float*)(lds + wave * 16384);
    const int gw = vcu * NWAVES + wave, NGW = G * NWAVES;
    unsigned char* ws = p.ws;
    bf16* Win_t = (bf16*)(ws + WS_WIN); bf16* Wg_t = (bf16*)(ws + WS_WG); bf16* Wbp_t = (bf16*)(ws + WS_WBP); bf16* Wpool_b = (bf16*)(ws + WS_WPOOL);
    constexpr int I_IN = (DM / 64) * (DIN / 32), I_SQ = (DM / 64) * (DM / 32), I_G = 32 * 2, I_PC = 4 * 256 * 256 / 512;
    constexpr int NITEMS = I_IN + I_SQ + I_G + I_PC;
    for (int it = gw; it < NITEMS; it += NGW) {
        int r = it;
        if (r < I_IN) { const int nblk = DIN / 32; p0_transpose_item(p.in[I_WIN], DIN, 64 * (r / nblk), 32 * (r % nblk), Win_t, DM, 0, RowGate(), nullptr, scr, lane); continue; } r -= I_IN;
        if (r < I_SQ) { const int nblk = DM / 32; p0_transpose_item(p.in[I_WBRP], DM, 64 * (r / nblk), 32 * (r % nblk), Wbp_t, DM, 0, RowId(), p.in[I_PSCALE], scr, lane); continue; } r -= I_SQ;
        if (r < I_G) { const int mat = r >> 1, nb = r & 1; const float* W = (mat < 16 ? p.in[I_WRA] : p.in[I_WIX]) + (size_t)(mat & 15) * 4096;
          p0_transpose_item(W, 64, 0, 32 * nb, Wg_t + (size_t)mat * 4096, 64, 0, RowId(), nullptr, scr, lane); continue; } r -= I_G;
        { const float* s = p.in[I_WPOOL] + (size_t)r * 512 + lane * 8; const f32x4 a = *(const f32x4*)s, b = *(const f32x4*)(s + 4);
          v4u o; o.x = pk2(a[0], a[1]); o.y = pk2(a[2], a[3]); o.z = pk2(b[0], b[1]); o.w = pk2(b[2], b[3]); *(v4u*)(Wpool_b + (size_t)r * 512 + lane * 8) = o; }
    }
    {
        bf16* XN = (bf16*)(ws + WS_R0); const float* g1 = p.in[I_NMIX];
        f32x4 gv[4];
#pragma unroll
        for (int j = 0; j < 4; ++j) gv[j] = *((const f32x4*)g1 + lane + 64 * j);
        for (int m0 = gw; m0 < M; m0 += 4 * NGW) {
            f32x4 v[4][4]; float s[4];
#pragma unroll
            for (int r = 0; r < 4; ++r) { const int m = m0 + r * NGW; s[r] = 0.f;
                if (m < M) { const float* xrow = m < MP ? p.in[I_XP] + (size_t)m * DM : p.in[I_XS] + (size_t)(m - MP) * DM; const f32x4* xr = (const f32x4*)xrow + lane;
#pragma unroll
                    for (int j = 0; j < 4; ++j) v[r][j] = xr[64 * j]; } }
#pragma unroll
            for (int r = 0; r < 4; ++r) { const int m = m0 + r * NGW;
                if (m < M) {
#pragma unroll
                    for (int j = 0; j < 4; ++j) s[r] += (v[r][j][0] * v[r][j][0] + v[r][j][1] * v[r][j][1]) + (v[r][j][2] * v[r][j][2] + v[r][j][3] * v[r][j][3]);
                    const float rstd = 1.0f / sqrtf(wave_sum(s[r]) * (1.f / DM) + EPS);
                    v2u* o8 = (v2u*)(XN + (size_t)m * DM) + lane;
#pragma unroll
                    for (int j = 0; j < 4; ++j) { const f32x4 y = v[r][j] * rstd * gv[j]; v2u o; o.x = pk2(y[0], y[1]); o.y = pk2(y[2], y[3]); o8[64 * j] = o; } } }
        }
    }
}
__device__ __forceinline__ void p1_weights(const KP& p, LAS unsigned char* lds, int gw, int NGW, int wave, int lane) {
    LAS float* scr = (LAS float*)(lds + wave * 16384);
    unsigned char* ws = p.ws;
    bf16* Wcat_t = (bf16*)(ws + WS_WCAT); bf16* Wout_t = (bf16*)(ws + WS_WOUT); bf16* Wup_t = (bf16*)(ws + WS_WUP); bf16* Wdn_t = (bf16*)(ws + WS_WDN);
    constexpr int I_UP = (DM / 64) * (DUP / 32), I_SQ = (DM / 64) * (DM / 32), I_DN = (DFF / 64) * (DM / 32);
    for (int it = gw; it < I_UP + 2 * I_SQ + I_DN; it += NGW) {
        int r = it;
        if (r < I_SQ) { const int nblk = DM / 32; p0_transpose_item(p.in[I_WBRL], DM, 64 * (r / nblk), 32 * (r % nblk), Wcat_t, 2048, 0, RowId(), nullptr, scr, lane); continue; } r -= I_SQ;
        if (r < I_SQ) { const int nblk = DM / 32; p0_transpose_item(p.in[I_WOUT], DM, 64 * (r / nblk), 32 * (r % nblk), Wout_t, DM, 0, RowId(), nullptr, scr, lane); continue; } r -= I_SQ;
        if (r < I_UP) { const int nblk = DUP / 32; p0_transpose_item(p.in[I_WUP], DUP, 64 * (r / nblk), 32 * (r % nblk), Wup_t, DM, 0, RowUp(), p.in[I_NFFN]  , scr, lane); continue; } r -= I_UP;
        { const int nblk = DM / 32; p0_transpose_item(p.in[I_WDN], DM, 64 * (r / nblk), 32 * (r % nblk), Wdn_t, DFF, 0, RowId(), nullptr, scr, lane); }
    }
}

constexpr int XR_OFF = 0, XR_BYTES = 16 * 19 * 128, SEG_OFF = 40960, CIN_OFF = 45056;
template <bool FINAL>
__device__ __forceinline__ void lru_unit(const KP& p, LAS unsigned char* lds, int pm, int n, int tid, int lane, int wave) {
    constexpr bool samp = true;
    const bf16* ZR = (const bf16*)(p.ws + WS_R1); const bf16* Wg_t = (const bf16*)(p.ws + WS_WG);
    typedef float f32x2v __attribute__((ext_vector_type(2)));
    f32x2v* SUMM = (f32x2v*)(p.ws + WS_SUMM);
    bf16* HP = (bf16*)(p.ws + WS_R3);
    LAS unsigned char* XR = lds + XR_OFF; LAS f32x2v* SEG = (LAS f32x2v*)(lds + SEG_OFF); LAS float* CIN = (LAS float*)(lds + CIN_OFF);
    const int t0 = samp ? 0 : 256 * (pm & 15);
    __syncthreads();
    { v4u sv[5];
#pragma unroll
      for (int kk = 0; kk < 5; ++kk) { const int idx = tid + kk * (NWAVES * 64), row = idx >> 3, ck = idx & 7, g = row / 19, k = row - g * 19, tt = 16 * g + k - 3;
          v4u v = {0u, 0u, 0u, 0u};
          if (idx < 304 * 8) {
              if (!samp) { if (t0 + tt >= 0) v = *(const v4u*)(ZR + (size_t)(pm * 256 + tt) * 2048 + n * 64 + ck * 8); }
              else if (k < 3) { const float* s = p.in[I_STLC] + (size_t)(g * 3 + k) * DM + n * 64 + ck * 8; const f32x4 a = *(const f32x4*)s, b = *(const f32x4*)(s + 4);
                  v.x = pk2(a[0], a[1]); v.y = pk2(a[2], a[3]); v.z = pk2(b[0], b[1]); v.w = pk2(b[2], b[3]); }
              else v = *(const v4u*)(ZR + (size_t)(MP + 16 * g + k - 3) * 2048 + n * 64 + ck * 8); }
          sv[kk] = v; }
#pragma unroll
      for (int kk = 0; kk < 5; ++kk) { const int idx = tid + kk * (NWAVES * 64); if (idx < 304 * 8) *(LAS v4u*)(XR + (idx >> 3) * 128 + (idx & 7) * 16) = sv[kk]; } }
    if (FINAL && !samp && tid < 64) {
        const int npre = pm & 15; f32x2v sv[15];
#pragma unroll
        for (int k = 0; k < 15; ++k) sv[k] = (k < npre) ? SUMM[(size_t)(pm - npre + k) * DM + n * 64 + tid] : (f32x2v){1.f, 0.f};
        float c = 0.f;
#pragma unroll
        for (int k = 0; k < 15; ++k) c = sv[k].y + sv[k].x * c;
        CIN[tid] = c;
    }
    __syncthreads();
    const int i16 = lane & 15, fq = lane >> 4;
    const float* cwl = p.in[I_CLW]; const float* cbl = p.in[I_CLB];
    bf16x8 fa[2][2];
#pragma unroll
    for (int ks = 0; ks < 2; ++ks) {
        const int ch0 = 32 * ks + 8 * fq; f32x4 w[4][2], bb[2];
#pragma unroll
        for (int tp = 0; tp < 4; ++tp) { w[tp][0] = *(const f32x4*)(cwl + tp * DM + n * 64 + ch0); w[tp][1] = *(const f32x4*)(cwl + tp * DM + n * 64 + ch0 + 4); }
        bb[0] = *(const f32x4*)(cbl + n * 64 + ch0); bb[1] = *(const f32x4*)(cbl + n * 64 + ch0 + 4);
#pragma unroll
        for (int m = 0; m < 2; ++m) {
            const int tau = 8 * (i16 >> 2) + 4 * m + (i16 & 3), T = 32 * wave + tau, rb = (T >> 4) * 19 + (T & 15);
            f32x4 u0 = bb[0], u1 = bb[1];
#pragma unroll
            for (int tp = 0; tp < 4; ++tp) { const v4u x = *(const LAS v4u*)(XR + (rb + tp) * 128 + ch0 * 2);
                u0 += w[tp][0] * (f32x4){bflo(x.x), bfhi(x.x), bflo(x.y), bfhi(x.y)}; u1 += w[tp][1] * (f32x4){bflo(x.z), bfhi(x.z), bflo(x.w), bfhi(x.w)}; }
            v4u f; f.x = pk2(u0[0], u0[1]); f.y = pk2(u0[2], u0[3]); f.z = pk2(u1[0], u1[1]); f.w = pk2(u1[2], u1[3]);
            fa[m][ks] = __builtin_bit_cast(bf16x8, f);
        }
    }
    float hloc[4][8], pc[4][8], P8[4], H8[4];
    const int T0 = 32 * wave + 8 * fq, rb0 = (T0 >> 4) * 19 + (T0 & 15);
#pragma unroll
    for (int nb = 0; nb < 4; ++nb) {
        const int ch = 16 * nb + i16, gch = n * 64 + ch;
        f32x4 aR[2] = {{0.f, 0.f, 0.f, 0.f}, {0.f, 0.f, 0.f, 0.f}}, aI[2] = {{0.f, 0.f, 0.f, 0.f}, {0.f, 0.f, 0.f, 0.f}};
#pragma unroll
        for (int ks = 0; ks < 2; ++ks) {
            const bf16x8 bR = *(const bf16x8*)(Wg_t + (size_t)(n * 64 + ch) * 64 + 8 * fq + 32 * ks);
            const bf16x8 bI = *(const bf16x8*)(Wg_t + (size_t)((16 + n) * 64 + ch) * 64 + 8 * fq + 32 * ks);
#pragma unroll
            for (int m = 0; m < 2; ++m) { aR[m] = __builtin_amdgcn_mfma_f32_16x16x32_bf16(fa[m][ks], bR, aR[m], 0, 0, 0); aI[m] = __builtin_amdgcn_mfma_f32_16x16x32_bf16(fa[m][ks], bI, aI[m], 0, 0, 0); }
        }
        float x[11];
#pragma unroll
        for (int r = 0; r < 11; ++r) x[r] = __builtin_bit_cast(float, (unsigned)(*(const LAS unsigned short*)(XR + (rb0 + r) * 128 + ch * 2)) << 16);
        const float c0 = cwl[gch], c1 = cwl[DM + gch], c2 = cwl[2 * DM + gch], c3 = cwl[3 * DM + gch], cbv = cbl[gch];
        const float bra = p.in[I_BRA][gch], bix = p.in[I_BIX][gch], lam = p.in[I_LAM][gch];
        const float zz = -lam, sp = fmaxf(zz, 0.f) + log1pf(expf(-fabsf(zz))), c8 = -8.0f * sp;
        float hl = 0.f, P = 1.f;
#pragma unroll
        for (int q = 0; q < 8; ++q) {
            const float u = cbv + c0 * x[q] + c1 * x[q + 1] + c2 * x[q + 2] + c3 * x[q + 3];
            const float r = sigmoidf_fast(aR[q >> 2][q & 3] + bra), ig = sigmoidf_fast(aI[q >> 2][q & 3] + bix);
            const float la = r * c8, a = __builtin_amdgcn_exp2f(la * 1.4426950408889634f);
            const float x2 = 2.0f * la, em_small = -x2 * (1.0f + x2 * (0.5f + x2 * (0.16666667f + x2 * 0.041666668f))), em = (x2 > -0.05f) ? em_small : (1.0f - a * a);
            const float b = sqrtf(em) * ig * u;
            hl = a * hl + b; P = P * a;
            hloc[nb][q] = hl; pc[nb][q] = P;
        }
        P8[nb] = P; H8[nb] = hl;
    }
    float Pf[4][4], Hf[4][4];
#pragma unroll
    for (int nb = 0; nb < 4; ++nb)
#pragma unroll
        for (int f = 0; f < 4; ++f) { Pf[nb][f] = __shfl(P8[nb], i16 + 16 * f); Hf[nb][f] = __shfl(H8[nb], i16 + 16 * f); }
    if (!samp) {
        if (fq == 0) {
#pragma unroll
            for (int nb = 0; nb < 4; ++nb) { float hw = 0.f, pw = 1.f;
#pragma unroll
                for (int f = 0; f < 4; ++f) { hw = Hf[nb][f] + Pf[nb][f] * hw; pw *= Pf[nb][f]; }
                SEG[wave * 64 + 16 * nb + i16] = (f32x2v){pw, hw}; }
        }
        __syncthreads();
        if (!FINAL) {
            if (tid < 64) { float hu = 0.f, pu = 1.f;
#pragma unroll
                for (int w = 0; w < 8; ++w) { const f32x2v s = SEG[w * 64 + tid]; hu = s.y + s.x * hu; pu *= s.x; }
                SUMM[(size_t)pm * DM + n * 64 + tid] = (f32x2v){pu, hu}; }
            return;
        }
    }
#pragma unroll
    for (int nb = 0; nb < 4; ++nb) {
        const int ch = 16 * nb + i16, gch = n * 64 + ch;
        float c;
        if (!samp) {
            c = CIN[ch];
#pragma unroll
            for (int w = 0; w < 8; ++w) { const f32x2v s = SEG[w * 64 + ch]; if (w < wave) c = s.y + s.x * c; }
#pragma unroll
            for (int f = 0; f < 4; ++f) if (f < fq) c = Hf[nb][f] + Pf[nb][f] * c;
        } else {
            const int sq = 2 * wave + (fq >> 1);
            c = p.in[I_STH][(size_t)sq * DM + gch];
            if (fq & 1) { const float pp = (fq == 1) ? Pf[nb][0] : Pf[nb][2], hh = (fq == 1) ? Hf[nb][0] : Hf[nb][2]; c = hh + pp * c; }
        }
        bf16* hp = HP + (size_t)(pm * 256 + T0) * 2048 + gch; float hlast = 0.f;
#pragma unroll
        for (int q = 0; q < 8; ++q) { const float h = hloc[nb][q] + pc[nb][q] * c; hp[(size_t)q * 2048] = (bf16)f2bf(h); hlast = h; }
        if (!samp) { if ((pm & 15) == 15 && wave == 7 && fq == 3) p.out[OFF_HP + (size_t)(pm >> 4) * DM + gch] = hlast; }
        else if (fq & 1) p.out[OFF_HS + (size_t)(2 * wave + (fq >> 1)) * DM + gch] = hlast;
    }
}

constexpr int XL_RS = 144  , XL_BYTES = 259 * XL_RS + 16, XL_SEG = 2 * XL_BYTES, XL_CW = XL_SEG + 4096;
__device__ __forceinline__ void lru_task(const KP& p, LAS unsigned char* lds, int s, int n, int hf, int tid, int lane, int wave) {
    const bf16* ZR = (const bf16*)(p.ws + WS_R1); const bf16* Wg_t = (const bf16*)(p.ws + WS_WG); bf16* HP = (bf16*)(p.ws + WS_R3);
    typedef float f32x2v __attribute__((ext_vector_type(2)));
    LAS f32x2v* SEG = (LAS f32x2v*)(lds + XL_SEG); LAS float* CW = (LAS float*)(lds + XL_CW);
    const int i16 = lane & 15, fq = lane >> 4;
    const float* cwl = p.in[I_CLW]; const float* cbl = p.in[I_CLB];
    const size_t rowbase = (size_t)s * SEQ;
    __syncthreads();
    if (tid < 320) { const int tp = tid >> 6, c = tid & 63; CW[tid] = tp < 4 ? cwl[tp * DM + n * 64 + c] : cbl[n * 64 + c]; }
    { v4u f0[5];
#pragma unroll
      for (int k = 0; k < 5; ++k) { const int idx = tid + k * (NWAVES * 64), row = idx >> 3, ck = idx & 7; f0[k] = (v4u){0u, 0u, 0u, 0u};
          if (idx < 259 * 8 && row >= 3) f0[k] = *(const v4u*)(ZR + (rowbase + row - 3) * 2048 + n * 64 + ck * 8); }
#pragma unroll
      for (int k = 0; k < 5; ++k) { const int idx = tid + k * (NWAVES * 64); if (idx < 259 * 8) *(LAS v4u*)(lds + (idx >> 3) * XL_RS + (idx & 7) * 16) = f0[k]; } }
    bf16x8 bR[2][2], bI[2][2]; float c0[2], c1[2], c2[2], c3[2], cbv[2], bra[2], bix[2], c8[2], cin[2];
#pragma unroll
    for (int b2 = 0; b2 < 2; ++b2) { const int ch = 16 * (2 * hf + b2) + i16, gch = n * 64 + ch;
#pragma unroll
        for (int ks = 0; ks < 2; ++ks) { bR[b2][ks] = *(const bf16x8*)(Wg_t + (size_t)(n * 64 + ch) * 64 + 8 * fq + 32 * ks); bI[b2][ks] = *(const bf16x8*)(Wg_t + (size_t)((16 + n) * 64 + ch) * 64 + 8 * fq + 32 * ks); }
        c0[b2] = cwl[gch]; c1[b2] = cwl[DM + gch]; c2[b2] = cwl[2 * DM + gch]; c3[b2] = cwl[3 * DM + gch]; cbv[b2] = cbl[gch];
        bra[b2] = p.in[I_BRA][gch]; bix[b2] = p.in[I_BIX][gch];
        const float zz = -p.in[I_LAM][gch]; c8[b2] = -8.0f * (fmaxf(zz, 0.f) + log1pf(expf(-fabsf(zz)))) * 1.4426950408889634f;
        cin[b2] = 0.f; }
    __syncthreads();
    for (int tt = 0; tt < 16; ++tt) {
        LAS unsigned char* XR = lds + (tt & 1) * XL_BYTES; LAS unsigned char* XN_ = lds + ((tt + 1) & 1) * XL_BYTES;
        v4u pf[5];
        if (tt < 15) {
#pragma unroll
            for (int k = 0; k < 5; ++k) { const int idx = tid + k * (NWAVES * 64); if (idx < 259 * 8) pf[k] = *(const v4u*)(ZR + (rowbase + 256 * (tt + 1) - 3 + (idx >> 3)) * 2048 + n * 64 + (idx & 7) * 8); } }
        bf16x8 fa[2][2];
#pragma unroll
        for (int ks = 0; ks < 2; ++ks) { const int ch0 = 32 * ks + 8 * fq; f32x4 w[4][2], bb[2];
#pragma unroll
            for (int tp = 0; tp < 4; ++tp) { w[tp][0] = *(const LAS f32x4*)(CW + tp * 64 + ch0); w[tp][1] = *(const LAS f32x4*)(CW + tp * 64 + ch0 + 4); }
            bb[0] = *(const LAS f32x4*)(CW + 256 + ch0); bb[1] = *(const LAS f32x4*)(CW + 256 + ch0 + 4);
#pragma unroll
            for (int m = 0; m < 2; ++m) { const int rb = 32 * wave + 8 * (i16 >> 2) + 4 * m + (i16 & 3); f32x4 u0 = bb[0], u1 = bb[1];
#pragma unroll
                for (int tp = 0; tp < 4; ++tp) { const v4u x = *(const LAS v4u*)(XR + (rb + tp) * XL_RS + ch0 * 2);
                    u0 += w[tp][0] * (f32x4){bflo(x.x), bfhi(x.x), bflo(x.y), bfhi(x.y)}; u1 += w[tp][1] * (f32x4){bflo(x.z), bfhi(x.z), bflo(x.w), bfhi(x.w)}; }
                v4u f; f.x = pg8::cvt_pk_bf16(u0[0], u0[1]); f.y = pg8::cvt_pk_bf16(u0[2], u0[3]); f.z = pg8::cvt_pk_bf16(u1[0], u1[1]); f.w = pg8::cvt_pk_bf16(u1[2], u1[3]);
                fa[m][ks] = __builtin_bit_cast(bf16x8, f); } }
        float hloc[2][8], pc[2][8], P8[2], H8[2];
        const int rb0 = 32 * wave + 8 * fq;
#pragma unroll
        for (int b2 = 0; b2 < 2; ++b2) { const int ch = 16 * (2 * hf + b2) + i16;
            f32x4 aR[2] = {{0.f, 0.f, 0.f, 0.f}, {0.f, 0.f, 0.f, 0.f}}, aI[2] = {{0.f, 0.f, 0.f, 0.f}, {0.f, 0.f, 0.f, 0.f}};
#pragma unroll
            for (int ks = 0; ks < 2; ++ks)
#pragma unroll
                for (int m = 0; m < 2; ++m) { aR[m] = __builtin_amdgcn_mfma_f32_16x16x32_bf16(fa[m][ks], bR[b2][ks], aR[m], 0, 0, 0); aI[m] = __builtin_amdgcn_mfma_f32_16x16x32_bf16(fa[m][ks], bI[b2][ks], aI[m], 0, 0, 0); }
            float x[11];
#pragma unroll
            for (int r = 0; r < 11; ++r) x[r] = __builtin_bit_cast(float, (unsigned)(*(const LAS unsigned short*)(XR + (rb0 + r) * XL_RS + ch * 2)) << 16);
            float hl = 0.f, P = 1.f;
#pragma unroll
            for (int q = 0; q < 8; ++q) {
                const float u = cbv[b2] + c0[b2] * x[q] + c1[b2] * x[q + 1] + c2[b2] * x[q + 2] + c3[b2] * x[q + 3];
                const float r = sigmoidf_fast(aR[q >> 2][q & 3] + bra[b2]), ig = sigmoidf_fast(aI[q >> 2][q & 3] + bix[b2]);
                const float a = __builtin_amdgcn_exp2f(r * c8[b2]);
                const float b = __builtin_amdgcn_sqrtf(fmaxf(__builtin_fmaf(-a, a, 1.0f), 0.f)) * ig * u;
                hl = __builtin_fmaf(a, hl, b); P = P * a; hloc[b2][q] = hl; pc[b2][q] = P; }
            P8[b2] = P; H8[b2] = hl; }
        float Pf[2][4], Hf[2][4];
#pragma unroll
        for (int b2 = 0; b2 < 2; ++b2)
#pragma unroll
            for (int f = 0; f < 4; ++f) { Pf[b2][f] = __shfl(P8[b2], i16 + 16 * f); Hf[b2][f] = __shfl(H8[b2], i16 + 16 * f); }
        if (fq == 0) {
#pragma unroll
            for (int b2 = 0; b2 < 2; ++b2) { float hw = 0.f, pw = 1.f;
#pragma unroll
                for (int f = 0; f < 4; ++f) { hw = __builtin_fmaf(Pf[b2][f], hw, Hf[b2][f]); pw *= Pf[b2][f]; }
                SEG[(tt & 1) * 256 + wave * 32 + 16 * b2 + i16] = (f32x2v){pw, hw}; } }
        if (tt < 15) {
#pragma unroll
            for (int k = 0; k < 5; ++k) { const int idx = tid + k * (NWAVES * 64); if (idx < 259 * 8) *(LAS v4u*)(XN_ + (idx >> 3) * XL_RS + (idx & 7) * 16) = pf[k]; } }
        LDS_WAIT(); __syncthreads();
#pragma unroll
        for (int b2 = 0; b2 < 2; ++b2) { const int ch = 16 * (2 * hf + b2) + i16, gch = n * 64 + ch;
            float c = cin[b2], call = cin[b2];
#pragma unroll
            for (int w = 0; w < 8; ++w) { const f32x2v sg = SEG[(tt & 1) * 256 + w * 32 + 16 * b2 + i16]; call = __builtin_fmaf(sg.x, call, sg.y); if (w < wave) c = __builtin_fmaf(sg.x, c, sg.y); }
            cin[b2] = call;
#pragma unroll
            for (int f = 0; f < 4; ++f) if (f < fq) c = __builtin_fmaf(Pf[b2][f], c, Hf[b2][f]);
            bf16* hp = HP + (rowbase + 256 * tt + rb0) * 2048 + gch; float hlast = 0.f;
#pragma unroll
            for (int q = 0; q < 8; ++q) { const float h = __builtin_fmaf(pc[b2][q], c, hloc[b2][q]); hp[(size_t)q * 2048] = (bf16)f2bf(h); hlast = h; }
            if (tt == 15 && wave == 7 && fq == 3) p.out[OFF_HP + (size_t)s * DM + gch] = hlast; }
    }
}

__device__ __forceinline__ v4u pool_load8(const KP& p, const bf16* ZR, int pm, int tt, int run, int ch) {
    const bool samp = (pm == STILE); v4u w = {0u, 0u, 0u, 0u};
    if (!samp) { if (256 * (pm & 15) + tt >= 0) w = *(const v4u*)(ZR + (size_t)(pm * 256 + tt) * 2048 + 1024 + ch); }
    else { const int tl = tt - 16 * run;
        if (tl < 0) { const float* s = p.in[I_STPOOL] + (size_t)(run * 15 + 15 + tl) * DM + ch; const f32x4 a = *(const f32x4*)s, b = *(const f32x4*)(s + 4);
            w.x = pk2(a[0], a[1]); w.y = pk2(a[2], a[3]); w.z = pk2(b[0], b[1]); w.w = pk2(b[2], b[3]); }
        else w = *(const v4u*)(ZR + (size_t)(MP + tt) * 2048 + 1024 + ch); }
    return w;
}
__device__ __forceinline__ void unpack8(const v4u w, float (&v)[8]) { v[0] = bflo(w.x); v[1] = bfhi(w.x); v[2] = bflo(w.y); v[3] = bfhi(w.y); v[4] = bflo(w.z); v[5] = bfhi(w.z); v[6] = bflo(w.w); v[7] = bfhi(w.w); }
template <int W> __device__ __forceinline__ void pool_unit_w(const KP& p, int pm, int g, int tid) {
    const bf16* ZR = (const bf16*)(p.ws + WS_R1); bf16* HP = (bf16*)(p.ws + WS_R3);
    const bool samp = (pm == STILE);
    const int oct = tid & 31, run = tid >> 5, ch = 256 * g + 8 * oct;
#pragma unroll 1
    for (int hf = 0; hf < 2; ++hf) {
        const int tf = 16 * run + 8 * hf;
        const int pos0 = samp ? PAST : 256 * (pm & 15) + tf;
        v4u raw[W - 1 + 8];
#pragma unroll
        for (int r = 0; r < W - 1 + 8; ++r) raw[r] = pool_load8(p, ZR, pm, tf - (W - 1) + r, run, ch);
        float s[8];
#pragma unroll
        for (int e = 0; e < 8; ++e) s[e] = 0.f;
#pragma unroll
        for (int r = 0; r < W - 1; ++r) { float v[8]; unpack8(raw[r], v);
#pragma unroll
            for (int e = 0; e < 8; ++e) s[e] += v[e]; }
#pragma unroll
        for (int i = 0; i < 8; ++i) {
            const int cnt = min(pos0 + i + 1, W); const float inv = 1.0f / (float)cnt; float o[8], v[8], vo[8]; unpack8(raw[W - 1 + i], v); unpack8(raw[i], vo);
#pragma unroll
            for (int e = 0; e < 8; ++e) { s[e] += v[e]; o[e] = s[e] * inv - v[e]; }
            v4u ow; ow.x = pk2(o[0], o[1]); ow.y = pk2(o[2], o[3]); ow.z = pk2(o[4], o[5]); ow.w = pk2(o[6], o[7]);
            *(v4u*)(HP + (size_t)(pm * 256 + tf + i) * 2048 + 1024 + ch) = ow;
#pragma unroll
            for (int e = 0; e < 8; ++e) s[e] -= vo[e];
        }
    }
}
__device__ __forceinline__ void pool_unit(const KP& p, int pm, int g, int tid) {
    if (g == 0) pool_unit_w<2>(p, pm, g, tid); else if (g == 1) pool_unit_w<4>(p, pm, g, tid); else if (g == 2) pool_unit_w<8>(p, pm, g, tid); else pool_unit_w<16>(p, pm, g, tid);
}
constexpr int PL_RS = 272;
template <int W> __device__ __forceinline__ void pool_half_w(const KP& p, LAS unsigned char* lds, int pm, int g, int half, int tid) {
    const bf16* ZR = (const bf16*)(p.ws + WS_R1); bf16* HP = (bf16*)(p.ws + WS_R3);
    const int ch0 = 256 * g + 128 * half, t0seq = 256 * (pm & 15);
    __syncthreads();
    v4u st[9];
#pragma unroll
    for (int k = 0; k < 9; ++k) { const int idx = tid + k * (NWAVES * 64), row = idx >> 4, ck = idx & 15; st[k] = (v4u){0u, 0u, 0u, 0u};
        if (idx < 271 * 16 && t0seq + row - 15 >= 0) st[k] = *(const v4u*)(ZR + (size_t)(pm * 256 + row - 15) * 2048 + 1024 + ch0 + ck * 8); }
#pragma unroll
    for (int k = 0; k < 9; ++k) { const int idx = tid + k * (NWAVES * 64); if (idx < 271 * 16) *(LAS v4u*)(lds + (idx >> 4) * PL_RS + (idx & 15) * 16) = st[k]; }
    __syncthreads();
    const int oct = tid & 15, tf = 8 * (tid >> 4), pos0 = t0seq + tf;
    v4u raw[W - 1 + 8];
#pragma unroll
    for (int r = 0; r < W - 1 + 8; ++r) raw[r] = *(const LAS v4u*)(lds + (tf - (W - 1) + r + 15) * PL_RS + oct * 16);
    float s[8];
#pragma unroll
    for (int e = 0; e < 8; ++e) s[e] = 0.f;
#pragma unroll
    for (int r = 0; r < W - 1; ++r) { float v[8]; unpack8(raw[r], v);
#pragma unroll
        for (int e = 0; e < 8; ++e) s[e] += v[e]; }
#pragma unroll
    for (int i = 0; i < 8; ++i) {
        const int cnt = min(pos0 + i + 1, W); const float inv = __builtin_amdgcn_rcpf((float)cnt); float o[8], v[8], vo[8]; unpack8(raw[W - 1 + i], v); unpack8(raw[i], vo);
#pragma unroll
        for (int e = 0; e < 8; ++e) { s[e] += v[e]; o[e] = s[e] * inv - v[e]; }
        v4u ow; ow.x = pg8::cvt_pk_bf16(o[0], o[1]); ow.y = pg8::cvt_pk_bf16(o[2], o[3]); ow.z = pg8::cvt_pk_bf16(o[4], o[5]); ow.w = pg8::cvt_pk_bf16(o[6], o[7]);
        *(v4u*)(HP + (size_t)(pm * 256 + tf + i) * 2048 + 1024 + ch0 + oct * 8) = ow;
#pragma unroll
        for (int e = 0; e < 8; ++e) s[e] -= vo[e];
    }
}
__device__ __forceinline__ void pool_half(const KP& p, LAS unsigned char* lds, int pm, int g, int half, int tid) {
    if (g == 0) pool_half_w<2>(p, lds, pm, g, half, tid); else if (g == 1) pool_half_w<4>(p, lds, pm, g, half, tid); else if (g == 2) pool_half_w<8>(p, lds, pm, g, half, tid); else pool_half_w<16>(p, lds, pm, g, half, tid);
}
__device__ __forceinline__ void state_copy(const KP& p, int gtid, int gthreads) {
    const bf16* ZR = (const bf16*)(p.ws + WS_R1);
    constexpr int N1 = NBATCH * 3 * DM, N2 = NBATCH * 15 * DM, N3 = SBATCH * 3 * DM, N4 = SBATCH * 15 * DM;
    constexpr int NT = N1 + N2 + N3 + N4;
    for (int i0 = gtid; i0 < NT; i0 += 4 * gthreads) {
        unsigned short raw[4]; float* dsts[4];
#pragma unroll
        for (int k = 0; k < 4; ++k) { const int i = i0 + k * gthreads; raw[k] = 0; dsts[k] = nullptr;
            if (i < NT) { int r = i; size_t row, col; float* dst;
                if (r < N1) { const int b = r / (3 * DM), kk = (r / DM) % 3, c = r % DM; row = (size_t)b * SEQ + SEQ - 3 + kk; col = c; dst = p.out + OFF_LCP + r; }
                else if ((r -= N1) < N2) { const int b = r / (15 * DM), kk = (r / DM) % 15, c = r % DM; row = (size_t)b * SEQ + SEQ - 15 + kk; col = 1024 + c; dst = p.out + OFF_PLP + r; }
                else if ((r -= N2) < N3) { const int b = r / (3 * DM), kk = (r / DM) % 3, c = r % DM; row = (size_t)MP + b * SSEQ + SSEQ - 3 + kk; col = c; dst = p.out + OFF_LCS + r; }
                else { r -= N3; const int b = r / (15 * DM), kk = (r / DM) % 15, c = r % DM; row = (size_t)MP + b * SSEQ + SSEQ - 15 + kk; col = 1024 + c; dst = p.out + OFF_PLS + r; }
                raw[k] = ZR[row * 2048 + col]; dsts[k] = dst; } }
#pragma unroll
        for (int k = 0; k < 4; ++k) if (dsts[k]) *dsts[k] = __builtin_bit_cast(float, (unsigned)raw[k] << 16);
    }
}

template <int MODE = 0> __device__ __forceinline__ void strip_pre(const KP& p, LAS unsigned char* lds, int pm0, int pn, int cnt, int tid, int lane, int wave) {
    const float* SSQ = (const float*)(p.ws + WS_SSQ); const bf16* XG2 = (const bf16*)(p.ws + WS_R1); const bf16* Wup_t = (const bf16*)(p.ws + WS_WUP);
    LAS float* RS = (LAS float*)(lds + RS_OFF); LAS float* ES = (LAS float*)(lds + EDGE_START_OFF); LAS float* CWL = (LAS float*)(lds + CWL_OFF);
    __syncthreads();
#pragma unroll
    for (int k = 0; k < 2; ++k) { const int idx = tid + k * (NWAVES * 64), vec = idx >> 8, col = idx & 255, oc = (col >> 7) * DFF + 128 * pn + (col & 127);
        CWL[idx] = vec < 3 ? p.in[I_CFW][(size_t)vec * DUP + oc] : p.in[I_CFB][oc]; }
    if (MODE != 2) for (int i = tid; i < cnt * 256; i += NWAVES * 64) RS[i] = row_rs(SSQ, (size_t)pm0 * 256 + i);
    ES[tid] = 0.f;
    __syncthreads();
}

__device__ __forceinline__ void strip_fix(const KP& p, int gtid, int gthreads) {
    const float* HA = (const float*)(p.ws + WS_HA); const float* HB = (const float*)(p.ws + WS_HB); bf16* ACT = (bf16*)(p.ws + WS_R2);
    const float* cw = p.in[I_CFW]; const float* cb = p.in[I_CFB];
    for (int i = gtid; i < 32 * 24 * 128; i += gthreads) {
        const int c = i & 127, sp = i >> 7, pn = sp % 24, sr = sp / 24;
        if ((sr & 3) == 0) continue;
        const float* ha = HA + (size_t)sp * 512; const float* hb = HB + (size_t)sp * 512;
        float hg[4], hv[4];
        hg[0] = ha[c]; hg[1] = ha[256 + c]; hg[2] = hb[c]; hg[3] = hb[256 + c];
        hv[0] = ha[128 + c]; hv[1] = ha[384 + c]; hv[2] = hb[128 + c]; hv[3] = hb[384 + c];
        const int og = 128 * pn + c, ov = DFF + og;
        const float g0 = cw[og], g1 = cw[DUP + og], g2 = cw[2 * DUP + og], gb = cb[og], v0 = cw[ov], v1 = cw[DUP + ov], v2 = cw[2 * DUP + ov], vb = cb[ov];
#pragma unroll
        for (int t = 0; t < 2; ++t) { const float cg = gb + g0 * hg[t] + g1 * hg[t + 1] + g2 * hg[t + 2], cv = vb + v0 * hv[t] + v1 * hv[t + 1] + v2 * hv[t + 2];
            ACT[((size_t)sr * 1024 + t) * DFF + og] = (bf16)f2bf(gelu_tanh(cg) * cv); }
    }
}

__device__ __forceinline__ void final_norm(const KP& p, int gw, int NGW, int lane) {
    const float* SSQ2 = (const float*)(p.ws + WS_SSQ2); const float* gf = p.in[I_NFIN];
    f32x4 gv[4];
#pragma unroll
    for (int j = 0; j < 4; ++j) gv[j] = *((const f32x4*)gf + lane + 64 * j);
    for (int m = gw; m < M; m += NGW) {
        const float sv = (lane < 8) ? SSQ2[(size_t)m * 8 + lane] : 0.f;
        const float rstd = 1.0f / sqrtf(wave_sum(sv) * (1.f / DM) + EPS);
        f32x4* yr = (f32x4*)(p.out + OFF_Y + (size_t)m * DM) + lane;
#pragma unroll
        for (int j = 0; j < 4; ++j) { const f32x4 v = yr[64 * j]; yr[64 * j] = v * rstd * gv[j]; }
    }
}
#ifndef MK_ONE_LAUNCH
#define MK_ONE_LAUNCH 1
#endif
#ifndef PG8_SP2
#define PG8_SP2 true
#endif
#ifndef PG8_ALIGN
#define PG8_ALIGN true
#endif
#ifndef FUSE_FINAL
#define FUSE_FINAL 1
#endif
constexpr int N_PHASES = 11;
__global__ void __launch_bounds__(NWAVES * 64, 2) mk_fwd(KP p) {
    extern __shared__ __attribute__((aligned(16))) unsigned char lds_raw[];
    LAS unsigned char* lds = (LAS unsigned char*)lds_raw;
    const int tid = threadIdx.x, lane = tid & 63, wave = __builtin_amdgcn_readfirstlane(tid >> 6);
    const int G = gridDim.x, bx = blockIdx.x, vcu = (G % 8 == 0) ? (bx % 8) * (G / 8) + bx / 8 : bx;
    volatile LAS unsigned* MISC = (volatile LAS unsigned*)(lds + MISC_OFF);
    if (tid < 32) MISC[tid] = 0u;
    __syncthreads();
    unsigned* ctl = (unsigned*)(p.ws + WS_CTL);
    const int lo = p.ph_lo, hi = p.ph_hi;
    XcdBarrier bar; bar.bar = ctl + CW_BAR; bar.x = 0; bar.st = MISC + 8;
    if (hi - lo > 1) bar = xcd_barrier_post(ctl + CW_BAR, MISC + 8);
#ifndef PH_MASK
#define PH_MASK 0xfff
#endif
#define IN(k) (((PH_MASK >> (k)) & 1) && lo <= (k) && (k) < hi)
#ifndef REP_MASK
#define REP_MASK 0
#endif
#define PH(k) if (IN(k)) for (int rep_ = 0; rep_ <= ((REP_MASK >> (k)) & 1); ++rep_)
#define REPBAR() do { if (rep_) xcd_barrier(bar); } while (0)
#ifndef DLY1
#define DLY1 0
#endif
#ifndef DLY5
#define DLY5 0
#endif
#define PHASE_DELAY(ticks) do { if ((ticks) > 0 && ((bx >> 3) & 1)) { const unsigned long long t0_ = __builtin_amdgcn_s_memrealtime(); while (__builtin_amdgcn_s_memrealtime() - t0_ < (unsigned long long)(ticks)) __builtin_amdgcn_s_sleep(8); } } while (0)
#define SEAM(k) do { if (IN(k) && IN((k) + 1)) xcd_barrier(bar); } while (0)
    unsigned char* ws = p.ws;
    bf16* XN = (bf16*)(ws + WS_R0); bf16* MG = (bf16*)(ws + WS_R0); bf16* ZR = (bf16*)(ws + WS_R1); bf16* XG2 = (bf16*)(ws + WS_R1);
    bf16* GT = (bf16*)(ws + WS_R2); bf16* HP = (bf16*)(ws + WS_R3); bf16* ACT = (bf16*)(ws + WS_R2);
    bf16* Win_t = (bf16*)(ws + WS_WIN); bf16* Wcat_t = (bf16*)(ws + WS_WCAT); bf16* Wout_t = (bf16*)(ws + WS_WOUT); bf16* Wup_t = (bf16*)(ws + WS_WUP); bf16* Wdn_t = (bf16*)(ws + WS_WDN);
    float* SSQ = (float*)(ws + WS_SSQ); float* SSQ2 = (float*)(ws + WS_SSQ2);
    float* Y = p.out + OFF_Y;

    PH(0) { REPBAR(); p0_prologue(p, lds, vcu, G, wave, lane); }
    SEAM(0);
    PH(1) { REPBAR();
        pg8::Gemm g{XN, Win_t, DM, DM, DM}; pg8::StaticOrder S; S.init(MP, DIN, G, bx);
        EpiZ E{ZR, GT};
        const bool wfirst = (G > 64) && bx >= 64 && (bx & 1);
        for (int su = bx; su < 48; su += G) { if (su < 32) pg8::sub_gemm<1>(lds, g, STILE, su >> 2, (su >> 1) & 1, su & 1, E); else pg8::sub_gemm<2>(lds, g, STILE, 8 + ((su - 32) >> 1), su & 1, 0, E); }
        if (wfirst) { p1_weights(p, lds, (bx - 64) * NWAVES + wave, (G - 64) * NWAVES, wave, lane); __syncthreads(); }
        PHASE_DELAY(DLY1);
        pg8::gemm_phase<EpiZ, pg8::StaticOrder, PG8_ALIGN, PG8_SP2>(lds, g, S, E);
        if (G > 64) { if (bx >= 64 && !wfirst) p1_weights(p, lds, (bx - 64) * NWAVES + wave, (G - 64) * NWAVES, wave, lane); } else p1_weights(p, lds, bx * NWAVES + wave, G * NWAVES, wave, lane);
    }
    SEAM(1);
    PH(2) { REPBAR();
        state_copy(p, bx * NWAVES * 64 + tid, G * NWAVES * 64);
        for (int su = (bx >= 64 ? bx - 64 : bx + G - 64); su < 64; su += G) {
            const int g_ = su >> 4, q = su & 15; pg8::Gemm gw_{(const bf16*)(ws + WS_WBP) + 256 * g_, (const bf16*)(ws + WS_WPOOL) + (size_t)g_ * 65536, 256, DM, 256};
            EpiW EW{Wcat_t + 1024 + 256 * g_}; pg8::sub_gemm<1>(lds, gw_, q >> 2, 0, (q >> 1) & 1, q & 1, EW); }
        const bool pool_first = ((bx >> 3) & 1) != 0;
        if (pool_first) { for (int L = bx; L < 4 * 2 * STILE; L += G) { const int g_ = L / (2 * STILE), r = L % (2 * STILE); pool_half(p, lds, r >> 1, g_, r & 1, tid); } }
        for (int t = bx; t < NBATCH * 32; t += G) lru_task(p, lds, t >> 5, (t >> 1) & 15, t & 1, tid, lane, wave);
        for (int L = bx; L < 16; L += G) lru_unit<true>(p, lds, STILE, L, tid, lane, wave);
        for (int L = (bx >= 128 ? bx - 128 : bx + G - 128); L < 4; L += G) pool_unit(p, STILE, L, tid);
        if (!pool_first) { for (int L = bx; L < 4 * 2 * STILE; L += G) { const int g_ = L / (2 * STILE), r = L % (2 * STILE); pool_half(p, lds, r >> 1, g_, r & 1, tid); } }
    }
    if (IN(2) && IN(4)) xcd_barrier(bar);
    PH(4) { REPBAR();
        pg8::Gemm g{HP, Wcat_t, 2048, 2048, 2048}; pg8::StaticOrder S; S.init(MP, DM, G, bx);
        EpiBr E{GT, MG};
        pg8::gemm_phase<EpiBr, pg8::StaticOrder, PG8_ALIGN, PG8_SP2>(lds, g, S, E);
        for (int su = bx; su < 16; su += G) pg8::sub_gemm<1>(lds, g, STILE, su >> 2, (su >> 1) & 1, su & 1, E);
    }
    if (IN(4) && IN(6)) xcd_barrier(bar);
    PH(6) { REPBAR();
        pg8::Gemm g{MG, Wout_t, DM, DM, DM}; pg8::StaticOrder S; S.init(MP, DM, G, bx);
        EpiRes<false> E{p.in[I_XP], p.in[I_XS], Y, XG2, SSQ, lds};
        pg8::gemm_phase<EpiRes<false>, pg8::StaticOrder, true  , PG8_SP2>(lds, g, S, E);
        for (int su = bx; su < 16; su += G) pg8::sub_gemm<1>(lds, g, STILE, su >> 2, (su >> 1) & 1, su & 1, E);
    }
    SEAM(6);
    PH(7) { REPBAR();
        pg8::Gemm g{XG2, Wup_t, DM, DM, DM};
        { EpiUpS ES{ACT, p.in[I_CFW], p.in[I_CFB], p.in[I_STFFN], p.out + OFF_FCS, SSQ};
          for (int su = bx; su < 48; su += G) pg8::sub_gemm<2>(lds, g, STILE, su >> 1, su & 1, 0, ES); }
        PHASE_DELAY(DLY5);
        for (int sidx = vcu; sidx < 768; sidx += G) {
            const int rg = sidx >> 8, v = sidx & 255, x = v >> 5, w = v & 31, pm0 = 4 * (4 * x + (w >> 3)), pn = 8 * rg + (w & 7);
            strip_pre(p, lds, pm0, pn, 4, tid, lane, wave);
            pg8::StripOrder S{pm0, pn, 4};
            EpiUp E{ACT, p.in[I_CFW], p.in[I_CFB], p.in[I_STFFN], p.out + OFF_FCP, p.out + OFF_FCS, lds, pm0, nullptr, (float*)(ws + WS_HA), (float*)(ws + WS_HB)};
            pg8::gemm_phase<EpiUp, pg8::StripOrder, true, PG8_SP2>(lds, g, S, E);
        }
    }
    SEAM(7);
    PH(8) { REPBAR(); strip_fix(p, bx * NWAVES * 64 + tid, G * NWAVES * 64); }
    SEAM(8);
    const bool fuse_final = (G == 256) && FUSE_FINAL;
    PH(9) { REPBAR();
        pg8::Gemm g{ACT, Wdn_t, DFF, DFF, DFF}; pg8::StaticOrder S; S.init(MP, DM, G, bx);
        if (fuse_final) {
            EpiFinal E{Y, XG2, p.in[I_NFIN], SSQ2, ctl + CW_PANEL, ctl + CW_BAR + XB_TMO, lds};
            pg8::gemm_phase<EpiFinal, pg8::StaticOrder, true  , PG8_SP2>(lds, g, S, E);
            for (int su = bx; su < 16; su += G) pg8::sub_gemm<1>(lds, g, STILE, su >> 2, (su >> 1) & 1, su & 1, E);
        } else {
            EpiRes<true> E{nullptr, nullptr, Y, XG2, SSQ2, lds};
            pg8::gemm_phase<EpiRes<true>, pg8::StaticOrder, true, PG8_SP2>(lds, g, S, E);
            for (int su = bx; su < 16; su += G) pg8::sub_gemm<1>(lds, g, STILE, su >> 2, (su >> 1) & 1, su & 1, E);
        }
    }
#ifndef EXP
#define EXP 0
#endif
#if EXP != 0
    if (lo == 11) {
#if EXP == 1
        pg8::Gemm g{XG2, Wup_t, DM, DM, DM};
        for (int sidx = vcu; sidx < 768; sidx += G) {
            const int rg = sidx >> 8, v = sidx & 255, x = v >> 5, w = v & 31, pm0 = 4 * (4 * x + (w >> 3)), pn = 8 * rg + (w & 7);
            pg8::StripOrder S{pm0, pn, 4}; EpiNull<true> E;
            pg8::gemm_phase<EpiNull<true>, pg8::StripOrder, true, PG8_SP2>(lds, g, S, E);
        }
#elif EXP == 2
        pg8::Gemm g{XN, Win_t, DM, DM, DM}; pg8::StaticOrder S; S.init(MP, DIN, G, bx); EpiNull<false> E;
        pg8::gemm_phase<EpiNull<false>, pg8::StaticOrder, PG8_ALIGN, PG8_SP2>(lds, g, S, E);
#elif EXP == 3
        pg8::Gemm g{XG2, Wup_t, DM, DM, DM}; pg8::StaticOrder S; S.init(MP, DUP, G, bx); EpiNull<true> E;
        pg8::gemm_phase<EpiNull<true>, pg8::StaticOrder, true, PG8_SP2>(lds, g, S, E);
#elif EXP == 5
        pg8::Gemm g{XN, Win_t, DM, DM, DM}; pg8::StaticOrder S; S.init(MP, DIN, G, bx); EpiZScratch E{HP + (size_t)bx * 65536};
        pg8::gemm_phase<EpiZScratch, pg8::StaticOrder, PG8_ALIGN, PG8_SP2>(lds, g, S, E);
#elif EXP == 6
        pg8::Gemm g{XG2, Wup_t, DM, DM, DM};
        PHASE_DELAY(DLY5);
        for (int sidx = vcu; sidx < 768; sidx += G) {
            const int rg = sidx >> 8, v = sidx & 255, x = v >> 5, w = v & 31, pm0 = 4 * (4 * x + (w >> 3)), pn = 8 * rg + (w & 7);
            strip_pre(p, lds, pm0, pn, 4, tid, lane, wave);
            pg8::StripOrder S{pm0, pn, 4};
            EpiUp E{ACT, p.in[I_CFW], p.in[I_CFB], p.in[I_STFFN], p.out + OFF_FCP, p.out + OFF_FCS, lds, pm0, HP + (size_t)bx * 256 * 128, nullptr, nullptr};
            pg8::gemm_phase<EpiUp, pg8::StripOrder, true, PG8_SP2>(lds, g, S, E);
        }
#elif EXP == 7
        pg8::Gemm g{XG2, Wup_t, DM, DM, DM};
        for (int sidx = vcu; sidx < 768; sidx += G) {
            const int rg = sidx >> 8, v = sidx & 255, x = v >> 5, w = v & 31, pm0 = 4 * (4 * x + (w >> 3)), pn = 8 * rg + (w & 7);
            strip_pre(p, lds, pm0, pn, 4, tid, lane, wave);
            pg8::StripOrder S{pm0, pn, 4}; EpiNull<true> E;
            pg8::gemm_phase<EpiNull<true>, pg8::StripOrder, true, PG8_SP2>(lds, g, S, E);
        }
#elif EXP == 8 || EXP == 9
        pg8::Gemm g{XG2, Wup_t, DM, DM, DM};
        for (int sidx = vcu; sidx < 768; sidx += G) {
            const int rg = sidx >> 8, v = sidx & 255, x = v >> 5, w = v & 31, pm0 = 4 * (4 * x + (w >> 3)), pn = 8 * rg + (w & 7);
            strip_pre<EXP - 7>(p, lds, pm0, pn, 4, tid, lane, wave);
            pg8::StripOrder S{pm0, pn, 4}; EpiNull<true> E;
            pg8::gemm_phase<EpiNull<true>, pg8::StripOrder, true, PG8_SP2>(lds, g, S, E);
        }
#elif EXP == 10
        pg8::Gemm g{ACT, Wdn_t, DFF, DFF, DFF}; EpiNull<false> E;
        for (int su = bx; su < 16; su += G) pg8::sub_gemm<1>(lds, g, STILE, su >> 2, (su >> 1) & 1, su & 1, E);
#elif EXP == 11
        pg8::Gemm g{XN, Win_t, DM, DM, DM}; EpiNull<false> E;
        for (int su = bx; su < 64; su += G) pg8::sub_gemm<1>(lds, g, STILE, su >> 2, (su >> 1) & 1, su & 1, E);
#elif EXP == 12
        for (int t = bx; t < NBATCH * 32; t += G) lru_task(p, lds, t >> 5, (t >> 1) & 15, t & 1, tid, lane, wave);
#elif EXP == 13
        for (int L = bx + 16; L < 16 + NTILE * 4; L += G) { const int r = L - 16; pool_unit(p, r >> 2, r & 3, tid); }
#elif EXP == 14
        pg8::Gemm g{HP, Wcat_t, 2048, 2048, 2048}; pg8::StaticOrder S; S.init(MP, DM, G, bx); EpiNull<false> E;
        pg8::gemm_phase<EpiNull<false>, pg8::StaticOrder, PG8_ALIGN, PG8_SP2>(lds, g, S, E);
#elif EXP == 15
        pg8::Gemm g{HP, Wcat_t, 2048, 2048, 2048}; pg8::StaticOrder S; S.init(MP, DM, G, bx); EpiMidOnly E{GT};
        pg8::gemm_phase<EpiMidOnly, pg8::StaticOrder, PG8_ALIGN, PG8_SP2>(lds, g, S, E);
#elif EXP == 16 || EXP == 17
        pg8::Gemm g{ACT, Wdn_t, DFF, DFF, DFF}; pg8::StaticOrder S; S.init(MP, DM, G, bx);
        EpiFinalT<EXP - 15> E{(float*)(ws + WS_R3), XG2, p.in[I_NFIN], SSQ2, ctl + CW_PANEL, ctl + CW_BAR + XB_TMO, lds};
        pg8::gemm_phase<EpiFinalT<EXP - 15>, pg8::StaticOrder, true, PG8_SP2>(lds, g, S, E);
#elif EXP == 4
        pg8::Gemm g{ACT, Wdn_t, DFF, DFF, DFF}; pg8::StaticOrder S; S.init(MP, DM, G, bx); EpiNull<false> E;
        pg8::gemm_phase<EpiNull<false>, pg8::StaticOrder, true, PG8_SP2>(lds, g, S, E);
#endif
    }
#endif
    if (!fuse_final) { SEAM(9);
        PH(10) { REPBAR(); final_norm(p, vcu * NWAVES + wave, G * NWAVES, lane); } }
#undef IN
#undef SEAM
}

extern "C" void kernel_launch(void* const* d_in, const int* in_sizes, int n_in, void* d_out, int out_size, void* d_ws, size_t ws_size, hipStream_t stream) {
    static int grid = 0;
    if (grid == 0) {
        if (n_in != 26 || in_sizes[0] != MP * DM || (size_t)out_size != OUT_TOTAL || ws_size < WS_END) {
            fprintf(stderr, "kernel_launch: unexpected shapes: n_in %d in0 %d out %d ws %zu (need %zu)\n", n_in, n_in > 0 ? in_sizes[0] : -1, out_size, ws_size, (size_t)WS_END); grid = -1; return; }
        int dev = 0, cus = 0, per_cu = 0;
        if (hipGetDevice(&dev) != hipSuccess || hipDeviceGetAttribute(&cus, hipDeviceAttributeMultiprocessorCount, dev) != hipSuccess) { fprintf(stderr, "kernel_launch: device query failed\n"); grid = -1; return; }
        if (hipFuncSetAttribute((const void*)mk_fwd, hipFuncAttributeMaxDynamicSharedMemorySize, LDS_BYTES) != hipSuccess) { fprintf(stderr, "kernel_launch: hipFuncSetAttribute failed\n"); grid = -1; return; }
        if (hipOccupancyMaxActiveBlocksPerMultiprocessor(&per_cu, (const void*)mk_fwd, NWAVES * 64, LDS_BYTES) != hipSuccess || per_cu < 1) {
            fprintf(stderr, "kernel_launch: occupancy query reports %d blocks per CU\n", per_cu); (void)hipGetLastError(); per_cu = 1; }
        grid = cus;
        fprintf(stderr, "kernel_launch: grid %d (cus %d, occupancy %d/CU)\n", grid, cus, per_cu);
    }
    if (grid < 0) return;
    if (hipMemsetAsync((char*)d_ws + WS_CTL, 0, CTL_ZERO_BYTES, stream) != hipSuccess) { fprintf(stderr, "kernel_launch: memset failed\n"); return; }
    KP a{};
    for (int i = 0; i < 26; ++i) a.in[i] = (const float*)d_in[i];
    a.out = (float*)d_out; a.ws = (unsigned char*)d_ws;
#if MK_ONE_LAUNCH
    a.ph_lo = 0; a.ph_hi = N_PHASES;
    hipLaunchKernelGGL(mk_fwd, dim3(grid), dim3(NWAVES * 64), LDS_BYTES, stream, a);
#else
#ifndef PROBE_PHASE
#define PROBE_PHASE -1
#endif
    { const int phs[10] = {0, 1, 2, 4, 6, 7, 8, 9, 10, 11};
      for (int i = 0; i < 10; ++i) { if (phs[i] == 10 && FUSE_FINAL) continue; if (phs[i] == 11 && EXP == 0) continue; const int k = phs[i]; a.ph_lo = k; a.ph_hi = k + 1;
          for (int rep = 0; rep < (k == PROBE_PHASE ? 2 : 1); ++rep) hipLaunchKernelGGL(mk_fwd, dim3(grid), dim3(NWAVES * 64), LDS_BYTES, stream, a); } }
#endif
    const hipError_t le = hipPeekAtLastError();
    if (le != hipSuccess) fprintf(stderr, "kernel_launch: launch failed: %s\n", hipGetErrorName(le));
}
```
